# Optimizing an MI355X kernel written in HIP

```python
import math
import jax
import jax.numpy as jnp
from jax import lax
import numpy as np

D_MODEL = 1024
BATCH = 2
SEQ = 8192
DEPTH = 2

GRID_W = 64
CTX_LEN = 256
EPS = 1e-6

HEAD_DIM = 128
ATT_HEADS = 8
ATT_KV_HEADS = 2
GQA_REP = ATT_HEADS // ATT_KV_HEADS
ATT_WIDTH = ATT_HEADS * HEAD_DIM
KV_WIDTH = ATT_KV_HEADS * HEAD_DIM
ATT_SCALE = HEAD_DIM ** -0.5
ROPE_THETA = 10000.0
Q_BLOCK = 128
WINDOW = 128

SSD_HEADS = 16
SSD_HEAD_DIM = 64
SSD_WIDTH = SSD_HEADS * SSD_HEAD_DIM
SSD_GROUPS = 2
SSD_STATE = 64
SSD_CHUNK = 128
SSD_CONV_CH = SSD_WIDTH + 2 * SSD_GROUPS * SSD_STATE

LRU_WIDTH = 1024
LRU_BLOCKS = 16
LRU_BLOCK_DIM = LRU_WIDTH // LRU_BLOCKS
LRU_C = 8.0

CONV_W = 5

MIX_WIDTH = SSD_WIDTH + ATT_WIDTH
AB_SPLITS = (SSD_WIDTH,
             SSD_WIDTH + SSD_CONV_CH,
             SSD_WIDTH + SSD_CONV_CH + 2 * SSD_HEADS,
             SSD_WIDTH + SSD_CONV_CH + 2 * SSD_HEADS + ATT_WIDTH,
             SSD_WIDTH + SSD_CONV_CH + 2 * SSD_HEADS + ATT_WIDTH + KV_WIDTH)
AB_IN = AB_SPLITS[-1] + KV_WIDTH
CD_SPLITS = (LRU_WIDTH, 2 * LRU_WIDTH, 2 * LRU_WIDTH + ATT_WIDTH, 2 * LRU_WIDTH + ATT_WIDTH + KV_WIDTH)
CD_IN = CD_SPLITS[-1] + KV_WIDTH

MOE_GROUPS = 4
EXPERTS_PER_GROUP = 4
N_EXPERTS = MOE_GROUPS * EXPERTS_PER_GROUP
TOP_K = 2
D_EXPERT = 256

N_EVEN = (DEPTH + 1) // 2
N_ODD = DEPTH // 2

kernel_name = 'hybrid_ssd_gqa_rglru_swa_hmoe_dit'

F32 = jnp.float32


def rmsnorm(x, g):
    xf = x.astype(F32)
    y = xf * lax.rsqrt(jnp.mean(xf * xf, axis=-1, keepdims=True) + EPS)
    return (y * g.astype(F32)).astype(x.dtype)


def dwconv_centred(x, w, b):
    pad = CONV_W // 2
    y = lax.conv_general_dilated(x, w[:, None, :].astype(x.dtype), window_strides=(1,),
                                 padding=[(pad, pad)], dimension_numbers=('NWC', 'WIO', 'NWC'),
                                 feature_group_count=x.shape[-1])
    return y + b


def axial_rope(L):
    rows = L // GRID_W
    row = jnp.repeat(jnp.arange(rows), GRID_W).astype(F32)
    col = jnp.tile(jnp.arange(GRID_W), rows).astype(F32)
    n_freq = HEAD_DIM // 4
    inv = ROPE_THETA ** (-jnp.arange(n_freq, dtype=F32) / n_freq)
    ang = jnp.concatenate([row[:, None] * inv, col[:, None] * inv], axis=-1)
    return jnp.cos(ang), jnp.sin(ang)


def apply_rope(t, cos, sin):
    t1, t2 = jnp.split(t, 2, axis=-1)
    c = cos[None, :, None, :].astype(t.dtype)
    s = sin[None, :, None, :].astype(t.dtype)
    return jnp.concatenate([t1 * c - t2 * s, t1 * s + t2 * c], axis=-1)


def attend_full(q, k, v, sink=None):
    Bsz, Lq = q.shape[:2]
    qg = q.reshape(Bsz, Lq, ATT_KV_HEADS, GQA_REP, HEAD_DIM)
    s = jnp.einsum('bqgrd,bkgd->bgrqk', qg, k, preferred_element_type=F32) * ATT_SCALE
    if sink is not None:
        col = sink.astype(F32).reshape(ATT_KV_HEADS, GQA_REP)[None, :, :, None, None]
        s = jnp.concatenate([s, jnp.broadcast_to(col, s.shape[:-1] + (1,))], axis=-1)
    p = jax.nn.softmax(s, axis=-1)
    if sink is not None:
        p = p[..., :-1]
    o = jnp.einsum('bgrqk,bkgd->bqgrd', p.astype(v.dtype), v)
    return o.reshape(Bsz, Lq, ATT_WIDTH)


def attend_blocked(q, k, v, kc, vc):
    Bsz, L = q.shape[:2]
    nb = L // Q_BLOCK
    keys = jnp.concatenate([kc, k], axis=1)
    vals = jnp.concatenate([vc, v], axis=1)
    qb = jnp.moveaxis(q.reshape(Bsz, nb, Q_BLOCK, ATT_HEADS, HEAD_DIM), 1, 0)
    o = lax.map(lambda qi: attend_full(qi, keys, vals), qb)
    return jnp.moveaxis(o, 0, 1).reshape(Bsz, L, ATT_WIDTH)


def attend_window_sink(q, k, v, kc, vc, sink):
    Bsz, L = q.shape[:2]
    nb = L // Q_BLOCK
    Q = Q_BLOCK
    qb = q.reshape(Bsz, nb, Q, ATT_KV_HEADS, GQA_REP, HEAD_DIM)

    def band(t):
        tp = jnp.pad(t, ((0, 0), (Q, Q), (0, 0), (0, 0))).reshape(Bsz, nb + 2, Q, ATT_KV_HEADS, HEAD_DIM)
        return jnp.concatenate([tp[:, :-2], tp[:, 1:-1], tp[:, 2:]], axis=2)

    kb, vb = band(k), band(v)
    qpos = jnp.arange(L).reshape(nb, Q)
    kpos = (jnp.arange(nb)[:, None] - 1) * Q + jnp.arange(3 * Q)[None, :]
    valid = ((jnp.abs(qpos[:, :, None] - kpos[:, None, :]) <= WINDOW)
             & (kpos >= 0)[:, None, :] & (kpos < L)[:, None, :])
    s_loc = jnp.einsum('bnqgrd,bnkgd->bngrqk', qb, kb, preferred_element_type=F32) * ATT_SCALE
    s_loc = jnp.where(valid[None, :, None, None], s_loc, -jnp.inf)
    s_ctx = jnp.einsum('bnqgrd,bkgd->bngrqk', qb, kc, preferred_element_type=F32) * ATT_SCALE
    col = sink.astype(F32).reshape(ATT_KV_HEADS, GQA_REP)[None, None, :, :, None, None]
    s_sink = jnp.broadcast_to(col, s_loc.shape[:-1] + (1,))
    p = jax.nn.softmax(jnp.concatenate([s_loc, s_ctx, s_sink], axis=-1), axis=-1).astype(v.dtype)
    n_ctx = kc.shape[1]
    o = (jnp.einsum('bngrqk,bnkgd->bnqgrd', p[..., :3 * Q], vb)
         + jnp.einsum('bngrqk,bkgd->bnqgrd', p[..., 3 * Q:3 * Q + n_ctx], vc))
    return o.reshape(Bsz, L, ATT_WIDTH)


def ssd_scan(xs, dt, a_neg, bm, cm, h0):
    Bsz, L, H, P = xs.shape
    G, N = bm.shape[2], bm.shape[3]
    R = H // G
    Q = SSD_CHUNK
    nc = L // Q
    x = xs.astype(F32).reshape(Bsz, nc, Q, G, R, P)
    dt = dt.astype(F32).reshape(Bsz, nc, Q, G, R)
    bc = bm.astype(F32).reshape(Bsz, nc, Q, G, N)
    cc = cm.astype(F32).reshape(Bsz, nc, Q, G, N)
    acs = jnp.cumsum(dt * a_neg.reshape(G, R), axis=2)
    tri = jnp.tril(jnp.ones((Q, Q), dtype=bool))
    seg = acs[:, :, :, None] - acs[:, :, None, :]
    decay = jnp.exp(jnp.where(tri[:, :, None, None], seg, -jnp.inf))
    cb = jnp.einsum('bcign,bcjgn->bcijg', cc, bc)
    w = cb[..., None] * decay * dt[:, :, None]
    y_diag = jnp.einsum('bcijgr,bcjgrp->bcigrp', w, x)
    to_end = jnp.exp(acs[:, :, -1:] - acs) * dt
    states = jnp.einsum('bcjgn,bcjgr,bcjgrp->bcgrpn', bc, to_end, x)
    chunk_decay = jnp.exp(acs[:, :, -1])

    def step(h, inp):
        s_c, d_c = inp
        return d_c[..., None, None] * h + s_c, h

    h_last, h_prev = lax.scan(step, h0.astype(F32).reshape(Bsz, G, R, P, N),
                              (jnp.moveaxis(states, 1, 0), jnp.moveaxis(chunk_decay, 1, 0)))
    h_prev = jnp.moveaxis(h_prev, 0, 1)
    y_off = jnp.einsum('bcign,bcgrpn,bcigr->bcigrp', cc, h_prev, jnp.exp(acs))
    y = (y_diag + y_off).reshape(Bsz, L, H, P)
    return y, h_last.reshape(Bsz, H, P, N)


def flip_seq(t):
    return jnp.flip(t, axis=1)


def bidir_ssd(xs, dt, bm, cm, a_neg, h0f, h0b):
    yf, hf = ssd_scan(xs, dt[:, :, 0], a_neg[0], bm, cm, h0f)
    yb, hb = ssd_scan(flip_seq(xs), flip_seq(dt[:, :, 1]), a_neg[1], flip_seq(bm), flip_seq(cm), h0b)
    return yf + flip_seq(yb), hf, hb


def linear_scan(a, b, h0):
    def combine(left, right):
        return left[0] * right[0], right[0] * left[1] + right[1]
    a_cum, b_cum = lax.associative_scan(combine, (a, b), axis=1)
    h = a_cum * h0[:, None] + b_cum
    return h, h[:, -1]


def ssd_attn_mixer(hl, hc, cos, sin, w_in, conv_w, conv_b, dt_bias, a_log, d_skip, norm_g, q_g, k_g, ctx_out):
    a_neg = -jnp.exp(a_log.astype(F32))

    def project(h, rope):
        Bsz, L, _ = h.shape
        z, xbc, dt, q, k, v = jnp.split(h @ w_in, AB_SPLITS, axis=-1)
        xbc = jax.nn.silu(dwconv_centred(xbc, conv_w, conv_b))
        xs, bm, cm = jnp.split(xbc, [SSD_WIDTH, SSD_WIDTH + SSD_GROUPS * SSD_STATE], axis=-1)
        xs = xs.reshape(Bsz, L, SSD_HEADS, SSD_HEAD_DIM)
        bm = bm.reshape(Bsz, L, SSD_GROUPS, SSD_STATE)
        cm = cm.reshape(Bsz, L, SSD_GROUPS, SSD_STATE)
        dt = jax.nn.softplus(dt.reshape(Bsz, L, 2, SSD_HEADS).astype(F32) + dt_bias.astype(F32))
        q = rmsnorm(q.reshape(Bsz, L, ATT_HEADS, HEAD_DIM), q_g)
        k = rmsnorm(k.reshape(Bsz, L, ATT_KV_HEADS, HEAD_DIM), k_g)
        v = v.reshape(Bsz, L, ATT_KV_HEADS, HEAD_DIM)
        if rope:
            q, k = apply_rope(q, cos, sin), apply_rope(k, cos, sin)
        return z, xs, bm, cm, dt, q, k, v

    def ssd_out(y, xs, z):
        Bsz, L = xs.shape[:2]
        y = (y + d_skip.astype(F32)[:, None] * xs.astype(F32)).reshape(Bsz, L, SSD_WIDTH).astype(z.dtype)
        return rmsnorm(y * jax.nn.silu(z), norm_g)

    zc, xsc, bc, cc, dtc, qc, kc, vc = project(hc, False)
    zl, xsl, bl, cl, dtl, ql, kl, vl = project(hl, True)
    h0 = jnp.zeros((hl.shape[0], SSD_HEADS, SSD_HEAD_DIM, SSD_STATE), F32)
    yc_s, hf, hb = bidir_ssd(xsc, dtc, bc, cc, a_neg, h0, h0)
    yl_s, _, _ = bidir_ssd(xsl, dtl, bl, cl, a_neg, hf, hb)
    y_lat = jnp.concatenate([ssd_out(yl_s, xsl, zl), attend_blocked(ql, kl, vl, kc, vc)], axis=-1)
    y_ctx = None
    if ctx_out:
        y_ctx = jnp.concatenate([ssd_out(yc_s, xsc, zc), attend_full(qc, kc, vc)], axis=-1)
    return y_lat, y_ctx


def lru_swa_mixer(hl, hc, cos, sin, w_in, conv_w, conv_b, w_a, b_a, w_x, b_x, lam, sink, ctx_out):
    log_base = -LRU_C * jax.nn.softplus(-lam.astype(F32))

    def project(h, rope):
        Bsz, L, _ = h.shape
        gate, xr, q, k, v = jnp.split(h @ w_in, CD_SPLITS, axis=-1)
        xr = dwconv_centred(xr, conv_w, conv_b)
        q = q.reshape(Bsz, L, ATT_HEADS, HEAD_DIM)
        k = k.reshape(Bsz, L, ATT_KV_HEADS, HEAD_DIM)
        v = v.reshape(Bsz, L, ATT_KV_HEADS, HEAD_DIM)
        if rope:
            q, k = apply_rope(q, cos, sin), apply_rope(k, cos, sin)
        return gate, xr, q, k, v

    def bidir_lru(xr, h0f, h0b):
        Bsz, L, _ = xr.shape
        xf = xr.astype(F32)
        xb = xf.reshape(Bsz, L, LRU_BLOCKS, LRU_BLOCK_DIM)
        r = jax.nn.sigmoid(jnp.einsum('blhi,dhij->dblhj', xb, w_a.astype(F32)).reshape(2, Bsz, L, LRU_WIDTH)
                           + b_a.astype(F32)[:, None, None])
        ig = jax.nn.sigmoid(jnp.einsum('blhi,dhij->dblhj', xb, w_x.astype(F32)).reshape(2, Bsz, L, LRU_WIDTH)
                            + b_x.astype(F32)[:, None, None])
        log_a = r * log_base[:, None, None]
        a = jnp.exp(log_a)
        b = jnp.sqrt(-jnp.expm1(2.0 * log_a)) * (ig * xf)
        hf, lf = linear_scan(a[0], b[0], h0f)
        hb, lb = linear_scan(flip_seq(a[1]), flip_seq(b[1]), h0b)
        return hf + flip_seq(hb), lf, lb

    gc, xrc, qc, kc, vc = project(hc, False)
    gl, xrl, ql, kl, vl = project(hl, True)
    h0 = jnp.zeros((hl.shape[0], LRU_WIDTH), F32)
    yc_r, hf, hb = bidir_lru(xrc, h0, h0)
    yl_r, _, _ = bidir_lru(xrl, hf, hb)
    y_lat = jnp.concatenate([jax.nn.gelu(gl) * yl_r.astype(gl.dtype),
                             attend_window_sink(ql, kl, vl, kc, vc, sink)], axis=-1)
    y_ctx = None
    if ctx_out:
        y_ctx = jnp.concatenate([jax.nn.gelu(gc) * yc_r.astype(gc.dtype),
                                 attend_full(qc, kc, vc, sink)], axis=-1)
    return y_lat, y_ctx


def hier_moe(h, w_grp, b_grp, w_rt, b_rt, w1, w3, w2):
    Bsz, T, _ = h.shape
    gl = jnp.einsum('btd,dg->btg', h, w_grp, preferred_element_type=F32) + b_grp.astype(F32)
    pg = jax.nn.softmax(gl, axis=-1)
    g_idx = jnp.argmax(gl, axis=-1)
    p_grp = jnp.take_along_axis(pg, g_idx[..., None], axis=-1)
    el = (jnp.einsum('btd,de->bte', h, w_rt, preferred_element_type=F32) + b_rt.astype(F32))
    el = el.reshape(Bsz, T, MOE_GROUPS, EXPERTS_PER_GROUP)
    el_g = jnp.take_along_axis(el, g_idx[..., None, None], axis=2)[:, :, 0]
    top_v, top_i = lax.top_k(el_g, TOP_K)
    w_top = jax.nn.softmax(top_v, axis=-1) * p_grp
    eid = g_idx[..., None] * EXPERTS_PER_GROUP + top_i
    gates = jnp.sum(jax.nn.one_hot(eid, N_EXPERTS, dtype=F32) * w_top[..., None], axis=2)
    a = jnp.einsum('btd,edf->btef', h, w1)
    u = jnp.einsum('btd,edf->btef', h, w3)
    hid = jax.nn.silu(a) * u * gates[..., None].astype(h.dtype)
    return jnp.einsum('btef,efd->btd', hid, w2)


def setup_inputs(seed: int = 0) -> dict:
    key = jax.random.key(seed)
    ks = list(jax.random.split(key, 40))
    cnt = [0]

    def nk():
        cnt[0] += 1
        return ks[cnt[0] - 1]

    def nrm(shape, scale):
        return scale * jax.random.normal(nk(), shape, F32)

    def gain(shape):
        return 1.0 + nrm(shape, 0.02)

    D = D_MODEL
    dt0 = jnp.exp(jax.random.uniform(nk(), (N_EVEN, 2, SSD_HEADS), F32, math.log(1e-3), math.log(1e-1)))
    ssd_dt_bias = dt0 + jnp.log(-jnp.expm1(-dt0))
    ssd_a_log = jnp.log(jax.random.uniform(nk(), (N_EVEN, 2, SSD_HEADS), F32, 1.0, 16.0))
    a0 = jax.random.uniform(nk(), (N_ODD, 2, LRU_WIDTH), F32, 0.9, 0.999)
    sg = a0 ** (1.0 / LRU_C)
    lru_lam = jnp.log(sg) - jnp.log1p(-sg)
    return {
        'x': nrm((BATCH, SEQ, D), 1.0),
        'c': nrm((BATCH, D), 1.0),
        'ctx': nrm((BATCH, CTX_LEN, D), 1.0),
        'c_ctx': nrm((D,), 1.0),
        'w_mod': nrm((DEPTH, D, 6 * D), 0.5 * D ** -0.5),
        'b_mod': nrm((DEPTH, 6 * D), 0.01),
        'g_mix': gain((DEPTH, D)),
        'g_ffn': gain((DEPTH, D)),
        'moe_w_grp': nrm((DEPTH, D, MOE_GROUPS), D ** -0.5),
        'moe_b_grp': nrm((DEPTH, MOE_GROUPS), 0.01),
        'moe_w_rt': nrm((DEPTH, D, N_EXPERTS), D ** -0.5),
        'moe_b_rt': nrm((DEPTH, N_EXPERTS), 0.01),
        'moe_w1': nrm((DEPTH, N_EXPERTS, D, D_EXPERT), D ** -0.5),
        'moe_w3': nrm((DEPTH, N_EXPERTS, D, D_EXPERT), D ** -0.5),
        'moe_w2': nrm((DEPTH, N_EXPERTS, D_EXPERT, D), D_EXPERT ** -0.5),
        'ab_w_in': nrm((N_EVEN, D, AB_IN), D ** -0.5),
        'ab_w_out': nrm((N_EVEN, MIX_WIDTH, D), MIX_WIDTH ** -0.5),
        'ssd_conv_w': nrm((N_EVEN, CONV_W, SSD_CONV_CH), CONV_W ** -0.5),
        'ssd_conv_b': nrm((N_EVEN, SSD_CONV_CH), 0.01),
        'ssd_dt_bias': ssd_dt_bias,
        'ssd_a_log': ssd_a_log,
        'ssd_d': gain((N_EVEN, SSD_HEADS)),
        'ssd_norm_g': gain((N_EVEN, SSD_WIDTH)),
        'att_q_g': gain((N_EVEN, HEAD_DIM)),
        'att_k_g': gain((N_EVEN, HEAD_DIM)),
        'cd_w_in': nrm((N_ODD, D, CD_IN), D ** -0.5),
        'cd_w_out': nrm((N_ODD, MIX_WIDTH, D), MIX_WIDTH ** -0.5),
        'lru_conv_w': nrm((N_ODD, CONV_W, LRU_WIDTH), CONV_W ** -0.5),
        'lru_conv_b': nrm((N_ODD, LRU_WIDTH), 0.01),
        'lru_w_a': nrm((N_ODD, 2, LRU_BLOCKS, LRU_BLOCK_DIM, LRU_BLOCK_DIM), LRU_BLOCK_DIM ** -0.5),
        'lru_b_a': nrm((N_ODD, 2, LRU_WIDTH), 0.01),
        'lru_w_x': nrm((N_ODD, 2, LRU_BLOCKS, LRU_BLOCK_DIM, LRU_BLOCK_DIM), LRU_BLOCK_DIM ** -0.5),
        'lru_b_x': nrm((N_ODD, 2, LRU_WIDTH), 0.01),
        'lru_lam': lru_lam,
        'swa_sink': nrm((N_ODD, ATT_HEADS), 0.5),
        'g_final': gain((D,)),
    }


def reference(x, c, ctx, c_ctx, w_mod, b_mod, g_mix, g_ffn, moe_w_grp, moe_b_grp, moe_w_rt, moe_b_rt,
              moe_w1, moe_w3, moe_w2, ab_w_in, ab_w_out, ssd_conv_w, ssd_conv_b, ssd_dt_bias, ssd_a_log,
              ssd_d, ssd_norm_g, att_q_g, att_k_g, cd_w_in, cd_w_out, lru_conv_w, lru_conv_b, lru_w_a,
              lru_b_a, lru_w_x, lru_b_x, lru_lam, swa_sink, g_final):
    L = x.shape[1]
    cos, sin = axial_rope(L)
    c_act = jax.nn.silu(c)[:, None, :]
    cc_act = jax.nn.silu(c_ctx)[None, None, :]
    xc = ctx
    for i in range(DEPTH):
        last = i == DEPTH - 1
        j = i // 2
        sh1, sc1, g1, sh2, sc2, g2 = jnp.split(c_act @ w_mod[i] + b_mod[i], 6, axis=-1)
        ch1, cs1, cg1, ch2, cs2, cg2 = jnp.split(cc_act @ w_mod[i] + b_mod[i], 6, axis=-1)
        hl = rmsnorm(x, g_mix[i]) * (1.0 + sc1) + sh1
        hc = rmsnorm(xc, g_mix[i]) * (1.0 + cs1) + ch1
        if i % 2 == 0:
            yl, yc = ssd_attn_mixer(hl, hc, cos, sin, ab_w_in[j], ssd_conv_w[j], ssd_conv_b[j], ssd_dt_bias[j],
                                    ssd_a_log[j], ssd_d[j], ssd_norm_g[j], att_q_g[j], att_k_g[j], not last)
            w_out = ab_w_out[j]
        else:
            yl, yc = lru_swa_mixer(hl, hc, cos, sin, cd_w_in[j], lru_conv_w[j], lru_conv_b[j], lru_w_a[j],
                                   lru_b_a[j], lru_w_x[j], lru_b_x[j], lru_lam[j], swa_sink[j], not last)
            w_out = cd_w_out[j]
        moe = (moe_w_grp[i], moe_b_grp[i], moe_w_rt[i], moe_b_rt[i], moe_w1[i], moe_w3[i], moe_w2[i])
        x = x + g1 * (yl @ w_out)
        x = x + g2 * hier_moe(rmsnorm(x, g_ffn[i]) * (1.0 + sc2) + sh2, *moe)
        if not last:
            xc = xc + cg1 * (yc @ w_out)
            xc = xc + cg2 * hier_moe(rmsnorm(xc, g_ffn[i]) * (1.0 + cs2) + ch2, *moe)
    return rmsnorm(x, g_final)
```

```cpp
#include <hip/hip_runtime.h>
#include <hip/hip_cooperative_groups.h>
#include <cstdio>
#include <cstdint>
namespace cg = cooperative_groups;

#ifndef MK_PER_PHASE
#define MK_PER_PHASE 1
#endif

#ifndef EN_MASK
#define EN_MASK 0xFFFF
#endif
#define EN(k) (((EN_MASK) >> (k)) & 1)
#define LAS __attribute__((address_space(3)))
typedef unsigned short bf16;
typedef short bf16x8 __attribute__((ext_vector_type(8)));
typedef short s16x4 __attribute__((ext_vector_type(4)));
typedef float f32x4 __attribute__((ext_vector_type(4)));
typedef float f32x2 __attribute__((ext_vector_type(2)));
typedef float f32x16 __attribute__((ext_vector_type(16)));
typedef unsigned u32x4 __attribute__((ext_vector_type(4)));
typedef unsigned u32x2 __attribute__((ext_vector_type(2)));

constexpr int DM = 1024, NBATCH = 2, SEQL = 8192, CTXL = 256;
constexpr int BROWS = CTXL + SEQL;
constexpr int NROWS = NBATCH * BROWS;
constexpr float EPS = 1e-6f;
constexpr int NWAVES = 8, NTHREADS = 512;
constexpr int LDS_BYTES = 147456;
constexpr int N_PHASES = 22;

constexpr size_t MiB = 1u << 20;
constexpr size_t WS_CTL = 0, CTL_ZERO_BYTES = 64 * 1024;
constexpr size_t WS_MOD = 1 * MiB;
constexpr size_t WS_REC = 1 * MiB + 256 * 1024;
constexpr size_t WS_TOK = 2 * MiB;
constexpr size_t WS_GAB = 2 * MiB + 128 * 1024;
constexpr size_t WS_MT  = 2 * MiB + 512 * 1024;
constexpr size_t WS_XC  = 3 * MiB;
constexpr size_t WS_W   = 5 * MiB;
constexpr size_t WS_WIN = WS_W, WS_WOUT = WS_W + 8 * MiB, WS_W13 = WS_W + 12 * MiB, WS_W2 = WS_W + 28 * MiB;
constexpr size_t WS_A   = 41 * MiB;
constexpr size_t WS_Z   = 83 * MiB;
constexpr size_t WS_RAW = 116 * MiB;
constexpr size_t WS_DTR = 158 * MiB;
constexpr size_t WS_DT  = 160 * MiB;
constexpr size_t WS_K   = 163 * MiB;
constexpr size_t WS_V   = 172 * MiB;
constexpr size_t WS_YMIX = 181 * MiB;
constexpr size_t WS_END = 247 * MiB;
constexpr int MAXTILES = 90, MAXSLOT = MAXTILES * 256;
constexpr int CW_Q0 = 64, CW_Q1 = 128, CW_CNT = 256;

__device__ __forceinline__ float bf2f(unsigned short b) { return __uint_as_float(((unsigned)b) << 16); }
__device__ __forceinline__ unsigned f2bf(float f) { unsigned u = __float_as_uint(f); return (u + 0x7fffu + ((u >> 16) & 1u)) >> 16; }
__device__ __forceinline__ unsigned pk2(float lo, float hi) { return f2bf(lo) | (f2bf(hi) << 16); }
__device__ __forceinline__ float wave_sum(float v) {
#pragma unroll
    for (int o = 1; o < 64; o <<= 1) v += __shfl_xor(v, o);
    return v;
}
__device__ __forceinline__ float silu_f(float x) { return x / (1.f + __expf(-x)); }
__device__ __forceinline__ float sigmoid_f(float x) { return 1.f / (1.f + __expf(-x)); }
__device__ __forceinline__ float softplus_f(float x) { return fmaxf(x, 0.f) + log1pf(__expf(-fabsf(x))); }
__device__ __forceinline__ float gelu_tanh_f(float x) { const float u = 0.7978845608028654f * (x + 0.044715f * x * x * x); return 0.5f * x * (1.f + tanhf(u)); }
__device__ __forceinline__ void unpack8(const u32x4 w, float* f) {
    f[0] = __uint_as_float(w.x << 16); f[1] = __uint_as_float(w.x & 0xffff0000u);
    f[2] = __uint_as_float(w.y << 16); f[3] = __uint_as_float(w.y & 0xffff0000u);
    f[4] = __uint_as_float(w.z << 16); f[5] = __uint_as_float(w.z & 0xffff0000u);
    f[6] = __uint_as_float(w.w << 16); f[7] = __uint_as_float(w.w & 0xffff0000u);
}

namespace pg8 {
constexpr int BM = 256, BK = 64, HALF = 128, HTB = HALF * BK * 2, STAGE_BYTES = 8 * HTB, NXCD = 8, WGM = 8;
__host__ __device__ __forceinline__ int lds_byte(int r, int c) { const int st = (r >> 4) * 2 + (c >> 5), rr = r & 15, cc = c & 31, ob = rr * 64 + cc * 2; return st * 1024 + (ob ^ (((ob >> 9) & 1) << 5)); }
__host__ __device__ __forceinline__ void stage_rc(int b, int& R, int& C) { const int st = b / 1024, sb = b % 1024, swz = sb ^ (((sb >> 9) & 1) << 5); R = (st >> 1) * 16 + swz / 64; C = (st & 1) * 32 + (swz % 64) / 2; }
__host__ __device__ __forceinline__ int perm32(int rho) { const int n = rho >> 4, i = rho & 15; return 8 * (i >> 2) + 4 * n + (i & 3); }

struct Unit { int pm, pn; const char* a; const char* b; long bd; };
struct Gemm { int lda, ldb, K, ksplit; };

__device__ __forceinline__ unsigned cvt_pk_bf16(float lo, float hi) { unsigned r; asm volatile("v_cvt_pk_bf16_f32 %0, %1, %2" : "=v"(r) : "v"(lo), "v"(hi)); return r; }

template <class Epi, class Sched>
__device__ __forceinline__ void gemm_phase(LAS unsigned char* lds, const Gemm g, const Sched& S, const Epi& E) {
    int tid_ = threadIdx.x; asm volatile("" : "+v"(tid_));
    const int tid = tid_, wid = __builtin_amdgcn_readfirstlane(tid >> 6), lane = tid & 63, wr = wid >> 2, wc = wid & 3, fr = lane & 15, fq = lane >> 4;
    const int nt = g.K / BK;
    unsigned voffA[2], voffB[2];
#pragma unroll
    for (int i = 0; i < 2; ++i) { int R, C; stage_rc(tid * 16 + i * 8192, R, C); const int Rb = Epi::PERM ? ((R & ~31) + perm32(R & 31)) : R;
        voffA[i] = (unsigned)(R * g.lda + C) * 2u; voffB[i] = (unsigned)(Rb * g.ldb + C) * 2u; }
    const size_t kstep = (size_t)(BK * 2);
    const size_t hstepA = (size_t)HALF * g.lda * 2, hstepB = (size_t)HALF * g.ldb * 2;
    const unsigned ldsw = (unsigned)wid * 1024u;
    const int aoff = lds_byte(wr * 64 + fr, fq * 8), boff = lds_byte(wc * 32 + fr, fq * 8);
#define PG8_SA(b, h) (((b) * 2 + (h)) * HTB)
#define PG8_SB(b, h) ((4 + (b) * 2 + (h)) * HTB)
#define PG8_STAGE(bufoff, gbase, voff) do { _Pragma("unroll") for (int _i = 0; _i < 2; ++_i) \
        __builtin_amdgcn_global_load_lds((const unsigned*)((const char*)(gbase) + (voff)[_i]), (LAS unsigned*)(lds + (bufoff) + ldsw + _i * 8192), 16, 0, 0); } while (0)
#define PG8_LDA(dst, b, h) do { _Pragma("unroll") for (int m = 0; m < 4; ++m) _Pragma("unroll") for (int k = 0; k < 2; ++k) dst[m][k] = *(const LAS bf16x8*)(lds + PG8_SA(b, h) + aoff + m * 2048 + k * 1024); } while (0)
#define PG8_LDB(dst, b, h) do { _Pragma("unroll") for (int n = 0; n < 2; ++n) _Pragma("unroll") for (int k = 0; k < 2; ++k) dst[n][k] = *(const LAS bf16x8*)(lds + PG8_SB(b, h) + boff + n * 2048 + k * 1024); } while (0)
#define PG8_MMA(ai, bj, At, Bt) do { __builtin_amdgcn_s_setprio(1); _Pragma("unroll") for (int m = 0; m < 4; ++m) _Pragma("unroll") for (int n = 0; n < 2; ++n) _Pragma("unroll") for (int k = 0; k < 2; ++k) \
        acc[ai][bj][m][n] = __builtin_amdgcn_mfma_f32_16x16x32_bf16(Bt[n][k], At[m][k], acc[ai][bj][m][n], 0, 0, 0); __builtin_amdgcn_s_setprio(0); } while (0)
#define PG8_WAIT_V(n) asm volatile("s_waitcnt vmcnt(" #n ")" ::: "memory")
#define PG8_WAIT_L(n) asm volatile("s_waitcnt lgkmcnt(" #n ")" ::: "memory")
#define PG8_BAR __builtin_amdgcn_s_barrier()
#define PG8_SCHED __builtin_amdgcn_sched_barrier(0)
    Unit cur, nxt; int ui = 0;
    if (!S.next(0, cur)) return;
    f32x4 acc[2][2][4][2];
#pragma unroll
    for (int a = 0; a < 2; ++a)
#pragma unroll
        for (int b = 0; b < 2; ++b)
#pragma unroll
            for (int m = 0; m < 4; ++m)
#pragma unroll
                for (int n = 0; n < 2; ++n) acc[a][b][m][n] = (f32x4){0.f, 0.f, 0.f, 0.f};
    bf16x8 At[4][2], B0[2][2], B1[2][2];
    const char* cA = cur.a; const char* cB = cur.b; long cBd = cur.bd;
    PG8_STAGE(PG8_SB(0, 0), cB, voffB); PG8_STAGE(PG8_SA(0, 0), cA, voffA); PG8_STAGE(PG8_SB(0, 1), cB + hstepB, voffB); PG8_STAGE(PG8_SA(0, 1), cA + hstepA, voffA);
    if (wr == 1) PG8_BAR;
    PG8_WAIT_V(4); PG8_BAR;
    PG8_STAGE(PG8_SB(1, 0), cB + kstep, voffB); PG8_STAGE(PG8_SA(1, 0), cA + kstep, voffA); PG8_STAGE(PG8_SB(1, 1), cB + hstepB + kstep, voffB);
    PG8_WAIT_V(6); PG8_BAR;
    for (;;) {
        const bool has_next = S.next(ui + 1, nxt);
        const char* nA = has_next ? nxt.a : cA; const char* nB = has_next ? nxt.b : cB;
#pragma unroll 1
        for (int t = 0; t < nt; t += 2) {
            const bool last = (t == nt - 2);
            const char* a1 = cA + (size_t)(t + 1) * kstep;
            const char* a2 = last ? nA : cA + (size_t)(t + 2) * kstep;
            const char* b2 = last ? nB : cB + (size_t)(t + 2) * kstep + ((t + 2) >= g.ksplit ? cBd : 0);
            const char* a3 = a2 + kstep; const char* b3 = b2 + kstep;
            PG8_LDB(B0, 0, 0); PG8_SCHED; PG8_LDA(At, 0, 0); PG8_STAGE(PG8_SA(1, 1), a1 + hstepA, voffA);
            PG8_WAIT_L(8); PG8_BAR; PG8_WAIT_L(0); PG8_MMA(0, 0, At, B0); PG8_BAR; PG8_SCHED;
            PG8_LDB(B1, 0, 1); PG8_STAGE(PG8_SB(0, 0), b2, voffB);
            PG8_BAR; PG8_WAIT_L(0); PG8_MMA(0, 1, At, B1); PG8_BAR;
            PG8_LDA(At, 0, 1); PG8_STAGE(PG8_SA(0, 0), a2, voffA);
            PG8_BAR; PG8_WAIT_L(0); PG8_MMA(1, 0, At, B0); PG8_BAR; PG8_SCHED;
            PG8_STAGE(PG8_SB(0, 1), b2 + hstepB, voffB);
            PG8_WAIT_V(6); PG8_BAR; PG8_MMA(1, 1, At, B1); PG8_BAR;
            PG8_LDB(B0, 1, 0); PG8_SCHED; PG8_LDA(At, 1, 0); PG8_STAGE(PG8_SA(0, 1), a2 + hstepA, voffA);
            PG8_WAIT_L(8); PG8_BAR; PG8_WAIT_L(0); PG8_MMA(0, 0, At, B0); PG8_BAR; PG8_SCHED;
            PG8_LDB(B1, 1, 1); PG8_STAGE(PG8_SB(1, 0), b3, voffB);
            PG8_BAR; PG8_WAIT_L(0); PG8_MMA(0, 1, At, B1); PG8_BAR;
            PG8_LDA(At, 1, 1); PG8_STAGE(PG8_SA(1, 0), a3, voffA);
            PG8_BAR; PG8_WAIT_L(0); PG8_MMA(1, 0, At, B0); PG8_BAR; PG8_SCHED;
            PG8_STAGE(PG8_SB(1, 1), b3 + hstepB, voffB);
            PG8_WAIT_V(6); PG8_BAR; PG8_MMA(1, 1, At, B1); PG8_BAR;
        }
        E(acc, cur, wr, wc, fr, fq);
        if (!has_next) break;
#pragma unroll
        for (int a = 0; a < 2; ++a)
#pragma unroll
            for (int b = 0; b < 2; ++b)
#pragma unroll
                for (int m = 0; m < 4; ++m)
#pragma unroll
                    for (int n = 0; n < 2; ++n) acc[a][b][m][n] = (f32x4){0.f, 0.f, 0.f, 0.f};
        cur = nxt; cA = nA; cB = nB; cBd = cur.bd; ++ui;
    }
    PG8_WAIT_V(0);
    if (wr == 0) PG8_BAR;
    PG8_BAR;
#undef PG8_SA
#undef PG8_SB
#undef PG8_STAGE
#undef PG8_LDA
#undef PG8_LDB
#undef PG8_MMA
#undef PG8_WAIT_V
#undef PG8_WAIT_L
#undef PG8_BAR
#undef PG8_SCHED
}
}

namespace att {
constexpr int D = 128, NW = 8, QBLK = 32, KVBLK = 64;
constexpr float SCALE = 0.088388347648318440f;
constexpr float THR = 8.f;
constexpr int LDQ = 2048, LDK = 256, LDO = 2048;
constexpr size_t SHM_V = KVBLK * D * 2, SHM_K = KVBLK * D * 2, SHM_ATTN = 2 * SHM_V + 2 * SHM_K + NW * 64 * 4;
#define KSWZ(row, colB) ((row) * 256 + ((colB) ^ (((row) & 7) << 4)))
#define SBAR() __builtin_amdgcn_sched_barrier(0)
__device__ __forceinline__ int crow(int r, int hi) { return (r & 3) + 8 * (r >> 2) + 4 * hi; }
__device__ __forceinline__ unsigned cvtpk(float lo, float hi) { unsigned r; asm volatile("v_cvt_pk_bf16_f32 %0, %1, %2" : "=v"(r) : "v"(lo), "v"(hi)); return r; }

__device__ __forceinline__ void partialSM(f32x16& p0, f32x16& p1, float& m_reg, float& mn, float& alpha) {
  constexpr float C = SCALE * 1.4426950408889634f;
  float pmax = p0[0]; for (int r = 1; r < 16; ++r) pmax = fmaxf(pmax, p0[r]); for (int r = 0; r < 16; ++r) pmax = fmaxf(pmax, p1[r]);
  { auto rr = __builtin_amdgcn_permlane32_swap(__float_as_uint(pmax), __float_as_uint(pmax), false, false);
    pmax = fmaxf(__uint_as_float(rr[0]), __uint_as_float(rr[1])); }
  if (__builtin_expect(__all(pmax - m_reg <= THR / SCALE), 1)) { mn = m_reg; alpha = 1.f; }
  else { mn = fmaxf(m_reg, pmax); alpha = __builtin_amdgcn_exp2f((m_reg - mn) * C); m_reg = mn; }
  float mnC = -mn * C;
  for (int r = 0; r < 16; ++r) p0[r] = fmaf(p0[r], C, mnC); for (int r = 0; r < 16; ++r) p1[r] = fmaf(p1[r], C, mnC);
  for (int r = 0; r < 16; ++r) p0[r] = __builtin_amdgcn_exp2f(p0[r]);
}
__device__ __forceinline__ void finishSM(f32x16& p0, f32x16& p1, float alpha, float& l_reg, bf16x8& pa0, bf16x8& pa1, bf16x8& pa2, bf16x8& pa3) {
  for (int r = 0; r < 16; ++r) p1[r] = __builtin_amdgcn_exp2f(p1[r]);
  float ps = 0; for (int r = 0; r < 16; ++r) ps += p0[r]; for (int r = 0; r < 16; ++r) ps += p1[r];
  { auto rr = __builtin_amdgcn_permlane32_swap(__float_as_uint(ps), __float_as_uint(ps), false, false);
    ps = __uint_as_float(rr[0]) + __uint_as_float(rr[1]); }
  l_reg = l_reg * alpha + ps;
#define PK4(P, BASE, OUT) do { unsigned a0 = cvtpk(P[BASE + 0], P[BASE + 1]), a1 = cvtpk(P[BASE + 2], P[BASE + 3]);   \
    unsigned b0 = cvtpk(P[BASE + 4], P[BASE + 5]), b1 = cvtpk(P[BASE + 6], P[BASE + 7]);                              \
    auto r0 = __builtin_amdgcn_permlane32_swap(a0, b0, false, false); auto r1 = __builtin_amdgcn_permlane32_swap(a1, b1, false, false); \
    u32x4 w = {r0[0], r1[0], r0[1], r1[1]}; OUT = *reinterpret_cast<bf16x8*>(&w); } while (0)
  PK4(p0, 0, pa0); PK4(p0, 8, pa1); PK4(p1, 0, pa2); PK4(p1, 8, pa3);
#undef PK4
}
__device__ __forceinline__ void qkt(f32x16& p0, f32x16& p1, const bf16* Ks, const bf16x8* qr, int r32, int hi) {
  asm volatile("" : "+v"(r32), "+v"(hi));
  p0 = f32x16{}; p1 = f32x16{};
  for (int d0 = 0; d0 < 8; ++d0) { int cb = (d0 * 16 + hi * 8) * 2;
    bf16x8 b0 = *reinterpret_cast<const bf16x8*>((const char*)Ks + KSWZ(r32, cb));
    bf16x8 b1 = *reinterpret_cast<const bf16x8*>((const char*)Ks + KSWZ(32 + r32, cb));
    p0 = __builtin_amdgcn_mfma_f32_32x32x16_bf16(b0, qr[d0], p0, 0, 0, 0);
    p1 = __builtin_amdgcn_mfma_f32_32x32x16_bf16(b1, qr[d0], p1, 0, 0, 0); }
}
__device__ __forceinline__ int v_st(int k, int c) { const int kk = (k & ~0xC) | ((k & 4) << 1) | ((k & 8) >> 1); return ((kk >> 3) * 4 + (c >> 5)) * 512 + ((kk & 7) * 32 + (c & 31)) * 2; }
__device__ __forceinline__ int v_rd_base(int lane) { return ((lane & 3) << 3) | (((lane >> 2) & 3) << 6) | (((lane >> 4) & 1) << 5) | (((lane >> 5) & 1) << 8); }
constexpr int v_rd_off(int d0, int ks, int half) { return d0 * 512 + ks * 4096 + half * 2048; }
template <int OFF> __device__ __forceinline__ s16x4 tr_read(int vb) {
  s16x4 r; asm volatile("ds_read_b64_tr_b16 %0, %1 offset:%2" : "=&v"(r) : "v"(vb), "i"(OFF) : "memory"); return r;
}
template <int D0> __device__ __forceinline__ void pv_one(f32x16& od, int vb, bf16x8 pa0, bf16x8 pa1, bf16x8 pa2, bf16x8 pa3) {
  const s16x4 l0 = tr_read<v_rd_off(D0, 0, 0)>(vb), h0 = tr_read<v_rd_off(D0, 0, 1)>(vb), l1 = tr_read<v_rd_off(D0, 1, 0)>(vb), h1 = tr_read<v_rd_off(D0, 1, 1)>(vb);
  const s16x4 l2 = tr_read<v_rd_off(D0, 2, 0)>(vb), h2 = tr_read<v_rd_off(D0, 2, 1)>(vb), l3 = tr_read<v_rd_off(D0, 3, 0)>(vb), h3 = tr_read<v_rd_off(D0, 3, 1)>(vb);
  asm volatile("s_waitcnt lgkmcnt(0)" ::: "memory"); SBAR();
#define PK(L, H) (bf16x8){L[0], L[1], L[2], L[3], H[0], H[1], H[2], H[3]}
  od = __builtin_amdgcn_mfma_f32_32x32x16_bf16(pa0, PK(l0, h0), od, 0, 0, 0);
  od = __builtin_amdgcn_mfma_f32_32x32x16_bf16(pa1, PK(l1, h1), od, 0, 0, 0);
  od = __builtin_amdgcn_mfma_f32_32x32x16_bf16(pa2, PK(l2, h2), od, 0, 0, 0);
  od = __builtin_amdgcn_mfma_f32_32x32x16_bf16(pa3, PK(l3, h3), od, 0, 0, 0);
#undef PK
}
__device__ __forceinline__ void pv_d0(f32x16* o, int vb, bf16x8 pa0, bf16x8 pa1, bf16x8 pa2, bf16x8 pa3) {
  pv_one<0>(o[0], vb, pa0, pa1, pa2, pa3); pv_one<1>(o[1], vb, pa0, pa1, pa2, pa3); pv_one<2>(o[2], vb, pa0, pa1, pa2, pa3); pv_one<3>(o[3], vb, pa0, pa1, pa2, pa3);
}
__device__ __forceinline__ void band_mask(f32x16& p0, f32x16& p1, int dbase, int hi) {
#pragma unroll
  for (int r = 0; r < 16; ++r) { const int d = dbase + crow(r, hi);
    if (d < -128 || d > 128) p0[r] = -1e30f;
    if (d + 32 < -128 || d + 32 > 128) p1[r] = -1e30f; }
}
template <int MODE>
__device__ __forceinline__ void attn_body(const bf16* Qb, const bf16* Kh, const bf16* Vh, bf16* Ob, int NT, int kb0, int q0, float sink, char* lds) {
  int tid_ = threadIdx.x; asm volatile("" : "+v"(tid_));
  const int tid = tid_, wid = tid >> 6, lane = tid & 63, r32 = lane & 31, hi = lane >> 5;
  bf16* V_lds = (bf16*)lds; bf16* K_lds = (bf16*)(lds + 2 * SHM_V);
  float* ws = (float*)(lds + 2 * SHM_V + 2 * SHM_K) + wid * 64; float* li_l = ws; float* al_l = ws + 32;
  float m_reg = -1e30f, l_reg = 0; f32x16 o[4] = {}; bf16x8 qr[8];
  const bf16* Qw = Qb + (long)(wid * QBLK + r32) * LDQ + hi * 8;
#pragma unroll
  for (int d0 = 0; d0 < 8; ++d0) qr[d0] = *reinterpret_cast<const bf16x8*>(Qw + d0 * 16);
  const int sr = tid >> 4, sc = (tid & 15) * 8, vst0 = v_st(sr, sc), vst1 = v_st(32 + sr, sc);
  const int vb0 = (int)(uintptr_t)V_lds + v_rd_base(lane);
  struct { bf16x8 vs0, vs1, ks0, ks1; } sr_[1];
#define TK0(j) ((MODE == 0 || (j) < 4) ? (j) * KVBLK : kb0 + ((j) - 4) * KVBLK)
#define SLOAD(i, k0) do { sr_[i].vs0 = *reinterpret_cast<const bf16x8*>(&Vh[(long)((k0) + sr) * LDK + sc]); sr_[i].vs1 = *reinterpret_cast<const bf16x8*>(&Vh[(long)((k0) + 32 + sr) * LDK + sc]); \
    sr_[i].ks0 = *reinterpret_cast<const bf16x8*>(&Kh[(long)((k0) + sr) * LDK + sc]); sr_[i].ks1 = *reinterpret_cast<const bf16x8*>(&Kh[(long)((k0) + 32 + sr) * LDK + sc]); } while (0)
#define SWRITE(b, i) do { *(bf16x8*)((char*)V_lds + (b) * SHM_V + vst0) = sr_[i].vs0;          \
    *(bf16x8*)((char*)V_lds + (b) * SHM_V + vst1) = sr_[i].vs1; int kc = sc * 2;               \
    *(bf16x8*)((char*)K_lds + (b) * SHM_K + KSWZ(sr, kc)) = sr_[i].ks0;                       \
    *(bf16x8*)((char*)K_lds + (b) * SHM_K + KSWZ(32 + sr, kc)) = sr_[i].ks1; } while (0)
#define SWAIT() asm volatile("s_waitcnt vmcnt(0)" ::: "memory")
#define RESC(a) do { if (__any((a) < 1.f)) { if (hi == 0) al_l[r32] = (a); asm volatile("s_waitcnt lgkmcnt(0)" ::: "memory"); \
    for (int d = 0; d < 4; ++d) for (int r = 0; r < 16; ++r) o[d][r] *= al_l[crow(r, hi)]; } } while (0)
#define MASKT(P0, P1, j) do { if (MODE == 1 && (j) >= 4) { const int s0_ = kb0 - 256 + ((j) - 4) * KVBLK, tw_ = q0 + wid * QBLK; \
    if (!(s0_ - (tw_ + 31) >= -128 && (s0_ + 63) - tw_ <= 128)) band_mask(P0, P1, s0_ - tw_ - r32, hi); } } while (0)
  f32x16 pA0, pA1, pB0, pB1; float mnA, mnB, alA, alB; bf16x8 pa0, pa1, pa2, pa3;
  constexpr int SE = 0, SO = 0;
  SLOAD(SE, TK0(0)); asm volatile("s_waitcnt vmcnt(0)" ::: "memory"); SWRITE(0, SE); __syncthreads();
  qkt(pA0, pA1, K_lds, qr, r32, hi); partialSM(pA0, pA1, m_reg, mnA, alA);
  SLOAD(SO, TK0(1));
  SWAIT(); SWRITE(1, SO); __syncthreads();
  for (int j = 1; j + 1 < NT; j += 2) {
    SBAR(); qkt(pB0, pB1, (bf16*)((char*)K_lds + SHM_K), qr, r32, hi);
    finishSM(pA0, pA1, alA, l_reg, pa0, pa1, pa2, pa3); SBAR();
    SLOAD(SO, TK0(j + 1)); SBAR();
    pv_d0(o, vb0, pa0, pa1, pa2, pa3); MASKT(pB0, pB1, j); partialSM(pB0, pB1, m_reg, mnB, alB);
    __syncthreads(); SWAIT(); SWRITE(0, SE);
    RESC(alB); __syncthreads();
    SBAR(); qkt(pA0, pA1, K_lds, qr, r32, hi);
    finishSM(pB0, pB1, alB, l_reg, pa0, pa1, pa2, pa3); SBAR();
    SLOAD(SE, TK0(j + 2)); SBAR();
    pv_d0(o, vb0 + (int)SHM_V, pa0, pa1, pa2, pa3); MASKT(pA0, pA1, j + 1); partialSM(pA0, pA1, m_reg, mnA, alA);
    __syncthreads(); SWAIT(); SWRITE(1, SO);
    RESC(alA); __syncthreads();
  }
  SBAR(); qkt(pB0, pB1, (bf16*)((char*)K_lds + SHM_K), qr, r32, hi);
  finishSM(pA0, pA1, alA, l_reg, pa0, pa1, pa2, pa3); SBAR();
  pv_d0(o, vb0, pa0, pa1, pa2, pa3); MASKT(pB0, pB1, NT - 1); partialSM(pB0, pB1, m_reg, mnB, alB);
  __syncthreads(); RESC(alB);
  finishSM(pB0, pB1, alB, l_reg, pa0, pa1, pa2, pa3); SBAR();
  pv_d0(o, vb0 + (int)SHM_V, pa0, pa1, pa2, pa3);
  if (MODE == 1) { constexpr float C = SCALE * 1.4426950408889634f; l_reg += __builtin_amdgcn_exp2f(sink * 1.4426950408889634f - m_reg * C); }
  if (hi == 0) li_l[r32] = l_reg; asm volatile("s_waitcnt lgkmcnt(0)" ::: "memory");
  float rli[16];
#pragma unroll
  for (int r = 0; r < 16; ++r) rli[r] = __builtin_amdgcn_rcpf(li_l[crow(r, hi)]);
  bf16* Ow = Ob + (long)(wid * QBLK) * LDO;
#pragma unroll
  for (int r = 0; r < 16; ++r) { int orow = crow(r, hi);
    for (int d0 = 0; d0 < 4; ++d0) Ow[(long)orow * LDO + d0 * 32 + r32] = (bf16)f2bf(o[d0][r] * rli[r]); }
  asm volatile("s_waitcnt vmcnt(0) lgkmcnt(0)" ::: "memory");
  __syncthreads();
#undef TK0
#undef SLOAD
#undef SWRITE
#undef SWAIT
#undef RESC
#undef MASKT
}
#undef KSWZ
#undef SBAR
}

struct Args { const float* in[36]; float* out; unsigned char* ws; int ph_lo, ph_hi; };
enum { I_X = 0, I_C, I_CTX, I_CCTX, I_WMOD, I_BMOD, I_GMIX, I_GFFN, I_WGRP, I_BGRP, I_WRT, I_BRT, I_W1, I_W3, I_W2, I_ABIN, I_ABOUT, I_SCONVW, I_SCONVB,
       I_DTBIAS, I_ALOG, I_SSDD, I_SNORMG, I_QG, I_KG, I_CDIN, I_CDOUT, I_LCONVW, I_LCONVB, I_LWA, I_LBA, I_LWX, I_LBX, I_LAM, I_SINK, I_GFINAL };

struct Ctx {
    const float* const* in; float* out; unsigned char* ws;
    int bid, G;
    __device__ __forceinline__ unsigned* ctl() const { return (unsigned*)(ws + WS_CTL); }
    __device__ __forceinline__ float* mod(int layer, int mv) const { return (float*)(ws + WS_MOD) + (size_t)(layer * 3 + mv) * 6144; }
    __device__ __forceinline__ float* xc() const { return (float*)(ws + WS_XC); }
    __device__ __forceinline__ float* xrow(int r) const { const int b = r / BROWS, q = r - b * BROWS; return q < CTXL ? xc() + (size_t)(b * CTXL + q) * DM : out + (size_t)(b * SEQL + (q - CTXL)) * DM; }
    __device__ __forceinline__ const float* xin_row(int r) const { const int b = r / BROWS, q = r - b * BROWS; return q < CTXL ? in[I_CTX] + (size_t)(b * CTXL + q) * DM : in[I_X] + (size_t)(b * SEQL + (q - CTXL)) * DM; }
};
struct TC { int tid, lane, wave; };
__device__ __forceinline__ TC phase_tc() { TC t; int x = threadIdx.x; asm volatile("" : "+v"(x)); t.tid = x; t.lane = x & 63; t.wave = __builtin_amdgcn_readfirstlane(x >> 6); return t; }
__device__ __forceinline__ int row_mv(int r) { const int b = r / BROWS, q = r - b * BROWS; return q < CTXL ? 2 : b; }

struct RowSched {
    int nM, nN, nwg, G, c, skipctx; const char* A; const char* Bt; size_t a_tile, b_tile;
    __device__ __forceinline__ bool next(int i, pg8::Unit& u) const {
        const long L = (long)i * G + c; if (L >= nwg) return false;
        int wgid = (int)L; { const int q = nwg / 8, r = nwg % 8, xcd = wgid % 8, off = wgid / 8; wgid = (xcd < r ? xcd * (q + 1) : r * (q + 1) + (xcd - r) * q) + off; }
        const int nig = 8 * nN, gid = wgid / nig, fm = gid * 8, gsz = (nM - fm) < 8 ? (nM - fm) : 8;
        const int pmi = fm + ((wgid % nig) % gsz); u.pn = (wgid % nig) / gsz;
        u.pm = skipctx ? (pmi / 32) * 33 + 1 + (pmi % 32) : pmi;
        u.a = A + (size_t)u.pm * a_tile; u.b = Bt + (size_t)u.pn * b_tile; u.bd = 0; return true;
    }
};
struct MoeSched {
    const int* mt; int G, c, which; const char* A; const char* W; size_t a_tile;
    __device__ __forceinline__ bool next(int i, pg8::Unit& u) const {
        const int ntl = mt[0]; const long L = (long)i * G + c; if (L >= (long)ntl * 4) return false;
        const int tile = (int)(L >> 2), pn = (int)(L & 3), cls = mt[1 + tile], g = cls / 6, pi = cls - g * 6;
        const int ia = pi < 3 ? 0 : (pi < 5 ? 1 : 2), ib = pi < 3 ? pi + 1 : (pi < 5 ? pi - 1 : 3);
        const int ea = g * 4 + ia, eb = g * 4 + ib;
        u.pm = tile; u.pn = pn; u.a = A + (size_t)tile * a_tile;
        if (which == 1) { const int e = (pn >> 1) ? eb : ea; u.b = W + ((size_t)e * 512 + (pn & 1) * 256) * 1024 * 2; u.bd = 0; }
        else { u.b = W + ((size_t)ea * 1024 + pn * 256) * 256 * 2; u.bd = (long)(eb - ea) * 1024 * 256 * 2 - 4 * 128; }
        return true;
    }
};

struct EpiProj {
    static constexpr bool PERM = true;
    bf16 *d0, *d1, *d2, *d3, *d4, *d5; int e0, e1, e2, e3, e4; int l0, l1, l2, l3, l4, l5; int lastcols;
    __device__ __forceinline__ void operator()(const f32x4 (&acc)[2][2][4][2], const pg8::Unit& u, int wr, int wc, int fr, int fq) const {
        const int pn = u.pn; bf16* base; int ld, tl, ncol = 256;
        if (pn < e0) { base = d0; ld = l0; tl = pn; } else if (pn < e1) { base = d1; ld = l1; tl = pn - e0; } else if (pn < e2) { base = d2; ld = l2; tl = pn - e1; }
        else if (pn < e3) { base = d3; ld = l3; tl = pn - e2; } else if (pn < e4) { base = d4; ld = l4; tl = pn - e3; } else { base = d5; ld = l5; tl = pn - e4; ncol = lastcols; }
        const int row0 = u.pm * 256 + wr * 64 + fr, col0 = wc * 32 + 8 * fq;
#pragma unroll
        for (int ai = 0; ai < 2; ++ai)
#pragma unroll
            for (int m = 0; m < 4; ++m) { bf16* rowp = base + (size_t)(row0 + ai * 128 + m * 16) * ld + tl * 256 + col0;
#pragma unroll
                for (int bj = 0; bj < 2; ++bj) { if (col0 + bj * 128 < ncol) { const f32x4 v0 = acc[ai][bj][m][0], v1 = acc[ai][bj][m][1];
                    u32x4 w; w.x = pg8::cvt_pk_bf16(v0[0], v0[1]); w.y = pg8::cvt_pk_bf16(v0[2], v0[3]); w.z = pg8::cvt_pk_bf16(v1[0], v1[1]); w.w = pg8::cvt_pk_bf16(v1[2], v1[3]);
                    *(u32x4*)(rowp + bj * 128) = w; } } }
    }
};
struct EpiRes {
    static constexpr bool PERM = false;
    const float* xin_lat; const float* xin_ctx; float* xout_lat; float* xout_ctx; const float* modbase;
    __device__ __forceinline__ void operator()(const f32x4 (&acc)[2][2][4][2], const pg8::Unit& u, int wr, int wc, int fr, int fq) const {
        const int b = u.pm / 33, qt = u.pm - b * 33; const bool isctx = (qt == 0);
        const size_t rbase = isctx ? (size_t)b * CTXL : (size_t)b * SEQL + (size_t)(qt - 1) * 256;
        const float* xi = (isctx ? xin_ctx : xin_lat) + rbase * DM; float* xo = (isctx ? xout_ctx : xout_lat) + rbase * DM;
        const float* gate = modbase + (size_t)(isctx ? 2 : b) * 6144 + 2 * 1024;
        const int row0 = wr * 64 + fr, col0 = u.pn * 256 + wc * 32 + 4 * fq;
        f32x4 gv[2][2];
#pragma unroll
        for (int bj = 0; bj < 2; ++bj)
#pragma unroll
            for (int n = 0; n < 2; ++n) gv[bj][n] = *(const f32x4*)(gate + col0 + bj * 128 + n * 16);
#pragma unroll
        for (int ai = 0; ai < 2; ++ai)
#pragma unroll
            for (int m = 0; m < 4; ++m) { const size_t off = (size_t)(row0 + ai * 128 + m * 16) * DM + col0;
#pragma unroll
                for (int bj = 0; bj < 2; ++bj)
#pragma unroll
                    for (int n = 0; n < 2; ++n) { const f32x4 xv = *(const f32x4*)(xi + off + bj * 128 + n * 16);
                        *(f32x4*)(xo + off + bj * 128 + n * 16) = xv + gv[bj][n] * acc[ai][bj][m][n]; } }
    }
};
struct EpiMoe1 {
    static constexpr bool PERM = true;
    bf16* H; const float* gab;
    __device__ __forceinline__ void operator()(const f32x4 (&acc)[2][2][4][2], const pg8::Unit& u, int wr, int wc, int fr, int fq) const {
        const int row0 = u.pm * 256 + wr * 64 + fr, colh = (u.pn >> 1) * 256 + (u.pn & 1) * 128 + wc * 32 + 8 * fq, which = u.pn >> 1;
#pragma unroll
        for (int ai = 0; ai < 2; ++ai)
#pragma unroll
            for (int m = 0; m < 4; ++m) { const int slot = row0 + ai * 128 + m * 16; const float gt = gab[(size_t)slot * 2 + which];
                float hv[8];
#pragma unroll
                for (int n = 0; n < 2; ++n)
#pragma unroll
                    for (int e = 0; e < 4; ++e) { const float a = acc[ai][0][m][n][e], uu = acc[ai][1][m][n][e]; hv[n * 4 + e] = silu_f(a) * uu * gt; }
                u32x4 w; w.x = pg8::cvt_pk_bf16(hv[0], hv[1]); w.y = pg8::cvt_pk_bf16(hv[2], hv[3]); w.z = pg8::cvt_pk_bf16(hv[4], hv[5]); w.w = pg8::cvt_pk_bf16(hv[6], hv[7]);
                *(u32x4*)(H + (size_t)slot * 512 + colh) = w; }
    }
};
struct EpiMoe2 {
    static constexpr bool PERM = false;
    const int* tok; float* out; float* xc; const float* modbase;
    __device__ __forceinline__ void operator()(const f32x4 (&acc)[2][2][4][2], const pg8::Unit& u, int wr, int wc, int fr, int fq) const {
        const int row0 = u.pm * 256 + wr * 64 + fr, col0 = u.pn * 256 + wc * 32 + 4 * fq;
#ifdef MOE2_DUMMY
        for (int ai = 0; ai < 2; ++ai) for (int m = 0; m < 4; ++m) for (int bj = 0; bj < 2; ++bj) for (int n = 0; n < 2; ++n) *(f32x4*)(out + (size_t)(row0 + ai * 128 + m * 16) * 1024 + col0 + bj * 128 + n * 16) = acc[ai][bj][m][n];
        return;
#endif
#pragma unroll
        for (int ai = 0; ai < 2; ++ai)
#pragma unroll
            for (int m = 0; m < 4; ++m) { const int slot = row0 + ai * 128 + m * 16; int r = tok[slot];
                asm volatile("" : "+v"(r) :: "memory");
                if (r >= 0) { const int b = r / BROWS, q = r - b * BROWS; const bool isctx = q < CTXL;
                    float* xp = isctx ? xc + (size_t)(b * CTXL + q) * DM : out + (size_t)(b * SEQL + (q - CTXL)) * DM;
                    const float* gate = modbase + (size_t)(isctx ? 2 : b) * 6144 + 5 * 1024;
#pragma unroll
                    for (int bj = 0; bj < 2; ++bj)
#pragma unroll
                        for (int n = 0; n < 2; ++n) { const int c = col0 + bj * 128 + n * 16; const f32x4 gv = *(const f32x4*)(gate + c); const f32x4 xv = *(const f32x4*)(xp + c);
                            *(f32x4*)(xp + c) = xv + gv * acc[ai][bj][m][n]; } }
                asm volatile("" ::: "memory"); }
    }
};

__device__ __forceinline__ void transpose_item(const float* W, int ldw, int k0, int n0src, bf16* WT, int ldt, int drow0, int dk0, LAS float* scr, int lane) {
#pragma unroll 8
    for (int i = 0; i < 32; ++i) { const int kk = 2 * i + (lane >> 5); scr[kk * 33 + (lane & 31)] = n0src >= 0 ? W[(size_t)(k0 + kk) * ldw + n0src + (lane & 31)] : 0.f; }
    asm volatile("s_waitcnt lgkmcnt(0)" ::: "memory");
    const int c = lane & 7;
#pragma unroll
    for (int j = 0; j < 4; ++j) { const int n = (lane >> 3) + 8 * j; const LAS float* s = scr + (8 * c) * 33 + n;
        u32x4 o; o.x = pk2(s[0 * 33], s[1 * 33]); o.y = pk2(s[2 * 33], s[3 * 33]); o.z = pk2(s[4 * 33], s[5 * 33]); o.w = pk2(s[6 * 33], s[7 * 33]);
        *(u32x4*)(WT + (size_t)(drow0 + n) * ldt + dk0 + 8 * c) = o; }
    asm volatile("s_waitcnt lgkmcnt(0)" ::: "memory");
}
__device__ __forceinline__ int ab_src_col(int n) {
    if (n < 2304) return n;
    if (n < 3840) return n + 32;
    if (n < 3872) return n - 3840 + 2304;
    return -1;
}
__device__ __forceinline__ void ph_convert(const Ctx& C, int layer, LAS unsigned char* lds) {
    const TC T = phase_tc();
    LAS float* scr = (LAS float*)(lds + T.wave * 16384);
    const int gw = C.bid * NWAVES + T.wave, NGW = C.G * NWAVES;
    bf16* Win = (bf16*)(C.ws + WS_WIN); bf16* Wout = (bf16*)(C.ws + WS_WOUT); bf16* W13 = (bf16*)(C.ws + WS_W13); bf16* W2 = (bf16*)(C.ws + WS_W2);
    const int nin = layer == 0 ? 4096 : 3584;
    const int I_IN = 16 * (nin / 32), I_OUT = 32 * 32, I_E = 16 * 128;
    const int NIT = I_IN + I_OUT + 3 * I_E;
    const float* win = C.in[layer == 0 ? I_ABIN : I_CDIN]; const float* wout = C.in[layer == 0 ? I_ABOUT : I_CDOUT];
    const int ldin = layer == 0 ? 3872 : 3584;
    for (int it = gw; it < NIT; it += NGW) {
        int r = it;
        if (r < I_IN) { const int nblk = nin / 32, kb = r / nblk, nb = r % nblk; const int src = layer == 0 ? ab_src_col(nb * 32) : nb * 32;
            transpose_item(win, ldin, kb * 64, src, Win, 1024, nb * 32, kb * 64, scr, T.lane); continue; } r -= I_IN;
        if (r < I_OUT) { const int kb = r / 32, nb = r % 32; transpose_item(wout, 1024, kb * 64, nb * 32, Wout, 2048, nb * 32, kb * 64, scr, T.lane); continue; } r -= I_OUT;
        if (r < 2 * I_E) { const int w3 = r >= I_E; if (w3) r -= I_E; const int e = r / 128, q = r % 128, kb = q / 8, nb = q % 8;
            const float* W = C.in[w3 ? I_W3 : I_W1] + (size_t)(layer * 16 + e) * 1024 * 256; const int n0 = nb * 32;
            transpose_item(W, 256, kb * 64, n0, W13 + (size_t)e * 512 * 1024, 1024, (n0 / 128) * 256 + (w3 ? 128 : 0) + (n0 % 128), kb * 64, scr, T.lane); continue; } r -= 2 * I_E;
        { const int e = r / 128, q = r % 128, kb = q / 32, nb = q % 32;
            const float* W = C.in[I_W2] + (size_t)(layer * 16 + e) * 256 * 1024;
            transpose_item(W, 1024, kb * 64, nb * 32, W2 + (size_t)e * 1024 * 256, 256, nb * 32, kb * 64, scr, T.lane); }
    }
}
__device__ __forceinline__ void ph_mod(const Ctx& C, LAS unsigned char* lds) {
    const TC T = phase_tc();
    LAS float* red = (LAS float*)lds;
    for (int item = C.bid; item < 48; item += C.G) {
        const int layer = item / 24, chunk = item % 24;
        const float* W = C.in[I_WMOD] + (size_t)layer * 1024 * 6144 + chunk * 256 + T.lane * 4;
        f32x4 a0 = {0, 0, 0, 0}, a1 = a0, a2 = a0;
        const int d0 = T.wave * 128;
        for (int d = d0; d < d0 + 128; ++d) {
            const f32x4 w = *(const f32x4*)(W + (size_t)d * 6144);
            const float c0 = silu_f(C.in[I_C][d]), c1 = silu_f(C.in[I_C][1024 + d]), c2 = silu_f(C.in[I_CCTX][d]);
            a0 += w * c0; a1 += w * c1; a2 += w * c2;
        }
        __syncthreads();
#pragma unroll
        for (int e = 0; e < 4; ++e) { red[(T.wave * 3 + 0) * 256 + T.lane * 4 + e] = a0[e]; red[(T.wave * 3 + 1) * 256 + T.lane * 4 + e] = a1[e]; red[(T.wave * 3 + 2) * 256 + T.lane * 4 + e] = a2[e]; }
        __syncthreads();
        for (int o = T.tid; o < 768; o += NTHREADS) { const int v = o >> 8, j = o & 255; float s = 0.f;
#pragma unroll
            for (int w = 0; w < 8; ++w) s += red[(w * 3 + v) * 256 + j];
            C.mod(layer, v)[chunk * 256 + j] = s + C.in[I_BMOD][layer * 6144 + chunk * 256 + j]; }
        __syncthreads();
    }
}
__device__ __forceinline__ void ph_prenorm(const Ctx& C, int layer) {
    const TC T = phase_tc();
    bf16* HN = (bf16*)(C.ws + WS_A);
    const float* gm = C.in[I_GMIX] + layer * 1024;
    const int gw = C.bid * NWAVES + T.wave, NGW = C.G * NWAVES;
    for (int r = gw; r < NROWS; r += NGW) {
        const float* xr = layer == 0 ? C.xin_row(r) : C.xrow(r);
        const float* md = C.mod(layer, row_mv(r));
        f32x4 v[4]; float ss = 0.f;
#pragma unroll
        for (int j = 0; j < 4; ++j) { v[j] = *(const f32x4*)(xr + 256 * j + 4 * T.lane); ss += (v[j].x * v[j].x + v[j].y * v[j].y) + (v[j].z * v[j].z + v[j].w * v[j].w); }
        const float rs = rsqrtf(wave_sum(ss) * (1.f / DM) + EPS);
#pragma unroll
        for (int j = 0; j < 4; ++j) { const int c = 256 * j + 4 * T.lane; const f32x4 g = *(const f32x4*)(gm + c), sc = *(const f32x4*)(md + 1024 + c), sh = *(const f32x4*)(md + c);
            const f32x4 h = v[j] * rs * g * (sc + 1.f) + sh;
            u32x2 w; w.x = pk2(h.x, h.y); w.y = pk2(h.z, h.w); *(u32x2*)(HN + (size_t)r * DM + c) = w; }
    }
}
__device__ __forceinline__ bool nb_valid(int r, int dk) { const int b = r / BROWS, q = r - b * BROWS; if (q < CTXL) { const int t = q + dk; return t >= 0 && t < CTXL; } const int t = q - CTXL + dk; return t >= 0 && t < SEQL; }
__device__ __forceinline__ void rope_angle(int r, int lane, float& cs, float& sn, bool& latent) {
    const int b = r / BROWS, q = r - b * BROWS; latent = q >= CTXL; const int t = q - CTXL;
    const int pos = lane < 32 ? (t >> 6) : (t & 63); const int jf = lane & 31;
    const float inv = exp2f(-(float)jf * (13.287712379549449f / 32.f));
    const float ang = (float)pos * inv; sincosf(ang, &sn, &cs);
}
__device__ __forceinline__ void ph_elem0(const Ctx& C) {
    const TC T = phase_tc();
    const bf16* RAW = (const bf16*)(C.ws + WS_RAW); bf16* XBC = (bf16*)(C.ws + WS_A);
    const bf16* DTR = (const bf16*)(C.ws + WS_DTR); float* DT = (float*)(C.ws + WS_DT);
    bf16* Q = (bf16*)(C.ws + WS_YMIX) + 1024; bf16* K = (bf16*)(C.ws + WS_K);
    const float* cw = C.in[I_SCONVW]; const float* cb = C.in[I_SCONVB];
    const int gw = C.bid * NWAVES + T.wave, NGW = C.G * NWAVES, lane = T.lane;
    for (int r = gw; r < NROWS; r += NGW) {
        for (int ch = lane; ch < 160; ch += 64) { const int c0 = ch * 8; float acc[8];
#pragma unroll
            for (int e = 0; e < 8; ++e) acc[e] = cb[c0 + e];
#pragma unroll
            for (int k = 0; k < 5; ++k) { if (nb_valid(r, k - 2)) { const u32x4 w = *(const u32x4*)(RAW + (size_t)(r + k - 2) * 1280 + c0); float xv[8]; unpack8(w, xv);
#pragma unroll
                for (int e = 0; e < 8; ++e) acc[e] += xv[e] * cw[k * 1280 + c0 + e]; } }
            u32x4 o; o.x = pk2(silu_f(acc[0]), silu_f(acc[1])); o.y = pk2(silu_f(acc[2]), silu_f(acc[3])); o.z = pk2(silu_f(acc[4]), silu_f(acc[5])); o.w = pk2(silu_f(acc[6]), silu_f(acc[7]));
            *(u32x4*)(XBC + (size_t)r * 1280 + c0) = o; }
        if (lane < 32) DT[(size_t)r * 32 + lane] = softplus_f(bf2f(DTR[(size_t)r * 32 + lane]) + C.in[I_DTBIAS][lane]);
        float cs, sn; bool latent; rope_angle(r, lane, cs, sn, latent);
        const float qg0 = C.in[I_QG][lane], qg1 = C.in[I_QG][64 + lane], kg0 = C.in[I_KG][lane], kg1 = C.in[I_KG][64 + lane];
#pragma unroll
        for (int h = 0; h < 10; ++h) { bf16* p = h < 8 ? Q + (size_t)r * 2048 + h * 128 : K + (size_t)r * 256 + (h - 8) * 128;
            float t1 = bf2f(p[lane]), t2 = bf2f(p[64 + lane]);
            const float rs = rsqrtf(wave_sum(t1 * t1 + t2 * t2) * (1.f / 128.f) + EPS);
            t1 = t1 * rs * (h < 8 ? qg0 : kg0); t2 = t2 * rs * (h < 8 ? qg1 : kg1);
            if (latent) { const float o1 = t1 * cs - t2 * sn, o2 = t1 * sn + t2 * cs; t1 = o1; t2 = o2; }
            p[lane] = (bf16)f2bf(t1); p[64 + lane] = (bf16)f2bf(t2); }
    }
}
__device__ __forceinline__ void ph_elem1(const Ctx& C) {
    const TC T = phase_tc();
    const bf16* RAW = (const bf16*)(C.ws + WS_RAW); bf16* XR = (bf16*)(C.ws + WS_A);
    bf16* Q = (bf16*)(C.ws + WS_YMIX) + 1024; bf16* K = (bf16*)(C.ws + WS_K);
    const float* cw = C.in[I_LCONVW]; const float* cb = C.in[I_LCONVB];
    const int gw = C.bid * NWAVES + T.wave, NGW = C.G * NWAVES, lane = T.lane;
    for (int r = gw; r < NROWS; r += NGW) {
        for (int ch = lane; ch < 128; ch += 64) { const int c0 = ch * 8; float acc[8];
#pragma unroll
            for (int e = 0; e < 8; ++e) acc[e] = cb[c0 + e];
#pragma unroll
            for (int k = 0; k < 5; ++k) { if (nb_valid(r, k - 2)) { const u32x4 w = *(const u32x4*)(RAW + (size_t)(r + k - 2) * 1024 + c0); float xv[8]; unpack8(w, xv);
#pragma unroll
                for (int e = 0; e < 8; ++e) acc[e] += xv[e] * cw[k * 1024 + c0 + e]; } }
            u32x4 o; o.x = pk2(acc[0], acc[1]); o.y = pk2(acc[2], acc[3]); o.z = pk2(acc[4], acc[5]); o.w = pk2(acc[6], acc[7]);
            *(u32x4*)(XR + (size_t)r * 1024 + c0) = o; }
        float cs, sn; bool latent; rope_angle(r, lane, cs, sn, latent);
        if (latent) {
#pragma unroll
            for (int h = 0; h < 10; ++h) { bf16* p = h < 8 ? Q + (size_t)r * 2048 + h * 128 : K + (size_t)r * 256 + (h - 8) * 128;
                const float t1 = bf2f(p[lane]), t2 = bf2f(p[64 + lane]);
                p[lane] = (bf16)f2bf(t1 * cs - t2 * sn); p[64 + lane] = (bf16)f2bf(t1 * sn + t2 * cs); }
        }
    }
}
__device__ __forceinline__ int step_row(int dir, int s) { return dir == 0 ? s : (s < CTXL ? CTXL - 1 - s : BROWS + CTXL - 1 - s); }
__device__ __forceinline__ void ssd_seq_unit(const Ctx& C, int item, LAS unsigned char* lds) {
    const TC T = phase_tc();
    const int b = item >> 5, dir = (item >> 4) & 1, h = item & 15, g = h >> 3, lane = T.lane, wid = T.wave;
    LAS float* part = (LAS float*)lds;
    LAS float* xs = part + 8 * 32 * 64; LAS float* Bs = xs + 32 * 64; LAS float* Cs = Bs + 32 * 64; LAS float* dts = Cs + 32 * 64;
    const float aneg = -__expf(C.in[I_ALOG][dir * 16 + h]);
    const bf16* XBC = (const bf16*)(C.ws + WS_A) + (size_t)b * BROWS * 1280;
    const float* DT = (const float*)(C.ws + WS_DT) + (size_t)b * BROWS * 32 + dir * 16 + h;
    bf16* Y = dir == 0 ? (bf16*)(C.ws + WS_YMIX) + (size_t)b * BROWS * 2048 + h * 64 : (bf16*)(C.ws + WS_RAW) + (size_t)b * BROWS * 1024 + h * 64;
    const int ldy = dir == 0 ? 2048 : 1024;
    float hs[8];
#pragma unroll
    for (int k = 0; k < 8; ++k) hs[k] = 0.f;
    for (int s0 = 0; s0 < BROWS; s0 += 32) {
        for (int i = T.tid; i < 32 * 192; i += NTHREADS) { const int tt = i / 192, c = i - tt * 192; const int q = step_row(dir, s0 + tt);
            const bf16* row = XBC + (size_t)q * 1280;
            if (c < 64) xs[tt * 64 + c] = bf2f(row[h * 64 + c]); else if (c < 128) Bs[tt * 64 + c - 64] = bf2f(row[1024 + g * 64 + c - 64]); else Cs[tt * 64 + c - 128] = bf2f(row[1152 + g * 64 + c - 128]); }
        if (T.tid < 32) dts[T.tid] = DT[(size_t)step_row(dir, s0 + T.tid) * 32];
        __syncthreads();
        for (int tt = 0; tt < 32; ++tt) {
            const float x = xs[tt * 64 + lane], dt = dts[tt];
            const f32x4 b0 = *(const LAS f32x4*)(Bs + tt * 64 + wid * 8), b1 = *(const LAS f32x4*)(Bs + tt * 64 + wid * 8 + 4);
            const f32x4 c0 = *(const LAS f32x4*)(Cs + tt * 64 + wid * 8), c1 = *(const LAS f32x4*)(Cs + tt * 64 + wid * 8 + 4);
            const float a = __expf(dt * aneg), dx = dt * x; float y = 0.f;
#pragma unroll
            for (int k = 0; k < 4; ++k) { hs[k] = a * hs[k] + dx * b0[k]; y += c0[k] * hs[k]; }
#pragma unroll
            for (int k = 0; k < 4; ++k) { hs[4 + k] = a * hs[4 + k] + dx * b1[k]; y += c1[k] * hs[4 + k]; }
            part[(wid * 32 + tt) * 64 + lane] = y;
        }
        __syncthreads();
        for (int i = T.tid; i < 2048; i += NTHREADS) { const int tt = i >> 6, p = i & 63; float s = 0.f;
#pragma unroll
            for (int w = 0; w < 8; ++w) s += part[(w * 32 + tt) * 64 + p];
            const int q = step_row(dir, s0 + tt); Y[(size_t)q * ldy + p] = (bf16)f2bf(s); }
        __syncthreads();
    }
}
__device__ __forceinline__ void lru_seq_unit(const Ctx& C, int item, LAS unsigned char* lds) {
    const TC T = phase_tc();
    const int b = item >> 5, dir = (item >> 4) & 1, hb = item & 15, lane = T.lane, wid = T.wave;
    LAS float* wa = (LAS float*)lds; LAS float* wx = wa + 4096; LAS float* xs = wx + 4096; LAS float* as_ = xs + 512; LAS float* bs_ = as_ + 512;
    const float* gwa = C.in[I_LWA] + (size_t)(dir * 16 + hb) * 4096; const float* gwx = C.in[I_LWX] + (size_t)(dir * 16 + hb) * 4096;
    for (int i = T.tid; i < 4096; i += NTHREADS) { wa[i] = gwa[i]; wx[i] = gwx[i]; }
    const int c = hb * 64 + lane;
    const float ba = C.in[I_LBA][dir * 1024 + c], bx = C.in[I_LBX][dir * 1024 + c], logbase = -8.f * softplus_f(-C.in[I_LAM][dir * 1024 + c]);
    const bf16* XR = (const bf16*)(C.ws + WS_A) + (size_t)b * BROWS * 1024 + hb * 64;
    bf16* Y = dir == 0 ? (bf16*)(C.ws + WS_YMIX) + (size_t)b * BROWS * 2048 + hb * 64 : (bf16*)(C.ws + WS_RAW) + (size_t)b * BROWS * 1024 + hb * 64;
    const int ldy = dir == 0 ? 2048 : 1024;
    float hst = 0.f;
    __syncthreads();
    unsigned short xnext = XR[(size_t)step_row(dir, wid) * 1024 + lane];
    for (int it = 0; it < BROWS / 8; ++it) {
        const float xv = bf2f(xnext);
        if (it + 1 < BROWS / 8) xnext = XR[(size_t)step_row(dir, (it + 1) * 8 + wid) * 1024 + lane];
        xs[wid * 64 + lane] = xv;
        asm volatile("s_waitcnt lgkmcnt(0)" ::: "memory");
        float pa = ba, px = bx;
#pragma unroll 8
        for (int i = 0; i < 64; ++i) { const float xi = xs[wid * 64 + i]; pa += xi * wa[i * 64 + lane]; px += xi * wx[i * 64 + lane]; }
        const float la = logbase * sigmoid_f(pa), a = __expf(la), bc = sqrtf(-expm1f(2.f * la)) * sigmoid_f(px) * xv;
        as_[wid * 64 + lane] = a; bs_[wid * 64 + lane] = bc;
        __syncthreads();
        if (wid == 0) {
#pragma unroll
            for (int tt = 0; tt < 8; ++tt) { hst = as_[tt * 64 + lane] * hst + bs_[tt * 64 + lane]; const int q2 = step_row(dir, it * 8 + tt); Y[(size_t)q2 * ldy + lane] = (bf16)f2bf(hst); }
        }
        __syncthreads();
    }
}
__device__ __forceinline__ int queue_pop(const Ctx& C, unsigned* qword, LAS unsigned char* lds) {
    const TC T = phase_tc();
    LAS int* slot = (LAS int*)(lds + LDS_BYTES - 64);
    __syncthreads();
    if (T.tid == 0) slot[0] = (int)atomicAdd(qword, 1u);
    __syncthreads();
    const int v = slot[0];
    return __builtin_amdgcn_readfirstlane(v);
}
__device__ __forceinline__ void ph_mix0(const Ctx& C, LAS unsigned char* lds, char* ldsg) {
    bf16* YM = (bf16*)(C.ws + WS_YMIX); const bf16* K = (const bf16*)(C.ws + WS_K); const bf16* V = (const bf16*)(C.ws + WS_V);
    for (;;) {
        const int item = queue_pop(C, C.ctl() + CW_Q0, lds);
        if (item >= 64 + 512 + 16) break;
        if (item < 64) { ssd_seq_unit(C, item, lds); continue; }
        const int a = item - 64;
        if (a < 512) { const int hr = a & 3, qb = (a >> 2) & 31, kvh = (a >> 7) & 1, b = a >> 8, h = kvh * 4 + hr;
            bf16* Qb = YM + ((size_t)b * BROWS + CTXL + (size_t)qb * 256) * 2048 + 1024 + h * 128;
            att::attn_body<0>(Qb, K + (size_t)b * BROWS * 256 + kvh * 128, V + (size_t)b * BROWS * 256 + kvh * 128, Qb, BROWS / 64, 0, 0, 0.f, ldsg);
        } else { const int a2 = a - 512, b = a2 >> 3, h = a2 & 7, kvh = h >> 2;
            bf16* Qb = YM + ((size_t)b * BROWS) * 2048 + 1024 + h * 128;
            att::attn_body<0>(Qb, K + (size_t)b * BROWS * 256 + kvh * 128, V + (size_t)b * BROWS * 256 + kvh * 128, Qb, CTXL / 64, 0, 0, 0.f, ldsg);
        }
    }
}
__device__ __forceinline__ void ph_mix1(const Ctx& C, LAS unsigned char* lds, char* ldsg) {
    bf16* YM = (bf16*)(C.ws + WS_YMIX); const bf16* K = (const bf16*)(C.ws + WS_K); const bf16* V = (const bf16*)(C.ws + WS_V);
    for (;;) {
        const int item = queue_pop(C, C.ctl() + CW_Q1, lds);
        if (item >= 64 + 512) break;
        if (item < 64) { lru_seq_unit(C, item, lds); continue; }
        const int a = item - 64, hr = a & 3, qb = (a >> 2) & 31, kvh = (a >> 7) & 1, b = a >> 8, h = kvh * 4 + hr;
        const int q0 = qb * 256, lo = q0 - 128 < 0 ? 0 : q0 - 128, hi_ = q0 + 384 > SEQL ? SEQL : q0 + 384;
        bf16* Qb = YM + ((size_t)b * BROWS + CTXL + (size_t)q0) * 2048 + 1024 + h * 128;
        att::attn_body<1>(Qb, K + (size_t)b * BROWS * 256 + kvh * 128, V + (size_t)b * BROWS * 256 + kvh * 128, Qb, 4 + (hi_ - lo) / 64, CTXL + lo, q0, C.in[I_SINK][h], ldsg);
    }
}
__device__ __forceinline__ void ph_ssdpost(const Ctx& C) {
    const TC T = phase_tc();
    bf16* YM = (bf16*)(C.ws + WS_YMIX); const bf16* YB = (const bf16*)(C.ws + WS_RAW); const bf16* XBC = (const bf16*)(C.ws + WS_A); const bf16* Z = (const bf16*)(C.ws + WS_Z);
    const int gw = C.bid * NWAVES + T.wave, NGW = C.G * NWAVES, lane = T.lane;
    for (int r = gw; r < NROWS; r += NGW) {
        float v[16]; float ss = 0.f;
#pragma unroll
        for (int j = 0; j < 2; ++j) { const int c0 = j * 512 + lane * 8;
            const u32x4 wy = *(const u32x4*)(YM + (size_t)r * 2048 + c0), wb = *(const u32x4*)(YB + (size_t)r * 1024 + c0), wx = *(const u32x4*)(XBC + (size_t)r * 1280 + c0), wz = *(const u32x4*)(Z + (size_t)r * 1024 + c0);
            float fy[8], fb[8], fx[8], fz[8]; unpack8(wy, fy); unpack8(wb, fb); unpack8(wx, fx); unpack8(wz, fz);
            const float dsk = C.in[I_SSDD][c0 >> 6];
#pragma unroll
            for (int e = 0; e < 8; ++e) { const float y = (fy[e] + fb[e] + dsk * fx[e]) * silu_f(fz[e]); v[j * 8 + e] = y; ss += y * y; } }
        const float rs = rsqrtf(wave_sum(ss) * (1.f / 1024.f) + EPS);
#pragma unroll
        for (int j = 0; j < 2; ++j) { const int c0 = j * 512 + lane * 8; const float* ng = C.in[I_SNORMG] + c0;
            u32x4 o; o.x = pk2(v[j * 8 + 0] * rs * ng[0], v[j * 8 + 1] * rs * ng[1]); o.y = pk2(v[j * 8 + 2] * rs * ng[2], v[j * 8 + 3] * rs * ng[3]);
            o.z = pk2(v[j * 8 + 4] * rs * ng[4], v[j * 8 + 5] * rs * ng[5]); o.w = pk2(v[j * 8 + 6] * rs * ng[6], v[j * 8 + 7] * rs * ng[7]);
            *(u32x4*)(YM + (size_t)r * 2048 + c0) = o; }
    }
}
__device__ __forceinline__ void ph_lrupost(const Ctx& C) {
    const TC T = phase_tc();
    bf16* YM = (bf16*)(C.ws + WS_YMIX); const bf16* YB = (const bf16*)(C.ws + WS_RAW); const bf16* GT = (const bf16*)(C.ws + WS_Z);
    const int gw = C.bid * NWAVES + T.wave, NGW = C.G * NWAVES, lane = T.lane;
    for (int r = gw; r < NROWS; r += NGW) {
        if (r % BROWS < CTXL) continue;
#pragma unroll
        for (int j = 0; j < 2; ++j) { const int c0 = j * 512 + lane * 8;
            const u32x4 wy = *(const u32x4*)(YM + (size_t)r * 2048 + c0), wb = *(const u32x4*)(YB + (size_t)r * 1024 + c0), wg = *(const u32x4*)(GT + (size_t)r * 1024 + c0);
            float fy[8], fb[8], fg[8], o[8]; unpack8(wy, fy); unpack8(wb, fb); unpack8(wg, fg);
#pragma unroll
            for (int e = 0; e < 8; ++e) o[e] = gelu_tanh_f(fg[e]) * (fy[e] + fb[e]);
            u32x4 w; w.x = pk2(o[0], o[1]); w.y = pk2(o[2], o[3]); w.z = pk2(o[4], o[5]); w.w = pk2(o[6], o[7]);
            *(u32x4*)(YM + (size_t)r * 2048 + c0) = w; }
    }
}
__device__ __forceinline__ void ph_route(const Ctx& C, int layer, LAS unsigned char* lds) {
    const TC T = phase_tc();
    LAS float* Wt = (LAS float*)lds;
    const float* wg = C.in[I_WGRP] + (size_t)layer * 1024 * 4; const float* wr = C.in[I_WRT] + (size_t)layer * 1024 * 16;
    for (int i = T.tid; i < 4096; i += NTHREADS) Wt[(i & 3) * 1024 + (i >> 2)] = wg[i];
    for (int i = T.tid; i < 16384; i += NTHREADS) Wt[(4 + (i & 15)) * 1024 + (i >> 4)] = wr[i];
    __syncthreads();
    bf16* HN2 = (bf16*)(C.ws + WS_A); int* REC = (int*)(C.ws + WS_REC);
    unsigned* cnt = C.ctl() + CW_CNT + layer * 2048;
    const float* gf = C.in[I_GFFN] + layer * 1024;
    const int gw = C.bid * NWAVES + T.wave, NGW = C.G * NWAVES, lane = T.lane;
    for (int r = gw; r < NROWS; r += NGW) {
        if (layer == 1 && (r % BROWS) < CTXL) continue;
        const float* xr = C.xrow(r); const float* md = C.mod(layer, row_mv(r));
        f32x4 v[4]; float ss = 0.f;
#pragma unroll
        for (int j = 0; j < 4; ++j) { v[j] = *(const f32x4*)(xr + 256 * j + 4 * lane); ss += (v[j].x * v[j].x + v[j].y * v[j].y) + (v[j].z * v[j].z + v[j].w * v[j].w); }
        const float rs = rsqrtf(wave_sum(ss) * (1.f / DM) + EPS);
#pragma unroll
        for (int j = 0; j < 4; ++j) { const int c = 256 * j + 4 * lane; const f32x4 g = *(const f32x4*)(gf + c), sc = *(const f32x4*)(md + 4 * 1024 + c), sh = *(const f32x4*)(md + 3 * 1024 + c);
            v[j] = v[j] * rs * g * (sc + 1.f) + sh;
            u32x2 w; w.x = pk2(v[j].x, v[j].y); w.y = pk2(v[j].z, v[j].w); *(u32x2*)(HN2 + (size_t)r * DM + c) = w; }
        float lg[20];
#pragma unroll
        for (int o = 0; o < 20; ++o) { float s = 0.f;
#pragma unroll
            for (int j = 0; j < 4; ++j) { const f32x4 w = *(const LAS f32x4*)(Wt + o * 1024 + 256 * j + 4 * lane); s += (v[j].x * w.x + v[j].y * w.y) + (v[j].z * w.z + v[j].w * w.w); }
            lg[o] = wave_sum(s); }
        float gl[4];
#pragma unroll
        for (int k = 0; k < 4; ++k) gl[k] = lg[k] + C.in[I_BGRP][layer * 4 + k];
        int gi = 0; float gmx = gl[0];
#pragma unroll
        for (int k = 1; k < 4; ++k) if (gl[k] > gmx) { gmx = gl[k]; gi = k; }
        float den = 0.f;
#pragma unroll
        for (int k = 0; k < 4; ++k) den += __expf(gl[k] - gmx);
        const float pgrp = 1.f / den;
        float el[4];
#pragma unroll
        for (int k = 0; k < 4; ++k) { const float e0 = lg[4 + k] + C.in[I_BRT][layer * 16 + k], e1 = lg[8 + k] + C.in[I_BRT][layer * 16 + 4 + k], e2 = lg[12 + k] + C.in[I_BRT][layer * 16 + 8 + k], e3 = lg[16 + k] + C.in[I_BRT][layer * 16 + 12 + k];
            el[k] = gi == 0 ? e0 : (gi == 1 ? e1 : (gi == 2 ? e2 : e3)); }
        int i1 = 0; float v1 = el[0];
#pragma unroll
        for (int k = 1; k < 4; ++k) if (el[k] > v1) { v1 = el[k]; i1 = k; }
        int i2 = -1; float v2 = -3.4e38f;
#pragma unroll
        for (int k = 0; k < 4; ++k) if (k != i1 && el[k] > v2) { v2 = el[k]; i2 = k; }
        const float w1 = pgrp / (1.f + __expf(v2 - v1)), w2 = pgrp - w1;
        const int ia = i1 < i2 ? i1 : i2, ib = i1 < i2 ? i2 : i1; const float wa = i1 < i2 ? w1 : w2, wb = i1 < i2 ? w2 : w1;
        const int cls = gi * 6 + (ia * (7 - ia)) / 2 + (ib - ia - 1);
        if (lane == 0) { const int pos = (int)atomicAdd(cnt + cls * 64, 1u); REC[(size_t)r * 4 + 0] = cls; REC[(size_t)r * 4 + 1] = pos; REC[(size_t)r * 4 + 2] = (int)__float_as_uint(wa); REC[(size_t)r * 4 + 3] = (int)__float_as_uint(wb); }
    }
}
__device__ __forceinline__ void ph_gather(const Ctx& C, int layer, LAS unsigned char* lds) {
    const TC T = phase_tc();
    LAS int* tb = (LAS int*)lds;
    unsigned* cnt = C.ctl() + CW_CNT + layer * 2048;
    if (T.tid == 0) { int acc = 0; for (int c = 0; c < 24; ++c) { const int n = (int)__hip_atomic_load(cnt + c * 64, __ATOMIC_RELAXED, __HIP_MEMORY_SCOPE_AGENT); tb[c] = acc; tb[32 + c] = n; acc += (n + 255) >> 8; } tb[24] = acc; }
    __syncthreads();
    const bf16* HN2 = (const bf16*)(C.ws + WS_A); bf16* Xg = (bf16*)(C.ws + WS_YMIX); const int* REC = (const int*)(C.ws + WS_REC);
    int* TOK = (int*)(C.ws + WS_TOK); float* GAB = (float*)(C.ws + WS_GAB); int* MT = (int*)(C.ws + WS_MT);
    const int gw = C.bid * NWAVES + T.wave, NGW = C.G * NWAVES, lane = T.lane;
    for (int r = gw; r < NROWS; r += NGW) {
        if (layer == 1 && (r % BROWS) < CTXL) continue;
        const int cls = REC[(size_t)r * 4 + 0], pos = REC[(size_t)r * 4 + 1];
        const int slot = tb[cls] * 256 + pos;
        const u32x4* src = (const u32x4*)(HN2 + (size_t)r * DM); u32x4* dst = (u32x4*)(Xg + (size_t)slot * DM);
        dst[lane] = src[lane]; dst[64 + lane] = src[64 + lane];
        if (lane == 0) { TOK[slot] = r; GAB[(size_t)slot * 2] = __uint_as_float((unsigned)REC[(size_t)r * 4 + 2]); GAB[(size_t)slot * 2 + 1] = __uint_as_float((unsigned)REC[(size_t)r * 4 + 3]); }
    }
    for (int c = C.bid; c < 24; c += C.G) { const int n = tb[32 + c], end = ((n + 255) >> 8) << 8, base = tb[c] * 256;
        for (int p = n + T.tid; p < end; p += NTHREADS) { TOK[base + p] = -1; GAB[(size_t)(base + p) * 2] = 0.f; GAB[(size_t)(base + p) * 2 + 1] = 0.f; } }
    if (C.bid == 0) { if (T.tid == 0) MT[0] = tb[24];
        if (T.tid < 24) { const int t0 = tb[T.tid], t1 = tb[T.tid + 1]; for (int t = t0; t < t1; ++t) MT[1 + t] = T.tid; } }
}
__device__ __forceinline__ void ph_final(const Ctx& C) {
    const TC T = phase_tc();
    const float* gf = C.in[I_GFINAL];
    const int gw = C.bid * NWAVES + T.wave, NGW = C.G * NWAVES, lane = T.lane;
    for (int r = gw; r < NBATCH * SEQL; r += NGW) {
        float* xr = C.out + (size_t)r * DM;
        f32x4 v[4]; float ss = 0.f;
#pragma unroll
        for (int j = 0; j < 4; ++j) { v[j] = *(const f32x4*)(xr + 256 * j + 4 * lane); ss += (v[j].x * v[j].x + v[j].y * v[j].y) + (v[j].z * v[j].z + v[j].w * v[j].w); }
        const float rs = rsqrtf(wave_sum(ss) * (1.f / DM) + EPS);
#pragma unroll
        for (int j = 0; j < 4; ++j) { const int c = 256 * j + 4 * lane; *(f32x4*)(xr + c) = v[j] * rs * *(const f32x4*)(gf + c); }
    }
}

__global__ void __launch_bounds__(NTHREADS, 2) fwd_kernel(Args args) {
    extern __shared__ __attribute__((aligned(16))) unsigned char lds_raw[];
    LAS unsigned char* lds = (LAS unsigned char*)lds_raw;
    Ctx C; C.in = args.in; C.out = args.out; C.ws = args.ws;
    C.bid = blockIdx.x; C.G = gridDim.x;
    const int lo = args.ph_lo, hi = args.ph_hi;
    int ph = 0;
#define IN(k) (lo <= (k) && (k) < hi)
#define SEAM(k) do { if (IN(k) && IN((k) + 1)) { cg::this_grid().sync(); } } while (0)
    if (EN(0) && IN(0)) { ph_mod(C, lds); ph_convert(C, 0, lds); }
    SEAM(0);
#pragma unroll 1
    for (int layer = 0; layer < 2; ++layer) {
        const int pb = 1 + 10 * layer;
        unsigned char* ws = C.ws;
        if (EN(1) && IN(pb + 0)) { if (layer == 1) ph_convert(C, 1, lds); ph_prenorm(C, layer); }
        SEAM(pb + 0);
        if (EN(2) && IN(pb + 1)) {
            const int nN = layer == 0 ? 16 : 14;
            pg8::Gemm g{1024, 1024, 1024, 1 << 30};
            RowSched S; S.nM = 66; S.nN = nN; S.nwg = 66 * nN; S.G = C.G; S.c = C.bid; S.skipctx = 0; S.A = (const char*)(ws + WS_A); S.Bt = (const char*)(ws + WS_WIN); S.a_tile = (size_t)256 * 1024 * 2; S.b_tile = (size_t)256 * 1024 * 2;
            EpiProj E;
            if (layer == 0) { E.d0 = (bf16*)(ws + WS_Z); E.l0 = 1024; E.e0 = 4; E.d1 = (bf16*)(ws + WS_RAW); E.l1 = 1280; E.e1 = 9; E.d2 = (bf16*)(ws + WS_YMIX) + 1024; E.l2 = 2048; E.e2 = 13;
                E.d3 = (bf16*)(ws + WS_K); E.l3 = 256; E.e3 = 14; E.d4 = (bf16*)(ws + WS_V); E.l4 = 256; E.e4 = 15; E.d5 = (bf16*)(ws + WS_DTR); E.l5 = 32; E.lastcols = 32; }
            else { E.d0 = (bf16*)(ws + WS_Z); E.l0 = 1024; E.e0 = 4; E.d1 = (bf16*)(ws + WS_RAW); E.l1 = 1024; E.e1 = 8; E.d2 = (bf16*)(ws + WS_YMIX) + 1024; E.l2 = 2048; E.e2 = 12;
                E.d3 = (bf16*)(ws + WS_K); E.l3 = 256; E.e3 = 13; E.d4 = (bf16*)(ws + WS_V); E.l4 = 256; E.e4 = 14; E.d5 = (bf16*)(ws + WS_DTR); E.l5 = 32; E.lastcols = 32; }
            pg8::gemm_phase<EpiProj, RowSched>(lds, g, S, E);
        }
        SEAM(pb + 1);
        if (EN(3) && IN(pb + 2)) { if (layer == 0) ph_elem0(C); else ph_elem1(C); }
        SEAM(pb + 2);
        if (IN(pb + 3)) { if (layer == 0) { if (EN(4)) ph_mix0(C, lds, (char*)lds_raw); } else { if (EN(5)) ph_mix1(C, lds, (char*)lds_raw); } }
        SEAM(pb + 3);
        if (EN(6) && IN(pb + 4)) { if (layer == 0) ph_ssdpost(C); else ph_lrupost(C); }
        SEAM(pb + 4);
        if (EN(7) && IN(pb + 5)) {
            pg8::Gemm g{2048, 2048, 2048, 1 << 30};
            RowSched S; S.nM = layer == 0 ? 66 : 64; S.nN = 4; S.nwg = S.nM * 4; S.G = C.G; S.c = C.bid; S.skipctx = layer; S.A = (const char*)(ws + WS_YMIX); S.Bt = (const char*)(ws + WS_WOUT); S.a_tile = (size_t)256 * 2048 * 2; S.b_tile = (size_t)256 * 2048 * 2;
            EpiRes E; E.xin_lat = layer == 0 ? C.in[I_X] : C.out; E.xin_ctx = layer == 0 ? C.in[I_CTX] : C.xc(); E.xout_lat = C.out; E.xout_ctx = C.xc(); E.modbase = C.mod(layer, 0);
            pg8::gemm_phase<EpiRes, RowSched>(lds, g, S, E);
        }
        SEAM(pb + 5);
        if (EN(8) && IN(pb + 6)) ph_route(C, layer, lds);
        SEAM(pb + 6);
        if (EN(9) && IN(pb + 7)) ph_gather(C, layer, lds);
        SEAM(pb + 7);
        if (EN(10) && IN(pb + 8)) {
            pg8::Gemm g{1024, 1024, 1024, 1 << 30};
            MoeSched S; S.mt = (const int*)(ws + WS_MT); S.G = C.G; S.c = C.bid; S.which = 1; S.A = (const char*)(ws + WS_YMIX); S.W = (const char*)(ws + WS_W13); S.a_tile = (size_t)256 * 1024 * 2;
            EpiMoe1 E; E.H = (bf16*)(ws + WS_Z); E.gab = (const float*)(ws + WS_GAB);
            pg8::gemm_phase<EpiMoe1, MoeSched>(lds, g, S, E);
        }
        SEAM(pb + 8);
        if (EN(11) && IN(pb + 9)) {
            pg8::Gemm g{512, 256, 512, 4};
            MoeSched S; S.mt = (const int*)(ws + WS_MT); S.G = C.G; S.c = C.bid; S.which = 2; S.A = (const char*)(ws + WS_Z); S.W = (const char*)(ws + WS_W2); S.a_tile = (size_t)256 * 512 * 2;
            EpiMoe2 E; E.tok = (const int*)(ws + WS_TOK); E.out = C.out; E.xc = C.xc(); E.modbase = C.mod(layer, 0);
            pg8::gemm_phase<EpiMoe2, MoeSched>(lds, g, S, E);
        }
        SEAM(pb + 9);
    }
    if (EN(12) && IN(21)) ph_final(C);
    (void)ph;
#undef IN
#undef SEAM
}

extern "C" void kernel_launch(void* const* d_in, const int* in_sizes, int n_in, void* d_out, int out_size, void* d_ws, size_t ws_size, hipStream_t stream) {
    static int grid = 0;
    if (grid == 0) {
        if (n_in != 36 || out_size != NBATCH * SEQL * DM || ws_size < WS_END) { fprintf(stderr, "kernel_launch: unexpected shapes (n_in %d, out %d, ws %zu)\n", n_in, out_size, ws_size); grid = -1; return; }
        int dev = 0, cus = 0, per_cu = 0;
        if (hipGetDevice(&dev) != hipSuccess || hipDeviceGetAttribute(&cus, hipDeviceAttributeMultiprocessorCount, dev) != hipSuccess) { grid = -1; return; }
        if (hipFuncSetAttribute((const void*)fwd_kernel, hipFuncAttributeMaxDynamicSharedMemorySize, LDS_BYTES) != hipSuccess) { fprintf(stderr, "kernel_launch: hipFuncSetAttribute failed\n"); grid = -1; return; }
        if (hipOccupancyMaxActiveBlocksPerMultiprocessor(&per_cu, (const void*)fwd_kernel, NTHREADS, LDS_BYTES) != hipSuccess || per_cu < 1) { fprintf(stderr, "kernel_launch: occupancy query failed (%d)\n", per_cu); (void)hipGetLastError(); per_cu = 1; }
        grid = cus * 1;
    }
    if (grid < 0) return;
    (void)hipMemsetAsync((char*)d_ws + WS_CTL, 0, CTL_ZERO_BYTES, stream);
    Args a{};
    for (int i = 0; i < 36; ++i) a.in[i] = (const float*)d_in[i];
    a.out = (float*)d_out; a.ws = (unsigned char*)d_ws;
#if MK_PER_PHASE
    for (int p = 0; p < N_PHASES; ++p) { a.ph_lo = p; a.ph_hi = p + 1; hipLaunchKernelGGL(fwd_kernel, dim3(grid), dim3(NTHREADS), LDS_BYTES, stream, a); }
#else
    a.ph_lo = 0; a.ph_hi = N_PHASES;
    void* kargs[] = {&a};
    hipError_t e = hipLaunchCooperativeKernel((const void*)fwd_kernel, dim3(grid), dim3(NTHREADS), kargs, LDS_BYTES, stream);
    if (e != hipSuccess) fprintf(stderr, "kernel_launch: cooperative launch failed: %s (grid %d)\n", hipGetErrorString(e), grid);
#endif
}
```

```cpp
#include <hip/hip_runtime.h>
#include <hip/hip_cooperative_groups.h>
#include <cstdio>
#include <cstdint>
namespace cg = cooperative_groups;

#ifndef MK_PER_PHASE
#define MK_PER_PHASE 0
#endif

#ifndef EN_MASK
#define EN_MASK 0xFFFF
#endif
#define EN(k) (((EN_MASK) >> (k)) & 1)
#define LAS __attribute__((address_space(3)))
typedef unsigned short bf16;
typedef short bf16x8 __attribute__((ext_vector_type(8)));
typedef short s16x4 __attribute__((ext_vector_type(4)));
typedef float f32x4 __attribute__((ext_vector_type(4)));
typedef float f32x2 __attribute__((ext_vector_type(2)));
typedef float f32x16 __attribute__((ext_vector_type(16)));
typedef unsigned u32x4 __attribute__((ext_vector_type(4)));
typedef unsigned u32x2 __attribute__((ext_vector_type(2)));

constexpr int DM = 1024, NBATCH = 2, SEQL = 8192, CTXL = 256;
constexpr int BROWS = CTXL + SEQL;
constexpr int NROWS = NBATCH * BROWS;
constexpr float EPS = 1e-6f;
constexpr int NWAVES = 8, NTHREADS = 512;
constexpr int LDS_BYTES = 147456;
constexpr int N_PHASES = 22;

constexpr size_t MiB = 1u << 20;
constexpr size_t WS_CTL = 0, CTL_ZERO_BYTES = 64 * 1024;
constexpr size_t WS_MOD = 1 * MiB;
constexpr size_t WS_REC = 1 * MiB + 256 * 1024;
constexpr size_t WS_TOK = 2 * MiB;
constexpr size_t WS_GAB = 2 * MiB + 128 * 1024;
constexpr size_t WS_MT  = 2 * MiB + 512 * 1024;
constexpr size_t WS_XC  = 3 * MiB;
constexpr size_t WS_W   = 5 * MiB;
constexpr size_t WS_WIN = WS_W, WS_WOUT = WS_W + 8 * MiB, WS_W13 = WS_W + 12 * MiB, WS_W2 = WS_W + 28 * MiB;
constexpr size_t WS_A   = 41 * MiB;
constexpr size_t WS_Z   = 83 * MiB;
constexpr size_t WS_RAW = 116 * MiB;
constexpr size_t WS_DTR = 158 * MiB;
constexpr size_t WS_DT  = 160 * MiB;
constexpr size_t WS_K   = 163 * MiB;
constexpr size_t WS_V   = 172 * MiB;
constexpr size_t WS_YMIX = 181 * MiB;
constexpr size_t WS_END = 247 * MiB;
constexpr int MAXTILES = 90, MAXSLOT = MAXTILES * 256;
constexpr int CW_Q0 = 64, CW_Q1 = 128, CW_CNT = 256;

__device__ __forceinline__ float bf2f(unsigned short b) { return __uint_as_float(((unsigned)b) << 16); }
__device__ __forceinline__ unsigned f2bf(float f) { unsigned u = __float_as_uint(f); return (u + 0x7fffu + ((u >> 16) & 1u)) >> 16; }
__device__ __forceinline__ unsigned pk2(float lo, float hi) { return f2bf(lo) | (f2bf(hi) << 16); }
__device__ __forceinline__ float wave_sum(float v) {
#pragma unroll
    for (int o = 1; o < 64; o <<= 1) v += __shfl_xor(v, o);
    return v;
}
__device__ __forceinline__ float silu_f(float x) { return x / (1.f + __expf(-x)); }
__device__ __forceinline__ float sigmoid_f(float x) { return 1.f / (1.f + __expf(-x)); }
__device__ __forceinline__ float softplus_f(float x) { return fmaxf(x, 0.f) + log1pf(__expf(-fabsf(x))); }
__device__ __forceinline__ float gelu_tanh_f(float x) { const float u = 0.7978845608028654f * (x + 0.044715f * x * x * x); return 0.5f * x * (1.f + tanhf(u)); }
__device__ __forceinline__ void unpack8(const u32x4 w, float* f) {
    f[0] = __uint_as_float(w.x << 16); f[1] = __uint_as_float(w.x & 0xffff0000u);
    f[2] = __uint_as_float(w.y << 16); f[3] = __uint_as_float(w.y & 0xffff0000u);
    f[4] = __uint_as_float(w.z << 16); f[5] = __uint_as_float(w.z & 0xffff0000u);
    f[6] = __uint_as_float(w.w << 16); f[7] = __uint_as_float(w.w & 0xffff0000u);
}

namespace pg8 {
constexpr int BM = 256, BK = 64, HALF = 128, HTB = HALF * BK * 2, STAGE_BYTES = 8 * HTB, NXCD = 8, WGM = 8;
__host__ __device__ __forceinline__ int lds_byte(int r, int c) { const int st = (r >> 4) * 2 + (c >> 5), rr = r & 15, cc = c & 31, ob = rr * 64 + cc * 2; return st * 1024 + (ob ^ (((ob >> 9) & 1) << 5)); }
__host__ __device__ __forceinline__ void stage_rc(int b, int& R, int& C) { const int st = b / 1024, sb = b % 1024, swz = sb ^ (((sb >> 9) & 1) << 5); R = (st >> 1) * 16 + swz / 64; C = (st & 1) * 32 + (swz % 64) / 2; }
__host__ __device__ __forceinline__ int perm32(int rho) { const int n = rho >> 4, i = rho & 15; return 8 * (i >> 2) + 4 * n + (i & 3); }

struct Unit { int pm, pn; const char* a; const char* b; long bd; };
struct Gemm { int lda, ldb, K, ksplit; };

__device__ __forceinline__ unsigned cvt_pk_bf16(float lo, float hi) { unsigned r; asm volatile("v_cvt_pk_bf16_f32 %0, %1, %2" : "=v"(r) : "v"(lo), "v"(hi)); return r; }

template <class Epi, class Sched>
__device__ __forceinline__ void gemm_phase(LAS unsigned char* lds, const Gemm g, const Sched& S, const Epi& E) {
    int tid_ = threadIdx.x; asm volatile("" : "+v"(tid_));
    const int tid = tid_, wid = __builtin_amdgcn_readfirstlane(tid >> 6), lane = tid & 63, wr = wid >> 2, wc = wid & 3, fr = lane & 15, fq = lane >> 4;
    const int nt = g.K / BK;
    unsigned voffA[2], voffB[2];
#pragma unroll
    for (int i = 0; i < 2; ++i) { int R, C; stage_rc(tid * 16 + i * 8192, R, C); const int Rb = Epi::PERM ? ((R & ~31) + perm32(R & 31)) : R;
        voffA[i] = (unsigned)(R * g.lda + C) * 2u; voffB[i] = (unsigned)(Rb * g.ldb + C) * 2u; }
    const size_t kstep = (size_t)(BK * 2);
    const size_t hstepA = (size_t)HALF * g.lda * 2, hstepB = (size_t)HALF * g.ldb * 2;
    const unsigned ldsw = (unsigned)wid * 1024u;
    const int aoff = lds_byte(wr * 64 + fr, fq * 8), boff = lds_byte(wc * 32 + fr, fq * 8);
#define PG8_SA(b, h) (((b) * 2 + (h)) * HTB)
#define PG8_SB(b, h) ((4 + (b) * 2 + (h)) * HTB)
#define PG8_STAGE(bufoff, gbase, voff) do { _Pragma("unroll") for (int _i = 0; _i < 2; ++_i) \
        __builtin_amdgcn_global_load_lds((const unsigned*)((const char*)(gbase) + (voff)[_i]), (LAS unsigned*)(lds + (bufoff) + ldsw + _i * 8192), 16, 0, 0); } while (0)
#define PG8_LDA(dst, b, h) do { _Pragma("unroll") for (int m = 0; m < 4; ++m) _Pragma("unroll") for (int k = 0; k < 2; ++k) dst[m][k] = *(const LAS bf16x8*)(lds + PG8_SA(b, h) + aoff + m * 2048 + k * 1024); } while (0)
#define PG8_LDB(dst, b, h) do { _Pragma("unroll") for (int n = 0; n < 2; ++n) _Pragma("unroll") for (int k = 0; k < 2; ++k) dst[n][k] = *(const LAS bf16x8*)(lds + PG8_SB(b, h) + boff + n * 2048 + k * 1024); } while (0)
#define PG8_MMA(ai, bj, At, Bt) do { __builtin_amdgcn_s_setprio(1); _Pragma("unroll") for (int m = 0; m < 4; ++m) _Pragma("unroll") for (int n = 0; n < 2; ++n) _Pragma("unroll") for (int k = 0; k < 2; ++k) \
        acc[ai][bj][m][n] = __builtin_amdgcn_mfma_f32_16x16x32_bf16(Bt[n][k], At[m][k], acc[ai][bj][m][n], 0, 0, 0); __builtin_amdgcn_s_setprio(0); } while (0)
#define PG8_WAIT_V(n) asm volatile("s_waitcnt vmcnt(" #n ")" ::: "memory")
#define PG8_WAIT_L(n) asm volatile("s_waitcnt lgkmcnt(" #n ")" ::: "memory")
#define PG8_BAR __builtin_amdgcn_s_barrier()
#define PG8_SCHED __builtin_amdgcn_sched_barrier(0)
    Unit cur, nxt; int ui = 0;
    if (!S.next(0, cur)) return;
    f32x4 acc[2][2][4][2];
#pragma unroll
    for (int a = 0; a < 2; ++a)
#pragma unroll
        for (int b = 0; b < 2; ++b)
#pragma unroll
            for (int m = 0; m < 4; ++m)
#pragma unroll
                for (int n = 0; n < 2; ++n) acc[a][b][m][n] = (f32x4){0.f, 0.f, 0.f, 0.f};
    bf16x8 At[4][2], B0[2][2], B1[2][2];
    const char* cA = cur.a; const char* cB = cur.b; long cBd = cur.bd;
    PG8_STAGE(PG8_SB(0, 0), cB, voffB); PG8_STAGE(PG8_SA(0, 0), cA, voffA); PG8_STAGE(PG8_SB(0, 1), cB + hstepB, voffB); PG8_STAGE(PG8_SA(0, 1), cA + hstepA, voffA);
    if (wr == 1) PG8_BAR;
    PG8_WAIT_V(4); PG8_BAR;
    PG8_STAGE(PG8_SB(1, 0), cB + kstep, voffB); PG8_STAGE(PG8_SA(1, 0), cA + kstep, voffA); PG8_STAGE(PG8_SB(1, 1), cB + hstepB + kstep, voffB);
    PG8_WAIT_V(6); PG8_BAR;
    for (;;) {
        const bool has_next = S.next(ui + 1, nxt);
        const char* nA = has_next ? nxt.a : cA; const char* nB = has_next ? nxt.b : cB;
#pragma unroll 1
        for (int t = 0; t < nt; t += 2) {
            const bool last = (t == nt - 2);
            const char* a1 = cA + (size_t)(t + 1) * kstep;
            const char* a2 = last ? nA : cA + (size_t)(t + 2) * kstep;
            const char* b2 = last ? nB : cB + (size_t)(t + 2) * kstep + ((t + 2) >= g.ksplit ? cBd : 0);
            const char* a3 = a2 + kstep; const char* b3 = b2 + kstep;
            PG8_LDB(B0, 0, 0); PG8_SCHED; PG8_LDA(At, 0, 0); PG8_STAGE(PG8_SA(1, 1), a1 + hstepA, voffA);
            PG8_WAIT_L(8); PG8_BAR; PG8_WAIT_L(0); PG8_MMA(0, 0, At, B0); PG8_BAR; PG8_SCHED;
            PG8_LDB(B1, 0, 1); PG8_STAGE(PG8_SB(0, 0), b2, voffB);
            PG8_BAR; PG8_WAIT_L(0); PG8_MMA(0, 1, At, B1); PG8_BAR;
            PG8_LDA(At, 0, 1); PG8_STAGE(PG8_SA(0, 0), a2, voffA);
            PG8_BAR; PG8_WAIT_L(0); PG8_MMA(1, 0, At, B0); PG8_BAR; PG8_SCHED;
            PG8_STAGE(PG8_SB(0, 1), b2 + hstepB, voffB);
            PG8_WAIT_V(6); PG8_BAR; PG8_MMA(1, 1, At, B1); PG8_BAR;
            PG8_LDB(B0, 1, 0); PG8_SCHED; PG8_LDA(At, 1, 0); PG8_STAGE(PG8_SA(0, 1), a2 + hstepA, voffA);
            PG8_WAIT_L(8); PG8_BAR; PG8_WAIT_L(0); PG8_MMA(0, 0, At, B0); PG8_BAR; PG8_SCHED;
            PG8_LDB(B1, 1, 1); PG8_STAGE(PG8_SB(1, 0), b3, voffB);
            PG8_BAR; PG8_WAIT_L(0); PG8_MMA(0, 1, At, B1); PG8_BAR;
            PG8_LDA(At, 1, 1); PG8_STAGE(PG8_SA(1, 0), a3, voffA);
            PG8_BAR; PG8_WAIT_L(0); PG8_MMA(1, 0, At, B0); PG8_BAR; PG8_SCHED;
            PG8_STAGE(PG8_SB(1, 1), b3 + hstepB, voffB);
            PG8_WAIT_V(6); PG8_BAR; PG8_MMA(1, 1, At, B1); PG8_BAR;
        }
        E(acc, cur, wr, wc, fr, fq);
        if (!has_next) break;
#pragma unroll
        for (int a = 0; a < 2; ++a)
#pragma unroll
            for (int b = 0; b < 2; ++b)
#pragma unroll
                for (int m = 0; m < 4; ++m)
#pragma unroll
                    for (int n = 0; n < 2; ++n) acc[a][b][m][n] = (f32x4){0.f, 0.f, 0.f, 0.f};
        cur = nxt; cA = nA; cB = nB; cBd = cur.bd; ++ui;
    }
    PG8_WAIT_V(0);
    if (wr == 0) PG8_BAR;
    PG8_BAR;
#undef PG8_SA
#undef PG8_SB
#undef PG8_STAGE
#undef PG8_LDA
#undef PG8_LDB
#undef PG8_MMA
#undef PG8_WAIT_V
#undef PG8_WAIT_L
#undef PG8_BAR
#undef PG8_SCHED
}
}

namespace att {
constexpr int D = 128, NW = 8, QBLK = 32, KVBLK = 64;
constexpr float SCALE = 0.088388347648318440f;
constexpr float THR = 8.f;
constexpr int LDQ = 2048, LDK = 256, LDO = 2048;
constexpr size_t SHM_V = KVBLK * D * 2, SHM_K = KVBLK * D * 2, SHM_ATTN = 2 * SHM_V + 2 * SHM_K + NW * 64 * 4;
#define KSWZ(row, colB) ((row) * 256 + ((colB) ^ (((row) & 7) << 4)))
#define SBAR() __builtin_amdgcn_sched_barrier(0)
__device__ __forceinline__ int crow(int r, int hi) { return (r & 3) + 8 * (r >> 2) + 4 * hi; }
__device__ __forceinline__ unsigned cvtpk(float lo, float hi) { unsigned r; asm volatile("v_cvt_pk_bf16_f32 %0, %1, %2" : "=v"(r) : "v"(lo), "v"(hi)); return r; }

__device__ __forceinline__ void partialSM(f32x16& p0, f32x16& p1, float& m_reg, float& mn, float& alpha) {
  constexpr float C = SCALE * 1.4426950408889634f;
  float pmax = p0[0]; for (int r = 1; r < 16; ++r) pmax = fmaxf(pmax, p0[r]); for (int r = 0; r < 16; ++r) pmax = fmaxf(pmax, p1[r]);
  { auto rr = __builtin_amdgcn_permlane32_swap(__float_as_uint(pmax), __float_as_uint(pmax), false, false);
    pmax = fmaxf(__uint_as_float(rr[0]), __uint_as_float(rr[1])); }
  if (__builtin_expect(__all(pmax - m_reg <= THR / SCALE), 1)) { mn = m_reg; alpha = 1.f; }
  else { mn = fmaxf(m_reg, pmax); alpha = __builtin_amdgcn_exp2f((m_reg - mn) * C); m_reg = mn; }
  float mnC = -mn * C;
  for (int r = 0; r < 16; ++r) p0[r] = fmaf(p0[r], C, mnC); for (int r = 0; r < 16; ++r) p1[r] = fmaf(p1[r], C, mnC);
  for (int r = 0; r < 16; ++r) p0[r] = __builtin_amdgcn_exp2f(p0[r]);
}
__device__ __forceinline__ void finishSM(f32x16& p0, f32x16& p1, float alpha, float& l_reg, bf16x8& pa0, bf16x8& pa1, bf16x8& pa2, bf16x8& pa3) {
  for (int r = 0; r < 16; ++r) p1[r] = __builtin_amdgcn_exp2f(p1[r]);
  float ps = 0; for (int r = 0; r < 16; ++r) ps += p0[r]; for (int r = 0; r < 16; ++r) ps += p1[r];
  { auto rr = __builtin_amdgcn_permlane32_swap(__float_as_uint(ps), __float_as_uint(ps), false, false);
    ps = __uint_as_float(rr[0]) + __uint_as_float(rr[1]); }
  l_reg = l_reg * alpha + ps;
#define PK4(P, BASE, OUT) do { unsigned a0 = cvtpk(P[BASE + 0], P[BASE + 1]), a1 = cvtpk(P[BASE + 2], P[BASE + 3]);   \
    unsigned b0 = cvtpk(P[BASE + 4], P[BASE + 5]), b1 = cvtpk(P[BASE + 6], P[BASE + 7]);                              \
    auto r0 = __builtin_amdgcn_permlane32_swap(a0, b0, false, false); auto r1 = __builtin_amdgcn_permlane32_swap(a1, b1, false, false); \
    u32x4 w = {r0[0], r1[0], r0[1], r1[1]}; OUT = *reinterpret_cast<bf16x8*>(&w); } while (0)
  PK4(p0, 0, pa0); PK4(p0, 8, pa1); PK4(p1, 0, pa2); PK4(p1, 8, pa3);
#undef PK4
}
__device__ __forceinline__ void qkt(f32x16& p0, f32x16& p1, const bf16* Ks, const bf16x8* qr, int r32, int hi) {
  asm volatile("" : "+v"(r32), "+v"(hi));
  p0 = f32x16{}; p1 = f32x16{};
  for (int d0 = 0; d0 < 8; ++d0) { int cb = (d0 * 16 + hi * 8) * 2;
    bf16x8 b0 = *reinterpret_cast<const bf16x8*>((const char*)Ks + KSWZ(r32, cb));
    bf16x8 b1 = *reinterpret_cast<const bf16x8*>((const char*)Ks + KSWZ(32 + r32, cb));
    p0 = __builtin_amdgcn_mfma_f32_32x32x16_bf16(b0, qr[d0], p0, 0, 0, 0);
    p1 = __builtin_amdgcn_mfma_f32_32x32x16_bf16(b1, qr[d0], p1, 0, 0, 0); }
}
__device__ __forceinline__ int v_st(int k, int c) { const int kk = (k & ~0xC) | ((k & 4) << 1) | ((k & 8) >> 1); return ((kk >> 3) * 4 + (c >> 5)) * 512 + ((kk & 7) * 32 + (c & 31)) * 2; }
__device__ __forceinline__ int v_rd_base(int lane) { return ((lane & 3) << 3) | (((lane >> 2) & 3) << 6) | (((lane >> 4) & 1) << 5) | (((lane >> 5) & 1) << 8); }
constexpr int v_rd_off(int d0, int ks, int half) { return d0 * 512 + ks * 4096 + half * 2048; }
template <int OFF> __device__ __forceinline__ s16x4 tr_read(int vb) {
  s16x4 r; asm volatile("ds_read_b64_tr_b16 %0, %1 offset:%2" : "=&v"(r) : "v"(vb), "i"(OFF) : "memory"); return r;
}
template <int D0> __device__ __forceinline__ void pv_one(f32x16& od, int vb, bf16x8 pa0, bf16x8 pa1, bf16x8 pa2, bf16x8 pa3) {
  const s16x4 l0 = tr_read<v_rd_off(D0, 0, 0)>(vb), h0 = tr_read<v_rd_off(D0, 0, 1)>(vb), l1 = tr_read<v_rd_off(D0, 1, 0)>(vb), h1 = tr_read<v_rd_off(D0, 1, 1)>(vb);
  const s16x4 l2 = tr_read<v_rd_off(D0, 2, 0)>(vb), h2 = tr_read<v_rd_off(D0, 2, 1)>(vb), l3 = tr_read<v_rd_off(D0, 3, 0)>(vb), h3 = tr_read<v_rd_off(D0, 3, 1)>(vb);
  asm volatile("s_waitcnt lgkmcnt(0)" ::: "memory"); SBAR();
#define PK(L, H) (bf16x8){L[0], L[1], L[2], L[3], H[0], H[1], H[2], H[3]}
  od = __builtin_amdgcn_mfma_f32_32x32x16_bf16(pa0, PK(l0, h0), od, 0, 0, 0);
  od = __builtin_amdgcn_mfma_f32_32x32x16_bf16(pa1, PK(l1, h1), od, 0, 0, 0);
  od = __builtin_amdgcn_mfma_f32_32x32x16_bf16(pa2, PK(l2, h2), od, 0, 0, 0);
  od = __builtin_amdgcn_mfma_f32_32x32x16_bf16(pa3, PK(l3, h3), od, 0, 0, 0);
#undef PK
}
__device__ __forceinline__ void pv_d0(f32x16* o, int vb, bf16x8 pa0, bf16x8 pa1, bf16x8 pa2, bf16x8 pa3) {
  pv_one<0>(o[0], vb, pa0, pa1, pa2, pa3); pv_one<1>(o[1], vb, pa0, pa1, pa2, pa3); pv_one<2>(o[2], vb, pa0, pa1, pa2, pa3); pv_one<3>(o[3], vb, pa0, pa1, pa2, pa3);
}
__device__ __forceinline__ void band_mask(f32x16& p0, f32x16& p1, int dbase, int hi) {
#pragma unroll
  for (int r = 0; r < 16; ++r) { const int d = dbase + crow(r, hi);
    if (d < -128 || d > 128) p0[r] = -1e30f;
    if (d + 32 < -128 || d + 32 > 128) p1[r] = -1e30f; }
}
template <int MODE>
__device__ __forceinline__ void attn_body(const bf16* Qb, const bf16* Kh, const bf16* Vh, bf16* Ob, int NT, int kb0, int q0, float sink, char* lds) {
  int tid_ = threadIdx.x; asm volatile("" : "+v"(tid_));
  const int tid = tid_, wid = tid >> 6, lane = tid & 63, r32 = lane & 31, hi = lane >> 5;
  bf16* V_lds = (bf16*)lds; bf16* K_lds = (bf16*)(lds + 2 * SHM_V);
  float* ws = (float*)(lds + 2 * SHM_V + 2 * SHM_K) + wid * 64; float* li_l = ws; float* al_l = ws + 32;
  float m_reg = -1e30f, l_reg = 0; f32x16 o[4] = {}; bf16x8 qr[8];
  const bf16* Qw = Qb + (long)(wid * QBLK + r32) * LDQ + hi * 8;
#pragma unroll
  for (int d0 = 0; d0 < 8; ++d0) qr[d0] = *reinterpret_cast<const bf16x8*>(Qw + d0 * 16);
  const int sr = tid >> 4, sc = (tid & 15) * 8, vst0 = v_st(sr, sc), vst1 = v_st(32 + sr, sc);
  const int vb0 = (int)(uintptr_t)V_lds + v_rd_base(lane);
  struct { bf16x8 vs0, vs1, ks0, ks1; } sr_[1];
#define TK0(j) ((MODE == 0 || (j) < 4) ? (j) * KVBLK : kb0 + ((j) - 4) * KVBLK)
#define SLOAD(i, k0) do { sr_[i].vs0 = *reinterpret_cast<const bf16x8*>(&Vh[(long)((k0) + sr) * LDK + sc]); sr_[i].vs1 = *reinterpret_cast<const bf16x8*>(&Vh[(long)((k0) + 32 + sr) * LDK + sc]); \
    sr_[i].ks0 = *reinterpret_cast<const bf16x8*>(&Kh[(long)((k0) + sr) * LDK + sc]); sr_[i].ks1 = *reinterpret_cast<const bf16x8*>(&Kh[(long)((k0) + 32 + sr) * LDK + sc]); } while (0)
#define SWRITE(b, i) do { *(bf16x8*)((char*)V_lds + (b) * SHM_V + vst0) = sr_[i].vs0;          \
    *(bf16x8*)((char*)V_lds + (b) * SHM_V + vst1) = sr_[i].vs1; int kc = sc * 2;               \
    *(bf16x8*)((char*)K_lds + (b) * SHM_K + KSWZ(sr, kc)) = sr_[i].ks0;                       \
    *(bf16x8*)((char*)K_lds + (b) * SHM_K + KSWZ(32 + sr, kc)) = sr_[i].ks1; } while (0)
#define SWAIT() asm volatile("s_waitcnt vmcnt(0)" ::: "memory")
#define RESC(a) do { if (__any((a) < 1.f)) { if (hi == 0) al_l[r32] = (a); asm volatile("s_waitcnt lgkmcnt(0)" ::: "memory"); \
    for (int d = 0; d < 4; ++d) for (int r = 0; r < 16; ++r) o[d][r] *= al_l[crow(r, hi)]; } } while (0)
#define MASKT(P0, P1, j) do { if (MODE == 1 && (j) >= 4) { const int s0_ = kb0 - 256 + ((j) - 4) * KVBLK, tw_ = q0 + wid * QBLK; \
    if (!(s0_ - (tw_ + 31) >= -128 && (s0_ + 63) - tw_ <= 128)) band_mask(P0, P1, s0_ - tw_ - r32, hi); } } while (0)
  f32x16 pA0, pA1, pB0, pB1; float mnA, mnB, alA, alB; bf16x8 pa0, pa1, pa2, pa3;
  constexpr int SE = 0, SO = 0;
  SLOAD(SE, TK0(0)); asm volatile("s_waitcnt vmcnt(0)" ::: "memory"); SWRITE(0, SE); __syncthreads();
  qkt(pA0, pA1, K_lds, qr, r32, hi); partialSM(pA0, pA1, m_reg, mnA, alA);
  SLOAD(SO, TK0(1));
  SWAIT(); SWRITE(1, SO); __syncthreads();
  for (int j = 1; j + 1 < NT; j += 2) {
    SBAR(); qkt(pB0, pB1, (bf16*)((char*)K_lds + SHM_K), qr, r32, hi);
    finishSM(pA0, pA1, alA, l_reg, pa0, pa1, pa2, pa3); SBAR();
    SLOAD(SO, TK0(j + 1)); SBAR();
    pv_d0(o, vb0, pa0, pa1, pa2, pa3); MASKT(pB0, pB1, j); partialSM(pB0, pB1, m_reg, mnB, alB);
    __syncthreads(); SWAIT(); SWRITE(0, SE);
    RESC(alB); __syncthreads();
    SBAR(); qkt(pA0, pA1, K_lds, qr, r32, hi);
    finishSM(pB0, pB1, alB, l_reg, pa0, pa1, pa2, pa3); SBAR();
    SLOAD(SE, TK0(j + 2)); SBAR();
    pv_d0(o, vb0 + (int)SHM_V, pa0, pa1, pa2, pa3); MASKT(pA0, pA1, j + 1); partialSM(pA0, pA1, m_reg, mnA, alA);
    __syncthreads(); SWAIT(); SWRITE(1, SO);
    RESC(alA); __syncthreads();
  }
  SBAR(); qkt(pB0, pB1, (bf16*)((char*)K_lds + SHM_K), qr, r32, hi);
  finishSM(pA0, pA1, alA, l_reg, pa0, pa1, pa2, pa3); SBAR();
  pv_d0(o, vb0, pa0, pa1, pa2, pa3); MASKT(pB0, pB1, NT - 1); partialSM(pB0, pB1, m_reg, mnB, alB);
  __syncthreads(); RESC(alB);
  finishSM(pB0, pB1, alB, l_reg, pa0, pa1, pa2, pa3); SBAR();
  pv_d0(o, vb0 + (int)SHM_V, pa0, pa1, pa2, pa3);
  if (MODE == 1) { constexpr float C = SCALE * 1.4426950408889634f; l_reg += __builtin_amdgcn_exp2f(sink * 1.4426950408889634f - m_reg * C); }
  if (hi == 0) li_l[r32] = l_reg; asm volatile("s_waitcnt lgkmcnt(0)" ::: "memory");
  float rli[16];
#pragma unroll
  for (int r = 0; r < 16; ++r) rli[r] = __builtin_amdgcn_rcpf(li_l[crow(r, hi)]);
  bf16* Ow = Ob + (long)(wid * QBLK) * LDO;
#pragma unroll
  for (int r = 0; r < 16; ++r) { int orow = crow(r, hi);
    for (int d0 = 0; d0 < 4; ++d0) Ow[(long)orow * LDO + d0 * 32 + r32] = (bf16)f2bf(o[d0][r] * rli[r]); }
  asm volatile("s_waitcnt vmcnt(0) lgkmcnt(0)" ::: "memory");
  __syncthreads();
#undef TK0
#undef SLOAD
#undef SWRITE
#undef SWAIT
#undef RESC
#undef MASKT
}
#undef KSWZ
#undef SBAR
}

struct Args { const float* in[36]; float* out; unsigned char* ws; int ph_lo, ph_hi; };
enum { I_X = 0, I_C, I_CTX, I_CCTX, I_WMOD, I_BMOD, I_GMIX, I_GFFN, I_WGRP, I_BGRP, I_WRT, I_BRT, I_W1, I_W3, I_W2, I_ABIN, I_ABOUT, I_SCONVW, I_SCONVB,
       I_DTBIAS, I_ALOG, I_SSDD, I_SNORMG, I_QG, I_KG, I_CDIN, I_CDOUT, I_LCONVW, I_LCONVB, I_LWA, I_LBA, I_LWX, I_LBX, I_LAM, I_SINK, I_GFINAL };

struct Ctx {
    const float* const* in; float* out; unsigned char* ws;
    int bid, G;
    __device__ __forceinline__ unsigned* ctl() const { return (unsigned*)(ws + WS_CTL); }
    __device__ __forceinline__ float* mod(int layer, int mv) const { return (float*)(ws + WS_MOD) + (size_t)(layer * 3 + mv) * 6144; }
    __device__ __forceinline__ float* xc() const { return (float*)(ws + WS_XC); }
    __device__ __forceinline__ float* xrow(int r) const { const int b = r / BROWS, q = r - b * BROWS; return q < CTXL ? xc() + (size_t)(b * CTXL + q) * DM : out + (size_t)(b * SEQL + (q - CTXL)) * DM; }
    __device__ __forceinline__ const float* xin_row(int r) const { const int b = r / BROWS, q = r - b * BROWS; return q < CTXL ? in[I_CTX] + (size_t)(b * CTXL + q) * DM : in[I_X] + (size_t)(b * SEQL + (q - CTXL)) * DM; }
};
struct TC { int tid, lane, wave; };
__device__ __forceinline__ TC phase_tc() { TC t; int x = threadIdx.x; asm volatile("" : "+v"(x)); t.tid = x; t.lane = x & 63; t.wave = __builtin_amdgcn_readfirstlane(x >> 6); return t; }
__device__ __forceinline__ int row_mv(int r) { const int b = r / BROWS, q = r - b * BROWS; return q < CTXL ? 2 : b; }

struct RowSched {
    int nM, nN, nwg, G, c, skipctx; const char* A; const char* Bt; size_t a_tile, b_tile;
    __device__ __forceinline__ bool next(int i, pg8::Unit& u) const {
        const long L = (long)i * G + c; if (L >= nwg) return false;
        int wgid = (int)L; { const int q = nwg / 8, r = nwg % 8, xcd = wgid % 8, off = wgid / 8; wgid = (xcd < r ? xcd * (q + 1) : r * (q + 1) + (xcd - r) * q) + off; }
        const int nig = 8 * nN, gid = wgid / nig, fm = gid * 8, gsz = (nM - fm) < 8 ? (nM - fm) : 8;
        const int pmi = fm + ((wgid % nig) % gsz); u.pn = (wgid % nig) / gsz;
        u.pm = skipctx ? (pmi / 32) * 33 + 1 + (pmi % 32) : pmi;
        u.a = A + (size_t)u.pm * a_tile; u.b = Bt + (size_t)u.pn * b_tile; u.bd = 0; return true;
    }
};
struct MoeSched {
    const int* mt; int G, c, which; const char* A; const char* W; size_t a_tile;
    __device__ __forceinline__ bool next(int i, pg8::Unit& u) const {
        const int ntl = mt[0]; const long L = (long)i * G + c; if (L >= (long)ntl * 4) return false;
        const int tile = (int)(L >> 2), pn = (int)(L & 3), cls = mt[1 + tile], g = cls / 6, pi = cls - g * 6;
        const int ia = pi < 3 ? 0 : (pi < 5 ? 1 : 2), ib = pi < 3 ? pi + 1 : (pi < 5 ? pi - 1 : 3);
        const int ea = g * 4 + ia, eb = g * 4 + ib;
        u.pm = tile; u.pn = pn; u.a = A + (size_t)tile * a_tile;
        if (which == 1) { const int e = (pn >> 1) ? eb : ea; u.b = W + ((size_t)e * 512 + (pn & 1) * 256) * 1024 * 2; u.bd = 0; }
        else { u.b = W + ((size_t)ea * 1024 + pn * 256) * 256 * 2; u.bd = (long)(eb - ea) * 1024 * 256 * 2 - 4 * 128; }
        return true;
    }
};

struct EpiProj {
    static constexpr bool PERM = true;
    bf16 *d0, *d1, *d2, *d3, *d4, *d5; int e0, e1, e2, e3, e4; int l0, l1, l2, l3, l4, l5; int lastcols;
    __device__ __forceinline__ void operator()(const f32x4 (&acc)[2][2][4][2], const pg8::Unit& u, int wr, int wc, int fr, int fq) const {
        const int pn = u.pn; bf16* base; int ld, tl, ncol = 256;
        if (pn < e0) { base = d0; ld = l0; tl = pn; } else if (pn < e1) { base = d1; ld = l1; tl = pn - e0; } else if (pn < e2) { base = d2; ld = l2; tl = pn - e1; }
        else if (pn < e3) { base = d3; ld = l3; tl = pn - e2; } else if (pn < e4) { base = d4; ld = l4; tl = pn - e3; } else { base = d5; ld = l5; tl = pn - e4; ncol = lastcols; }
        const int row0 = u.pm * 256 + wr * 64 + fr, col0 = wc * 32 + 8 * fq;
#pragma unroll
        for (int ai = 0; ai < 2; ++ai)
#pragma unroll
            for (int m = 0; m < 4; ++m) { bf16* rowp = base + (size_t)(row0 + ai * 128 + m * 16) * ld + tl * 256 + col0;
#pragma unroll
                for (int bj = 0; bj < 2; ++bj) { if (col0 + bj * 128 < ncol) { const f32x4 v0 = acc[ai][bj][m][0], v1 = acc[ai][bj][m][1];
                    u32x4 w; w.x = pg8::cvt_pk_bf16(v0[0], v0[1]); w.y = pg8::cvt_pk_bf16(v0[2], v0[3]); w.z = pg8::cvt_pk_bf16(v1[0], v1[1]); w.w = pg8::cvt_pk_bf16(v1[2], v1[3]);
                    *(u32x4*)(rowp + bj * 128) = w; } } }
    }
};
struct EpiRes {
    static constexpr bool PERM = false;
    const float* xin_lat; const float* xin_ctx; float* xout_lat; float* xout_ctx; const float* modbase;
    __device__ __forceinline__ void operator()(const f32x4 (&acc)[2][2][4][2], const pg8::Unit& u, int wr, int wc, int fr, int fq) const {
        const int b = u.pm / 33, qt = u.pm - b * 33; const bool isctx = (qt == 0);
        const size_t rbase = isctx ? (size_t)b * CTXL : (size_t)b * SEQL + (size_t)(qt - 1) * 256;
        const float* xi = (isctx ? xin_ctx : xin_lat) + rbase * DM; float* xo = (isctx ? xout_ctx : xout_lat) + rbase * DM;
        const float* gate = modbase + (size_t)(isctx ? 2 : b) * 6144 + 2 * 1024;
        const int row0 = wr * 64 + fr, col0 = u.pn * 256 + wc * 32 + 4 * fq;
        f32x4 gv[2][2];
#pragma unroll
        for (int bj = 0; bj < 2; ++bj)
#pragma unroll
            for (int n = 0; n < 2; ++n) gv[bj][n] = *(const f32x4*)(gate + col0 + bj * 128 + n * 16);
#pragma unroll
        for (int ai = 0; ai < 2; ++ai)
#pragma unroll
            for (int m = 0; m < 4; ++m) { const size_t off = (size_t)(row0 + ai * 128 + m * 16) * DM + col0;
#pragma unroll
                for (int bj = 0; bj < 2; ++bj)
#pragma unroll
                    for (int n = 0; n < 2; ++n) { const f32x4 xv = *(const f32x4*)(xi + off + bj * 128 + n * 16);
                        *(f32x4*)(xo + off + bj * 128 + n * 16) = xv + gv[bj][n] * acc[ai][bj][m][n]; } }
    }
};
struct EpiMoe1 {
    static constexpr bool PERM = true;
    bf16* H; const float* gab;
    __device__ __forceinline__ void operator()(const f32x4 (&acc)[2][2][4][2], const pg8::Unit& u, int wr, int wc, int fr, int fq) const {
        const int row0 = u.pm * 256 + wr * 64 + fr, colh = (u.pn >> 1) * 256 + (u.pn & 1) * 128 + wc * 32 + 8 * fq, which = u.pn >> 1;
#pragma unroll
        for (int ai = 0; ai < 2; ++ai)
#pragma unroll
            for (int m = 0; m < 4; ++m) { const int slot = row0 + ai * 128 + m * 16; const float gt = gab[(size_t)slot * 2 + which];
                float hv[8];
#pragma unroll
                for (int n = 0; n < 2; ++n)
#pragma unroll
                    for (int e = 0; e < 4; ++e) { const float a = acc[ai][0][m][n][e], uu = acc[ai][1][m][n][e]; hv[n * 4 + e] = silu_f(a) * uu * gt; }
                u32x4 w; w.x = pg8::cvt_pk_bf16(hv[0], hv[1]); w.y = pg8::cvt_pk_bf16(hv[2], hv[3]); w.z = pg8::cvt_pk_bf16(hv[4], hv[5]); w.w = pg8::cvt_pk_bf16(hv[6], hv[7]);
                *(u32x4*)(H + (size_t)slot * 512 + colh) = w; }
    }
};
struct EpiMoe2 {
    static constexpr bool PERM = false;
    const int* tok; float* out; float* xc; const float* modbase;
    __device__ __forceinline__ void operator()(const f32x4 (&acc)[2][2][4][2], const pg8::Unit& u, int wr, int wc, int fr, int fq) const {
        const int row0 = u.pm * 256 + wr * 64 + fr, col0 = u.pn * 256 + wc * 32 + 4 * fq;
#ifdef MOE2_DUMMY
        for (int ai = 0; ai < 2; ++ai) for (int m = 0; m < 4; ++m) for (int bj = 0; bj < 2; ++bj) for (int n = 0; n < 2; ++n) *(f32x4*)(out + (size_t)(row0 + ai * 128 + m * 16) * 1024 + col0 + bj * 128 + n * 16) = acc[ai][bj][m][n];
        return;
#endif
#pragma unroll
        for (int ai = 0; ai < 2; ++ai)
#pragma unroll
            for (int m = 0; m < 4; ++m) { const int slot = row0 + ai * 128 + m * 16; int r = tok[slot];
                asm volatile("" : "+v"(r) :: "memory");
                if (r >= 0) { const int b = r / BROWS, q = r - b * BROWS; const bool isctx = q < CTXL;
                    float* xp = isctx ? xc + (size_t)(b * CTXL + q) * DM : out + (size_t)(b * SEQL + (q - CTXL)) * DM;
                    const float* gate = modbase + (size_t)(isctx ? 2 : b) * 6144 + 5 * 1024;
#pragma unroll
                    for (int bj = 0; bj < 2; ++bj)
#pragma unroll
                        for (int n = 0; n < 2; ++n) { const int c = col0 + bj * 128 + n * 16; const f32x4 gv = *(const f32x4*)(gate + c); const f32x4 xv = *(const f32x4*)(xp + c);
                            *(f32x4*)(xp + c) = xv + gv * acc[ai][bj][m][n]; } }
                asm volatile("" ::: "memory"); }
    }
};

__device__ __forceinline__ void transpose_item(const float* W, int ldw, int k0, int n0src, bf16* WT, int ldt, int drow0, int dk0, LAS float* scr, int lane) {
#pragma unroll 8
    for (int i = 0; i < 32; ++i) { const int kk = 2 * i + (lane >> 5); scr[kk * 33 + (lane & 31)] = n0src >= 0 ? W[(size_t)(k0 + kk) * ldw + n0src + (lane & 31)] : 0.f; }
    asm volatile("s_waitcnt lgkmcnt(0)" ::: "memory");
    const int c = lane & 7;
#pragma unroll
    for (int j = 0; j < 4; ++j) { const int n = (lane >> 3) + 8 * j; const LAS float* s = scr + (8 * c) * 33 + n;
        u32x4 o; o.x = pk2(s[0 * 33], s[1 * 33]); o.y = pk2(s[2 * 33], s[3 * 33]); o.z = pk2(s[4 * 33], s[5 * 33]); o.w = pk2(s[6 * 33], s[7 * 33]);
        *(u32x4*)(WT + (size_t)(drow0 + n) * ldt + dk0 + 8 * c) = o; }
    asm volatile("s_waitcnt lgkmcnt(0)" ::: "memory");
}
__device__ __forceinline__ int ab_src_col(int n) {
    if (n < 2304) return n;
    if (n < 3840) return n + 32;
    if (n < 3872) return n - 3840 + 2304;
    return -1;
}
__device__ __forceinline__ void ph_convert(const Ctx& C, int layer, LAS unsigned char* lds) {
    const TC T = phase_tc();
    LAS float* scr = (LAS float*)(lds + T.wave * 16384);
    const int gw = C.bid * NWAVES + T.wave, NGW = C.G * NWAVES;
    bf16* Win = (bf16*)(C.ws + WS_WIN); bf16* Wout = (bf16*)(C.ws + WS_WOUT); bf16* W13 = (bf16*)(C.ws + WS_W13); bf16* W2 = (bf16*)(C.ws + WS_W2);
    const int nin = layer == 0 ? 4096 : 3584;
    const int I_IN = 16 * (nin / 32), I_OUT = 32 * 32, I_E = 16 * 128;
    const int NIT = I_IN + I_OUT + 3 * I_E;
    const float* win = C.in[layer == 0 ? I_ABIN : I_CDIN]; const float* wout = C.in[layer == 0 ? I_ABOUT : I_CDOUT];
    const int ldin = layer == 0 ? 3872 : 3584;
    for (int it = gw; it < NIT; it += NGW) {
        int r = it;
        if (r < I_IN) { const int nblk = nin / 32, kb = r / nblk, nb = r % nblk; const int src = layer == 0 ? ab_src_col(nb * 32) : nb * 32;
            transpose_item(win, ldin, kb * 64, src, Win, 1024, nb * 32, kb * 64, scr, T.lane); continue; } r -= I_IN;
        if (r < I_OUT) { const int kb = r / 32, nb = r % 32; transpose_item(wout, 1024, kb * 64, nb * 32, Wout, 2048, nb * 32, kb * 64, scr, T.lane); continue; } r -= I_OUT;
        if (r < 2 * I_E) { const int w3 = r >= I_E; if (w3) r -= I_E; const int e = r / 128, q = r % 128, kb = q / 8, nb = q % 8;
            const float* W = C.in[w3 ? I_W3 : I_W1] + (size_t)(layer * 16 + e) * 1024 * 256; const int n0 = nb * 32;
            transpose_item(W, 256, kb * 64, n0, W13 + (size_t)e * 512 * 1024, 1024, (n0 / 128) * 256 + (w3 ? 128 : 0) + (n0 % 128), kb * 64, scr, T.lane); continue; } r -= 2 * I_E;
        { const int e = r / 128, q = r % 128, kb = q / 32, nb = q % 32;
            const float* W = C.in[I_W2] + (size_t)(layer * 16 + e) * 256 * 1024;
            transpose_item(W, 1024, kb * 64, nb * 32, W2 + (size_t)e * 1024 * 256, 256, nb * 32, kb * 64, scr, T.lane); }
    }
}
__device__ __forceinline__ void ph_mod(const Ctx& C, LAS unsigned char* lds) {
    const TC T = phase_tc();
    LAS float* red = (LAS float*)lds;
    for (int item = C.bid; item < 48; item += C.G) {
        const int layer = item / 24, chunk = item % 24;
        const float* W = C.in[I_WMOD] + (size_t)layer * 1024 * 6144 + chunk * 256 + T.lane * 4;
        f32x4 a0 = {0, 0, 0, 0}, a1 = a0, a2 = a0;
        const int d0 = T.wave * 128;
        for (int d = d0; d < d0 + 128; ++d) {
            const f32x4 w = *(const f32x4*)(W + (size_t)d * 6144);
            const float c0 = silu_f(C.in[I_C][d]), c1 = silu_f(C.in[I_C][1024 + d]), c2 = silu_f(C.in[I_CCTX][d]);
            a0 += w * c0; a1 += w * c1; a2 += w * c2;
        }
        __syncthreads();
#pragma unroll
        for (int e = 0; e < 4; ++e) { red[(T.wave * 3 + 0) * 256 + T.lane * 4 + e] = a0[e]; red[(T.wave * 3 + 1) * 256 + T.lane * 4 + e] = a1[e]; red[(T.wave * 3 + 2) * 256 + T.lane * 4 + e] = a2[e]; }
        __syncthreads();
        for (int o = T.tid; o < 768; o += NTHREADS) { const int v = o >> 8, j = o & 255; float s = 0.f;
#pragma unroll
            for (int w = 0; w < 8; ++w) s += red[(w * 3 + v) * 256 + j];
            C.mod(layer, v)[chunk * 256 + j] = s + C.in[I_BMOD][layer * 6144 + chunk * 256 + j]; }
        __syncthreads();
    }
}
__device__ __forceinline__ void ph_prenorm(const Ctx& C, int layer) {
    const TC T = phase_tc();
    bf16* HN = (bf16*)(C.ws + WS_A);
    const float* gm = C.in[I_GMIX] + layer * 1024;
    const int gw = C.bid * NWAVES + T.wave, NGW = C.G * NWAVES;
    for (int r = gw; r < NROWS; r += NGW) {
        const float* xr = layer == 0 ? C.xin_row(r) : C.xrow(r);
        const float* md = C.mod(layer, row_mv(r));
        f32x4 v[4]; float ss = 0.f;
#pragma unroll
        for (int j = 0; j < 4; ++j) { v[j] = *(const f32x4*)(xr + 256 * j + 4 * T.lane); ss += (v[j].x * v[j].x + v[j].y * v[j].y) + (v[j].z * v[j].z + v[j].w * v[j].w); }
        const float rs = rsqrtf(wave_sum(ss) * (1.f / DM) + EPS);
#pragma unroll
        for (int j = 0; j < 4; ++j) { const int c = 256 * j + 4 * T.lane; const f32x4 g = *(const f32x4*)(gm + c), sc = *(const f32x4*)(md + 1024 + c), sh = *(const f32x4*)(md + c);
            const f32x4 h = v[j] * rs * g * (sc + 1.f) + sh;
            u32x2 w; w.x = pk2(h.x, h.y); w.y = pk2(h.z, h.w); *(u32x2*)(HN + (size_t)r * DM + c) = w; }
    }
}
__device__ __forceinline__ bool nb_valid(int r, int dk) { const int b = r / BROWS, q = r - b * BROWS; if (q < CTXL) { const int t = q + dk; return t >= 0 && t < CTXL; } const int t = q - CTXL + dk; return t >= 0 && t < SEQL; }
__device__ __forceinline__ void rope_angle(int r, int lane, float& cs, float& sn, bool& latent) {
    const int b = r / BROWS, q = r - b * BROWS; latent = q >= CTXL; const int t = q - CTXL;
    const int pos = lane < 32 ? (t >> 6) : (t & 63); const int jf = lane & 31;
    const float inv = exp2f(-(float)jf * (13.287712379549449f / 32.f));
    const float ang = (float)pos * inv; sincosf(ang, &sn, &cs);
}
__device__ __forceinline__ void ph_elem0(const Ctx& C) {
    const TC T = phase_tc();
    const bf16* RAW = (const bf16*)(C.ws + WS_RAW); bf16* XBC = (bf16*)(C.ws + WS_A);
    const bf16* DTR = (const bf16*)(C.ws + WS_DTR); float* DT = (float*)(C.ws + WS_DT);
    bf16* Q = (bf16*)(C.ws + WS_YMIX) + 1024; bf16* K = (bf16*)(C.ws + WS_K);
    const float* cw = C.in[I_SCONVW]; const float* cb = C.in[I_SCONVB];
    const int gw = C.bid * NWAVES + T.wave, NGW = C.G * NWAVES, lane = T.lane;
    for (int r = gw; r < NROWS; r += NGW) {
        for (int ch = lane; ch < 160; ch += 64) { const int c0 = ch * 8; float acc[8];
#pragma unroll
            for (int e = 0; e < 8; ++e) acc[e] = cb[c0 + e];
#pragma unroll
            for (int k = 0; k < 5; ++k) { if (nb_valid(r, k - 2)) { const u32x4 w = *(const u32x4*)(RAW + (size_t)(r + k - 2) * 1280 + c0); float xv[8]; unpack8(w, xv);
#pragma unroll
                for (int e = 0; e < 8; ++e) acc[e] += xv[e] * cw[k * 1280 + c0 + e]; } }
            u32x4 o; o.x = pk2(silu_f(acc[0]), silu_f(acc[1])); o.y = pk2(silu_f(acc[2]), silu_f(acc[3])); o.z = pk2(silu_f(acc[4]), silu_f(acc[5])); o.w = pk2(silu_f(acc[6]), silu_f(acc[7]));
            *(u32x4*)(XBC + (size_t)r * 1280 + c0) = o; }
        if (lane < 32) DT[(size_t)r * 32 + lane] = softplus_f(bf2f(DTR[(size_t)r * 32 + lane]) + C.in[I_DTBIAS][lane]);
        float cs, sn; bool latent; rope_angle(r, lane, cs, sn, latent);
        const float qg0 = C.in[I_QG][lane], qg1 = C.in[I_QG][64 + lane], kg0 = C.in[I_KG][lane], kg1 = C.in[I_KG][64 + lane];
#pragma unroll
        for (int h = 0; h < 10; ++h) { bf16* p = h < 8 ? Q + (size_t)r * 2048 + h * 128 : K + (size_t)r * 256 + (h - 8) * 128;
            float t1 = bf2f(p[lane]), t2 = bf2f(p[64 + lane]);
            const float rs = rsqrtf(wave_sum(t1 * t1 + t2 * t2) * (1.f / 128.f) + EPS);
            t1 = t1 * rs * (h < 8 ? qg0 : kg0); t2 = t2 * rs * (h < 8 ? qg1 : kg1);
            if (latent) { const float o1 = t1 * cs - t2 * sn, o2 = t1 * sn + t2 * cs; t1 = o1; t2 = o2; }
            p[lane] = (bf16)f2bf(t1); p[64 + lane] = (bf16)f2bf(t2); }
    }
}
__device__ __forceinline__ void ph_elem1(const Ctx& C) {
    const TC T = phase_tc();
    const bf16* RAW = (const bf16*)(C.ws + WS_RAW); bf16* XR = (bf16*)(C.ws + WS_A);
    bf16* Q = (bf16*)(C.ws + WS_YMIX) + 1024; bf16* K = (bf16*)(C.ws + WS_K);
    const float* cw = C.in[I_LCONVW]; const float* cb = C.in[I_LCONVB];
    const int gw = C.bid * NWAVES + T.wave, NGW = C.G * NWAVES, lane = T.lane;
    for (int r = gw; r < NROWS; r += NGW) {
        for (int ch = lane; ch < 128; ch += 64) { const int c0 = ch * 8; float acc[8];
#pragma unroll
            for (int e = 0; e < 8; ++e) acc[e] = cb[c0 + e];
#pragma unroll
            for (int k = 0; k < 5; ++k) { if (nb_valid(r, k - 2)) { const u32x4 w = *(const u32x4*)(RAW + (size_t)(r + k - 2) * 1024 + c0); float xv[8]; unpack8(w, xv);
#pragma unroll
                for (int e = 0; e < 8; ++e) acc[e] += xv[e] * cw[k * 1024 + c0 + e]; } }
            u32x4 o; o.x = pk2(acc[0], acc[1]); o.y = pk2(acc[2], acc[3]); o.z = pk2(acc[4], acc[5]); o.w = pk2(acc[6], acc[7]);
            *(u32x4*)(XR + (size_t)r * 1024 + c0) = o; }
        float cs, sn; bool latent; rope_angle(r, lane, cs, sn, latent);
        if (latent) {
#pragma unroll
            for (int h = 0; h < 10; ++h) { bf16* p = h < 8 ? Q + (size_t)r * 2048 + h * 128 : K + (size_t)r * 256 + (h - 8) * 128;
                const float t1 = bf2f(p[lane]), t2 = bf2f(p[64 + lane]);
                p[lane] = (bf16)f2bf(t1 * cs - t2 * sn); p[64 + lane] = (bf16)f2bf(t1 * sn + t2 * cs); }
        }
    }
}
__device__ __forceinline__ int step_row(int dir, int s) { return dir == 0 ? s : (s < CTXL ? CTXL - 1 - s : BROWS + CTXL - 1 - s); }
__device__ __forceinline__ void ssd_seq_unit(const Ctx& C, int item, LAS unsigned char* lds) {
    const TC T = phase_tc();
    const int b = item >> 5, dir = (item >> 4) & 1, h = item & 15, g = h >> 3, lane = T.lane, wid = T.wave;
    LAS float* part = (LAS float*)lds;
    LAS float* xs = part + 8 * 32 * 64; LAS float* Bs = xs + 32 * 64; LAS float* Cs = Bs + 32 * 64; LAS float* dts = Cs + 32 * 64;
    const float aneg = -__expf(C.in[I_ALOG][dir * 16 + h]);
    const bf16* XBC = (const bf16*)(C.ws + WS_A) + (size_t)b * BROWS * 1280;
    const float* DT = (const float*)(C.ws + WS_DT) + (size_t)b * BROWS * 32 + dir * 16 + h;
    bf16* Y = dir == 0 ? (bf16*)(C.ws + WS_YMIX) + (size_t)b * BROWS * 2048 + h * 64 : (bf16*)(C.ws + WS_RAW) + (size_t)b * BROWS * 1024 + h * 64;
    const int ldy = dir == 0 ? 2048 : 1024;
    float hs[8];
#pragma unroll
    for (int k = 0; k < 8; ++k) hs[k] = 0.f;
    for (int s0 = 0; s0 < BROWS; s0 += 32) {
        for (int i = T.tid; i < 32 * 192; i += NTHREADS) { const int tt = i / 192, c = i - tt * 192; const int q = step_row(dir, s0 + tt);
            const bf16* row = XBC + (size_t)q * 1280;
            if (c < 64) xs[tt * 64 + c] = bf2f(row[h * 64 + c]); else if (c < 128) Bs[tt * 64 + c - 64] = bf2f(row[1024 + g * 64 + c - 64]); else Cs[tt * 64 + c - 128] = bf2f(row[1152 + g * 64 + c - 128]); }
        if (T.tid < 32) dts[T.tid] = DT[(size_t)step_row(dir, s0 + T.tid) * 32];
        __syncthreads();
        for (int tt = 0; tt < 32; ++tt) {
            const float x = xs[tt * 64 + lane], dt = dts[tt];
            const f32x4 b0 = *(const LAS f32x4*)(Bs + tt * 64 + wid * 8), b1 = *(const LAS f32x4*)(Bs + tt * 64 + wid * 8 + 4);
            const f32x4 c0 = *(const LAS f32x4*)(Cs + tt * 64 + wid * 8), c1 = *(const LAS f32x4*)(Cs + tt * 64 + wid * 8 + 4);
            const float a = __expf(dt * aneg), dx = dt * x; float y = 0.f;
#pragma unroll
            for (int k = 0; k < 4; ++k) { hs[k] = a * hs[k] + dx * b0[k]; y += c0[k] * hs[k]; }
#pragma unroll
            for (int k = 0; k < 4; ++k) { hs[4 + k] = a * hs[4 + k] + dx * b1[k]; y += c1[k] * hs[4 + k]; }
            part[(wid * 32 + tt) * 64 + lane] = y;
        }
        __syncthreads();
        for (int i = T.tid; i < 2048; i += NTHREADS) { const int tt = i >> 6, p = i & 63; float s = 0.f;
#pragma unroll
            for (int w = 0; w < 8; ++w) s += part[(w * 32 + tt) * 64 + p];
            const int q = step_row(dir, s0 + tt); Y[(size_t)q * ldy + p] = (bf16)f2bf(s); }
        __syncthreads();
    }
}
__device__ __forceinline__ void lru_seq_unit(const Ctx& C, int item, LAS unsigned char* lds) {
    const TC T = phase_tc();
    const int b = item >> 5, dir = (item >> 4) & 1, hb = item & 15, lane = T.lane, wid = T.wave;
    LAS float* wa = (LAS float*)lds; LAS float* wx = wa + 4096; LAS float* xs = wx + 4096; LAS float* as_ = xs + 512; LAS float* bs_ = as_ + 512;
    const float* gwa = C.in[I_LWA] + (size_t)(dir * 16 + hb) * 4096; const float* gwx = C.in[I_LWX] + (size_t)(dir * 16 + hb) * 4096;
    for (int i = T.tid; i < 4096; i += NTHREADS) { wa[i] = gwa[i]; wx[i] = gwx[i]; }
    const int c = hb * 64 + lane;
    const float ba = C.in[I_LBA][dir * 1024 + c], bx = C.in[I_LBX][dir * 1024 + c], logbase = -8.f * softplus_f(-C.in[I_LAM][dir * 1024 + c]);
    const bf16* XR = (const bf16*)(C.ws + WS_A) + (size_t)b * BROWS * 1024 + hb * 64;
    bf16* Y = dir == 0 ? (bf16*)(C.ws + WS_YMIX) + (size_t)b * BROWS * 2048 + hb * 64 : (bf16*)(C.ws + WS_RAW) + (size_t)b * BROWS * 1024 + hb * 64;
    const int ldy = dir == 0 ? 2048 : 1024;
    float hst = 0.f;
    __syncthreads();
    unsigned short xnext = XR[(size_t)step_row(dir, wid) * 1024 + lane];
    for (int it = 0; it < BROWS / 8; ++it) {
        const float xv = bf2f(xnext);
        if (it + 1 < BROWS / 8) xnext = XR[(size_t)step_row(dir, (it + 1) * 8 + wid) * 1024 + lane];
        xs[wid * 64 + lane] = xv;
        asm volatile("s_waitcnt lgkmcnt(0)" ::: "memory");
        float pa = ba, px = bx;
#pragma unroll 8
        for (int i = 0; i < 64; ++i) { const float xi = xs[wid * 64 + i]; pa += xi * wa[i * 64 + lane]; px += xi * wx[i * 64 + lane]; }
        const float la = logbase * sigmoid_f(pa), a = __expf(la), bc = sqrtf(-expm1f(2.f * la)) * sigmoid_f(px) * xv;
        as_[wid * 64 + lane] = a; bs_[wid * 64 + lane] = bc;
        __syncthreads();
        if (wid == 0) {
#pragma unroll
            for (int tt = 0; tt < 8; ++tt) { hst = as_[tt * 64 + lane] * hst + bs_[tt * 64 + lane]; const int q2 = step_row(dir, it * 8 + tt); Y[(size_t)q2 * ldy + lane] = (bf16)f2bf(hst); }
        }
        __syncthreads();
    }
}
__device__ __forceinline__ int queue_pop(const Ctx& C, unsigned* qword, LAS unsigned char* lds) {
    const TC T = phase_tc();
    LAS int* slot = (LAS int*)(lds + LDS_BYTES - 64);
    __syncthreads();
    if (T.tid == 0) slot[0] = (int)atomicAdd(qword, 1u);
    __syncthreads();
    const int v = slot[0];
    return __builtin_amdgcn_readfirstlane(v);
}
__device__ __forceinline__ void ph_mix0(const Ctx& C, LAS unsigned char* lds, char* ldsg) {
    bf16* YM = (bf16*)(C.ws + WS_YMIX); const bf16* K = (const bf16*)(C.ws + WS_K); const bf16* V = (const bf16*)(C.ws + WS_V);
    for (;;) {
        const int item = queue_pop(C, C.ctl() + CW_Q0, lds);
        if (item >= 64 + 512 + 16) break;
        if (item < 64) { ssd_seq_unit(C, item, lds); continue; }
        const int a = item - 64;
        if (a < 512) { const int hr = a & 3, qb = (a >> 2) & 31, kvh = (a >> 7) & 1, b = a >> 8, h = kvh * 4 + hr;
            bf16* Qb = YM + ((size_t)b * BROWS + CTXL + (size_t)qb * 256) * 2048 + 1024 + h * 128;
            att::attn_body<0>(Qb, K + (size_t)b * BROWS * 256 + kvh * 128, V + (size_t)b * BROWS * 256 + kvh * 128, Qb, BROWS / 64, 0, 0, 0.f, ldsg);
        } else { const int a2 = a - 512, b = a2 >> 3, h = a2 & 7, kvh = h >> 2;
            bf16* Qb = YM + ((size_t)b * BROWS) * 2048 + 1024 + h * 128;
            att::attn_body<0>(Qb, K + (size_t)b * BROWS * 256 + kvh * 128, V + (size_t)b * BROWS * 256 + kvh * 128, Qb, CTXL / 64, 0, 0, 0.f, ldsg);
        }
    }
}
__device__ __forceinline__ void ph_mix1(const Ctx& C, LAS unsigned char* lds, char* ldsg) {
    bf16* YM = (bf16*)(C.ws + WS_YMIX); const bf16* K = (const bf16*)(C.ws + WS_K); const bf16* V = (const bf16*)(C.ws + WS_V);
    for (;;) {
        const int item = queue_pop(C, C.ctl() + CW_Q1, lds);
        if (item >= 64 + 512) break;
        if (item < 64) { lru_seq_unit(C, item, lds); continue; }
        const int a = item - 64, hr = a & 3, qb = (a >> 2) & 31, kvh = (a >> 7) & 1, b = a >> 8, h = kvh * 4 + hr;
        const int q0 = qb * 256, lo = q0 - 128 < 0 ? 0 : q0 - 128, hi_ = q0 + 384 > SEQL ? SEQL : q0 + 384;
        bf16* Qb = YM + ((size_t)b * BROWS + CTXL + (size_t)q0) * 2048 + 1024 + h * 128;
        att::attn_body<1>(Qb, K + (size_t)b * BROWS * 256 + kvh * 128, V + (size_t)b * BROWS * 256 + kvh * 128, Qb, 4 + (hi_ - lo) / 64, CTXL + lo, q0, C.in[I_SINK][h], ldsg);
    }
}
__device__ __forceinline__ void ph_ssdpost(const Ctx& C) {
    const TC T = phase_tc();
    bf16* YM = (bf16*)(C.ws + WS_YMIX); const bf16* YB = (const bf16*)(C.ws + WS_RAW); const bf16* XBC = (const bf16*)(C.ws + WS_A); const bf16* Z = (const bf16*)(C.ws + WS_Z);
    const int gw = C.bid * NWAVES + T.wave, NGW = C.G * NWAVES, lane = T.lane;
    for (int r = gw; r < NROWS; r += NGW) {
        float v[16]; float ss = 0.f;
#pragma unroll
        for (int j = 0; j < 2; ++j) { const int c0 = j * 512 + lane * 8;
            const u32x4 wy = *(const u32x4*)(YM + (size_t)r * 2048 + c0), wb = *(const u32x4*)(YB + (size_t)r * 1024 + c0), wx = *(const u32x4*)(XBC + (size_t)r * 1280 + c0), wz = *(const u32x4*)(Z + (size_t)r * 1024 + c0);
            float fy[8], fb[8], fx[8], fz[8]; unpack8(wy, fy); unpack8(wb, fb); unpack8(wx, fx); unpack8(wz, fz);
            const float dsk = C.in[I_SSDD][c0 >> 6];
#pragma unroll
            for (int e = 0; e < 8; ++e) { const float y = (fy[e] + fb[e] + dsk * fx[e]) * silu_f(fz[e]); v[j * 8 + e] = y; ss += y * y; } }
        const float rs = rsqrtf(wave_sum(ss) * (1.f / 1024.f) + EPS);
#pragma unroll
        for (int j = 0; j < 2; ++j) { const int c0 = j * 512 + lane * 8; const float* ng = C.in[I_SNORMG] + c0;
            u32x4 o; o.x = pk2(v[j * 8 + 0] * rs * ng[0], v[j * 8 + 1] * rs * ng[1]); o.y = pk2(v[j * 8 + 2] * rs * ng[2], v[j * 8 + 3] * rs * ng[3]);
            o.z = pk2(v[j * 8 + 4] * rs * ng[4], v[j * 8 + 5] * rs * ng[5]); o.w = pk2(v[j * 8 + 6] * rs * ng[6], v[j * 8 + 7] * rs * ng[7]);
            *(u32x4*)(YM + (size_t)r * 2048 + c0) = o; }
    }
}
__device__ __forceinline__ void ph_lrupost(const Ctx& C) {
    const TC T = phase_tc();
    bf16* YM = (bf16*)(C.ws + WS_YMIX); const bf16* YB = (const bf16*)(C.ws + WS_RAW); const bf16* GT = (const bf16*)(C.ws + WS_Z);
    const int gw = C.bid * NWAVES + T.wave, NGW = C.G * NWAVES, lane = T.lane;
    for (int r = gw; r < NROWS; r += NGW) {
        if (r % BROWS < CTXL) continue;
#pragma unroll
        for (int j = 0; j < 2; ++j) { const int c0 = j * 512 + lane * 8;
            const u32x4 wy = *(const u32x4*)(YM + (size_t)r * 2048 + c0), wb = *(const u32x4*)(YB + (size_t)r * 1024 + c0), wg = *(const u32x4*)(GT + (size_t)r * 1024 + c0);
            float fy[8], fb[8], fg[8], o[8]; unpack8(wy, fy); unpack8(wb, fb); unpack8(wg, fg);
#pragma unroll
            for (int e = 0; e < 8; ++e) o[e] = gelu_tanh_f(fg[e]) * (fy[e] + fb[e]);
            u32x4 w; w.x = pk2(o[0], o[1]); w.y = pk2(o[2], o[3]); w.z = pk2(o[4], o[5]); w.w = pk2(o[6], o[7]);
            *(u32x4*)(YM + (size_t)r * 2048 + c0) = w; }
    }
}
__device__ __forceinline__ void ph_route(const Ctx& C, int layer, LAS unsigned char* lds) {
    const TC T = phase_tc();
    LAS float* Wt = (LAS float*)lds;
    const float* wg = C.in[I_WGRP] + (size_t)layer * 1024 * 4; const float* wr = C.in[I_WRT] + (size_t)layer * 1024 * 16;
    for (int i = T.tid; i < 4096; i += NTHREADS) Wt[(i & 3) * 1024 + (i >> 2)] = wg[i];
    for (int i = T.tid; i < 16384; i += NTHREADS) Wt[(4 + (i & 15)) * 1024 + (i >> 4)] = wr[i];
    __syncthreads();
    bf16* HN2 = (bf16*)(C.ws + WS_A); int* REC = (int*)(C.ws + WS_REC);
    unsigned* cnt = C.ctl() + CW_CNT + layer * 2048;
    const float* gf = C.in[I_GFFN] + layer * 1024;
    const int gw = C.bid * NWAVES + T.wave, NGW = C.G * NWAVES, lane = T.lane;
    for (int r = gw; r < NROWS; r += NGW) {
        if (layer == 1 && (r % BROWS) < CTXL) continue;
        const float* xr = C.xrow(r); const float* md = C.mod(layer, row_mv(r));
        f32x4 v[4]; float ss = 0.f;
#pragma unroll
        for (int j = 0; j < 4; ++j) { v[j] = *(const f32x4*)(xr + 256 * j + 4 * lane); ss += (v[j].x * v[j].x + v[j].y * v[j].y) + (v[j].z * v[j].z + v[j].w * v[j].w); }
        const float rs = rsqrtf(wave_sum(ss) * (1.f / DM) + EPS);
#pragma unroll
        for (int j = 0; j < 4; ++j) { const int c = 256 * j + 4 * lane; const f32x4 g = *(const f32x4*)(gf + c), sc = *(const f32x4*)(md + 4 * 1024 + c), sh = *(const f32x4*)(md + 3 * 1024 + c);
            v[j] = v[j] * rs * g * (sc + 1.f) + sh;
            u32x2 w; w.x = pk2(v[j].x, v[j].y); w.y = pk2(v[j].z, v[j].w); *(u32x2*)(HN2 + (size_t)r * DM + c) = w; }
        float lg[20];
#pragma unroll
        for (int o = 0; o < 20; ++o) { float s = 0.f;
#pragma unroll
            for (int j = 0; j < 4; ++j) { const f32x4 w = *(const LAS f32x4*)(Wt + o * 1024 + 256 * j + 4 * lane); s += (v[j].x * w.x + v[j].y * w.y) + (v[j].z * w.z + v[j].w * w.w); }
            lg[o] = wave_sum(s); }
        float gl[4];
#pragma unroll
        for (int k = 0; k < 4; ++k) gl[k] = lg[k] + C.in[I_BGRP][layer * 4 + k];
        int gi = 0; float gmx = gl[0];
#pragma unroll
        for (int k = 1; k < 4; ++k) if (gl[k] > gmx) { gmx = gl[k]; gi = k; }
        float den = 0.f;
#pragma unroll
        for (int k = 0; k < 4; ++k) den += __expf(gl[k] - gmx);
        const float pgrp = 1.f / den;
        float el[4];
#pragma unroll
        for (int k = 0; k < 4; ++k) { const float e0 = lg[4 + k] + C.in[I_BRT][layer * 16 + k], e1 = lg[8 + k] + C.in[I_BRT][layer * 16 + 4 + k], e2 = lg[12 + k] + C.in[I_BRT][layer * 16 + 8 + k], e3 = lg[16 + k] + C.in[I_BRT][layer * 16 + 12 + k];
            el[k] = gi == 0 ? e0 : (gi == 1 ? e1 : (gi == 2 ? e2 : e3)); }
        int i1 = 0; float v1 = el[0];
#pragma unroll
        for (int k = 1; k < 4; ++k) if (el[k] > v1) { v1 = el[k]; i1 = k; }
        int i2 = -1; float v2 = -3.4e38f;
#pragma unroll
        for (int k = 0; k < 4; ++k) if (k != i1 && el[k] > v2) { v2 = el[k]; i2 = k; }
        const float w1 = pgrp / (1.f + __expf(v2 - v1)), w2 = pgrp - w1;
        const int ia = i1 < i2 ? i1 : i2, ib = i1 < i2 ? i2 : i1; const float wa = i1 < i2 ? w1 : w2, wb = i1 < i2 ? w2 : w1;
        const int cls = gi * 6 + (ia * (7 - ia)) / 2 + (ib - ia - 1);
        if (lane == 0) { const int pos = (int)atomicAdd(cnt + cls * 64, 1u); REC[(size_t)r * 4 + 0] = cls; REC[(size_t)r * 4 + 1] = pos; REC[(size_t)r * 4 + 2] = (int)__float_as_uint(wa); REC[(size_t)r * 4 + 3] = (int)__float_as_uint(wb); }
    }
}
__device__ __forceinline__ void ph_gather(const Ctx& C, int layer, LAS unsigned char* lds) {
    const TC T = phase_tc();
    LAS int* tb = (LAS int*)lds;
    unsigned* cnt = C.ctl() + CW_CNT + layer * 2048;
    if (T.tid == 0) { int acc = 0; for (int c = 0; c < 24; ++c) { const int n = (int)__hip_atomic_load(cnt + c * 64, __ATOMIC_RELAXED, __HIP_MEMORY_SCOPE_AGENT); tb[c] = acc; tb[32 + c] = n; acc += (n + 255) >> 8; } tb[24] = acc; }
    __syncthreads();
    const bf16* HN2 = (const bf16*)(C.ws + WS_A); bf16* Xg = (bf16*)(C.ws + WS_YMIX); const int* REC = (const int*)(C.ws + WS_REC);
    int* TOK = (int*)(C.ws + WS_TOK); float* GAB = (float*)(C.ws + WS_GAB); int* MT = (int*)(C.ws + WS_MT);
    const int gw = C.bid * NWAVES + T.wave, NGW = C.G * NWAVES, lane = T.lane;
    for (int r = gw; r < NROWS; r += NGW) {
        if (layer == 1 && (r % BROWS) < CTXL) continue;
        const int cls = REC[(size_t)r * 4 + 0], pos = REC[(size_t)r * 4 + 1];
        const int slot = tb[cls] * 256 + pos;
        const u32x4* src = (const u32x4*)(HN2 + (size_t)r * DM); u32x4* dst = (u32x4*)(Xg + (size_t)slot * DM);
        dst[lane] = src[lane]; dst[64 + lane] = src[64 + lane];
        if (lane == 0) { TOK[slot] = r; GAB[(size_t)slot * 2] = __uint_as_float((unsigned)REC[(size_t)r * 4 + 2]); GAB[(size_t)slot * 2 + 1] = __uint_as_float((unsigned)REC[(size_t)r * 4 + 3]); }
    }
    for (int c = C.bid; c < 24; c += C.G) { const int n = tb[32 + c], end = ((n + 255) >> 8) << 8, base = tb[c] * 256;
        for (int p = n + T.tid; p < end; p += NTHREADS) { TOK[base + p] = -1; GAB[(size_t)(base + p) * 2] = 0.f; GAB[(size_t)(base + p) * 2 + 1] = 0.f; } }
    if (C.bid == 0) { if (T.tid == 0) MT[0] = tb[24];
        if (T.tid < 24) { const int t0 = tb[T.tid], t1 = tb[T.tid + 1]; for (int t = t0; t < t1; ++t) MT[1 + t] = T.tid; } }
}
__device__ __forceinline__ void ph_final(const Ctx& C) {
    const TC T = phase_tc();
    const float* gf = C.in[I_GFINAL];
    const int gw = C.bid * NWAVES + T.wave, NGW = C.G * NWAVES, lane = T.lane;
    for (int r = gw; r < NBATCH * SEQL; r += NGW) {
        float* xr = C.out + (size_t)r * DM;
        f32x4 v[4]; float ss = 0.f;
#pragma unroll
        for (int j = 0; j < 4; ++j) { v[j] = *(const f32x4*)(xr + 256 * j + 4 * lane); ss += (v[j].x * v[j].x + v[j].y * v[j].y) + (v[j].z * v[j].z + v[j].w * v[j].w); }
        const float rs = rsqrtf(wave_sum(ss) * (1.f / DM) + EPS);
#pragma unroll
        for (int j = 0; j < 4; ++j) { const int c = 256 * j + 4 * lane; *(f32x4*)(xr + c) = v[j] * rs * *(const f32x4*)(gf + c); }
    }
}

__global__ void __launch_bounds__(NTHREADS, 2) fwd_kernel(Args args) {
    extern __shared__ __attribute__((aligned(16))) unsigned char lds_raw[];
    LAS unsigned char* lds = (LAS unsigned char*)lds_raw;
    Ctx C; C.in = args.in; C.out = args.out; C.ws = args.ws;
    C.bid = blockIdx.x; C.G = gridDim.x;
    const int lo = args.ph_lo, hi = args.ph_hi;
    int ph = 0;
#define IN(k) (lo <= (k) && (k) < hi)
#define SEAM(k) do { if (IN(k) && IN((k) + 1)) { cg::this_grid().sync(); } } while (0)
    if (EN(0) && IN(0)) { ph_mod(C, lds); ph_convert(C, 0, lds); }
    SEAM(0);
#pragma unroll 1
    for (int layer = 0; layer < 2; ++layer) {
        const int pb = 1 + 10 * layer;
        unsigned char* ws = C.ws;
        if (EN(1) && IN(pb + 0)) { if (layer == 1) ph_convert(C, 1, lds); ph_prenorm(C, layer); }
        SEAM(pb + 0);
        if (EN(2) && IN(pb + 1)) {
            const int nN = layer == 0 ? 16 : 14;
            pg8::Gemm g{1024, 1024, 1024, 1 << 30};
            RowSched S; S.nM = 66; S.nN = nN; S.nwg = 66 * nN; S.G = C.G; S.c = C.bid; S.skipctx = 0; S.A = (const char*)(ws + WS_A); S.Bt = (const char*)(ws + WS_WIN); S.a_tile = (size_t)256 * 1024 * 2; S.b_tile = (size_t)256 * 1024 * 2;
            EpiProj E;
            if (layer == 0) { E.d0 = (bf16*)(ws + WS_Z); E.l0 = 1024; E.e0 = 4; E.d1 = (bf16*)(ws + WS_RAW); E.l1 = 1280; E.e1 = 9; E.d2 = (bf16*)(ws + WS_YMIX) + 1024; E.l2 = 2048; E.e2 = 13;
                E.d3 = (bf16*)(ws + WS_K); E.l3 = 256; E.e3 = 14; E.d4 = (bf16*)(ws + WS_V); E.l4 = 256; E.e4 = 15; E.d5 = (bf16*)(ws + WS_DTR); E.l5 = 32; E.lastcols = 32; }
            else { E.d0 = (bf16*)(ws + WS_Z); E.l0 = 1024; E.e0 = 4; E.d1 = (bf16*)(ws + WS_RAW); E.l1 = 1024; E.e1 = 8; E.d2 = (bf16*)(ws + WS_YMIX) + 1024; E.l2 = 2048; E.e2 = 12;
                E.d3 = (bf16*)(ws + WS_K); E.l3 = 256; E.e3 = 13; E.d4 = (bf16*)(ws + WS_V); E.l4 = 256; E.e4 = 14; E.d5 = (bf16*)(ws + WS_DTR); E.l5 = 32; E.lastcols = 32; }
            pg8::gemm_phase<EpiProj, RowSched>(lds, g, S, E);
        }
        SEAM(pb + 1);
        if (EN(3) && IN(pb + 2)) { if (layer == 0) ph_elem0(C); else ph_elem1(C); }
        SEAM(pb + 2);
        if (IN(pb + 3)) { if (layer == 0) { if (EN(4)) ph_mix0(C, lds, (char*)lds_raw); } else { if (EN(5)) ph_mix1(C, lds, (char*)lds_raw); } }
        SEAM(pb + 3);
        if (EN(6) && IN(pb + 4)) { if (layer == 0) ph_ssdpost(C); else ph_lrupost(C); }
        SEAM(pb + 4);
        if (EN(7) && IN(pb + 5)) {
            pg8::Gemm g{2048, 2048, 2048, 1 << 30};
            RowSched S; S.nM = layer == 0 ? 66 : 64; S.nN = 4; S.nwg = S.nM * 4; S.G = C.G; S.c = C.bid; S.skipctx = layer; S.A = (const char*)(ws + WS_YMIX); S.Bt = (const char*)(ws + WS_WOUT); S.a_tile = (size_t)256 * 2048 * 2; S.b_tile = (size_t)256 * 2048 * 2;
            EpiRes E; E.xin_lat = layer == 0 ? C.in[I_X] : C.out; E.xin_ctx = layer == 0 ? C.in[I_CTX] : C.xc(); E.xout_lat = C.out; E.xout_ctx = C.xc(); E.modbase = C.mod(layer, 0);
            pg8::gemm_phase<EpiRes, RowSched>(lds, g, S, E);
        }
        SEAM(pb + 5);
        if (EN(8) && IN(pb + 6)) ph_route(C, layer, lds);
        SEAM(pb + 6);
        if (EN(9) && IN(pb + 7)) ph_gather(C, layer, lds);
        SEAM(pb + 7);
        if (EN(10) && IN(pb + 8)) {
            pg8::Gemm g{1024, 1024, 1024, 1 << 30};
            MoeSched S; S.mt = (const int*)(ws + WS_MT); S.G = C.G; S.c = C.bid; S.which = 1; S.A = (const char*)(ws + WS_YMIX); S.W = (const char*)(ws + WS_W13); S.a_tile = (size_t)256 * 1024 * 2;
            EpiMoe1 E; E.H = (bf16*)(ws + WS_Z); E.gab = (const float*)(ws + WS_GAB);
            pg8::gemm_phase<EpiMoe1, MoeSched>(lds, g, S, E);
        }
        SEAM(pb + 8);
        if (EN(11) && IN(pb + 9)) {
            pg8::Gemm g{512, 256, 512, 4};
            MoeSched S; S.mt = (const int*)(ws + WS_MT); S.G = C.G; S.c = C.bid; S.which = 2; S.A = (const char*)(ws + WS_Z); S.W = (const char*)(ws + WS_W2); S.a_tile = (size_t)256 * 512 * 2;
            EpiMoe2 E; E.tok = (const int*)(ws + WS_TOK); E.out = C.out; E.xc = C.xc(); E.modbase = C.mod(layer, 0);
            pg8::gemm_phase<EpiMoe2, MoeSched>(lds, g, S, E);
        }
        SEAM(pb + 9);
    }
    if (EN(12) && IN(21)) ph_final(C);
    (void)ph;
#undef IN
#undef SEAM
}

extern "C" void kernel_launch(void* const* d_in, const int* in_sizes, int n_in, void* d_out, int out_size, void* d_ws, size_t ws_size, hipStream_t stream) {
    static int grid = 0;
    if (grid == 0) {
        if (n_in != 36 || out_size != NBATCH * SEQL * DM || ws_size < WS_END) { fprintf(stderr, "kernel_launch: unexpected shapes (n_in %d, out %d, ws %zu)\n", n_in, out_size, ws_size); grid = -1; return; }
        int dev = 0, cus = 0, per_cu = 0;
        if (hipGetDevice(&dev) != hipSuccess || hipDeviceGetAttribute(&cus, hipDeviceAttributeMultiprocessorCount, dev) != hipSuccess) { grid = -1; return; }
        if (hipFuncSetAttribute((const void*)fwd_kernel, hipFuncAttributeMaxDynamicSharedMemorySize, LDS_BYTES) != hipSuccess) { fprintf(stderr, "kernel_launch: hipFuncSetAttribute failed\n"); grid = -1; return; }
        if (hipOccupancyMaxActiveBlocksPerMultiprocessor(&per_cu, (const void*)fwd_kernel, NTHREADS, LDS_BYTES) != hipSuccess || per_cu < 1) { fprintf(stderr, "kernel_launch: occupancy query failed (%d)\n", per_cu); (void)hipGetLastError(); per_cu = 1; }
        grid = cus * 1;
    }
    if (grid < 0) return;
    (void)hipMemsetAsync((char*)d_ws + WS_CTL, 0, CTL_ZERO_BYTES, stream);
    Args a{};
    for (int i = 0; i < 36; ++i) a.in[i] = (const float*)d_in[i];
    a.out = (float*)d_out; a.ws = (unsigned char*)d_ws;
#if MK_PER_PHASE
    for (int p = 0; p < N_PHASES; ++p) { a.ph_lo = p; a.ph_hi = p + 1; hipLaunchKernelGGL(fwd_kernel, dim3(grid), dim3(NTHREADS), LDS_BYTES, stream, a); }
#else
    a.ph_lo = 0; a.ph_hi = N_PHASES;
    void* kargs[] = {&a};
    hipError_t e = hipLaunchCooperativeKernel((const void*)fwd_kernel, dim3(grid), dim3(NTHREADS), kargs, LDS_BYTES, stream);
    if (e != hipSuccess) fprintf(stderr, "kernel_launch: cooperative launch failed: %s (grid %d)\n", hipGetErrorString(e), grid);
#endif
}
```

```cpp
#include <hip/hip_runtime.h>
#include <hip/hip_cooperative_groups.h>
#include <cstdio>
#include <cstdint>
namespace cg = cooperative_groups;

#ifndef MK_PER_PHASE
#define MK_PER_PHASE 0
#endif

#ifndef EN_MASK
#define EN_MASK 0xFFFF
#endif
#define EN(k) (((EN_MASK) >> (k)) & 1)
#define LAS __attribute__((address_space(3)))
typedef unsigned short bf16;
typedef short bf16x8 __attribute__((ext_vector_type(8)));
typedef short s16x4 __attribute__((ext_vector_type(4)));
typedef float f32x4 __attribute__((ext_vector_type(4)));
typedef float f32x2 __attribute__((ext_vector_type(2)));
typedef float f32x16 __attribute__((ext_vector_type(16)));
typedef unsigned u32x4 __attribute__((ext_vector_type(4)));
typedef unsigned u32x2 __attribute__((ext_vector_type(2)));

constexpr int DM = 1024, NBATCH = 2, SEQL = 8192, CTXL = 256;
constexpr int BROWS = CTXL + SEQL;
constexpr int NROWS = NBATCH * BROWS;
constexpr float EPS = 1e-6f;
constexpr int NWAVES = 8, NTHREADS = 512;
constexpr int LDS_BYTES = 147456;
constexpr int N_PHASES = 22;

constexpr size_t MiB = 1u << 20;
constexpr size_t WS_CTL = 0, CTL_ZERO_BYTES = 128 * 1024;
constexpr size_t WS_MOD = 1 * MiB;
constexpr size_t WS_REC = 1 * MiB + 256 * 1024;
constexpr size_t WS_TOK = 2 * MiB;
constexpr size_t WS_GAB = 2 * MiB + 128 * 1024;
constexpr size_t WS_MT  = 2 * MiB + 512 * 1024;
constexpr size_t WS_STAMP = 2 * MiB + 768 * 1024;
constexpr size_t WS_XC  = 3 * MiB;
constexpr size_t WS_W   = 5 * MiB;
constexpr size_t WS_WIN = WS_W, WS_WOUT = WS_W + 8 * MiB, WS_W13 = WS_W + 12 * MiB, WS_W2 = WS_W + 28 * MiB;
constexpr size_t WS_A   = 41 * MiB;
constexpr size_t WS_Z   = 83 * MiB;
constexpr size_t WS_RAW = 116 * MiB;
constexpr size_t WS_DTR = 158 * MiB;
constexpr size_t WS_DT  = 160 * MiB;
constexpr size_t WS_K   = 163 * MiB;
constexpr size_t WS_V   = 172 * MiB;
constexpr size_t WS_YMIX = 181 * MiB;
constexpr size_t WS_SSDST = 247 * MiB;
constexpr size_t WS_SSDLD = WS_SSDST + 64 * 3 * 16384;
constexpr size_t WS_TBL = 251 * MiB;
constexpr size_t WS_MTG = 253 * MiB;
constexpr size_t WS_END = 254 * MiB;
constexpr int MAXTILES = 90, MAXSLOT = MAXTILES * 256;
constexpr int CW_MODDONE = 192;
constexpr int CW_Q0 = 64, CW_Q1 = 128, CW_CNT = 256, CW_BAR = 4096, CW_TDONE = 8192;

__device__ __forceinline__ float bf2f(unsigned short b) { return __uint_as_float(((unsigned)b) << 16); }
__device__ __forceinline__ unsigned f2bf(float f) { unsigned u = __float_as_uint(f); return (u + 0x7fffu + ((u >> 16) & 1u)) >> 16; }
__device__ __forceinline__ unsigned pk2(float lo, float hi) { return f2bf(lo) | (f2bf(hi) << 16); }
__device__ __forceinline__ float dpp_add(float v, float src, const int ctrl_unused) { return v + src; }
#define DPP_F(v, ctrl, rmask) __builtin_bit_cast(float, __builtin_amdgcn_update_dpp(0, __builtin_bit_cast(int, v), ctrl, rmask, 0xf, false))
__device__ __forceinline__ float wave_sum(float v) {
    v += DPP_F(v, 0xB1, 0xf);
    v += DPP_F(v, 0x4E, 0xf);
    v += DPP_F(v, 0x141, 0xf);
    v += DPP_F(v, 0x140, 0xf);
    v += DPP_F(v, 0x142, 0xa);
    v += DPP_F(v, 0x143, 0xc);
    return __builtin_bit_cast(float, __builtin_amdgcn_readlane(__builtin_bit_cast(int, v), 63));
}
__device__ __forceinline__ float silu_f(float x) { return x / (1.f + __expf(-x)); }
__device__ __forceinline__ float sigmoid_f(float x) { return 1.f / (1.f + __expf(-x)); }
__device__ __forceinline__ float softplus_lite(float x) { const float e = __expf(-fabsf(x)); const float l = e < 0.03f ? e * (1.f - e * (0.5f - e * (1.f / 3.f - 0.25f * e))) : __logf(1.f + e); return fmaxf(x, 0.f) + l; }
__device__ __forceinline__ float softplus_f(float x) { return fmaxf(x, 0.f) + log1pf(__expf(-fabsf(x))); }
__device__ __forceinline__ float gelu_tanh_f(float x) { const float u = 0.7978845608028654f * (x + 0.044715f * x * x * x); return 0.5f * x * (1.f + tanhf(u)); }
__device__ __forceinline__ void unpack8(const u32x4 w, float* f) {
    f[0] = __uint_as_float(w.x << 16); f[1] = __uint_as_float(w.x & 0xffff0000u);
    f[2] = __uint_as_float(w.y << 16); f[3] = __uint_as_float(w.y & 0xffff0000u);
    f[4] = __uint_as_float(w.z << 16); f[5] = __uint_as_float(w.z & 0xffff0000u);
    f[6] = __uint_as_float(w.w << 16); f[7] = __uint_as_float(w.w & 0xffff0000u);
}

namespace pg8 {
constexpr int BM = 256, BK = 64, HALF = 128, HTB = HALF * BK * 2, STAGE_BYTES = 8 * HTB, NXCD = 8, WGM = 8;
__host__ __device__ __forceinline__ int lds_byte(int r, int c) { const int st = (r >> 4) * 2 + (c >> 5), rr = r & 15, cc = c & 31, ob = rr * 64 + cc * 2; return st * 1024 + (ob ^ (((ob >> 9) & 1) << 5)); }
__host__ __device__ __forceinline__ void stage_rc(int b, int& R, int& C) { const int st = b / 1024, sb = b % 1024, swz = sb ^ (((sb >> 9) & 1) << 5); R = (st >> 1) * 16 + swz / 64; C = (st & 1) * 32 + (swz % 64) / 2; }
__host__ __device__ __forceinline__ int perm32(int rho) { const int n = rho >> 4, i = rho & 15; return 8 * (i >> 2) + 4 * n + (i & 3); }

struct Unit { int pm, pn; const char* a; const char* b; long bd; int tbo; int nrow; };
struct Gemm { int lda, ldb, K, ksplit; int asplit; long ad; };

__device__ __forceinline__ unsigned cvt_pk_bf16(float lo, float hi) { unsigned r; asm volatile("v_cvt_pk_bf16_f32 %0, %1, %2" : "=v"(r) : "v"(lo), "v"(hi)); return r; }

template <class Epi, class Sched, bool GATHER = false>
__device__ __forceinline__ void gemm_phase(LAS unsigned char* lds, const Gemm g, const Sched& S, const Epi& E, const int* gtbl = nullptr) {
    int tid_ = threadIdx.x; asm volatile("" : "+v"(tid_));
    const int tid = tid_, wid = __builtin_amdgcn_readfirstlane(tid >> 6), lane = tid & 63, wr = wid >> 2, wc = wid & 3, fr = lane & 15, fq = lane >> 4;
    const int nt = g.K / BK;
    unsigned voffA[2][2], nvoffA[2][2], voffB[2];
#pragma unroll
    for (int i = 0; i < 2; ++i) { int R, C; stage_rc(tid * 16 + i * 8192, R, C); const int Rb = Epi::PERM ? ((R & ~31) + perm32(R & 31)) : R;
        voffA[0][i] = (unsigned)(R * g.lda + C) * 2u; voffA[1][i] = (unsigned)((R + HALF) * g.lda + C) * 2u; nvoffA[0][i] = voffA[0][i]; nvoffA[1][i] = voffA[1][i];
        voffB[i] = (unsigned)(Rb * g.ldb + C) * 2u; }
#define PG8_GATHER_OFF(dst, uu) do { if constexpr (GATHER) { int _t = tid; asm volatile("" : "+v"(_t)); _Pragma("unroll") for (int _i = 0; _i < 2; ++_i) { int _R, _C; stage_rc(_t * 16 + _i * 8192, _R, _C); \
        _Pragma("unroll") for (int _h = 0; _h < 2; ++_h) { int _rho = _h * HALF + _R; _rho = _rho < (uu).nrow ? _rho : (uu).nrow - 1; dst[_h][_i] = (unsigned)gtbl[(uu).tbo + _rho] * (unsigned)(g.lda * 2) + (unsigned)_C * 2u; } } } } while (0)
    const size_t kstep = (size_t)(BK * 2);
    const size_t hstepA = (size_t)HALF * g.lda * 2, hstepB = (size_t)HALF * g.ldb * 2;
    const unsigned ldsw = (unsigned)wid * 1024u;
    const int aoff = lds_byte(wr * 64 + fr, fq * 8), boff = lds_byte(wc * 32 + fr, fq * 8);
#define PG8_SA(b, h) (((b) * 2 + (h)) * HTB)
#define PG8_SB(b, h) ((4 + (b) * 2 + (h)) * HTB)
#define PG8_STAGE(bufoff, gbase, voff) do { _Pragma("unroll") for (int _i = 0; _i < 2; ++_i) \
        __builtin_amdgcn_global_load_lds((const unsigned*)((const char*)(gbase) + (voff)[_i]), (LAS unsigned*)(lds + (bufoff) + ldsw + _i * 8192), 16, 0, 0); } while (0)
#define PG8_STAGE_A(bufoff, gbase, hh, usenext) do { _Pragma("unroll") for (int _i = 0; _i < 2; ++_i) { \
        if constexpr (GATHER) { const unsigned _vo = (usenext) ? nvoffA[hh][_i] : voffA[hh][_i]; \
            __builtin_amdgcn_global_load_lds((const unsigned*)((const char*)(gbase) + _vo), (LAS unsigned*)(lds + (bufoff) + ldsw + _i * 8192), 16, 0, 0); } \
        else __builtin_amdgcn_global_load_lds((const unsigned*)((const char*)(gbase) + (hh) * hstepA + voffA[0][_i]), (LAS unsigned*)(lds + (bufoff) + ldsw + _i * 8192), 16, 0, 0); } } while (0)
#define PG8_LDA(dst, b, h) do { _Pragma("unroll") for (int m = 0; m < 4; ++m) _Pragma("unroll") for (int k = 0; k < 2; ++k) dst[m][k] = *(const LAS bf16x8*)(lds + PG8_SA(b, h) + aoff + m * 2048 + k * 1024); } while (0)
#define PG8_LDB(dst, b, h) do { _Pragma("unroll") for (int n = 0; n < 2; ++n) _Pragma("unroll") for (int k = 0; k < 2; ++k) dst[n][k] = *(const LAS bf16x8*)(lds + PG8_SB(b, h) + boff + n * 2048 + k * 1024); } while (0)
#define PG8_MMA(ai, bj, At, Bt) do { __builtin_amdgcn_s_setprio(1); _Pragma("unroll") for (int m = 0; m < 4; ++m) _Pragma("unroll") for (int n = 0; n < 2; ++n) _Pragma("unroll") for (int k = 0; k < 2; ++k) \
        acc[ai][bj][m][n] = __builtin_amdgcn_mfma_f32_16x16x32_bf16(Bt[n][k], At[m][k], acc[ai][bj][m][n], 0, 0, 0); __builtin_amdgcn_s_setprio(0); } while (0)
#define PG8_WAIT_V(n) asm volatile("s_waitcnt vmcnt(" #n ")" ::: "memory")
#define PG8_WAIT_L(n) asm volatile("s_waitcnt lgkmcnt(" #n ")" ::: "memory")
#define PG8_BAR __builtin_amdgcn_s_barrier()
#define PG8_SCHED __builtin_amdgcn_sched_barrier(0)
    Unit cur, nxt; int ui = 0;
    if (!S.next(0, cur)) return;
    f32x4 acc[2][2][4][2];
#pragma unroll
    for (int a = 0; a < 2; ++a)
#pragma unroll
        for (int b = 0; b < 2; ++b)
#pragma unroll
            for (int m = 0; m < 4; ++m)
#pragma unroll
                for (int n = 0; n < 2; ++n) acc[a][b][m][n] = (f32x4){0.f, 0.f, 0.f, 0.f};
    bf16x8 At[4][2], B0[2][2], B1[2][2];
    const char* cA = cur.a; const char* cB = cur.b; long cBd = cur.bd;
    S.a_ready(cur);
    PG8_GATHER_OFF(voffA, cur);
    PG8_STAGE(PG8_SB(0, 0), cB, voffB); PG8_STAGE_A(PG8_SA(0, 0), cA, 0, false); PG8_STAGE(PG8_SB(0, 1), cB + hstepB, voffB); PG8_STAGE_A(PG8_SA(0, 1), cA, 1, false);
    if (wr == 1) PG8_BAR;
    PG8_WAIT_V(4); PG8_BAR;
    PG8_STAGE(PG8_SB(1, 0), cB + kstep, voffB); PG8_STAGE_A(PG8_SA(1, 0), cA + kstep, 0, false); PG8_STAGE(PG8_SB(1, 1), cB + hstepB + kstep, voffB);
    PG8_WAIT_V(6); PG8_BAR;
    for (;;) {
        const bool has_next = S.next(ui + 1, nxt);
        const char* nA = has_next ? nxt.a : cA; const char* nB = has_next ? nxt.b : cB;
        if constexpr (GATHER) { if (has_next) PG8_GATHER_OFF(nvoffA, nxt); else {
#pragma unroll
            for (int _h = 0; _h < 2; ++_h)
#pragma unroll
                for (int _i = 0; _i < 2; ++_i) nvoffA[_h][_i] = voffA[_h][_i]; } }
#pragma unroll 1
        for (int t = 0; t < nt; t += 2) {
            const bool last = (t == nt - 2);
            const char* a1 = cA + (size_t)(t + 1) * kstep + ((t + 1) >= g.asplit ? g.ad : 0);
            const char* a2 = last ? nA : cA + (size_t)(t + 2) * kstep + ((t + 2) >= g.asplit ? g.ad : 0);
            const char* b2 = last ? nB : cB + (size_t)(t + 2) * kstep + ((t + 2) >= g.ksplit ? cBd : 0);
            const char* a3 = a2 + kstep; const char* b3 = b2 + kstep;
            if (last && has_next) S.a_ready(nxt);
            PG8_LDB(B0, 0, 0); PG8_SCHED; PG8_LDA(At, 0, 0); PG8_STAGE_A(PG8_SA(1, 1), a1, 1, false);
            PG8_WAIT_L(8); PG8_BAR; PG8_WAIT_L(0); PG8_MMA(0, 0, At, B0); PG8_BAR; PG8_SCHED;
            PG8_LDB(B1, 0, 1); PG8_STAGE(PG8_SB(0, 0), b2, voffB);
            PG8_BAR; PG8_WAIT_L(0); PG8_MMA(0, 1, At, B1); PG8_BAR;
            PG8_LDA(At, 0, 1); PG8_STAGE_A(PG8_SA(0, 0), a2, 0, last);
            PG8_BAR; PG8_WAIT_L(0); PG8_MMA(1, 0, At, B0); PG8_BAR; PG8_SCHED;
            PG8_STAGE(PG8_SB(0, 1), b2 + hstepB, voffB);
            PG8_WAIT_V(6); PG8_BAR; PG8_MMA(1, 1, At, B1); PG8_BAR;
            PG8_LDB(B0, 1, 0); PG8_SCHED; PG8_LDA(At, 1, 0); PG8_STAGE_A(PG8_SA(0, 1), a2, 1, last);
            PG8_WAIT_L(8); PG8_BAR; PG8_WAIT_L(0); PG8_MMA(0, 0, At, B0); PG8_BAR; PG8_SCHED;
            PG8_LDB(B1, 1, 1); PG8_STAGE(PG8_SB(1, 0), b3, voffB);
            PG8_BAR; PG8_WAIT_L(0); PG8_MMA(0, 1, At, B1); PG8_BAR;
            PG8_LDA(At, 1, 1); PG8_STAGE_A(PG8_SA(1, 0), a3, 0, last);
            PG8_BAR; PG8_WAIT_L(0); PG8_MMA(1, 0, At, B0); PG8_BAR; PG8_SCHED;
            PG8_STAGE(PG8_SB(1, 1), b3 + hstepB, voffB);
            PG8_WAIT_V(6); PG8_BAR; PG8_MMA(1, 1, At, B1); PG8_BAR;
        }
        E(acc, cur, wr, wc, fr, fq); S.done(cur);
        if (!has_next) break;
#pragma unroll
        for (int a = 0; a < 2; ++a)
#pragma unroll
            for (int b = 0; b < 2; ++b)
#pragma unroll
                for (int m = 0; m < 4; ++m)
#pragma unroll
                    for (int n = 0; n < 2; ++n) acc[a][b][m][n] = (f32x4){0.f, 0.f, 0.f, 0.f};
        cur = nxt; cA = nA; cB = nB; cBd = cur.bd; ++ui;
        if constexpr (GATHER) {
#pragma unroll
            for (int _h = 0; _h < 2; ++_h)
#pragma unroll
                for (int _i = 0; _i < 2; ++_i) voffA[_h][_i] = nvoffA[_h][_i]; }
    }
    PG8_WAIT_V(0);
    if (wr == 0) PG8_BAR;
    PG8_BAR;
#undef PG8_SA
#undef PG8_SB
#undef PG8_STAGE
#undef PG8_STAGE_A
#undef PG8_GATHER_OFF
#undef PG8_LDA
#undef PG8_LDB
#undef PG8_MMA
#undef PG8_WAIT_V
#undef PG8_WAIT_L
#undef PG8_BAR
#undef PG8_SCHED
}
}

namespace att {
constexpr int D = 128, NW = 8, QBLK = 32, KVBLK = 64;
constexpr float SCALE = 0.088388347648318440f;
constexpr float THR = 8.f;
constexpr int LDQ = 2048, LDK = 256, LDO = 2048;
constexpr size_t SHM_V = KVBLK * D * 2, SHM_K = KVBLK * D * 2, SHM_ATTN = 2 * SHM_V + 2 * SHM_K + NW * 64 * 4;
#define KSWZ(row, colB) ((row) * 256 + ((colB) ^ (((row) & 7) << 4)))
#define SBAR() __builtin_amdgcn_sched_barrier(0)
__device__ __forceinline__ int crow(int r, int hi) { return (r & 3) + 8 * (r >> 2) + 4 * hi; }
__device__ __forceinline__ unsigned cvtpk(float lo, float hi) { unsigned r; asm volatile("v_cvt_pk_bf16_f32 %0, %1, %2" : "=v"(r) : "v"(lo), "v"(hi)); return r; }

__device__ __forceinline__ void partialSM(f32x16& p0, f32x16& p1, float& m_reg, float& mn, float& alpha) {
  constexpr float C = SCALE * 1.4426950408889634f;
  float pmax = p0[0]; for (int r = 1; r < 16; ++r) pmax = fmaxf(pmax, p0[r]); for (int r = 0; r < 16; ++r) pmax = fmaxf(pmax, p1[r]);
  { auto rr = __builtin_amdgcn_permlane32_swap(__float_as_uint(pmax), __float_as_uint(pmax), false, false);
    pmax = fmaxf(__uint_as_float(rr[0]), __uint_as_float(rr[1])); }
  if (__builtin_expect(__all(pmax - m_reg <= THR / SCALE), 1)) { mn = m_reg; alpha = 1.f; }
  else { mn = fmaxf(m_reg, pmax); alpha = __builtin_amdgcn_exp2f((m_reg - mn) * C); m_reg = mn; }
  float mnC = -mn * C;
  for (int r = 0; r < 16; ++r) p0[r] = fmaf(p0[r], C, mnC); for (int r = 0; r < 16; ++r) p1[r] = fmaf(p1[r], C, mnC);
  for (int r = 0; r < 16; ++r) p0[r] = __builtin_amdgcn_exp2f(p0[r]);
}
__device__ __forceinline__ void finishSM(f32x16& p0, f32x16& p1, float alpha, float& l_reg, bf16x8& pa0, bf16x8& pa1, bf16x8& pa2, bf16x8& pa3) {
  for (int r = 0; r < 16; ++r) p1[r] = __builtin_amdgcn_exp2f(p1[r]);
  float ps = 0; for (int r = 0; r < 16; ++r) ps += p0[r]; for (int r = 0; r < 16; ++r) ps += p1[r];
  { auto rr = __builtin_amdgcn_permlane32_swap(__float_as_uint(ps), __float_as_uint(ps), false, false);
    ps = __uint_as_float(rr[0]) + __uint_as_float(rr[1]); }
  l_reg = l_reg * alpha + ps;
#define PK4(P, BASE, OUT) do { unsigned a0 = cvtpk(P[BASE + 0], P[BASE + 1]), a1 = cvtpk(P[BASE + 2], P[BASE + 3]);   \
    unsigned b0 = cvtpk(P[BASE + 4], P[BASE + 5]), b1 = cvtpk(P[BASE + 6], P[BASE + 7]);                              \
    auto r0 = __builtin_amdgcn_permlane32_swap(a0, b0, false, false); auto r1 = __builtin_amdgcn_permlane32_swap(a1, b1, false, false); \
    u32x4 w = {r0[0], r1[0], r0[1], r1[1]}; OUT = *reinterpret_cast<bf16x8*>(&w); } while (0)
  PK4(p0, 0, pa0); PK4(p0, 8, pa1); PK4(p1, 0, pa2); PK4(p1, 8, pa3);
#undef PK4
}
__device__ __forceinline__ void qkt(f32x16& p0, f32x16& p1, const bf16* Ks, const bf16x8* qr, int r32, int hi) {
  p0 = f32x16{}; p1 = f32x16{};
  for (int d0 = 0; d0 < 8; ++d0) { int cb = (d0 * 16 + hi * 8) * 2;
    bf16x8 b0 = *reinterpret_cast<const bf16x8*>((const char*)Ks + KSWZ(r32, cb));
    bf16x8 b1 = *reinterpret_cast<const bf16x8*>((const char*)Ks + KSWZ(32 + r32, cb));
    p0 = __builtin_amdgcn_mfma_f32_32x32x16_bf16(b0, qr[d0], p0, 0, 0, 0);
    p1 = __builtin_amdgcn_mfma_f32_32x32x16_bf16(b1, qr[d0], p1, 0, 0, 0); }
}
__device__ __forceinline__ int v_st(int k, int c) { const int kk = (k & ~0xC) | ((k & 4) << 1) | ((k & 8) >> 1); return ((kk >> 3) * 4 + (c >> 5)) * 512 + ((kk & 7) * 32 + (c & 31)) * 2; }
__device__ __forceinline__ int v_rd_base(int lane) { return ((lane & 3) << 3) | (((lane >> 2) & 3) << 6) | (((lane >> 4) & 1) << 5) | (((lane >> 5) & 1) << 8); }
constexpr int v_rd_off(int d0, int ks, int half) { return d0 * 512 + ks * 4096 + half * 2048; }
template <int OFF> __device__ __forceinline__ s16x4 tr_read(int vb) {
  s16x4 r; asm volatile("ds_read_b64_tr_b16 %0, %1 offset:%2" : "=&v"(r) : "v"(vb), "i"(OFF) : "memory"); return r;
}
template <int D0> __device__ __forceinline__ void pv_one(f32x16& od, int vb, bf16x8 pa0, bf16x8 pa1, bf16x8 pa2, bf16x8 pa3) {
  const s16x4 l0 = tr_read<v_rd_off(D0, 0, 0)>(vb), h0 = tr_read<v_rd_off(D0, 0, 1)>(vb), l1 = tr_read<v_rd_off(D0, 1, 0)>(vb), h1 = tr_read<v_rd_off(D0, 1, 1)>(vb);
  const s16x4 l2 = tr_read<v_rd_off(D0, 2, 0)>(vb), h2 = tr_read<v_rd_off(D0, 2, 1)>(vb), l3 = tr_read<v_rd_off(D0, 3, 0)>(vb), h3 = tr_read<v_rd_off(D0, 3, 1)>(vb);
  asm volatile("s_waitcnt lgkmcnt(0)" ::: "memory"); SBAR();
#define PK(L, H) (bf16x8){L[0], L[1], L[2], L[3], H[0], H[1], H[2], H[3]}
  od = __builtin_amdgcn_mfma_f32_32x32x16_bf16(pa0, PK(l0, h0), od, 0, 0, 0);
  od = __builtin_amdgcn_mfma_f32_32x32x16_bf16(pa1, PK(l1, h1), od, 0, 0, 0);
  od = __builtin_amdgcn_mfma_f32_32x32x16_bf16(pa2, PK(l2, h2), od, 0, 0, 0);
  od = __builtin_amdgcn_mfma_f32_32x32x16_bf16(pa3, PK(l3, h3), od, 0, 0, 0);
#undef PK
}
__device__ __forceinline__ void pv_d0(f32x16* o, int vb, bf16x8 pa0, bf16x8 pa1, bf16x8 pa2, bf16x8 pa3) {
  pv_one<0>(o[0], vb, pa0, pa1, pa2, pa3); pv_one<1>(o[1], vb, pa0, pa1, pa2, pa3); pv_one<2>(o[2], vb, pa0, pa1, pa2, pa3); pv_one<3>(o[3], vb, pa0, pa1, pa2, pa3);
}
__device__ __forceinline__ void band_mask(f32x16& p0, f32x16& p1, int dbase, int hi) {
#pragma unroll
  for (int r = 0; r < 16; ++r) { const int d = dbase + crow(r, hi);
    if (d < -128 || d > 128) p0[r] = -1e30f;
    if (d + 32 < -128 || d + 32 > 128) p1[r] = -1e30f; }
}
template <int MODE>
__device__ __forceinline__ void attn_body(const bf16* Qb, const bf16* Kh, const bf16* Vh, bf16* Ob, int NT, int kb0, int q0, float sink, char* lds, const float* qg, int tq0) {
  int tid_ = threadIdx.x; asm volatile("" : "+v"(tid_));
  const int tid = tid_, wid = tid >> 6, lane = tid & 63, r32 = lane & 31, hi = lane >> 5;
  bf16* V_lds = (bf16*)lds; bf16* K_lds = (bf16*)(lds + 3 * SHM_V);
  float* ws = (float*)(lds + 3 * SHM_V + 3 * SHM_K) + wid * 64; float* li_l = ws; float* al_l = ws + 32;
  bf16x8 qr[8];
  const bf16* Qw = Qb + (long)(wid * QBLK + r32) * LDQ + hi * 8;
  { u32x4 raw[8];
#pragma unroll
    for (int d0 = 0; d0 < 8; ++d0) raw[d0] = *reinterpret_cast<const u32x4*>(Qw + d0 * 16);
    float rs = 1.f;
    if (qg != nullptr) { float ssq = 0.f;
#pragma unroll
      for (int d0 = 0; d0 < 8; ++d0) { float f[8]; unpack8(raw[d0], f);
#pragma unroll
        for (int e = 0; e < 8; ++e) ssq += f[e] * f[e]; }
      ssq += __shfl_xor(ssq, 32);
      rs = rsqrtf(ssq * (1.f / 128.f) + 1e-6f); }
    const int t = tq0 + wid * QBLK + r32;
#pragma unroll
    for (int d0 = 0; d0 < 4; ++d0) { float fa[8], fb[8]; unpack8(raw[d0], fa); unpack8(raw[d0 + 4], fb);
      if (qg != nullptr) { const f32x4 ga0 = *reinterpret_cast<const f32x4*>(qg + 16 * d0 + 8 * hi), ga1 = *reinterpret_cast<const f32x4*>(qg + 16 * d0 + 8 * hi + 4);
        const f32x4 gb0 = *reinterpret_cast<const f32x4*>(qg + 64 + 16 * d0 + 8 * hi), gb1 = *reinterpret_cast<const f32x4*>(qg + 64 + 16 * d0 + 8 * hi + 4);
#pragma unroll
        for (int e = 0; e < 4; ++e) { fa[e] *= rs * ga0[e]; fa[4 + e] *= rs * ga1[e]; fb[e] *= rs * gb0[e]; fb[4 + e] *= rs * gb1[e]; } }
      if (tq0 >= 0) {
#pragma unroll
        for (int e = 0; e < 8; ++e) { const int j = 16 * d0 + 8 * hi + e; const int pos = j < 32 ? (t >> 6) : (t & 63);
          const float inv = exp2f(-(float)(j & 31) * (13.287712379549449f / 32.f)); float sn, cs; sincosf((float)pos * inv, &sn, &cs);
          const float a = fa[e], b2 = fb[e]; fa[e] = a * cs - b2 * sn; fb[e] = a * sn + b2 * cs; } }
      u32x4 wa, wb; wa.x = cvtpk(fa[0], fa[1]); wa.y = cvtpk(fa[2], fa[3]); wa.z = cvtpk(fa[4], fa[5]); wa.w = cvtpk(fa[6], fa[7]);
      wb.x = cvtpk(fb[0], fb[1]); wb.y = cvtpk(fb[2], fb[3]); wb.z = cvtpk(fb[4], fb[5]); wb.w = cvtpk(fb[6], fb[7]);
      qr[d0] = *reinterpret_cast<bf16x8*>(&wa); qr[d0 + 4] = *reinterpret_cast<bf16x8*>(&wb); } }
  float m_reg = -1e30f, l_reg = 0; f32x16 o[4] = {};
  const int sr = tid >> 4, sc = (tid & 15) * 8, vst0 = v_st(sr, sc), vst1 = v_st(32 + sr, sc);
  const int vb0 = (int)(uintptr_t)V_lds + v_rd_base(lane);
  struct { bf16x8 vs0, vs1, ks0, ks1; } sr_;
#define TK0(j) ((MODE == 0 || (j) < 4) ? (j) * KVBLK : kb0 + ((j) - 4) * KVBLK)
#define SLOAD(k0) do { sr_.vs0 = *reinterpret_cast<const bf16x8*>(&Vh[(long)((k0) + sr) * LDK + sc]); sr_.vs1 = *reinterpret_cast<const bf16x8*>(&Vh[(long)((k0) + 32 + sr) * LDK + sc]); \
    sr_.ks0 = *reinterpret_cast<const bf16x8*>(&Kh[(long)((k0) + sr) * LDK + sc]); sr_.ks1 = *reinterpret_cast<const bf16x8*>(&Kh[(long)((k0) + 32 + sr) * LDK + sc]); } while (0)
#define SWRITE(b) do { *(bf16x8*)((char*)V_lds + (b) * (int)SHM_V + vst0) = sr_.vs0;          \
    *(bf16x8*)((char*)V_lds + (b) * (int)SHM_V + vst1) = sr_.vs1; int kc = sc * 2;               \
    *(bf16x8*)((char*)K_lds + (b) * (int)SHM_K + KSWZ(sr, kc)) = sr_.ks0;                       \
    *(bf16x8*)((char*)K_lds + (b) * (int)SHM_K + KSWZ(32 + sr, kc)) = sr_.ks1; } while (0)
#define SWAIT() asm volatile("s_waitcnt vmcnt(0)" ::: "memory")
#define RESC(a) do { if (__any((a) < 1.f)) { if (hi == 0) al_l[r32] = (a); asm volatile("s_waitcnt lgkmcnt(0)" ::: "memory"); \
    for (int d = 0; d < 4; ++d) for (int r = 0; r < 16; ++r) o[d][r] *= al_l[crow(r, hi)]; } } while (0)
#define MASKT(P0, P1, j) do { if (MODE == 1 && (j) >= 4) { const int s0_ = kb0 - 256 + ((j) - 4) * KVBLK, tw_ = q0 + wid * QBLK; \
    if (!(s0_ - (tw_ + 31) >= -128 && (s0_ + 63) - tw_ <= 128)) band_mask(P0, P1, s0_ - tw_ - r32, hi); } } while (0)
  f32x16 pA0, pA1, pB0, pB1; float mnA, mnB, alA, alB; bf16x8 pa0, pa1, pa2, pa3;
  int bp = 0, bq = 1;
  SLOAD(TK0(0)); SWAIT(); SWRITE(0); __syncthreads();
  qkt(pA0, pA1, K_lds, qr, r32, hi); partialSM(pA0, pA1, m_reg, mnA, alA);
  SLOAD(TK0(1));
  SWAIT(); SWRITE(1); __syncthreads();
  for (int j = 1; j + 1 < NT; j += 2) {
    { const int bw = 3 - bp - bq;
      SBAR(); qkt(pB0, pB1, (bf16*)((char*)K_lds + bq * (int)SHM_K), qr, r32, hi);
      finishSM(pA0, pA1, alA, l_reg, pa0, pa1, pa2, pa3); SBAR();
      SLOAD(TK0(j + 1)); SBAR();
      pv_d0(o, vb0 + bp * (int)SHM_V, pa0, pa1, pa2, pa3); MASKT(pB0, pB1, j); partialSM(pB0, pB1, m_reg, mnB, alB);
      SWAIT(); SWRITE(bw);
      RESC(alB); __syncthreads();
      bp = bq; bq = bw; }
    { const int bw = 3 - bp - bq;
      SBAR(); qkt(pA0, pA1, (bf16*)((char*)K_lds + bq * (int)SHM_K), qr, r32, hi);
      finishSM(pB0, pB1, alB, l_reg, pa0, pa1, pa2, pa3); SBAR();
      SLOAD(TK0(j + 2)); SBAR();
      pv_d0(o, vb0 + bp * (int)SHM_V, pa0, pa1, pa2, pa3); MASKT(pA0, pA1, j + 1); partialSM(pA0, pA1, m_reg, mnA, alA);
      SWAIT(); SWRITE(bw);
      RESC(alA); __syncthreads();
      bp = bq; bq = bw; }
  }
  SBAR(); qkt(pB0, pB1, (bf16*)((char*)K_lds + bq * (int)SHM_K), qr, r32, hi);
  finishSM(pA0, pA1, alA, l_reg, pa0, pa1, pa2, pa3); SBAR();
  pv_d0(o, vb0 + bp * (int)SHM_V, pa0, pa1, pa2, pa3); MASKT(pB0, pB1, NT - 1); partialSM(pB0, pB1, m_reg, mnB, alB);
  RESC(alB);
  finishSM(pB0, pB1, alB, l_reg, pa0, pa1, pa2, pa3); SBAR();
  pv_d0(o, vb0 + bq * (int)SHM_V, pa0, pa1, pa2, pa3);
  if (MODE == 1) { constexpr float C = SCALE * 1.4426950408889634f; l_reg += __builtin_amdgcn_exp2f(sink * 1.4426950408889634f - m_reg * C); }
  if (hi == 0) li_l[r32] = l_reg; asm volatile("s_waitcnt lgkmcnt(0)" ::: "memory");
  float rli[16];
#pragma unroll
  for (int r = 0; r < 16; ++r) rli[r] = __builtin_amdgcn_rcpf(li_l[crow(r, hi)]);
  bf16* Ow = Ob + (long)(wid * QBLK) * LDO;
#pragma unroll
  for (int r = 0; r < 16; ++r) { int orow = crow(r, hi);
    for (int d0 = 0; d0 < 4; ++d0) Ow[(long)orow * LDO + d0 * 32 + r32] = (bf16)f2bf(o[d0][r] * rli[r]); }
  asm volatile("s_waitcnt vmcnt(0) lgkmcnt(0)" ::: "memory");
  __syncthreads();
#undef TK0
#undef SLOAD
#undef SWRITE
#undef SWAIT
#undef RESC
#undef MASKT
}
#undef KSWZ
#undef SBAR
}

struct Args { const float* in[36]; float* out; unsigned char* ws; int ph_lo, ph_hi; };
enum { I_X = 0, I_C, I_CTX, I_CCTX, I_WMOD, I_BMOD, I_GMIX, I_GFFN, I_WGRP, I_BGRP, I_WRT, I_BRT, I_W1, I_W3, I_W2, I_ABIN, I_ABOUT, I_SCONVW, I_SCONVB,
       I_DTBIAS, I_ALOG, I_SSDD, I_SNORMG, I_QG, I_KG, I_CDIN, I_CDOUT, I_LCONVW, I_LCONVB, I_LWA, I_LBA, I_LWX, I_LBX, I_LAM, I_SINK, I_GFINAL };

#define CAS __attribute__((address_space(4)))
struct Ctx {
    const float* const CAS* in; float* out; unsigned char* ws;
    int bid, G;
    __device__ __forceinline__ unsigned* ctl() const { return (unsigned*)(ws + WS_CTL); }
    __device__ __forceinline__ float* mod(int layer, int mv) const { return (float*)(ws + WS_MOD) + (size_t)(layer * 3 + mv) * 6144; }
    __device__ __forceinline__ float* xc() const { return (float*)(ws + WS_XC); }
    __device__ __forceinline__ float* xrow(int r) const { const int b = r / BROWS, q = r - b * BROWS; return q < CTXL ? xc() + (size_t)(b * CTXL + q) * DM : out + (size_t)(b * SEQL + (q - CTXL)) * DM; }
    __device__ __forceinline__ const float* xin_row(int r) const { const int b = r / BROWS, q = r - b * BROWS; return q < CTXL ? in[I_CTX] + (size_t)(b * CTXL + q) * DM : in[I_X] + (size_t)(b * SEQL + (q - CTXL)) * DM; }
};
struct TC { int tid, lane, wave; };
__device__ __forceinline__ TC phase_tc() { TC t; int x = threadIdx.x; asm volatile("" : "+v"(x)); t.tid = x; t.lane = x & 63; t.wave = __builtin_amdgcn_readfirstlane(x >> 6); return t; }
__device__ __forceinline__ int row_mv(int r) { const int b = r / BROWS, q = r - b * BROWS; return q < CTXL ? 2 : b; }

struct RowSched {
    int nM, nN, nwg, G, c, skipctx; const char* A; const char* Bt; size_t a_tile, b_tile; long bdel;
    __device__ __forceinline__ bool next(int i, pg8::Unit& u) const {
        const long L = (long)i * G + c; if (L >= nwg) return false;
        if (skipctx == 2) { const int t8 = (int)L >> 2, ks = (int)L & 3; u.pm = (t8 >> 2) * 33; u.pn = t8 & 3;
            u.a = A + (size_t)u.pm * a_tile + (size_t)ks * 1024; u.b = Bt + (size_t)u.pn * b_tile + (size_t)ks * 1024; u.bd = 0; u.tbo = (int)L; u.nrow = 0; return true; }
        int wgid = (int)L; { const int q = nwg / 8, r = nwg % 8, xcd = wgid % 8, off = wgid / 8; wgid = (xcd < r ? xcd * (q + 1) : r * (q + 1) + (xcd - r) * q) + off; }
        const int nig = 8 * nN, gid = wgid / nig, fm = gid * 8, gsz = (nM - fm) < 8 ? (nM - fm) : 8;
        const int pmi = fm + ((wgid % nig) % gsz); u.pn = (wgid % nig) / gsz;
        u.pm = skipctx ? (pmi / 32) * 33 + 1 + (pmi % 32) : pmi;
        u.a = A + (size_t)u.pm * a_tile; u.b = Bt + (size_t)u.pn * b_tile; u.bd = bdel; u.tbo = 0; u.nrow = 0; return true;
    }
    __device__ __forceinline__ void a_ready(const pg8::Unit&) const {}
    __device__ __forceinline__ void done(const pg8::Unit&) const {}
};
struct MoeSchedBase {
    const int* mt; int G, c, layer; unsigned char* ws;
    __device__ __forceinline__ bool locate(int i, pg8::Unit& u, int& ea, int& eb) const {
        const int ntl = mt[24]; const long L = (long)i * G + c; if (L >= (long)ntl * 4) return false;
        const int tile = (int)(L >> 2), pn = (int)(L & 3), cls = mt[64 + tile], g = cls / 6, pi = cls - g * 6;
        const int ia = pi < 3 ? 0 : (pi < 5 ? 1 : 2), ib = pi < 3 ? pi + 1 : (pi < 5 ? pi - 1 : 3);
        ea = g * 4 + ia; eb = g * 4 + ib;
        const int ti = tile - mt[cls];
        u.pm = tile; u.pn = pn; u.tbo = cls * NROWS + ti * 256; u.nrow = mt[32 + cls] - ti * 256;
        return true;
    }
};
struct MoeSched1 : MoeSchedBase {
    __device__ __forceinline__ bool next(int i, pg8::Unit& u) const { int ea, eb; if (!locate(i, u, ea, eb)) return false;
        const int e = (u.pn >> 1) ? eb : ea; u.a = (const char*)(ws + WS_A); u.b = (const char*)(ws + WS_W13) + ((size_t)e * 512 + (u.pn & 1) * 256) * 1024 * 2; u.bd = 0; return true; }
    __device__ __forceinline__ void a_ready(const pg8::Unit&) const {}
    __device__ __forceinline__ void done(const pg8::Unit& u) const {
        asm volatile("s_waitcnt vmcnt(0)" ::: "memory");
        if ((threadIdx.x & 63) == 0) __hip_atomic_fetch_add((unsigned*)(ws + WS_CTL) + CW_TDONE + layer * 6144 + 64 * u.pm, 1u, __ATOMIC_RELAXED, __HIP_MEMORY_SCOPE_AGENT);
    }
};
struct MoeSched2 : MoeSchedBase {
    __device__ __forceinline__ bool next(int i, pg8::Unit& u) const { int ea, eb; if (!locate(i, u, ea, eb)) return false;
        u.a = (const char*)(ws + WS_Z) + (size_t)u.pm * 256 * 512 * 2; u.b = (const char*)(ws + WS_W2) + ((size_t)ea * 1024 + u.pn * 256) * 256 * 2; u.bd = (long)(eb - ea) * 1024 * 256 * 2 - 4 * 128; return true; }
    __device__ __forceinline__ void a_ready(const pg8::Unit& u) const {
        if (threadIdx.x < 64) {
            unsigned polls = 0;
            unsigned* tw = (unsigned*)(ws + WS_CTL) + CW_TDONE + layer * 6144 + 64 * u.pm;
            while ((unsigned)__builtin_amdgcn_readfirstlane(__hip_atomic_load(tw, __ATOMIC_RELAXED, __HIP_MEMORY_SCOPE_AGENT)) < 32u) {
                if (++polls > (1u << 17)) break;
                __builtin_amdgcn_s_sleep(16); }
            __builtin_amdgcn_fence(__ATOMIC_ACQUIRE, "agent");
            asm volatile("s_waitcnt vmcnt(0)" ::: "memory");
        }
        asm volatile("" ::: "memory"); __builtin_amdgcn_s_barrier(); asm volatile("" ::: "memory");
    }
    __device__ __forceinline__ void done(const pg8::Unit&) const {}
};

struct EpiProj {
    static constexpr bool PERM = true;
    bf16 *d0, *d1, *d2, *d3, *d4, *d5; int e0, e1, e2, e3, e4; int l0, l1, l2, l3, l4, l5; int lastcols;
    __device__ __forceinline__ void operator()(const f32x4 (&acc)[2][2][4][2], const pg8::Unit& u, int wr, int wc, int fr, int fq) const {
        const int pn = u.pn; bf16* base; int ld, tl, ncol = 256;
        if (pn < e0) { base = d0; ld = l0; tl = pn; } else if (pn < e1) { base = d1; ld = l1; tl = pn - e0; } else if (pn < e2) { base = d2; ld = l2; tl = pn - e1; }
        else if (pn < e3) { base = d3; ld = l3; tl = pn - e2; } else if (pn < e4) { base = d4; ld = l4; tl = pn - e3; } else { base = d5; ld = l5; tl = pn - e4; ncol = lastcols; }
        const int row0 = u.pm * 256 + wr * 64 + fr, col0 = wc * 32 + 8 * fq;
#pragma unroll
        for (int ai = 0; ai < 2; ++ai)
#pragma unroll
            for (int m = 0; m < 4; ++m) { bf16* rowp = base + (size_t)(row0 + ai * 128 + m * 16) * ld + tl * 256 + col0;
#pragma unroll
                for (int bj = 0; bj < 2; ++bj) { if (col0 + bj * 128 < ncol) { const f32x4 v0 = acc[ai][bj][m][0], v1 = acc[ai][bj][m][1];
                    u32x4 w; w.x = pg8::cvt_pk_bf16(v0[0], v0[1]); w.y = pg8::cvt_pk_bf16(v0[2], v0[3]); w.z = pg8::cvt_pk_bf16(v1[0], v1[1]); w.w = pg8::cvt_pk_bf16(v1[2], v1[3]);
                    *(u32x4*)(rowp + bj * 128) = w; } } }
    }
};
struct EpiRes {
    static constexpr bool PERM = false;
    float* slab;
    const float* xin_lat; const float* xin_ctx; float* xout_lat; float* xout_ctx; const float* modbase;
    __device__ __forceinline__ void operator()(const f32x4 (&acc)[2][2][4][2], const pg8::Unit& u, int wr, int wc, int fr, int fq) const {
        if (slab) { float* sp = slab + (size_t)u.tbo * 65536 + (size_t)(wr * 64 + fr) * 256 + wc * 32 + 4 * fq;
#pragma unroll
            for (int ai = 0; ai < 2; ++ai)
#pragma unroll
                for (int m = 0; m < 4; ++m)
#pragma unroll
                    for (int bj = 0; bj < 2; ++bj)
#pragma unroll
                        for (int n = 0; n < 2; ++n) *(f32x4*)(sp + (size_t)(ai * 128 + m * 16) * 256 + bj * 128 + n * 16) = acc[ai][bj][m][n];
            return; }
        const int b = u.pm / 33, qt = u.pm - b * 33; const bool isctx = (qt == 0);
        const size_t rbase = isctx ? (size_t)b * CTXL : (size_t)b * SEQL + (size_t)(qt - 1) * 256;
        const float* xi = (isctx ? xin_ctx : xin_lat) + rbase * DM; float* xo = (isctx ? xout_ctx : xout_lat) + rbase * DM;
        const float* gate = modbase + (size_t)(isctx ? 2 : b) * 6144 + 2 * 1024;
        const int row0 = wr * 64 + fr, col0 = u.pn * 256 + wc * 32 + 4 * fq;
        f32x4 gv[2][2];
#pragma unroll
        for (int bj = 0; bj < 2; ++bj)
#pragma unroll
            for (int n = 0; n < 2; ++n) gv[bj][n] = *(const f32x4*)(gate + col0 + bj * 128 + n * 16);
#pragma unroll
        for (int ai = 0; ai < 2; ++ai)
#pragma unroll
            for (int m = 0; m < 4; ++m) { const size_t off = (size_t)(row0 + ai * 128 + m * 16) * DM + col0;
#pragma unroll
                for (int bj = 0; bj < 2; ++bj)
#pragma unroll
                    for (int n = 0; n < 2; ++n) { const f32x4 xv = *(const f32x4*)(xi + off + bj * 128 + n * 16);
                        *(f32x4*)(xo + off + bj * 128 + n * 16) = xv + gv[bj][n] * acc[ai][bj][m][n]; } }
    }
};
struct EpiMoe1 {
    static constexpr bool PERM = true;
    unsigned char* ws;
    __device__ __forceinline__ void operator()(const f32x4 (&acc)[2][2][4][2], const pg8::Unit& u, int wr, int wc, int fr, int fq) const {
        const __amdgpu_buffer_rsrc_t hr = __builtin_amdgcn_make_buffer_rsrc((void*)(ws + WS_Z), 0, MAXSLOT * 512 * 2, 0x00020000);
        const int* TBL = (const int*)(ws + WS_TBL); const int* REC = (const int*)(ws + WS_REC);
        const int rho0 = wr * 64 + fr, colh = (u.pn >> 1) * 256 + (u.pn & 1) * 128 + wc * 32 + 8 * fq, which = u.pn >> 1;
        int rr[8]; float gts[8];
#pragma unroll
        for (int k = 0; k < 8; ++k) { const int rho = rho0 + (k >> 2) * 128 + (k & 3) * 16; const int rc = rho < u.nrow ? rho : u.nrow - 1; rr[k] = TBL[u.tbo + rc]; }
#pragma unroll
        for (int k = 0; k < 8; ++k) gts[k] = __uint_as_float((unsigned)REC[(size_t)rr[k] * 4 + 2 + which]);
#pragma unroll
        for (int ai = 0; ai < 2; ++ai)
#pragma unroll
            for (int m = 0; m < 4; ++m) { const int rho = rho0 + ai * 128 + m * 16; const float gt = gts[ai * 4 + m];
                float hv[8];
#pragma unroll
                for (int n = 0; n < 2; ++n)
#pragma unroll
                    for (int e = 0; e < 4; ++e) { const float a = acc[ai][0][m][n][e], uu = acc[ai][1][m][n][e]; hv[n * 4 + e] = silu_f(a) * uu * gt; }
                u32x4 w; w.x = pg8::cvt_pk_bf16(hv[0], hv[1]); w.y = pg8::cvt_pk_bf16(hv[2], hv[3]); w.z = pg8::cvt_pk_bf16(hv[4], hv[5]); w.w = pg8::cvt_pk_bf16(hv[6], hv[7]);
                __builtin_amdgcn_raw_buffer_store_b128(w, hr, (unsigned)(((size_t)(u.pm * 256 + rho) * 512 + colh) * 2), 0, 16); }
    }
};
struct EpiMoe2 {
    static constexpr bool PERM = false;
    float* out; unsigned char* ws; int layer;
    __device__ __forceinline__ void operator()(const f32x4 (&acc)[2][2][4][2], const pg8::Unit& u, int wr, int wc, int fr, int fq) const {
        const int rho0 = wr * 64 + fr, col0 = u.pn * 256 + wc * 32 + 4 * fq; const int* TBL = (const int*)(ws + WS_TBL); float* xc = (float*)(ws + WS_XC); const float* modbase = (const float*)(ws + WS_MOD) + (size_t)layer * 3 * 6144;
        int rr[8];
#pragma unroll
        for (int k = 0; k < 8; ++k) { const int rho = rho0 + (k >> 2) * 128 + (k & 3) * 16; rr[k] = rho < u.nrow ? TBL[u.tbo + rho] : -1; }
#pragma unroll
        for (int ai = 0; ai < 2; ++ai)
#pragma unroll
            for (int m = 0; m < 4; ++m) { const int r = rr[ai * 4 + m];
                if (r >= 0) { const int b = r / BROWS, q = r - b * BROWS; const bool isctx = q < CTXL;
                    float* xp = isctx ? xc + (size_t)(b * CTXL + q) * DM : out + (size_t)(b * SEQL + (q - CTXL)) * DM;
                    const float* gate = modbase + (size_t)(isctx ? 2 : b) * 6144 + 5 * 1024;
#pragma unroll
                    for (int bj = 0; bj < 2; ++bj)
#pragma unroll
                        for (int n = 0; n < 2; ++n) { const int c = col0 + bj * 128 + n * 16; const f32x4 gv = *(const f32x4*)(gate + c); const f32x4 xv = *(const f32x4*)(xp + c);
                            *(f32x4*)(xp + c) = xv + gv * acc[ai][bj][m][n]; } }
                if (m & 1) asm volatile("" ::: "memory"); }
    }
};

__device__ __forceinline__ void transpose_item(const float* W, int ldw, int k0, int n0src, bf16* WT, int ldt, int drow0, int dk0, LAS float* scr, int lane) {
    float tv[32];
#pragma unroll
    for (int i = 0; i < 32; ++i) { const int kk = 2 * i + (lane >> 5); tv[i] = n0src >= 0 ? W[(size_t)(k0 + kk) * ldw + n0src + (lane & 31)] : 0.f; }
#pragma unroll
    for (int i = 0; i < 32; ++i) { const int kk = 2 * i + (lane >> 5); scr[kk * 33 + (lane & 31)] = tv[i]; }
    asm volatile("s_waitcnt lgkmcnt(0)" ::: "memory");
    const int c = lane & 7;
#pragma unroll
    for (int j = 0; j < 4; ++j) { const int n = (lane >> 3) + 8 * j; const LAS float* s = scr + (8 * c) * 33 + n;
        u32x4 o; o.x = pk2(s[0 * 33], s[1 * 33]); o.y = pk2(s[2 * 33], s[3 * 33]); o.z = pk2(s[4 * 33], s[5 * 33]); o.w = pk2(s[6 * 33], s[7 * 33]);
        *(u32x4*)(WT + (size_t)(drow0 + n) * ldt + dk0 + 8 * c) = o; }
    asm volatile("s_waitcnt lgkmcnt(0)" ::: "memory");
}
__device__ __forceinline__ int ab_src_col(int n) {
    if (n < 2304) return n;
    if (n < 3840) return n + 32;
    if (n < 3872) return n - 3840 + 2304;
    return -1;
}
__device__ __forceinline__ void ph_convert(const Ctx& C, int layer, LAS unsigned char* lds) {
    const TC T = phase_tc();
    LAS float* scr = (LAS float*)(lds + T.wave * 16384);
    const int gw = C.bid * NWAVES + T.wave, NGW = C.G * NWAVES;
    bf16* Win = (bf16*)(C.ws + WS_WIN); bf16* Wout = (bf16*)(C.ws + WS_WOUT); bf16* W13 = (bf16*)(C.ws + WS_W13); bf16* W2 = (bf16*)(C.ws + WS_W2);
    const int nin = layer == 0 ? 3872 : 3584;
    const int I_IN = 16 * (nin / 32), I_OUT = 32 * 32, I_E = 16 * 128;
    const int NIT = I_IN + I_OUT + 3 * I_E;
    const float* win = C.in[layer == 0 ? I_ABIN : I_CDIN]; const float* wout = C.in[layer == 0 ? I_ABOUT : I_CDOUT];
    const int ldin = layer == 0 ? 3872 : 3584;
    for (int it = gw; it < NIT; it += NGW) {
        int r = it;
        if (r < I_IN) { const int nblk = nin / 32, kb = r / nblk, nb = r % nblk; const int src = layer == 0 ? ab_src_col(nb * 32) : nb * 32;
            transpose_item(win, ldin, kb * 64, src, Win, 1024, nb * 32, kb * 64, scr, T.lane); continue; } r -= I_IN;
        if (r < I_OUT) { const int kb = r / 32, nb = r % 32; transpose_item(wout, 1024, kb * 64, nb * 32, Wout, 2048, nb * 32, kb * 64, scr, T.lane); continue; } r -= I_OUT;
        if (r < 2 * I_E) { const int w3 = r >= I_E; if (w3) r -= I_E; const int e = r / 128, q = r % 128, kb = q / 8, nb = q % 8;
            const float* W = C.in[w3 ? I_W3 : I_W1] + (size_t)(layer * 16 + e) * 1024 * 256; const int n0 = nb * 32;
            transpose_item(W, 256, kb * 64, n0, W13 + (size_t)e * 512 * 1024, 1024, (n0 / 128) * 256 + (w3 ? 128 : 0) + (n0 % 128), kb * 64, scr, T.lane); continue; } r -= 2 * I_E;
        { const int e = r / 128, q = r % 128, kb = q / 32, nb = q % 32;
            const float* W = C.in[I_W2] + (size_t)(layer * 16 + e) * 256 * 1024;
            transpose_item(W, 1024, kb * 64, nb * 32, W2 + (size_t)e * 1024 * 256, 256, nb * 32, kb * 64, scr, T.lane); }
    }
}
__device__ __forceinline__ void ph_mod(const Ctx& C, LAS unsigned char* lds) {
    const TC T = phase_tc();
    LAS float* red = (LAS float*)lds;
    LAS float* act = red + 8 * 3 * 256;
    if (C.bid < 48) {
        for (int i = T.tid; i < 3072; i += NTHREADS) { const int v = i >> 10, d = i & 1023; act[i] = silu_f(v < 2 ? C.in[I_C][v * 1024 + d] : C.in[I_CCTX][d]); }
        __syncthreads();
    }
    for (int item = C.bid; item < 48; item += C.G) {
        const int layer = item / 24, chunk = item % 24;
        const float* W = C.in[I_WMOD] + (size_t)layer * 1024 * 6144 + chunk * 256 + T.lane * 4;
        f32x4 a0 = {0, 0, 0, 0}, a1 = a0, a2 = a0;
        const int d0 = T.wave * 128;
        for (int d = d0; d < d0 + 128; d += 8) {
            f32x4 w[8];
#pragma unroll
            for (int u = 0; u < 8; ++u) w[u] = *(const f32x4*)(W + (size_t)(d + u) * 6144);
#pragma unroll
            for (int u = 0; u < 8; ++u) { const float c0 = act[d + u], c1 = act[1024 + d + u], c2 = act[2048 + d + u]; a0 += w[u] * c0; a1 += w[u] * c1; a2 += w[u] * c2; }
        }
        __syncthreads();
#pragma unroll
        for (int e = 0; e < 4; ++e) { red[(T.wave * 3 + 0) * 256 + T.lane * 4 + e] = a0[e]; red[(T.wave * 3 + 1) * 256 + T.lane * 4 + e] = a1[e]; red[(T.wave * 3 + 2) * 256 + T.lane * 4 + e] = a2[e]; }
        __syncthreads();
        for (int o = T.tid; o < 768; o += NTHREADS) { const int v = o >> 8, j = o & 255; float s = 0.f;
#pragma unroll
            for (int w = 0; w < 8; ++w) s += red[(w * 3 + v) * 256 + j];
            C.mod(layer, v)[chunk * 256 + j] = s + C.in[I_BMOD][layer * 6144 + chunk * 256 + j]; }
        asm volatile("s_waitcnt vmcnt(0)" ::: "memory");
        __syncthreads();
        if (T.tid == 0) { __builtin_amdgcn_fence(__ATOMIC_RELEASE, "agent"); asm volatile("s_waitcnt vmcnt(0)" ::: "memory");
            __hip_atomic_fetch_add(C.ctl() + CW_MODDONE, 1u, __ATOMIC_RELAXED, __HIP_MEMORY_SCOPE_AGENT); }
    }
}
__device__ __forceinline__ void mod_wait(const Ctx& C) {
    const TC T = phase_tc();
    if (T.tid < 64) { unsigned polls = 0;
        while ((unsigned)__builtin_amdgcn_readfirstlane(__hip_atomic_load(C.ctl() + CW_MODDONE, __ATOMIC_RELAXED, __HIP_MEMORY_SCOPE_AGENT)) < 48u) { if (++polls > (1u << 17)) break; __builtin_amdgcn_s_sleep(16); }
        __builtin_amdgcn_fence(__ATOMIC_ACQUIRE, "agent"); asm volatile("s_waitcnt vmcnt(0)" ::: "memory"); }
    __syncthreads();
}
__device__ __forceinline__ void ph_prenorm(const Ctx& C, int layer) {
    const TC T = phase_tc();
    bf16* HN = (bf16*)(C.ws + WS_A);
    const float* gm = C.in[I_GMIX] + layer * 1024;
    const int gw = C.bid * NWAVES + T.wave, NGW = C.G * NWAVES;
    for (int r = gw; r < NROWS; r += NGW) {
        const float* xr = layer == 0 ? C.xin_row(r) : C.xrow(r);
        const float* md = C.mod(layer, row_mv(r));
        f32x4 v[4]; float ss = 0.f;
#pragma unroll
        for (int j = 0; j < 4; ++j) { v[j] = *(const f32x4*)(xr + 256 * j + 4 * T.lane); ss += (v[j].x * v[j].x + v[j].y * v[j].y) + (v[j].z * v[j].z + v[j].w * v[j].w); }
        const float rs = rsqrtf(wave_sum(ss) * (1.f / DM) + EPS);
#pragma unroll
        for (int j = 0; j < 4; ++j) { const int c = 256 * j + 4 * T.lane; const f32x4 g = *(const f32x4*)(gm + c), sc = *(const f32x4*)(md + 1024 + c), sh = *(const f32x4*)(md + c);
            const f32x4 h = v[j] * rs * g * (sc + 1.f) + sh;
            u32x2 w; w.x = pk2(h.x, h.y); w.y = pk2(h.z, h.w); *(u32x2*)(HN + (size_t)r * DM + c) = w; }
    }
}
__device__ __forceinline__ bool nb_valid(int r, int dk) { const int b = r / BROWS, q = r - b * BROWS; if (q < CTXL) { const int t = q + dk; return t >= 0 && t < CTXL; } const int t = q - CTXL + dk; return t >= 0 && t < SEQL; }
__device__ __forceinline__ void rope_angle(int r, int lane, float& cs, float& sn, bool& latent) {
    const int b = r / BROWS, q = r - b * BROWS; latent = q >= CTXL; const int t = q - CTXL;
    const int pos = lane < 32 ? (t >> 6) : (t & 63); const int jf = lane & 31;
    const float inv = exp2f(-(float)jf * (13.287712379549449f / 32.f));
    const float ang = (float)pos * inv; sincosf(ang, &sn, &cs);
}
__device__ __forceinline__ void ph_elem0(const Ctx& C) {
    const TC T = phase_tc();
    const bf16* RAW = (const bf16*)(C.ws + WS_RAW); bf16* XBC = (bf16*)C.out;
    float* DT = (float*)(C.ws + WS_DT);
    bf16* Q = (bf16*)(C.ws + WS_YMIX) + 1024; bf16* K = (bf16*)(C.ws + WS_K);
    const float* cw = C.in[I_SCONVW]; const float* cb = C.in[I_SCONVB];
    const int gw = C.bid * NWAVES + T.wave, NGW = C.G * NWAVES, lane = T.lane;
    { const bf16* HN = (const bf16*)(C.ws + WS_A); const bf16* Wd = (const bf16*)(C.ws + WS_WIN) + (size_t)3840 * 1024; const int l15 = lane & 15, lq = lane >> 4;
      const float bias0 = C.in[I_DTBIAS][l15], bias1 = C.in[I_DTBIAS][16 + l15];
      for (int gI = gw; gI < NROWS / 16; gI += NGW) { f32x4 a0 = {0.f, 0.f, 0.f, 0.f}, a1 = a0;
          const bf16* ap = HN + (size_t)(16 * gI + l15) * 1024 + 8 * lq; const bf16* b0p = Wd + (size_t)l15 * 1024 + 8 * lq; const bf16* b1p = Wd + (size_t)(16 + l15) * 1024 + 8 * lq;
#pragma unroll 8
          for (int ks = 0; ks < 32; ++ks) { const bf16x8 af = *(const bf16x8*)(ap + 32 * ks), f0 = *(const bf16x8*)(b0p + 32 * ks), f1 = *(const bf16x8*)(b1p + 32 * ks);
              a0 = __builtin_amdgcn_mfma_f32_16x16x32_bf16(af, f0, a0, 0, 0, 0); a1 = __builtin_amdgcn_mfma_f32_16x16x32_bf16(af, f1, a1, 0, 0, 0); }
#pragma unroll
          for (int rg = 0; rg < 4; ++rg) { const size_t ro = (size_t)(16 * gI + 4 * lq + rg) * 32; DT[ro + l15] = softplus_f(a0[rg] + bias0); DT[ro + 16 + l15] = softplus_f(a1[rg] + bias1); } } }
    for (int r = gw; r < NROWS; r += NGW) {
        for (int ch = lane; ch < 160; ch += 64) { const int c0 = ch * 8; float acc[8];
#pragma unroll
            for (int e = 0; e < 8; ++e) acc[e] = cb[c0 + e];
#pragma unroll
            for (int k = 0; k < 5; ++k) { if (nb_valid(r, k - 2)) { const u32x4 w = *(const u32x4*)(RAW + (size_t)(r + k - 2) * 1280 + c0); float xv[8]; unpack8(w, xv);
#pragma unroll
                for (int e = 0; e < 8; ++e) acc[e] += xv[e] * cw[k * 1280 + c0 + e]; } }
            u32x4 o; o.x = pk2(silu_f(acc[0]), silu_f(acc[1])); o.y = pk2(silu_f(acc[2]), silu_f(acc[3])); o.z = pk2(silu_f(acc[4]), silu_f(acc[5])); o.w = pk2(silu_f(acc[6]), silu_f(acc[7]));
            *(u32x4*)(XBC + (size_t)r * 1280 + c0) = o; }
        float cs, sn; bool latent; rope_angle(r, lane, cs, sn, latent);
        const float qg0 = C.in[I_QG][lane], qg1 = C.in[I_QG][64 + lane], kg0 = C.in[I_KG][lane], kg1 = C.in[I_KG][64 + lane];
#pragma unroll
        for (int h = 8; h < 10; ++h) { bf16* p = K + (size_t)r * 256 + (h - 8) * 128;
            float t1 = bf2f(p[lane]), t2 = bf2f(p[64 + lane]);
            const float rs = rsqrtf(wave_sum(t1 * t1 + t2 * t2) * (1.f / 128.f) + EPS);
            t1 = t1 * rs * (h < 8 ? qg0 : kg0); t2 = t2 * rs * (h < 8 ? qg1 : kg1);
            if (latent) { const float o1 = t1 * cs - t2 * sn, o2 = t1 * sn + t2 * cs; t1 = o1; t2 = o2; }
            p[lane] = (bf16)f2bf(t1); p[64 + lane] = (bf16)f2bf(t2); }
    }
}
__device__ __forceinline__ void ph_elem1(const Ctx& C) {
    const TC T = phase_tc();
    const bf16* RAW = (const bf16*)(C.ws + WS_YMIX); bf16* XR = (bf16*)(C.ws + WS_A);
    bf16* Q = (bf16*)(C.ws + WS_YMIX) + 1024; bf16* K = (bf16*)(C.ws + WS_K);
    const float* cw = C.in[I_LCONVW]; const float* cb = C.in[I_LCONVB];
    const int gw = C.bid * NWAVES + T.wave, NGW = C.G * NWAVES, lane = T.lane;
    for (int r = gw; r < NROWS; r += NGW) {
        for (int ch = lane; ch < 128; ch += 64) { const int c0 = ch * 8; float acc[8];
#pragma unroll
            for (int e = 0; e < 8; ++e) acc[e] = cb[c0 + e];
#pragma unroll
            for (int k = 0; k < 5; ++k) { if (nb_valid(r, k - 2)) { const u32x4 w = *(const u32x4*)(RAW + (size_t)(r + k - 2) * 2048 + c0); float xv[8]; unpack8(w, xv);
#pragma unroll
                for (int e = 0; e < 8; ++e) acc[e] += xv[e] * cw[k * 1024 + c0 + e]; } }
            u32x4 o; o.x = pk2(acc[0], acc[1]); o.y = pk2(acc[2], acc[3]); o.z = pk2(acc[4], acc[5]); o.w = pk2(acc[6], acc[7]);
            *(u32x4*)(XR + (size_t)r * 1024 + c0) = o; }
        float cs, sn; bool latent; rope_angle(r, lane, cs, sn, latent);
        if (latent) {
#pragma unroll
            for (int h = 8; h < 10; ++h) { bf16* p = K + (size_t)r * 256 + (h - 8) * 128;
                const float t1 = bf2f(p[lane]), t2 = bf2f(p[64 + lane]);
                p[lane] = (bf16)f2bf(t1 * cs - t2 * sn); p[64 + lane] = (bf16)f2bf(t1 * sn + t2 * cs); }
        }
    }
}
__device__ __forceinline__ int chunk_of(int dir, int ci) { return dir == 0 ? ci : (ci < 2 ? 1 - ci : 67 - ci); }
__device__ __forceinline__ int step_row(int dir, int s) { return dir == 0 ? s : (s < CTXL ? CTXL - 1 - s : BROWS + CTXL - 1 - s); }
__device__ __forceinline__ void ssd_seq_unit(const Ctx& C, int item, LAS unsigned char* lds) {
    const TC T = phase_tc();
    const int b = item >> 5, dir = (item >> 4) & 1, h = item & 15, g = h >> 3, lane = T.lane, wid = T.wave;
    LAS float* part = (LAS float*)lds;
    LAS float* xs = part + 8 * 32 * 64; LAS float* Bs = xs + 32 * 64; LAS float* Cs = Bs + 32 * 64; LAS float* dts = Cs + 32 * 64;
    const float aneg = -__expf(C.in[I_ALOG][dir * 16 + h]);
    const bf16* XBC = (const bf16*)C.out + (size_t)b * BROWS * 1280;
    const float* DT = (const float*)(C.ws + WS_DT) + (size_t)b * BROWS * 32 + dir * 16 + h;
    bf16* Y = dir == 0 ? (bf16*)(C.ws + WS_YMIX) + (size_t)b * BROWS * 2048 + h * 64 : (bf16*)(C.ws + WS_RAW) + (size_t)b * BROWS * 1024 + h * 64;
    const int ldy = dir == 0 ? 2048 : 1024;
    float hs[8];
#pragma unroll
    for (int k = 0; k < 8; ++k) hs[k] = 0.f;
    for (int s0 = 0; s0 < BROWS; s0 += 32) {
        for (int i = T.tid; i < 32 * 192; i += NTHREADS) { const int tt = i / 192, c = i - tt * 192; const int q = step_row(dir, s0 + tt);
            const bf16* row = XBC + (size_t)q * 1280;
            if (c < 64) xs[tt * 64 + c] = bf2f(row[h * 64 + c]); else if (c < 128) Bs[tt * 64 + c - 64] = bf2f(row[1024 + g * 64 + c - 64]); else Cs[tt * 64 + c - 128] = bf2f(row[1152 + g * 64 + c - 128]); }
        if (T.tid < 32) dts[T.tid] = DT[(size_t)step_row(dir, s0 + T.tid) * 32];
        __syncthreads();
        for (int tt = 0; tt < 32; ++tt) {
            const float x = xs[tt * 64 + lane], dt = dts[tt];
            const f32x4 b0 = *(const LAS f32x4*)(Bs + tt * 64 + wid * 8), b1 = *(const LAS f32x4*)(Bs + tt * 64 + wid * 8 + 4);
            const f32x4 c0 = *(const LAS f32x4*)(Cs + tt * 64 + wid * 8), c1 = *(const LAS f32x4*)(Cs + tt * 64 + wid * 8 + 4);
            const float a = __expf(dt * aneg), dx = dt * x; float y = 0.f;
#pragma unroll
            for (int k = 0; k < 4; ++k) { hs[k] = a * hs[k] + dx * b0[k]; y += c0[k] * hs[k]; }
#pragma unroll
            for (int k = 0; k < 4; ++k) { hs[4 + k] = a * hs[4 + k] + dx * b1[k]; y += c1[k] * hs[4 + k]; }
            part[(wid * 32 + tt) * 64 + lane] = y;
        }
        __syncthreads();
        for (int i = T.tid; i < 2048; i += NTHREADS) { const int tt = i >> 6, p = i & 63; float s = 0.f;
#pragma unroll
            for (int w = 0; w < 8; ++w) s += part[(w * 32 + tt) * 64 + p];
            const int q = step_row(dir, s0 + tt); Y[(size_t)q * ldy + p] = (bf16)f2bf(s); }
        __syncthreads();
    }
}

__device__ __forceinline__ int ssd_seg_begin(int s) { return s == 0 ? 0 : (s == 1 ? 17 : (s == 2 ? 34 : (s == 3 ? 50 : 66))); }
__device__ __forceinline__ unsigned short hw_bf16(float x) { unsigned r; asm volatile("v_cvt_pk_bf16_f32 %0, %1, %1" : "=v"(r) : "v"(x)); return (unsigned short)r; }
__device__ __forceinline__ int tswz(int row, int col) { return row * 136 + ((((col >> 3) ^ ((row >> 3) & 7)) << 3) | (col & 7)); }
template <int MODE>
__device__ __forceinline__ void ssd_chunk_unit(const Ctx& C, int item, int seg, LAS unsigned char* lds) {
    const TC T = phase_tc();
    const int b = item >> 5, dir = (item >> 4) & 1, h = item & 15, g = h >> 3, lane = T.lane, wid = T.wave, tid = T.tid;
    const int ci0 = ssd_seg_begin(seg), ci1 = ssd_seg_begin(seg + 1);
    float* SEND = (float*)(C.ws + WS_SSDST) + (size_t)item * 3 * 4096; float* SLD = (float*)(C.ws + WS_SSDLD) + item * 3;
    const int l15 = lane & 15, lq = lane >> 4;
    LAS bf16* Cs = (LAS bf16*)lds;
    LAS bf16* Bs = Cs + 128 * 72;
    LAS bf16* Xt = Bs + 128 * 72;
    LAS bf16* Bwt = Xt + 64 * 136;
    LAS bf16* Ws = Bwt + 64 * 136;
    LAS bf16* Hs = Ws + 128 * 136;
    LAS float* acs = (LAS float*)(Hs + 64 * 72); LAS float* dtv = acs + 128; LAS float* eacs = dtv + 128; LAS float* wend = eacs + 128;
    const float aneg = -__expf(C.in[I_ALOG][dir * 16 + h]);
    const bf16* XBC = (const bf16*)C.out + (size_t)b * BROWS * 1280;
    const float* DT = (const float*)(C.ws + WS_DT) + (size_t)b * BROWS * 32 + dir * 16 + h;
    bf16* Y = dir == 0 ? (bf16*)(C.ws + WS_YMIX) + (size_t)b * BROWS * 2048 + h * 64 : (bf16*)(C.ws + WS_RAW) + (size_t)b * BROWS * 1024 + h * 64;
    const int ldy = dir == 0 ? 2048 : 1024;
    f32x4 Hacc[2]; Hacc[0] = (f32x4){0.f, 0.f, 0.f, 0.f}; Hacc[1] = Hacc[0];
    float ldsum = 0.f;
    if (MODE == 1) {
        for (int sp = 0; sp < seg; ++sp) { const float dseg = __expf(SLD[sp]);
#pragma unroll
            for (int t = 0; t < 2; ++t) { const int tl = 2 * wid + t, nt_ = tl >> 2, pt = tl & 3;
                const f32x4 sv = *(const f32x4*)(SEND + (size_t)sp * 4096 + (16 * pt + l15) * 64 + 16 * nt_ + 4 * lq); Hacc[t] = Hacc[t] * dseg + sv; } }
#pragma unroll
        for (int t = 0; t < 2; ++t) { const int tl = 2 * wid + t, nt_ = tl >> 2, pt = tl & 3;
            u32x2 w; w.x = pg8::cvt_pk_bf16(Hacc[t][0], Hacc[t][1]); w.y = pg8::cvt_pk_bf16(Hacc[t][2], Hacc[t][3]); *(LAS u32x2*)(Hs + (16 * pt + l15) * 72 + 16 * nt_ + 4 * lq) = w; }
    }
    u32x4 xb[4], bb[2], cb[2]; float dt0 = 0.f, dt1 = 0.f;
    const int xtg = tid >> 3, xpg = tid & 7;
#define SSD_ROW(q0_, i_) (XBC + (size_t)(dir == 0 ? (q0_) + (i_) : (q0_) + 127 - (i_)) * 1280)
#define SSD_LOAD(q0_) do { \
        if (tid < 256) { _Pragma("unroll") for (int q_ = 0; q_ < 4; ++q_) xb[q_] = *(const u32x4*)(SSD_ROW(q0_, 4 * xtg + q_) + h * 64 + 8 * xpg); } \
        _Pragma("unroll") for (int k = 0; k < 2; ++k) { const int pidx = tid + 512 * k, i_ = pidx >> 3, c8_ = (pidx & 7) * 8; \
            bb[k] = *(const u32x4*)(SSD_ROW(q0_, i_) + 1024 + g * 64 + c8_); if (MODE == 1) cb[k] = *(const u32x4*)(SSD_ROW(q0_, i_) + 1152 + g * 64 + c8_); } \
        if (wid == 0) { dt0 = DT[(size_t)(dir == 0 ? (q0_) + 2 * lane : (q0_) + 127 - 2 * lane) * 32]; dt1 = DT[(size_t)(dir == 0 ? (q0_) + 2 * lane + 1 : (q0_) + 126 - 2 * lane) * 32]; } } while (0)
    SSD_LOAD(chunk_of(dir, ci0) * 128);
    for (int ci = ci0; ci < ci1; ++ci) {
        const int q0 = chunk_of(dir, ci) * 128;
        __syncthreads();
        if (wid == 0) {
            const float a0 = dt0 * aneg, a1 = dt1 * aneg; float v = a0 + a1;
#pragma unroll
            for (int o = 1; o < 64; o <<= 1) { const float t = __shfl_up(v, o); if (lane >= o) v += t; }
            const float tot = __shfl(v, 63), c0 = v - a1;
            acs[2 * lane] = c0; acs[2 * lane + 1] = v; dtv[2 * lane] = dt0; dtv[2 * lane + 1] = dt1;
            eacs[2 * lane] = __expf(c0); eacs[2 * lane + 1] = __expf(v);
            wend[2 * lane] = __expf(tot - c0) * dt0; wend[2 * lane + 1] = __expf(tot - v) * dt1; }
        if (tid < 256) {
#pragma unroll
            for (int m = 0; m < 4; ++m) { const unsigned w0 = xb[0][m], w1 = xb[1][m], w2 = xb[2][m], w3 = xb[3][m];
                u32x2 lo, hi; lo.x = (w0 & 0xffffu) | (w1 << 16); lo.y = (w2 & 0xffffu) | (w3 << 16); hi.x = (w0 >> 16) | (w1 & 0xffff0000u); hi.y = (w2 >> 16) | (w3 & 0xffff0000u);
                *(LAS u32x2*)(Xt + tswz(8 * xpg + 2 * m, 4 * xtg)) = lo; *(LAS u32x2*)(Xt + tswz(8 * xpg + 2 * m + 1, 4 * xtg)) = hi; } }
#pragma unroll
        for (int k = 0; k < 2; ++k) { const int pidx = tid + 512 * k, i_ = pidx >> 3, c8_ = (pidx & 7) * 8;
            *(LAS u32x4*)(Bs + i_ * 72 + c8_) = bb[k]; if (MODE == 1) *(LAS u32x4*)(Cs + i_ * 72 + c8_) = cb[k]; }
        if (ci + 1 < ci1) SSD_LOAD(chunk_of(dir, ci + 1) * 128);
        __syncthreads();
        const float al = acs[127], dchunk = __expf(al); ldsum += al;
        if (tid < 256) { float f[4][8];
#pragma unroll
            for (int q_ = 0; q_ < 4; ++q_) { const u32x4 w = *(const LAS u32x4*)(Bs + (4 * xtg + q_) * 72 + 8 * xpg); unpack8(w, f[q_]); const float we = wend[4 * xtg + q_];
#pragma unroll
                for (int e = 0; e < 8; ++e) f[q_][e] *= we; }
#pragma unroll
            for (int e = 0; e < 8; ++e) { u32x2 w; w.x = pg8::cvt_pk_bf16(f[0][e], f[1][e]); w.y = pg8::cvt_pk_bf16(f[2][e], f[3][e]); *(LAS u32x2*)(Bwt + tswz(8 * xpg + e, 4 * xtg)) = w; } }
        if (MODE == 1) {
            for (int t = wid; t < 40; t += 8) {
                if (t >= 36) { const int rt = 2 * (t - 36);
                    *(LAS u32x2*)(Ws + (16 * rt + l15) * 136 + 16 * (rt + 1) + 4 * lq) = (u32x2){0u, 0u};
                    continue; }
                int rt = 0, base = 0; while (base + rt + 1 <= t) { base += rt + 1; ++rt; }
                const int ct = t - base;
                f32x4 acc = (f32x4){0.f, 0.f, 0.f, 0.f};
#pragma unroll
                for (int kk = 0; kk < 2; ++kk) { const bf16x8 af = *(const LAS bf16x8*)(Bs + (16 * ct + l15) * 72 + kk * 32 + 8 * lq), bfr = *(const LAS bf16x8*)(Cs + (16 * rt + l15) * 72 + kk * 32 + 8 * lq);
                    acc = __builtin_amdgcn_mfma_f32_16x16x32_bf16(af, bfr, acc, 0, 0, 0); }
                const int i = 16 * rt + l15; const float ai = acs[i];
                const f32x4 aj = *(const LAS f32x4*)(acs + 16 * ct + 4 * lq), dj = *(const LAS f32x4*)(dtv + 16 * ct + 4 * lq);
                float val[4];
#pragma unroll
                for (int rg = 0; rg < 4; ++rg) { const int j = 16 * ct + 4 * lq + rg; val[rg] = j <= i ? acc[rg] * __expf(ai - aj[rg]) * dj[rg] : 0.f; }
                u32x2 w; w.x = pg8::cvt_pk_bf16(val[0], val[1]); w.y = pg8::cvt_pk_bf16(val[2], val[3]); *(LAS u32x2*)(Ws + i * 136 + 16 * ct + 4 * lq) = w; }
        }
        __syncthreads();
        if (MODE == 1) { const int it = wid; f32x4 acc[4];
#pragma unroll
          for (int pt = 0; pt < 4; ++pt) acc[pt] = (f32x4){0.f, 0.f, 0.f, 0.f};
#pragma unroll
          for (int kk = 0; kk < 2; ++kk) { const bf16x8 bfr = *(const LAS bf16x8*)(Cs + (16 * it + l15) * 72 + kk * 32 + 8 * lq);
#pragma unroll
              for (int pt = 0; pt < 4; ++pt) { const bf16x8 af = *(const LAS bf16x8*)(Hs + (16 * pt + l15) * 72 + kk * 32 + 8 * lq); acc[pt] = __builtin_amdgcn_mfma_f32_16x16x32_bf16(af, bfr, acc[pt], 0, 0, 0); } }
          const float ea = eacs[16 * it + l15];
#pragma unroll
          for (int pt = 0; pt < 4; ++pt) acc[pt] = acc[pt] * ea;
          for (int ks = 0; ks <= (it >> 1); ++ks) { const bf16x8 bfr = *(const LAS bf16x8*)(Ws + (16 * it + l15) * 136 + ks * 32 + 8 * lq);
#pragma unroll
              for (int pt = 0; pt < 4; ++pt) { const bf16x8 af = *(const LAS bf16x8*)(Xt + tswz(16 * pt + l15, ks * 32 + 8 * lq)); acc[pt] = __builtin_amdgcn_mfma_f32_16x16x32_bf16(af, bfr, acc[pt], 0, 0, 0); } }
          { const int i = 16 * it + l15; const int q = dir == 0 ? q0 + i : q0 + 127 - i;
#pragma unroll
            for (int pt = 0; pt < 4; ++pt) { u32x2 w; w.x = pg8::cvt_pk_bf16(acc[pt][0], acc[pt][1]); w.y = pg8::cvt_pk_bf16(acc[pt][2], acc[pt][3]); *(u32x2*)(Y + (size_t)q * ldy + 16 * pt + 4 * lq) = w; } } }
#pragma unroll
        for (int t = 0; t < 2; ++t) { const int tl = 2 * wid + t, nt_ = tl >> 2, pt = tl & 3; Hacc[t] = Hacc[t] * dchunk;
#pragma unroll
            for (int ks = 0; ks < 4; ++ks) { const bf16x8 af = *(const LAS bf16x8*)(Bwt + tswz(16 * nt_ + l15, ks * 32 + 8 * lq)), bfr = *(const LAS bf16x8*)(Xt + tswz(16 * pt + l15, ks * 32 + 8 * lq));
                Hacc[t] = __builtin_amdgcn_mfma_f32_16x16x32_bf16(af, bfr, Hacc[t], 0, 0, 0); } }
        if (MODE == 1) {
        __syncthreads();
#pragma unroll
        for (int t = 0; t < 2; ++t) { const int tl = 2 * wid + t, nt_ = tl >> 2, pt = tl & 3;
            u32x2 w; w.x = pg8::cvt_pk_bf16(Hacc[t][0], Hacc[t][1]); w.y = pg8::cvt_pk_bf16(Hacc[t][2], Hacc[t][3]); *(LAS u32x2*)(Hs + (16 * pt + l15) * 72 + 16 * nt_ + 4 * lq) = w; }
        }
    }
    if (MODE == 0) {
#pragma unroll
        for (int t = 0; t < 2; ++t) { const int tl = 2 * wid + t, nt_ = tl >> 2, pt = tl & 3;
            *(f32x4*)(SEND + (size_t)seg * 4096 + (16 * pt + l15) * 64 + 16 * nt_ + 4 * lq) = Hacc[t]; }
        if (tid == 0) SLD[seg] = ldsum;
    }
    __syncthreads();
#undef SSD_ROW
#undef SSD_LOAD
}

__device__ __forceinline__ void lru_seq_unit(const Ctx& C, int item, LAS unsigned char* lds) {
    const TC T = phase_tc();
    const int b = item >> 5, dir = (item >> 4) & 1, hb = item & 15, lane = T.lane, wid = T.wave;
    LAS float* wa = (LAS float*)lds; LAS float* wx = wa + 4096; LAS float* xs = wx + 4096; LAS float* as_ = xs + 512; LAS float* bs_ = as_ + 512;
    const float* gwa = C.in[I_LWA] + (size_t)(dir * 16 + hb) * 4096; const float* gwx = C.in[I_LWX] + (size_t)(dir * 16 + hb) * 4096;
    for (int i = T.tid; i < 4096; i += NTHREADS) { wa[i] = gwa[i]; wx[i] = gwx[i]; }
    const int c = hb * 64 + lane;
    const float ba = C.in[I_LBA][dir * 1024 + c], bx = C.in[I_LBX][dir * 1024 + c], logbase = -8.f * softplus_f(-C.in[I_LAM][dir * 1024 + c]);
    const bf16* XR = (const bf16*)(C.ws + WS_A) + (size_t)b * BROWS * 1024 + hb * 64;
    bf16* Y = dir == 0 ? (bf16*)(C.ws + WS_YMIX) + (size_t)b * BROWS * 2048 + hb * 64 : (bf16*)(C.ws + WS_RAW) + (size_t)b * BROWS * 1024 + hb * 64;
    const int ldy = dir == 0 ? 2048 : 1024;
    float hst = 0.f;
    __syncthreads();
    unsigned short xnext = XR[(size_t)step_row(dir, wid) * 1024 + lane];
    for (int it = 0; it < BROWS / 8; ++it) {
        const float xv = bf2f(xnext);
        if (it + 1 < BROWS / 8) xnext = XR[(size_t)step_row(dir, (it + 1) * 8 + wid) * 1024 + lane];
        xs[wid * 64 + lane] = xv;
        asm volatile("s_waitcnt lgkmcnt(0)" ::: "memory");
        float pa = ba, px = bx;
#pragma unroll 8
        for (int i = 0; i < 64; ++i) { const float xi = xs[wid * 64 + i]; pa += xi * wa[i * 64 + lane]; px += xi * wx[i * 64 + lane]; }
        const float la = logbase * sigmoid_f(pa), a = __expf(la), bc = sqrtf(-expm1f(2.f * la)) * sigmoid_f(px) * xv;
        as_[wid * 64 + lane] = a; bs_[wid * 64 + lane] = bc;
        __syncthreads();
        if (wid == 0) {
#pragma unroll
            for (int tt = 0; tt < 8; ++tt) { hst = as_[tt * 64 + lane] * hst + bs_[tt * 64 + lane]; const int q2 = step_row(dir, it * 8 + tt); Y[(size_t)q2 * ldy + lane] = (bf16)f2bf(hst); }
        }
        __syncthreads();
    }
}

__device__ __forceinline__ float fast_sigmoid(float x) { return __builtin_amdgcn_rcpf(1.f + __expf(-x)); }
__device__ __forceinline__ void lru_chunk_unit(const Ctx& C, int item4, LAS unsigned char* lds) {
    const TC T = phase_tc();
    const int item = item4 >> 2, qc = item4 & 3;
    const int b = item >> 5, dir = (item >> 4) & 1, hb = item & 15, lane = T.lane, wid = T.wave, tid = T.tid;
    LAS bf16* xs0 = (LAS bf16*)lds;
    LAS bf16* wT = (LAS bf16*)(lds + 36864);
    LAS float* sWP = (LAS float*)(lds + 36864 + 4608);
    LAS float* sWH = sWP + 128;
    const float* gwa = C.in[I_LWA] + (size_t)(dir * 16 + hb) * 4096; const float* gwx = C.in[I_LWX] + (size_t)(dir * 16 + hb) * 4096;
    for (int i = tid; i < 1024; i += NTHREADS) { const int ii = i >> 4, j = i & 15; wT[j * 72 + ii] = (bf16)f2bf(gwa[ii * 64 + qc * 16 + j]); wT[16 * 72 + j * 72 + ii] = (bf16)f2bf(gwx[ii * 64 + qc * 16 + j]); }
    const int l15 = lane & 15, lq = lane >> 4;
    const int c = hb * 64 + qc * 16 + l15;
    const float ba = C.in[I_LBA][dir * 1024 + c], bx = C.in[I_LBX][dir * 1024 + c], lb = -8.f * softplus_lite(-C.in[I_LAM][dir * 1024 + c]);
    float hst = 0.f;
    const bf16* XR = (const bf16*)(C.ws + WS_A) + (size_t)b * BROWS * 1024 + hb * 64;
    bf16* Y = (dir == 0 ? (bf16*)(C.ws + WS_YMIX) : (bf16*)(C.ws + WS_Z) + 1024) + (size_t)b * BROWS * 2048 + hb * 64 + qc * 16;
    const bf16* GT = (const bf16*)(C.ws + WS_Z) + (size_t)b * BROWS * 2048 + hb * 64 + qc * 16;
    const int ldy = 2048;
    const int pr0 = tid >> 3, pc = (tid & 7) * 8;
    u32x4 st0, st1;
    { const int q0 = chunk_of(dir, 0) * 128; const int qa = dir == 0 ? q0 + pr0 : q0 + 127 - pr0, qb = dir == 0 ? q0 + pr0 + 64 : q0 + 63 - pr0;
      st0 = *(const u32x4*)(XR + (size_t)qa * 1024 + pc); st1 = *(const u32x4*)(XR + (size_t)qb * 1024 + pc); }
    __syncthreads();
    for (int ci = 0; ci < 66; ++ci) {
        const int q0 = chunk_of(dir, ci) * 128;
        LAS bf16* xs = xs0 + (ci & 1) * (128 * 72);
        *(LAS u32x4*)(xs + pr0 * 72 + pc) = st0; *(LAS u32x4*)(xs + (pr0 + 64) * 72 + pc) = st1;
        if (ci + 1 < 66) { const int qn = chunk_of(dir, ci + 1) * 128; const int qa = dir == 0 ? qn + pr0 : qn + 127 - pr0, qb = dir == 0 ? qn + pr0 + 64 : qn + 63 - pr0;
            st0 = *(const u32x4*)(XR + (size_t)qa * 1024 + pc); st1 = *(const u32x4*)(XR + (size_t)qb * 1024 + pc); }
        unsigned short gt[4];
#pragma unroll
        for (int rg = 0; rg < 4; ++rg) { const int i = 16 * wid + 4 * lq + rg; const int q = dir == 0 ? q0 + i : q0 + 127 - i; gt[rg] = GT[(size_t)q * 2048 + l15]; }
        float gl[4];
        __syncthreads();
        f32x4 ga = (f32x4){0.f, 0.f, 0.f, 0.f}, gx = ga;
#pragma unroll
        for (int kk = 0; kk < 2; ++kk) { const bf16x8 af = *(const LAS bf16x8*)(xs + (16 * wid + l15) * 72 + kk * 32 + 8 * lq);
            const bf16x8 b0 = *(const LAS bf16x8*)(wT + l15 * 72 + kk * 32 + 8 * lq), b1 = *(const LAS bf16x8*)(wT + 16 * 72 + l15 * 72 + kk * 32 + 8 * lq);
            ga = __builtin_amdgcn_mfma_f32_16x16x32_bf16(af, b0, ga, 0, 0, 0); gx = __builtin_amdgcn_mfma_f32_16x16x32_bf16(af, b1, gx, 0, 0, 0); }
#pragma unroll
        for (int rg = 0; rg < 4; ++rg) { const float gv = bf2f(gt[rg]); gl[rg] = gv * fast_sigmoid(1.5957691216057308f * (gv + 0.044715f * gv * gv * gv)); }
        float p = 1.f, hh = 0.f;
#pragma unroll
        for (int rg = 0; rg < 4; ++rg) { const int i = 16 * wid + 4 * lq + rg;
            const float la = lb * fast_sigmoid(ga[rg] + ba), a = __expf(la), xv = bf2f(xs[i * 72 + qc * 16 + l15]);
            const float x2 = 2.f * la, oms = -x2 * (1.f + 0.5f * x2 * (1.f + (1.f / 3.f) * x2 * (1.f + 0.25f * x2 * (1.f + 0.2f * x2)))), om = x2 < -0.4f ? 1.f - a * a : oms;
            const float bc = __builtin_amdgcn_sqrtf(om) * fast_sigmoid(gx[rg] + bx) * xv;
            hh = a * hh + bc; p *= a; ga[rg] = p; gx[rg] = hh; }
        { const float pp = __shfl_up(p, 16), hp = __shfl_up(hh, 16); if (lq >= 1) { hh = p * hp + hh; p = pp * p; } }
        { const float pp = __shfl_up(p, 32), hp = __shfl_up(hh, 32); if (lq >= 2) { hh = p * hp + hh; p = pp * p; } }
        const float pe_ = __shfl_up(p, 16), he_ = __shfl_up(hh, 16);
        const float Pe = lq >= 1 ? pe_ : 1.f, He = lq >= 1 ? he_ : 0.f;
        if (lq == 3) { sWP[l15 * 8 + wid] = p; sWH[l15 * 8 + wid] = hh; }
        __syncthreads();
        { const f32x4 p0 = *(const LAS f32x4*)(sWP + l15 * 8), p1 = *(const LAS f32x4*)(sWP + l15 * 8 + 4), h0 = *(const LAS f32x4*)(sWH + l15 * 8), h1 = *(const LAS f32x4*)(sWH + l15 * 8 + 4);
            float cin = hst, cw = hst;
#pragma unroll
            for (int w = 0; w < 8; ++w) { if (w == wid) cw = cin; const float pw = w < 4 ? p0[w & 3] : p1[w & 3], hw = w < 4 ? h0[w & 3] : h1[w & 3]; cin = pw * cin + hw; }
            hst = cin;
            const float cl = Pe * cw + He;
#pragma unroll
            for (int rg = 0; rg < 4; ++rg) { const int i = 16 * wid + 4 * lq + rg; const int q = dir == 0 ? q0 + i : q0 + 127 - i;
                Y[(size_t)q * ldy + l15] = hw_bf16(gl[rg] * (gx[rg] + ga[rg] * cl)); } }
    }
    __syncthreads();
}

__device__ __forceinline__ int queue_pop(const Ctx& C, unsigned* qword, LAS unsigned char* lds) {
    const TC T = phase_tc();
    LAS int* slot = (LAS int*)(lds + LDS_BYTES - 64);
    __syncthreads();
    if (T.tid == 0) slot[0] = (int)atomicAdd(qword, 1u);
    __syncthreads();
    const int v = slot[0];
    return __builtin_amdgcn_readfirstlane(v);
}
__device__ __forceinline__ void ph_ssdpre(const Ctx& C, LAS unsigned char* lds) {
    for (int u = C.bid; u < 192; u += C.G) ssd_chunk_unit<0>(C, u / 3, u % 3, lds);
}
__device__ __forceinline__ void ph_mix0(const Ctx& C, LAS unsigned char* lds, char* ldsg) {
    bf16* YM = (bf16*)(C.ws + WS_YMIX); const bf16* K = (const bf16*)(C.ws + WS_K); const bf16* V = (const bf16*)(C.ws + WS_V);
    for (;;) {
        const int item = queue_pop(C, C.ctl() + CW_Q0, lds);
        if (item >= 256 + 512 + 16) break;
#ifdef SPLIT_MIX0
        if (item < 256) continue;
#else
        if (item < 256) { ssd_chunk_unit<1>(C, item >> 2, item & 3, lds); continue; }
#endif
        const int a = item - 256;
        if (a >= 16) { const int a1 = a - 16, hr = a1 & 3, qb = (a1 >> 2) & 31, kvh = (a1 >> 7) & 1, b = a1 >> 8, h = kvh * 4 + hr;
            bf16* Qb = YM + ((size_t)b * BROWS + CTXL + (size_t)qb * 256) * 2048 + 1024 + h * 128;
            att::attn_body<0>(Qb, K + (size_t)b * BROWS * 256 + kvh * 128, V + (size_t)b * BROWS * 256 + kvh * 128, Qb, BROWS / 64, 0, 0, 0.f, ldsg, C.in[I_QG], qb * 256);
        } else { const int b = a >> 3, h = a & 7, kvh = h >> 2;
            bf16* Qb = YM + ((size_t)b * BROWS) * 2048 + 1024 + h * 128;
            att::attn_body<0>(Qb, K + (size_t)b * BROWS * 256 + kvh * 128, V + (size_t)b * BROWS * 256 + kvh * 128, Qb, CTXL / 64, 0, 0, 0.f, ldsg, C.in[I_QG], -1);
        }
    }
}
__device__ __forceinline__ void ph_mix1(const Ctx& C, LAS unsigned char* lds, char* ldsg) {
    bf16* YM = (bf16*)(C.ws + WS_YMIX); const bf16* K = (const bf16*)(C.ws + WS_K); const bf16* V = (const bf16*)(C.ws + WS_V);
    for (;;) {
        const int item = queue_pop(C, C.ctl() + CW_Q1, lds);
        if (item >= 256 + 512) break;
        if (item < 256) { lru_chunk_unit(C, item, lds); continue; }
        const int a = item - 256, hr = a & 3, qb = (a >> 2) & 31, kvh = (a >> 7) & 1, b = a >> 8, h = kvh * 4 + hr;
        const int q0 = qb * 256, lo = q0 - 128 < 0 ? 0 : q0 - 128, hi_ = q0 + 384 > SEQL ? SEQL : q0 + 384;
        bf16* Qb = YM + ((size_t)b * BROWS + CTXL + (size_t)q0) * 2048 + 1024 + h * 128;
        att::attn_body<1>(Qb, K + (size_t)b * BROWS * 256 + kvh * 128, V + (size_t)b * BROWS * 256 + kvh * 128, Qb, 4 + (hi_ - lo) / 64, CTXL + lo, q0, C.in[I_SINK][h], ldsg, nullptr, q0);
    }
}
__device__ __forceinline__ void ph_ssdpost(const Ctx& C) {
    const TC T = phase_tc();
    bf16* YM = (bf16*)(C.ws + WS_YMIX); const bf16* YB = (const bf16*)(C.ws + WS_RAW); const bf16* XBC = (const bf16*)C.out; const bf16* Z = (const bf16*)(C.ws + WS_Z);
    const int gw = C.bid * NWAVES + T.wave, NGW = C.G * NWAVES, lane = T.lane;
    for (int r = gw; r < NROWS; r += NGW) {
        float v[16]; float ss = 0.f;
#pragma unroll
        for (int j = 0; j < 2; ++j) { const int c0 = j * 512 + lane * 8;
            const u32x4 wy = *(const u32x4*)(YM + (size_t)r * 2048 + c0), wb = *(const u32x4*)(YB + (size_t)r * 1024 + c0), wx = *(const u32x4*)(XBC + (size_t)r * 1280 + c0), wz = *(const u32x4*)(Z + (size_t)r * 1024 + c0);
            float fy[8], fb[8], fx[8], fz[8]; unpack8(wy, fy); unpack8(wb, fb); unpack8(wx, fx); unpack8(wz, fz);
            const float dsk = C.in[I_SSDD][c0 >> 6];
#pragma unroll
            for (int e = 0; e < 8; ++e) { const float y = (fy[e] + fb[e] + dsk * fx[e]) * silu_f(fz[e]); v[j * 8 + e] = y; ss += y * y; } }
        const float rs = rsqrtf(wave_sum(ss) * (1.f / 1024.f) + EPS);
#pragma unroll
        for (int j = 0; j < 2; ++j) { const int c0 = j * 512 + lane * 8; const float* ng = C.in[I_SNORMG] + c0;
            u32x4 o; o.x = pk2(v[j * 8 + 0] * rs * ng[0], v[j * 8 + 1] * rs * ng[1]); o.y = pk2(v[j * 8 + 2] * rs * ng[2], v[j * 8 + 3] * rs * ng[3]);
            o.z = pk2(v[j * 8 + 4] * rs * ng[4], v[j * 8 + 5] * rs * ng[5]); o.w = pk2(v[j * 8 + 6] * rs * ng[6], v[j * 8 + 7] * rs * ng[7]);
            *(u32x4*)(YM + (size_t)r * 2048 + c0) = o; }
    }
}
__device__ __forceinline__ void ph_lrupost(const Ctx& C) {
    const TC T = phase_tc();
    bf16* YM = (bf16*)(C.ws + WS_YMIX); const bf16* YB = (const bf16*)(C.ws + WS_RAW); const bf16* GT = (const bf16*)(C.ws + WS_Z);
    const int gw = C.bid * NWAVES + T.wave, NGW = C.G * NWAVES, lane = T.lane;
    for (int r = gw; r < NROWS; r += NGW) {
        if (r % BROWS < CTXL) continue;
#pragma unroll
        for (int j = 0; j < 2; ++j) { const int c0 = j * 512 + lane * 8;
            const u32x4 wy = *(const u32x4*)(YM + (size_t)r * 2048 + c0), wb = *(const u32x4*)(YB + (size_t)r * 1024 + c0), wg = *(const u32x4*)(GT + (size_t)r * 1024 + c0);
            float fy[8], fb[8], fg[8], o[8]; unpack8(wy, fy); unpack8(wb, fb); unpack8(wg, fg);
#pragma unroll
            for (int e = 0; e < 8; ++e) o[e] = gelu_tanh_f(fg[e]) * (fy[e] + fb[e]);
            u32x4 w; w.x = pk2(o[0], o[1]); w.y = pk2(o[2], o[3]); w.z = pk2(o[4], o[5]); w.w = pk2(o[6], o[7]);
            *(u32x4*)(YM + (size_t)r * 2048 + c0) = w; }
    }
}
__device__ __forceinline__ void ph_route(const Ctx& C, int layer, LAS unsigned char* lds) {
    const TC T = phase_tc();
    LAS float* Wt = (LAS float*)lds;
    const float* wg = C.in[I_WGRP] + (size_t)layer * 1024 * 4; const float* wr = C.in[I_WRT] + (size_t)layer * 1024 * 16;
    for (int i = T.tid; i < 4096; i += NTHREADS) Wt[(i & 3) * 1028 + (i >> 2)] = wg[i];
    for (int i = T.tid; i < 16384; i += NTHREADS) Wt[(4 + (i & 15)) * 1028 + (i >> 4)] = wr[i];
    __syncthreads();
    bf16* HN2 = (bf16*)(C.ws + WS_A); int* REC = (int*)(C.ws + WS_REC); int* TBL = (int*)(C.ws + WS_TBL);
    unsigned* cnt = C.ctl() + CW_CNT + layer * 2048;
    const float* gf = C.in[I_GFFN] + layer * 1024;
    const int gw = C.bid * NWAVES + T.wave, NGW = C.G * NWAVES, lane = T.lane;
    for (int r = gw; r < NROWS; r += NGW) {
        if (layer == 1 && (r % BROWS) < CTXL) continue;
        float* xr = C.xrow(r); const float* md = C.mod(layer, row_mv(r));
        f32x4 v[4]; float ss = 0.f;
        if (layer == 0 && (r % BROWS) < CTXL) { const int b_ = r / BROWS, q_ = r - b_ * BROWS; const float* xi = C.in[I_CTX] + (size_t)(b_ * CTXL + q_) * DM; const float* sl = (const float*)(C.ws + WS_RAW);
#pragma unroll
            for (int j = 0; j < 4; ++j) { const float* sp = sl + (size_t)((b_ * 4 + j) * 4) * 65536 + (size_t)q_ * 256 + 4 * lane;
                const f32x4 part = (*(const f32x4*)sp + *(const f32x4*)(sp + 65536)) + (*(const f32x4*)(sp + 2 * 65536) + *(const f32x4*)(sp + 3 * 65536));
                const f32x4 x1 = *(const f32x4*)(xi + 256 * j + 4 * lane) + *(const f32x4*)(md + 2 * 1024 + 256 * j + 4 * lane) * part;
                *(f32x4*)(xr + 256 * j + 4 * lane) = x1; } }
#pragma unroll
        for (int j = 0; j < 4; ++j) { v[j] = *(const f32x4*)(xr + 256 * j + 4 * lane); ss += (v[j].x * v[j].x + v[j].y * v[j].y) + (v[j].z * v[j].z + v[j].w * v[j].w); }
        const float rs = rsqrtf(wave_sum(ss) * (1.f / DM) + EPS);
#pragma unroll
        for (int j = 0; j < 4; ++j) { const int c = 256 * j + 4 * lane; const f32x4 g = *(const f32x4*)(gf + c), sc = *(const f32x4*)(md + 4 * 1024 + c), sh = *(const f32x4*)(md + 3 * 1024 + c);
            v[j] = v[j] * rs * g * (sc + 1.f) + sh;
            u32x2 w; w.x = pk2(v[j].x, v[j].y); w.y = pk2(v[j].z, v[j].w); *(u32x2*)(HN2 + (size_t)r * DM + c) = w; }
        float lg[20];
#pragma unroll
        for (int o = 0; o < 20; ++o) { float s = 0.f;
#pragma unroll
            for (int j = 0; j < 4; ++j) { const f32x4 w = *(const LAS f32x4*)(Wt + o * 1028 + 256 * j + 4 * lane); s += (v[j].x * w.x + v[j].y * w.y) + (v[j].z * w.z + v[j].w * w.w); }
            lg[o] = wave_sum(s); }
        float gl[4];
#pragma unroll
        for (int k = 0; k < 4; ++k) gl[k] = lg[k] + C.in[I_BGRP][layer * 4 + k];
        int gi = 0; float gmx = gl[0];
#pragma unroll
        for (int k = 1; k < 4; ++k) if (gl[k] > gmx) { gmx = gl[k]; gi = k; }
        float den = 0.f;
#pragma unroll
        for (int k = 0; k < 4; ++k) den += __expf(gl[k] - gmx);
        const float pgrp = 1.f / den;
        float el[4];
#pragma unroll
        for (int k = 0; k < 4; ++k) { const float e0 = lg[4 + k] + C.in[I_BRT][layer * 16 + k], e1 = lg[8 + k] + C.in[I_BRT][layer * 16 + 4 + k], e2 = lg[12 + k] + C.in[I_BRT][layer * 16 + 8 + k], e3 = lg[16 + k] + C.in[I_BRT][layer * 16 + 12 + k];
            el[k] = gi == 0 ? e0 : (gi == 1 ? e1 : (gi == 2 ? e2 : e3)); }
        int i1 = 0; float v1 = el[0];
#pragma unroll
        for (int k = 1; k < 4; ++k) if (el[k] > v1) { v1 = el[k]; i1 = k; }
        int i2 = -1; float v2 = -3.4e38f;
#pragma unroll
        for (int k = 0; k < 4; ++k) if (k != i1 && el[k] > v2) { v2 = el[k]; i2 = k; }
        const float w1 = pgrp / (1.f + __expf(v2 - v1)), w2 = pgrp - w1;
        const int ia = i1 < i2 ? i1 : i2, ib = i1 < i2 ? i2 : i1; const float wa = i1 < i2 ? w1 : w2, wb = i1 < i2 ? w2 : w1;
        const int cls = gi * 6 + (ia * (7 - ia)) / 2 + (ib - ia - 1);
        if (lane == 0) { const int pos = (int)atomicAdd(cnt + cls * 64, 1u); TBL[(size_t)cls * NROWS + pos] = r; REC[(size_t)r * 4 + 0] = cls; REC[(size_t)r * 4 + 1] = pos; REC[(size_t)r * 4 + 2] = (int)__float_as_uint(wa); REC[(size_t)r * 4 + 3] = (int)__float_as_uint(wb); }
    }
}
__device__ __forceinline__ void moe_tables(const Ctx& C, int layer, int* mt) {
    unsigned* cnt = C.ctl() + CW_CNT + layer * 2048;
    const TC T = phase_tc();
    { const int t_ = T.tid; if (t_ < 24) mt[32 + t_] = (int)__hip_atomic_load(cnt + t_ * 64, __ATOMIC_RELAXED, __HIP_MEMORY_SCOPE_AGENT); }
    asm volatile("s_waitcnt vmcnt(0)" ::: "memory");
    __syncthreads();
    if (T.tid == 0) { int acc = 0; for (int c = 0; c < 24; ++c) { const int n = mt[32 + c]; mt[c] = acc; const int nt = (n + 255) >> 8; for (int t = 0; t < nt; ++t) mt[64 + acc + t] = c; acc += nt; } mt[24] = acc; }
    asm volatile("s_waitcnt vmcnt(0)" ::: "memory");
    __syncthreads();
}
__device__ __forceinline__ void ph_final(const Ctx& C) {
    const TC T = phase_tc();
    const float* gf = C.in[I_GFINAL];
    const int gw = C.bid * NWAVES + T.wave, NGW = C.G * NWAVES, lane = T.lane;
    for (int r = gw; r < NBATCH * SEQL; r += NGW) {
        float* xr = C.out + (size_t)r * DM;
        f32x4 v[4]; float ss = 0.f;
#pragma unroll
        for (int j = 0; j < 4; ++j) { v[j] = *(const f32x4*)(xr + 256 * j + 4 * lane); ss += (v[j].x * v[j].x + v[j].y * v[j].y) + (v[j].z * v[j].z + v[j].w * v[j].w); }
        const float rs = rsqrtf(wave_sum(ss) * (1.f / DM) + EPS);
#pragma unroll
        for (int j = 0; j < 4; ++j) { const int c = 256 * j + 4 * lane; f32x4 o = v[j] * rs * *(const f32x4*)(gf + c);
#ifdef PROBE_A
            { const unsigned long long* st = (const unsigned long long*)(C.ws + WS_STAMP);
              const float ta = (float)(st[PROBE_A + 1] - st[PROBE_A]) * 0.01f, tb = (float)(st[PROBE_B + 1] - st[PROBE_B]) * 0.01f;
              int na = 0, nb = 0; float th = 15.f;
              for (int i = 0; i < 31; ++i) { na += ta > th; nb += tb > th; th *= 1.2f; }
              o = o * (1.f + 0.02f * (float)na);
              if (r == 0 && c == 0) o.x += 10.f + (float)nb; }
#endif
            *(f32x4*)(xr + c) = o; }
    }
}


#define XB_TMO      128
#define XB_XCNT(j)  (256  + 64 * (j))
#define XB_XSUB(j)  (1280 + 64 * (j))
#define XB_XGEN(j)  (2304 + 64 * (j))
#define XB_TOP      3328
#define XB_TOPGEN   3392
#define XCD_BAR_WORDS 3456
#define XB_SPIN_CAP (1u << 18)
__device__ __forceinline__ unsigned xb_ld(unsigned* p)              { return __hip_atomic_load(p, __ATOMIC_RELAXED, __HIP_MEMORY_SCOPE_AGENT); }
__device__ __forceinline__ unsigned xb_add(unsigned* p, unsigned v) { return __hip_atomic_fetch_add(p, v, __ATOMIC_RELAXED, __HIP_MEMORY_SCOPE_AGENT); }
__device__ __forceinline__ unsigned xb_xcc_id() { return (unsigned)__builtin_amdgcn_s_getreg((3 << 11) | 20) & 0xFu; }
#define XB_SPIN(cond, bar) do { unsigned _sp = 0; while (cond) { __builtin_amdgcn_s_sleep(1); \
    if ((++_sp & 255u) == 0u) { if (xb_ld(&(bar)[XB_TMO])) break; if (_sp > XB_SPIN_CAP) { atomicAdd(&(bar)[XB_TMO], 1u); break; } } } } while (0)
struct XcdBarrier { unsigned* bar; unsigned x; volatile LAS unsigned* st; };
__device__ __forceinline__ XcdBarrier xcd_barrier_post(unsigned* bar, volatile LAS unsigned* st) {
    XcdBarrier b; b.bar = bar; b.x = xb_xcc_id(); b.st = st;
    if (threadIdx.x == 0) (void)xb_add(&bar[XB_XCNT(b.x)], 1u);
    return b;
}
__device__ __forceinline__ void xcd_barrier_complete(unsigned* bar, unsigned x, unsigned& nloc, unsigned& nx) {
    const unsigned G = gridDim.x * gridDim.y * gridDim.z;
    unsigned sum, cnt, mine, sp = 0u;
    for (;;) {
        sum = 0u; cnt = 0u; mine = 0u;
#pragma unroll
        for (unsigned j = 0; j < 16; ++j) { const unsigned c = xb_ld(&bar[XB_XCNT(j)]); sum += c; cnt += (c > 0u) ? 1u : 0u; mine = (j == x) ? c : mine; }
        if (sum == G) break;
        __builtin_amdgcn_s_sleep(1);
        if ((++sp & 255u) == 0u) { if (xb_ld(&bar[XB_TMO])) break; if (sp > XB_SPIN_CAP) { atomicAdd(&bar[XB_TMO], 1u); break; } }
    }
    nloc = mine > 0u ? mine : 1u; nx = cnt > 0u ? cnt : 1u;
}
__device__ __forceinline__ void xcd_barrier(const XcdBarrier& b) {
    asm volatile("s_waitcnt vmcnt(0)" ::: "memory");
    __syncthreads();
    if (threadIdx.x == 0) {
        unsigned* bar = b.bar;
        __builtin_amdgcn_s_waitcnt(0);
        unsigned nloc = b.st[0], nx = b.st[1];
        if (nloc == 0u) { xcd_barrier_complete(bar, b.x, nloc, nx); b.st[0] = nloc; b.st[1] = nx; }
        const unsigned old = xb_add(&bar[XB_XSUB(b.x)], 1u);
        const unsigned gen = old / nloc;
        if (old + 1u == (gen + 1u) * nloc) {
            __builtin_amdgcn_fence(__ATOMIC_RELEASE, "agent");
            asm volatile("s_waitcnt vmcnt(0)" ::: "memory");
            const unsigned og = xb_add(&bar[XB_TOP], 1u);
            const unsigned tg = og / nx;
            if (og + 1u == (tg + 1u) * nx) xb_add(&bar[XB_TOPGEN], 1u);
            else XB_SPIN(xb_ld(&bar[XB_TOPGEN]) == tg, bar);
            __builtin_amdgcn_fence(__ATOMIC_ACQUIRE, "agent");
            xb_add(&bar[XB_XGEN(b.x)], 1u);
            asm volatile("s_waitcnt vmcnt(0)" ::: "memory");
        } else {
            XB_SPIN(xb_ld(&bar[XB_XGEN(b.x)]) == gen, bar);
            __builtin_amdgcn_fence(__ATOMIC_ACQUIRE, "agent");
            asm volatile("s_waitcnt vmcnt(0)" ::: "memory");
        }
    }
    __syncthreads();
}

__global__ void __launch_bounds__(NTHREADS, 2) fwd_kernel(Args args) {
    extern __shared__ __attribute__((aligned(16))) unsigned char lds_raw[];
    LAS unsigned char* lds = (LAS unsigned char*)lds_raw;
#define MKCTX() ({ const CAS Args* ap_ = (const CAS Args*)__builtin_amdgcn_kernarg_segment_ptr(); asm volatile("" : "+s"(ap_)); Ctx c_; c_.in = ap_->in; c_.out = ap_->out; c_.ws = ap_->ws; c_.bid = blockIdx.x; c_.G = gridDim.x; c_; })
    Ctx C = MKCTX(); unsigned char* ws = C.ws;
    const int lo = args.ph_lo, hi = args.ph_hi;
    int ph = 0;
    volatile LAS unsigned* bst = (volatile LAS unsigned*)(lds + LDS_BYTES - 32);
    if (threadIdx.x < 2) bst[threadIdx.x] = 0u;
    __syncthreads();
    XcdBarrier bar; bar.bar = (unsigned*)(C.ws + WS_CTL) + CW_BAR; bar.x = 0; bar.st = bst;
    if (hi - lo > 1) bar = xcd_barrier_post((unsigned*)(C.ws + WS_CTL) + CW_BAR, bst);
    if (lo < 0) cg::this_grid().sync();
#ifdef PROBE_A
    if (blockIdx.x == 0 && threadIdx.x == 0) ((unsigned long long*)(C.ws + WS_STAMP))[0] = __builtin_amdgcn_s_memrealtime();
#endif
#define IN(k) (lo <= (k) && (k) < hi)
#ifdef PROBE_A
#define STAMP(k) do { if (blockIdx.x == 0 && threadIdx.x == 0) ((unsigned long long*)(C.ws + WS_STAMP))[(k) + 1] = __builtin_amdgcn_s_memrealtime(); } while (0)
#else
#define STAMP(k) do { } while (0)
#endif
#ifdef PROBE_A
#define SEAM(k) do { if (IN(k) && IN((k) + 1)) { cg::this_grid().sync(); STAMP(k); } } while (0)
#else
#define SEAM(k) do { if (IN(k) && IN((k) + 1)) { xcd_barrier(bar); } } while (0)
#endif
    C = MKCTX(); ws = C.ws;
    if (EN(0) && IN(0)) { ph_mod(C, lds); ph_convert(C, 0, lds); mod_wait(C); ph_prenorm(C, 0); }
    SEAM(0);
#pragma unroll 1
    for (int layer = 0; layer < 2; ++layer) {
        const int pb = 1 + 10 * layer;
        C = MKCTX(); ws = C.ws;
        if (EN(1) && IN(pb + 0) && layer == 1) { ph_convert(C, 1, lds); ph_prenorm(C, layer); }
        if (layer == 1) SEAM(pb + 0);
        C = MKCTX(); ws = C.ws;
        if (EN(2) && IN(pb + 1)) {
            const int nN = layer == 0 ? 15 : 14;
            pg8::Gemm g{1024, 1024, 1024, 1 << 30, 1 << 30, 0};
            RowSched S; S.bdel = 0; S.nM = 66; S.nN = nN; S.nwg = 66 * nN; S.G = C.G; S.c = C.bid; S.skipctx = 0; S.A = (const char*)(ws + WS_A); S.Bt = (const char*)(ws + WS_WIN); S.a_tile = (size_t)256 * 1024 * 2; S.b_tile = (size_t)256 * 1024 * 2;
            EpiProj E;
            if (layer == 0) { E.d0 = (bf16*)(ws + WS_Z); E.l0 = 1024; E.e0 = 4; E.d1 = (bf16*)(ws + WS_RAW); E.l1 = 1280; E.e1 = 9; E.d2 = (bf16*)(ws + WS_YMIX) + 1024; E.l2 = 2048; E.e2 = 13;
                E.d3 = (bf16*)(ws + WS_K); E.l3 = 256; E.e3 = 14; E.d4 = (bf16*)(ws + WS_V); E.l4 = 256; E.e4 = 15; E.d5 = (bf16*)(ws + WS_DTR); E.l5 = 32; E.lastcols = 32; }
            else { E.d0 = (bf16*)(ws + WS_Z); E.l0 = 2048; E.e0 = 4; E.d1 = (bf16*)(ws + WS_YMIX); E.l1 = 2048; E.e1 = 8; E.d2 = (bf16*)(ws + WS_YMIX) + 1024; E.l2 = 2048; E.e2 = 12;
                E.d3 = (bf16*)(ws + WS_K); E.l3 = 256; E.e3 = 13; E.d4 = (bf16*)(ws + WS_V); E.l4 = 256; E.e4 = 14; E.d5 = (bf16*)(ws + WS_DTR); E.l5 = 32; E.lastcols = 32; }
            pg8::gemm_phase<EpiProj, RowSched>(lds, g, S, E);
        }
        SEAM(pb + 1);
        C = MKCTX(); ws = C.ws;
        if (EN(3) && IN(pb + 2)) { if (layer == 0) ph_elem0(C); else ph_elem1(C); }
        SEAM(pb + 2);
        C = MKCTX(); ws = C.ws;
        if (IN(pb + 3)) { if (layer == 0) { ph_ssdpre(C, lds);
#ifdef SPLIT_MIX0
            xcd_barrier(bar); for (int u = C.bid; u < 256; u += C.G) ssd_chunk_unit<1>(C, u >> 2, u & 3, lds);
#endif
        } }
        if (layer == 0) SEAM(pb + 3);
        C = MKCTX(); ws = C.ws;
        if (IN(pb + 4)) { if (layer == 0) { if (EN(4)) ph_mix0(C, lds, (char*)lds_raw); } else { if (EN(5)) ph_mix1(C, lds, (char*)lds_raw); } }
        SEAM(pb + 4);
        C = MKCTX(); ws = C.ws;
        if (EN(6) && IN(pb + 5) && layer == 0) ph_ssdpost(C);
        if (layer == 0) SEAM(pb + 5);
        C = MKCTX(); ws = C.ws;
        if (EN(7) && IN(pb + 6)) {
            for (int pass = 0; pass < (layer == 0 ? 2 : 1); ++pass) {
                pg8::Gemm g{2048, 2048, pass == 0 ? (layer == 0 ? 2048 : 3072) : 512, layer == 0 ? (1 << 30) : 32, layer == 0 ? (1 << 30) : 32, (long)(WS_Z + 2048) - (long)WS_YMIX - 32 * 128};
                RowSched S; S.bdel = layer == 0 ? 0 : -(long)(32 * 128); S.nM = 64; S.nN = 4; S.nwg = pass == 0 ? 256 : 32; S.G = C.G; S.c = C.bid; S.skipctx = pass == 0 ? 1 : 2; S.A = (const char*)(ws + WS_YMIX); S.Bt = (const char*)(ws + WS_WOUT); S.a_tile = (size_t)256 * 2048 * 2; S.b_tile = (size_t)256 * 2048 * 2;
                EpiRes E; E.slab = pass == 0 ? nullptr : (float*)(ws + WS_RAW); E.xin_lat = layer == 0 ? C.in[I_X] : C.out; E.xin_ctx = layer == 0 ? C.in[I_CTX] : C.xc(); E.xout_lat = C.out; E.xout_ctx = C.xc(); E.modbase = C.mod(layer, 0);
                pg8::gemm_phase<EpiRes, RowSched>(lds, g, S, E);
            }
        }
        SEAM(pb + 6);
        C = MKCTX(); ws = C.ws;
        if (EN(8) && IN(pb + 7)) ph_route(C, layer, lds);
        SEAM(pb + 7);
        C = MKCTX(); ws = C.ws;
        if (EN(10) && IN(pb + 8)) {
            int* mt = (int*)(ws + WS_MTG) + (size_t)(layer * 256 + C.bid) * 256;
            moe_tables(C, layer, mt);
            { pg8::Gemm g{1024, 1024, 1024, 1 << 30, 1 << 30, 0};
              MoeSched1 S; S.mt = mt; S.G = C.G; S.c = C.bid; S.layer = layer; S.ws = ws;
              EpiMoe1 E; E.ws = ws;
              pg8::gemm_phase<EpiMoe1, MoeSched1, true>(lds, g, S, E, (const int*)(ws + WS_TBL)); }
            { pg8::Gemm g{512, 256, 512, 4, 1 << 30, 0};
              const int nun = mt[24] * 4, extra = nun > C.G ? nun - C.G : 0;
              MoeSched2 S; S.mt = mt; S.G = C.G; S.c = (C.bid - extra % C.G + C.G) % C.G; S.layer = layer; S.ws = ws;
              EpiMoe2 E; E.out = C.out; E.ws = ws; E.layer = layer;
              pg8::gemm_phase<EpiMoe2, MoeSched2, false>(lds, g, S, E); }
        }
        SEAM(pb + 8);
    }
#ifdef PROBE_A
    cg::this_grid().sync();
#endif
    C = MKCTX(); ws = C.ws;
    if (EN(12) && IN(21)) ph_final(C);

    (void)ph;
#undef IN
#undef SEAM
}

extern "C" void kernel_launch(void* const* d_in, const int* in_sizes, int n_in, void* d_out, int out_size, void* d_ws, size_t ws_size, hipStream_t stream) {
    static int grid = 0;
    if (grid == 0) {
        if (n_in != 36 || out_size != NBATCH * SEQL * DM || ws_size < WS_END) { fprintf(stderr, "kernel_launch: unexpected shapes (n_in %d, out %d, ws %zu)\n", n_in, out_size, ws_size); grid = -1; return; }
        int dev = 0, cus = 0, per_cu = 0;
        if (hipGetDevice(&dev) != hipSuccess || hipDeviceGetAttribute(&cus, hipDeviceAttributeMultiprocessorCount, dev) != hipSuccess) { grid = -1; return; }
        if (hipFuncSetAttribute((const void*)fwd_kernel, hipFuncAttributeMaxDynamicSharedMemorySize, LDS_BYTES) != hipSuccess) { fprintf(stderr, "kernel_launch: hipFuncSetAttribute failed\n"); grid = -1; return; }
        if (hipOccupancyMaxActiveBlocksPerMultiprocessor(&per_cu, (const void*)fwd_kernel, NTHREADS, LDS_BYTES) != hipSuccess || per_cu < 1) { fprintf(stderr, "kernel_launch: occupancy query failed (%d)\n", per_cu); (void)hipGetLastError(); per_cu = 1; }
        grid = cus * 1;
    }
    if (grid < 0) return;
    (void)hipMemsetAsync((char*)d_ws + WS_CTL, 0, CTL_ZERO_BYTES, stream);
    Args a{};
    for (int i = 0; i < 36; ++i) a.in[i] = (const float*)d_in[i];
    a.out = (float*)d_out; a.ws = (unsigned char*)d_ws;
#if MK_PER_PHASE
    for (int p = 0; p < N_PHASES; ++p) { a.ph_lo = p; a.ph_hi = p + 1; hipLaunchKernelGGL(fwd_kernel, dim3(grid), dim3(NTHREADS), LDS_BYTES, stream, a); }
#else
    void* kargs[] = {&a};
#ifdef REPEAT_K
    a.ph_lo = 0; a.ph_hi = REPEAT_K + 1;
    (void)hipLaunchCooperativeKernel((const void*)fwd_kernel, dim3(grid), dim3(NTHREADS), kargs, LDS_BYTES, stream);
    (void)hipMemsetAsync((char*)d_ws + WS_CTL, 0, CTL_ZERO_BYTES, stream);
#endif
    a.ph_lo = 0; a.ph_hi = N_PHASES;
    hipError_t e = hipLaunchCooperativeKernel((const void*)fwd_kernel, dim3(grid), dim3(NTHREADS), kargs, LDS_BYTES, stream);
    if (e != hipSuccess) fprintf(stderr, "kernel_launch: cooperative launch failed: %s (grid %d)\n", hipGetErrorString(e), grid);
#endif
}
```

```cpp
#include <hip/hip_runtime.h>
#include <hip/hip_cooperative_groups.h>
#include <cstdio>
#include <cstdint>
namespace cg = cooperative_groups;

#ifndef MK_PER_PHASE
#define MK_PER_PHASE 0
#endif

#ifndef EN_MASK
#define EN_MASK 0xFFFF
#endif
#define EN(k) (((EN_MASK) >> (k)) & 1)
#define LAS __attribute__((address_space(3)))
typedef unsigned short bf16;
typedef short bf16x8 __attribute__((ext_vector_type(8)));
typedef short s16x4 __attribute__((ext_vector_type(4)));
typedef float f32x4 __attribute__((ext_vector_type(4)));
typedef float f32x2 __attribute__((ext_vector_type(2)));
typedef float f32x16 __attribute__((ext_vector_type(16)));
typedef unsigned u32x4 __attribute__((ext_vector_type(4)));
typedef unsigned u32x2 __attribute__((ext_vector_type(2)));

constexpr int DM = 1024, NBATCH = 2, SEQL = 8192, CTXL = 256;
constexpr int BROWS = CTXL + SEQL;
constexpr int NROWS = NBATCH * BROWS;
constexpr float EPS = 1e-6f;
constexpr int NWAVES = 8, NTHREADS = 512;
constexpr int LDS_BYTES = 147456;
constexpr int N_PHASES = 22;

constexpr size_t MiB = 1u << 20;
constexpr size_t WS_CTL = 0, CTL_ZERO_BYTES = 128 * 1024;
constexpr size_t WS_MOD = 1 * MiB;
constexpr size_t WS_REC = 1 * MiB + 256 * 1024;
constexpr size_t WS_TOK = 2 * MiB;
constexpr size_t WS_GAB = 2 * MiB + 128 * 1024;
constexpr size_t WS_MT  = 2 * MiB + 512 * 1024;
constexpr size_t WS_STAMP = 2 * MiB + 768 * 1024;
constexpr size_t WS_XC  = 3 * MiB;
constexpr size_t WS_W   = 5 * MiB;
constexpr size_t WS_WIN = WS_W, WS_WOUT = WS_W + 8 * MiB, WS_W13 = WS_W + 12 * MiB, WS_W2 = WS_W + 28 * MiB;
constexpr size_t WS_A   = 41 * MiB;
constexpr size_t WS_Z   = 83 * MiB;
constexpr size_t WS_RAW = 116 * MiB;
constexpr size_t WS_DTR = 158 * MiB;
constexpr size_t WS_DT  = 160 * MiB;
constexpr size_t WS_K   = 163 * MiB;
constexpr size_t WS_V   = 172 * MiB;
constexpr size_t WS_YMIX = 181 * MiB;
constexpr size_t WS_SSDST = 247 * MiB;
constexpr size_t WS_SSDLD = WS_SSDST + 64 * 3 * 16384;
constexpr size_t WS_TBL = 251 * MiB;
constexpr size_t WS_MTG = 253 * MiB;
constexpr size_t WS_END = 254 * MiB;
constexpr int MAXTILES = 90, MAXSLOT = MAXTILES * 256;
constexpr int CW_MODDONE = 192;
constexpr int CW_Q0 = 64, CW_Q1 = 128, CW_CNT = 256, CW_BAR = 4096, CW_TDONE = 8192;

__device__ __forceinline__ float bf2f(unsigned short b) { return __uint_as_float(((unsigned)b) << 16); }
__device__ __forceinline__ unsigned f2bf(float f) { unsigned u = __float_as_uint(f); return (u + 0x7fffu + ((u >> 16) & 1u)) >> 16; }
__device__ __forceinline__ unsigned pk2(float lo, float hi) { return f2bf(lo) | (f2bf(hi) << 16); }
__device__ __forceinline__ float dpp_add(float v, float src, const int ctrl_unused) { return v + src; }
#define DPP_F(v, ctrl, rmask) __builtin_bit_cast(float, __builtin_amdgcn_update_dpp(0, __builtin_bit_cast(int, v), ctrl, rmask, 0xf, false))
__device__ __forceinline__ float wave_sum(float v) {
    v += DPP_F(v, 0xB1, 0xf);
    v += DPP_F(v, 0x4E, 0xf);
    v += DPP_F(v, 0x141, 0xf);
    v += DPP_F(v, 0x140, 0xf);
    v += DPP_F(v, 0x142, 0xa);
    v += DPP_F(v, 0x143, 0xc);
    return __builtin_bit_cast(float, __builtin_amdgcn_readlane(__builtin_bit_cast(int, v), 63));
}
__device__ __forceinline__ float silu_f(float x) { return x / (1.f + __expf(-x)); }
__device__ __forceinline__ float sigmoid_f(float x) { return 1.f / (1.f + __expf(-x)); }
__device__ __forceinline__ float softplus_f(float x) { return fmaxf(x, 0.f) + log1pf(__expf(-fabsf(x))); }
__device__ __forceinline__ float gelu_tanh_f(float x) { const float u = 0.7978845608028654f * (x + 0.044715f * x * x * x); return 0.5f * x * (1.f + tanhf(u)); }
__device__ __forceinline__ void unpack8(const u32x4 w, float* f) {
    f[0] = __uint_as_float(w.x << 16); f[1] = __uint_as_float(w.x & 0xffff0000u);
    f[2] = __uint_as_float(w.y << 16); f[3] = __uint_as_float(w.y & 0xffff0000u);
    f[4] = __uint_as_float(w.z << 16); f[5] = __uint_as_float(w.z & 0xffff0000u);
    f[6] = __uint_as_float(w.w << 16); f[7] = __uint_as_float(w.w & 0xffff0000u);
}

namespace pg8 {
constexpr int BM = 256, BK = 64, HALF = 128, HTB = HALF * BK * 2, STAGE_BYTES = 8 * HTB, NXCD = 8, WGM = 8;
__host__ __device__ __forceinline__ int lds_byte(int r, int c) { const int st = (r >> 4) * 2 + (c >> 5), rr = r & 15, cc = c & 31, ob = rr * 64 + cc * 2; return st * 1024 + (ob ^ (((ob >> 9) & 1) << 5)); }
__host__ __device__ __forceinline__ void stage_rc(int b, int& R, int& C) { const int st = b / 1024, sb = b % 1024, swz = sb ^ (((sb >> 9) & 1) << 5); R = (st >> 1) * 16 + swz / 64; C = (st & 1) * 32 + (swz % 64) / 2; }
__host__ __device__ __forceinline__ int perm32(int rho) { const int n = rho >> 4, i = rho & 15; return 8 * (i >> 2) + 4 * n + (i & 3); }

struct Unit { int pm, pn; const char* a; const char* b; long bd; int tbo; int nrow; };
struct Gemm { int lda, ldb, K, ksplit; };

__device__ __forceinline__ unsigned cvt_pk_bf16(float lo, float hi) { unsigned r; asm volatile("v_cvt_pk_bf16_f32 %0, %1, %2" : "=v"(r) : "v"(lo), "v"(hi)); return r; }

template <class Epi, class Sched, bool GATHER = false>
__device__ __forceinline__ void gemm_phase(LAS unsigned char* lds, const Gemm g, const Sched& S, const Epi& E, const int* gtbl = nullptr) {
    int tid_ = threadIdx.x; asm volatile("" : "+v"(tid_));
    const int tid = tid_, wid = __builtin_amdgcn_readfirstlane(tid >> 6), lane = tid & 63, wr = wid >> 2, wc = wid & 3, fr = lane & 15, fq = lane >> 4;
    const int nt = g.K / BK;
    unsigned voffA[2][2], nvoffA[2][2], voffB[2];
#pragma unroll
    for (int i = 0; i < 2; ++i) { int R, C; stage_rc(tid * 16 + i * 8192, R, C); const int Rb = Epi::PERM ? ((R & ~31) + perm32(R & 31)) : R;
        voffA[0][i] = (unsigned)(R * g.lda + C) * 2u; voffA[1][i] = (unsigned)((R + HALF) * g.lda + C) * 2u; nvoffA[0][i] = voffA[0][i]; nvoffA[1][i] = voffA[1][i];
        voffB[i] = (unsigned)(Rb * g.ldb + C) * 2u; }
#define PG8_GATHER_OFF(dst, uu) do { if constexpr (GATHER) { int _t = tid; asm volatile("" : "+v"(_t)); _Pragma("unroll") for (int _i = 0; _i < 2; ++_i) { int _R, _C; stage_rc(_t * 16 + _i * 8192, _R, _C); \
        _Pragma("unroll") for (int _h = 0; _h < 2; ++_h) { int _rho = _h * HALF + _R; _rho = _rho < (uu).nrow ? _rho : (uu).nrow - 1; dst[_h][_i] = (unsigned)gtbl[(uu).tbo + _rho] * (unsigned)(g.lda * 2) + (unsigned)_C * 2u; } } } } while (0)
    const size_t kstep = (size_t)(BK * 2);
    const size_t hstepA = (size_t)HALF * g.lda * 2, hstepB = (size_t)HALF * g.ldb * 2;
    const unsigned ldsw = (unsigned)wid * 1024u;
    const int aoff = lds_byte(wr * 64 + fr, fq * 8), boff = lds_byte(wc * 32 + fr, fq * 8);
#define PG8_SA(b, h) (((b) * 2 + (h)) * HTB)
#define PG8_SB(b, h) ((4 + (b) * 2 + (h)) * HTB)
#define PG8_STAGE(bufoff, gbase, voff) do { _Pragma("unroll") for (int _i = 0; _i < 2; ++_i) \
        __builtin_amdgcn_global_load_lds((const unsigned*)((const char*)(gbase) + (voff)[_i]), (LAS unsigned*)(lds + (bufoff) + ldsw + _i * 8192), 16, 0, 0); } while (0)
#define PG8_STAGE_A(bufoff, gbase, hh, usenext) do { _Pragma("unroll") for (int _i = 0; _i < 2; ++_i) { \
        if constexpr (GATHER) { const unsigned _vo = (usenext) ? nvoffA[hh][_i] : voffA[hh][_i]; \
            __builtin_amdgcn_global_load_lds((const unsigned*)((const char*)(gbase) + _vo), (LAS unsigned*)(lds + (bufoff) + ldsw + _i * 8192), 16, 0, 0); } \
        else __builtin_amdgcn_global_load_lds((const unsigned*)((const char*)(gbase) + (hh) * hstepA + voffA[0][_i]), (LAS unsigned*)(lds + (bufoff) + ldsw + _i * 8192), 16, 0, 0); } } while (0)
#define PG8_LDA(dst, b, h) do { _Pragma("unroll") for (int m = 0; m < 4; ++m) _Pragma("unroll") for (int k = 0; k < 2; ++k) dst[m][k] = *(const LAS bf16x8*)(lds + PG8_SA(b, h) + aoff + m * 2048 + k * 1024); } while (0)
#define PG8_LDB(dst, b, h) do { _Pragma("unroll") for (int n = 0; n < 2; ++n) _Pragma("unroll") for (int k = 0; k < 2; ++k) dst[n][k] = *(const LAS bf16x8*)(lds + PG8_SB(b, h) + boff + n * 2048 + k * 1024); } while (0)
#define PG8_MMA(ai, bj, At, Bt) do { __builtin_amdgcn_s_setprio(1); _Pragma("unroll") for (int m = 0; m < 4; ++m) _Pragma("unroll") for (int n = 0; n < 2; ++n) _Pragma("unroll") for (int k = 0; k < 2; ++k) \
        acc[ai][bj][m][n] = __builtin_amdgcn_mfma_f32_16x16x32_bf16(Bt[n][k], At[m][k], acc[ai][bj][m][n], 0, 0, 0); __builtin_amdgcn_s_setprio(0); } while (0)
#define PG8_WAIT_V(n) asm volatile("s_waitcnt vmcnt(" #n ")" ::: "memory")
#define PG8_WAIT_L(n) asm volatile("s_waitcnt lgkmcnt(" #n ")" ::: "memory")
#define PG8_BAR __builtin_amdgcn_s_barrier()
#define PG8_SCHED __builtin_amdgcn_sched_barrier(0)
    Unit cur, nxt; int ui = 0;
    if (!S.next(0, cur)) return;
    f32x4 acc[2][2][4][2];
#pragma unroll
    for (int a = 0; a < 2; ++a)
#pragma unroll
        for (int b = 0; b < 2; ++b)
#pragma unroll
            for (int m = 0; m < 4; ++m)
#pragma unroll
                for (int n = 0; n < 2; ++n) acc[a][b][m][n] = (f32x4){0.f, 0.f, 0.f, 0.f};
    bf16x8 At[4][2], B0[2][2], B1[2][2];
    const char* cA = cur.a; const char* cB = cur.b; long cBd = cur.bd;
    S.a_ready(cur);
    PG8_GATHER_OFF(voffA, cur);
    PG8_STAGE(PG8_SB(0, 0), cB, voffB); PG8_STAGE_A(PG8_SA(0, 0), cA, 0, false); PG8_STAGE(PG8_SB(0, 1), cB + hstepB, voffB); PG8_STAGE_A(PG8_SA(0, 1), cA, 1, false);
    if (wr == 1) PG8_BAR;
    PG8_WAIT_V(4); PG8_BAR;
    PG8_STAGE(PG8_SB(1, 0), cB + kstep, voffB); PG8_STAGE_A(PG8_SA(1, 0), cA + kstep, 0, false); PG8_STAGE(PG8_SB(1, 1), cB + hstepB + kstep, voffB);
    PG8_WAIT_V(6); PG8_BAR;
    for (;;) {
        const bool has_next = S.next(ui + 1, nxt);
        const char* nA = has_next ? nxt.a : cA; const char* nB = has_next ? nxt.b : cB;
        if constexpr (GATHER) { if (has_next) PG8_GATHER_OFF(nvoffA, nxt); else {
#pragma unroll
            for (int _h = 0; _h < 2; ++_h)
#pragma unroll
                for (int _i = 0; _i < 2; ++_i) nvoffA[_h][_i] = voffA[_h][_i]; } }
#pragma unroll 1
        for (int t = 0; t < nt; t += 2) {
            const bool last = (t == nt - 2);
            const char* a1 = cA + (size_t)(t + 1) * kstep;
            const char* a2 = last ? nA : cA + (size_t)(t + 2) * kstep;
            const char* b2 = last ? nB : cB + (size_t)(t + 2) * kstep + ((t + 2) >= g.ksplit ? cBd : 0);
            const char* a3 = a2 + kstep; const char* b3 = b2 + kstep;
            if (last && has_next) S.a_ready(nxt);
            PG8_LDB(B0, 0, 0); PG8_SCHED; PG8_LDA(At, 0, 0); PG8_STAGE_A(PG8_SA(1, 1), a1, 1, false);
            PG8_WAIT_L(8); PG8_BAR; PG8_WAIT_L(0); PG8_MMA(0, 0, At, B0); PG8_BAR; PG8_SCHED;
            PG8_LDB(B1, 0, 1); PG8_STAGE(PG8_SB(0, 0), b2, voffB);
            PG8_BAR; PG8_WAIT_L(0); PG8_MMA(0, 1, At, B1); PG8_BAR;
            PG8_LDA(At, 0, 1); PG8_STAGE_A(PG8_SA(0, 0), a2, 0, last);
            PG8_BAR; PG8_WAIT_L(0); PG8_MMA(1, 0, At, B0); PG8_BAR; PG8_SCHED;
            PG8_STAGE(PG8_SB(0, 1), b2 + hstepB, voffB);
            PG8_WAIT_V(6); PG8_BAR; PG8_MMA(1, 1, At, B1); PG8_BAR;
            PG8_LDB(B0, 1, 0); PG8_SCHED; PG8_LDA(At, 1, 0); PG8_STAGE_A(PG8_SA(0, 1), a2, 1, last);
            PG8_WAIT_L(8); PG8_BAR; PG8_WAIT_L(0); PG8_MMA(0, 0, At, B0); PG8_BAR; PG8_SCHED;
            PG8_LDB(B1, 1, 1); PG8_STAGE(PG8_SB(1, 0), b3, voffB);
            PG8_BAR; PG8_WAIT_L(0); PG8_MMA(0, 1, At, B1); PG8_BAR;
            PG8_LDA(At, 1, 1); PG8_STAGE_A(PG8_SA(1, 0), a3, 0, last);
            PG8_BAR; PG8_WAIT_L(0); PG8_MMA(1, 0, At, B0); PG8_BAR; PG8_SCHED;
            PG8_STAGE(PG8_SB(1, 1), b3 + hstepB, voffB);
            PG8_WAIT_V(6); PG8_BAR; PG8_MMA(1, 1, At, B1); PG8_BAR;
        }
        E(acc, cur, wr, wc, fr, fq); S.done(cur);
        if (!has_next) break;
#pragma unroll
        for (int a = 0; a < 2; ++a)
#pragma unroll
            for (int b = 0; b < 2; ++b)
#pragma unroll
                for (int m = 0; m < 4; ++m)
#pragma unroll
                    for (int n = 0; n < 2; ++n) acc[a][b][m][n] = (f32x4){0.f, 0.f, 0.f, 0.f};
        cur = nxt; cA = nA; cB = nB; cBd = cur.bd; ++ui;
        if constexpr (GATHER) {
#pragma unroll
            for (int _h = 0; _h < 2; ++_h)
#pragma unroll
                for (int _i = 0; _i < 2; ++_i) voffA[_h][_i] = nvoffA[_h][_i]; }
    }
    PG8_WAIT_V(0);
    if (wr == 0) PG8_BAR;
    PG8_BAR;
#undef PG8_SA
#undef PG8_SB
#undef PG8_STAGE
#undef PG8_STAGE_A
#undef PG8_GATHER_OFF
#undef PG8_LDA
#undef PG8_LDB
#undef PG8_MMA
#undef PG8_WAIT_V
#undef PG8_WAIT_L
#undef PG8_BAR
#undef PG8_SCHED
}
}

namespace att {
constexpr int D = 128, NW = 8, QBLK = 32, KVBLK = 64;
constexpr float SCALE = 0.088388347648318440f;
constexpr float THR = 8.f;
constexpr int LDQ = 2048, LDK = 256, LDO = 2048;
constexpr size_t SHM_V = KVBLK * D * 2, SHM_K = KVBLK * D * 2, SHM_ATTN = 2 * SHM_V + 2 * SHM_K + NW * 64 * 4;
#define KSWZ(row, colB) ((row) * 256 + ((colB) ^ (((row) & 7) << 4)))
#define SBAR() __builtin_amdgcn_sched_barrier(0)
__device__ __forceinline__ int crow(int r, int hi) { return (r & 3) + 8 * (r >> 2) + 4 * hi; }
__device__ __forceinline__ unsigned cvtpk(float lo, float hi) { unsigned r; asm volatile("v_cvt_pk_bf16_f32 %0, %1, %2" : "=v"(r) : "v"(lo), "v"(hi)); return r; }

__device__ __forceinline__ void partialSM(f32x16& p0, f32x16& p1, float& m_reg, float& mn, float& alpha) {
  constexpr float C = SCALE * 1.4426950408889634f;
  float pmax = p0[0]; for (int r = 1; r < 16; ++r) pmax = fmaxf(pmax, p0[r]); for (int r = 0; r < 16; ++r) pmax = fmaxf(pmax, p1[r]);
  { auto rr = __builtin_amdgcn_permlane32_swap(__float_as_uint(pmax), __float_as_uint(pmax), false, false);
    pmax = fmaxf(__uint_as_float(rr[0]), __uint_as_float(rr[1])); }
  if (__builtin_expect(__all(pmax - m_reg <= THR / SCALE), 1)) { mn = m_reg; alpha = 1.f; }
  else { mn = fmaxf(m_reg, pmax); alpha = __builtin_amdgcn_exp2f((m_reg - mn) * C); m_reg = mn; }
  float mnC = -mn * C;
  for (int r = 0; r < 16; ++r) p0[r] = fmaf(p0[r], C, mnC); for (int r = 0; r < 16; ++r) p1[r] = fmaf(p1[r], C, mnC);
  for (int r = 0; r < 16; ++r) p0[r] = __builtin_amdgcn_exp2f(p0[r]);
}
__device__ __forceinline__ void finishSM(f32x16& p0, f32x16& p1, float alpha, float& l_reg, bf16x8& pa0, bf16x8& pa1, bf16x8& pa2, bf16x8& pa3) {
  for (int r = 0; r < 16; ++r) p1[r] = __builtin_amdgcn_exp2f(p1[r]);
  float ps = 0; for (int r = 0; r < 16; ++r) ps += p0[r]; for (int r = 0; r < 16; ++r) ps += p1[r];
  { auto rr = __builtin_amdgcn_permlane32_swap(__float_as_uint(ps), __float_as_uint(ps), false, false);
    ps = __uint_as_float(rr[0]) + __uint_as_float(rr[1]); }
  l_reg = l_reg * alpha + ps;
#define PK4(P, BASE, OUT) do { unsigned a0 = cvtpk(P[BASE + 0], P[BASE + 1]), a1 = cvtpk(P[BASE + 2], P[BASE + 3]);   \
    unsigned b0 = cvtpk(P[BASE + 4], P[BASE + 5]), b1 = cvtpk(P[BASE + 6], P[BASE + 7]);                              \
    auto r0 = __builtin_amdgcn_permlane32_swap(a0, b0, false, false); auto r1 = __builtin_amdgcn_permlane32_swap(a1, b1, false, false); \
    u32x4 w = {r0[0], r1[0], r0[1], r1[1]}; OUT = *reinterpret_cast<bf16x8*>(&w); } while (0)
  PK4(p0, 0, pa0); PK4(p0, 8, pa1); PK4(p1, 0, pa2); PK4(p1, 8, pa3);
#undef PK4
}
__device__ __forceinline__ void qkt(f32x16& p0, f32x16& p1, const bf16* Ks, const bf16x8* qr, int r32, int hi) {
  p0 = f32x16{}; p1 = f32x16{};
  for (int d0 = 0; d0 < 8; ++d0) { int cb = (d0 * 16 + hi * 8) * 2;
    bf16x8 b0 = *reinterpret_cast<const bf16x8*>((const char*)Ks + KSWZ(r32, cb));
    bf16x8 b1 = *reinterpret_cast<const bf16x8*>((const char*)Ks + KSWZ(32 + r32, cb));
    p0 = __builtin_amdgcn_mfma_f32_32x32x16_bf16(b0, qr[d0], p0, 0, 0, 0);
    p1 = __builtin_amdgcn_mfma_f32_32x32x16_bf16(b1, qr[d0], p1, 0, 0, 0); }
}
__device__ __forceinline__ int v_st(int k, int c) { const int kk = (k & ~0xC) | ((k & 4) << 1) | ((k & 8) >> 1); return ((kk >> 3) * 4 + (c >> 5)) * 512 + ((kk & 7) * 32 + (c & 31)) * 2; }
__device__ __forceinline__ int v_rd_base(int lane) { return ((lane & 3) << 3) | (((lane >> 2) & 3) << 6) | (((lane >> 4) & 1) << 5) | (((lane >> 5) & 1) << 8); }
constexpr int v_rd_off(int d0, int ks, int half) { return d0 * 512 + ks * 4096 + half * 2048; }
template <int OFF> __device__ __forceinline__ s16x4 tr_read(int vb) {
  s16x4 r; asm volatile("ds_read_b64_tr_b16 %0, %1 offset:%2" : "=&v"(r) : "v"(vb), "i"(OFF) : "memory"); return r;
}
template <int D0> __device__ __forceinline__ void pv_one(f32x16& od, int vb, bf16x8 pa0, bf16x8 pa1, bf16x8 pa2, bf16x8 pa3) {
  const s16x4 l0 = tr_read<v_rd_off(D0, 0, 0)>(vb), h0 = tr_read<v_rd_off(D0, 0, 1)>(vb), l1 = tr_read<v_rd_off(D0, 1, 0)>(vb), h1 = tr_read<v_rd_off(D0, 1, 1)>(vb);
  const s16x4 l2 = tr_read<v_rd_off(D0, 2, 0)>(vb), h2 = tr_read<v_rd_off(D0, 2, 1)>(vb), l3 = tr_read<v_rd_off(D0, 3, 0)>(vb), h3 = tr_read<v_rd_off(D0, 3, 1)>(vb);
  asm volatile("s_waitcnt lgkmcnt(0)" ::: "memory"); SBAR();
#define PK(L, H) (bf16x8){L[0], L[1], L[2], L[3], H[0], H[1], H[2], H[3]}
  od = __builtin_amdgcn_mfma_f32_32x32x16_bf16(pa0, PK(l0, h0), od, 0, 0, 0);
  od = __builtin_amdgcn_mfma_f32_32x32x16_bf16(pa1, PK(l1, h1), od, 0, 0, 0);
  od = __builtin_amdgcn_mfma_f32_32x32x16_bf16(pa2, PK(l2, h2), od, 0, 0, 0);
  od = __builtin_amdgcn_mfma_f32_32x32x16_bf16(pa3, PK(l3, h3), od, 0, 0, 0);
#undef PK
}
__device__ __forceinline__ void pv_d0(f32x16* o, int vb, bf16x8 pa0, bf16x8 pa1, bf16x8 pa2, bf16x8 pa3) {
  pv_one<0>(o[0], vb, pa0, pa1, pa2, pa3); pv_one<1>(o[1], vb, pa0, pa1, pa2, pa3); pv_one<2>(o[2], vb, pa0, pa1, pa2, pa3); pv_one<3>(o[3], vb, pa0, pa1, pa2, pa3);
}
__device__ __forceinline__ void band_mask(f32x16& p0, f32x16& p1, int dbase, int hi) {
#pragma unroll
  for (int r = 0; r < 16; ++r) { const int d = dbase + crow(r, hi);
    if (d < -128 || d > 128) p0[r] = -1e30f;
    if (d + 32 < -128 || d + 32 > 128) p1[r] = -1e30f; }
}
template <int MODE>
__device__ __forceinline__ void attn_body(const bf16* Qb, const bf16* Kh, const bf16* Vh, bf16* Ob, int NT, int kb0, int q0, float sink, char* lds, const float* qg, int tq0) {
  int tid_ = threadIdx.x; asm volatile("" : "+v"(tid_));
  const int tid = tid_, wid = tid >> 6, lane = tid & 63, r32 = lane & 31, hi = lane >> 5;
  bf16* V_lds = (bf16*)lds; bf16* K_lds = (bf16*)(lds + 3 * SHM_V);
  float* ws = (float*)(lds + 3 * SHM_V + 3 * SHM_K) + wid * 64; float* li_l = ws; float* al_l = ws + 32;
  bf16x8 qr[8];
  const bf16* Qw = Qb + (long)(wid * QBLK + r32) * LDQ + hi * 8;
  { u32x4 raw[8];
#pragma unroll
    for (int d0 = 0; d0 < 8; ++d0) raw[d0] = *reinterpret_cast<const u32x4*>(Qw + d0 * 16);
    float rs = 1.f;
    if (qg != nullptr) { float ssq = 0.f;
#pragma unroll
      for (int d0 = 0; d0 < 8; ++d0) { float f[8]; unpack8(raw[d0], f);
#pragma unroll
        for (int e = 0; e < 8; ++e) ssq += f[e] * f[e]; }
      ssq += __shfl_xor(ssq, 32);
      rs = rsqrtf(ssq * (1.f / 128.f) + 1e-6f); }
    const int t = tq0 + wid * QBLK + r32;
#pragma unroll
    for (int d0 = 0; d0 < 4; ++d0) { float fa[8], fb[8]; unpack8(raw[d0], fa); unpack8(raw[d0 + 4], fb);
      if (qg != nullptr) { const f32x4 ga0 = *reinterpret_cast<const f32x4*>(qg + 16 * d0 + 8 * hi), ga1 = *reinterpret_cast<const f32x4*>(qg + 16 * d0 + 8 * hi + 4);
        const f32x4 gb0 = *reinterpret_cast<const f32x4*>(qg + 64 + 16 * d0 + 8 * hi), gb1 = *reinterpret_cast<const f32x4*>(qg + 64 + 16 * d0 + 8 * hi + 4);
#pragma unroll
        for (int e = 0; e < 4; ++e) { fa[e] *= rs * ga0[e]; fa[4 + e] *= rs * ga1[e]; fb[e] *= rs * gb0[e]; fb[4 + e] *= rs * gb1[e]; } }
      if (tq0 >= 0) {
#pragma unroll
        for (int e = 0; e < 8; ++e) { const int j = 16 * d0 + 8 * hi + e; const int pos = j < 32 ? (t >> 6) : (t & 63);
          const float inv = exp2f(-(float)(j & 31) * (13.287712379549449f / 32.f)); float sn, cs; sincosf((float)pos * inv, &sn, &cs);
          const float a = fa[e], b2 = fb[e]; fa[e] = a * cs - b2 * sn; fb[e] = a * sn + b2 * cs; } }
      u32x4 wa, wb; wa.x = cvtpk(fa[0], fa[1]); wa.y = cvtpk(fa[2], fa[3]); wa.z = cvtpk(fa[4], fa[5]); wa.w = cvtpk(fa[6], fa[7]);
      wb.x = cvtpk(fb[0], fb[1]); wb.y = cvtpk(fb[2], fb[3]); wb.z = cvtpk(fb[4], fb[5]); wb.w = cvtpk(fb[6], fb[7]);
      qr[d0] = *reinterpret_cast<bf16x8*>(&wa); qr[d0 + 4] = *reinterpret_cast<bf16x8*>(&wb); } }
  float m_reg = -1e30f, l_reg = 0; f32x16 o[4] = {};
  const int sr = tid >> 4, sc = (tid & 15) * 8, vst0 = v_st(sr, sc), vst1 = v_st(32 + sr, sc);
  const int vb0 = (int)(uintptr_t)V_lds + v_rd_base(lane);
  struct { bf16x8 vs0, vs1, ks0, ks1; } sr_;
#define TK0(j) ((MODE == 0 || (j) < 4) ? (j) * KVBLK : kb0 + ((j) - 4) * KVBLK)
#define SLOAD(k0) do { sr_.vs0 = *reinterpret_cast<const bf16x8*>(&Vh[(long)((k0) + sr) * LDK + sc]); sr_.vs1 = *reinterpret_cast<const bf16x8*>(&Vh[(long)((k0) + 32 + sr) * LDK + sc]); \
    sr_.ks0 = *reinterpret_cast<const bf16x8*>(&Kh[(long)((k0) + sr) * LDK + sc]); sr_.ks1 = *reinterpret_cast<const bf16x8*>(&Kh[(long)((k0) + 32 + sr) * LDK + sc]); } while (0)
#define SWRITE(b) do { *(bf16x8*)((char*)V_lds + (b) * (int)SHM_V + vst0) = sr_.vs0;          \
    *(bf16x8*)((char*)V_lds + (b) * (int)SHM_V + vst1) = sr_.vs1; int kc = sc * 2;               \
    *(bf16x8*)((char*)K_lds + (b) * (int)SHM_K + KSWZ(sr, kc)) = sr_.ks0;                       \
    *(bf16x8*)((char*)K_lds + (b) * (int)SHM_K + KSWZ(32 + sr, kc)) = sr_.ks1; } while (0)
#define SWAIT() asm volatile("s_waitcnt vmcnt(0)" ::: "memory")
#define RESC(a) do { if (__any((a) < 1.f)) { if (hi == 0) al_l[r32] = (a); asm volatile("s_waitcnt lgkmcnt(0)" ::: "memory"); \
    for (int d = 0; d < 4; ++d) for (int r = 0; r < 16; ++r) o[d][r] *= al_l[crow(r, hi)]; } } while (0)
#define MASKT(P0, P1, j) do { if (MODE == 1 && (j) >= 4) { const int s0_ = kb0 - 256 + ((j) - 4) * KVBLK, tw_ = q0 + wid * QBLK; \
    if (!(s0_ - (tw_ + 31) >= -128 && (s0_ + 63) - tw_ <= 128)) band_mask(P0, P1, s0_ - tw_ - r32, hi); } } while (0)
  f32x16 pA0, pA1, pB0, pB1; float mnA, mnB, alA, alB; bf16x8 pa0, pa1, pa2, pa3;
  int bp = 0, bq = 1;
  SLOAD(TK0(0)); SWAIT(); SWRITE(0); __syncthreads();
  qkt(pA0, pA1, K_lds, qr, r32, hi); partialSM(pA0, pA1, m_reg, mnA, alA);
  SLOAD(TK0(1));
  SWAIT(); SWRITE(1); __syncthreads();
  for (int j = 1; j + 1 < NT; j += 2) {
    { const int bw = 3 - bp - bq;
      SBAR(); qkt(pB0, pB1, (bf16*)((char*)K_lds + bq * (int)SHM_K), qr, r32, hi);
      finishSM(pA0, pA1, alA, l_reg, pa0, pa1, pa2, pa3); SBAR();
      SLOAD(TK0(j + 1)); SBAR();
      pv_d0(o, vb0 + bp * (int)SHM_V, pa0, pa1, pa2, pa3); MASKT(pB0, pB1, j); partialSM(pB0, pB1, m_reg, mnB, alB);
      SWAIT(); SWRITE(bw);
      RESC(alB); __syncthreads();
      bp = bq; bq = bw; }
    { const int bw = 3 - bp - bq;
      SBAR(); qkt(pA0, pA1, (bf16*)((char*)K_lds + bq * (int)SHM_K), qr, r32, hi);
      finishSM(pB0, pB1, alB, l_reg, pa0, pa1, pa2, pa3); SBAR();
      SLOAD(TK0(j + 2)); SBAR();
      pv_d0(o, vb0 + bp * (int)SHM_V, pa0, pa1, pa2, pa3); MASKT(pA0, pA1, j + 1); partialSM(pA0, pA1, m_reg, mnA, alA);
      SWAIT(); SWRITE(bw);
      RESC(alA); __syncthreads();
      bp = bq; bq = bw; }
  }
  SBAR(); qkt(pB0, pB1, (bf16*)((char*)K_lds + bq * (int)SHM_K), qr, r32, hi);
  finishSM(pA0, pA1, alA, l_reg, pa0, pa1, pa2, pa3); SBAR();
  pv_d0(o, vb0 + bp * (int)SHM_V, pa0, pa1, pa2, pa3); MASKT(pB0, pB1, NT - 1); partialSM(pB0, pB1, m_reg, mnB, alB);
  RESC(alB);
  finishSM(pB0, pB1, alB, l_reg, pa0, pa1, pa2, pa3); SBAR();
  pv_d0(o, vb0 + bq * (int)SHM_V, pa0, pa1, pa2, pa3);
  if (MODE == 1) { constexpr float C = SCALE * 1.4426950408889634f; l_reg += __builtin_amdgcn_exp2f(sink * 1.4426950408889634f - m_reg * C); }
  if (hi == 0) li_l[r32] = l_reg; asm volatile("s_waitcnt lgkmcnt(0)" ::: "memory");
  float rli[16];
#pragma unroll
  for (int r = 0; r < 16; ++r) rli[r] = __builtin_amdgcn_rcpf(li_l[crow(r, hi)]);
  bf16* Ow = Ob + (long)(wid * QBLK) * LDO;
#pragma unroll
  for (int r = 0; r < 16; ++r) { int orow = crow(r, hi);
    for (int d0 = 0; d0 < 4; ++d0) Ow[(long)orow * LDO + d0 * 32 + r32] = (bf16)f2bf(o[d0][r] * rli[r]); }
  asm volatile("s_waitcnt vmcnt(0) lgkmcnt(0)" ::: "memory");
  __syncthreads();
#undef TK0
#undef SLOAD
#undef SWRITE
#undef SWAIT
#undef RESC
#undef MASKT
}
#undef KSWZ
#undef SBAR
}

struct Args { const float* in[36]; float* out; unsigned char* ws; int ph_lo, ph_hi; };
enum { I_X = 0, I_C, I_CTX, I_CCTX, I_WMOD, I_BMOD, I_GMIX, I_GFFN, I_WGRP, I_BGRP, I_WRT, I_BRT, I_W1, I_W3, I_W2, I_ABIN, I_ABOUT, I_SCONVW, I_SCONVB,
       I_DTBIAS, I_ALOG, I_SSDD, I_SNORMG, I_QG, I_KG, I_CDIN, I_CDOUT, I_LCONVW, I_LCONVB, I_LWA, I_LBA, I_LWX, I_LBX, I_LAM, I_SINK, I_GFINAL };

struct Ctx {
    const float* const* in; float* out; unsigned char* ws;
    int bid, G;
    __device__ __forceinline__ unsigned* ctl() const { return (unsigned*)(ws + WS_CTL); }
    __device__ __forceinline__ float* mod(int layer, int mv) const { return (float*)(ws + WS_MOD) + (size_t)(layer * 3 + mv) * 6144; }
    __device__ __forceinline__ float* xc() const { return (float*)(ws + WS_XC); }
    __device__ __forceinline__ float* xrow(int r) const { const int b = r / BROWS, q = r - b * BROWS; return q < CTXL ? xc() + (size_t)(b * CTXL + q) * DM : out + (size_t)(b * SEQL + (q - CTXL)) * DM; }
    __device__ __forceinline__ const float* xin_row(int r) const { const int b = r / BROWS, q = r - b * BROWS; return q < CTXL ? in[I_CTX] + (size_t)(b * CTXL + q) * DM : in[I_X] + (size_t)(b * SEQL + (q - CTXL)) * DM; }
};
struct TC { int tid, lane, wave; };
__device__ __forceinline__ TC phase_tc() { TC t; int x = threadIdx.x; asm volatile("" : "+v"(x)); t.tid = x; t.lane = x & 63; t.wave = __builtin_amdgcn_readfirstlane(x >> 6); return t; }
__device__ __forceinline__ int row_mv(int r) { const int b = r / BROWS, q = r - b * BROWS; return q < CTXL ? 2 : b; }

struct RowSched {
    int nM, nN, nwg, G, c, skipctx; const char* A; const char* Bt; size_t a_tile, b_tile;
    __device__ __forceinline__ bool next(int i, pg8::Unit& u) const {
        const long L = (long)i * G + c; if (L >= nwg) return false;
        if (skipctx == 2) { const int t8 = (int)L >> 2, ks = (int)L & 3; u.pm = (t8 >> 2) * 33; u.pn = t8 & 3;
            u.a = A + (size_t)u.pm * a_tile + (size_t)ks * 1024; u.b = Bt + (size_t)u.pn * b_tile + (size_t)ks * 1024; u.bd = 0; u.tbo = (int)L; u.nrow = 0; return true; }
        int wgid = (int)L; { const int q = nwg / 8, r = nwg % 8, xcd = wgid % 8, off = wgid / 8; wgid = (xcd < r ? xcd * (q + 1) : r * (q + 1) + (xcd - r) * q) + off; }
        const int nig = 8 * nN, gid = wgid / nig, fm = gid * 8, gsz = (nM - fm) < 8 ? (nM - fm) : 8;
        const int pmi = fm + ((wgid % nig) % gsz); u.pn = (wgid % nig) / gsz;
        u.pm = skipctx ? (pmi / 32) * 33 + 1 + (pmi % 32) : pmi;
        u.a = A + (size_t)u.pm * a_tile; u.b = Bt + (size_t)u.pn * b_tile; u.bd = 0; u.tbo = 0; u.nrow = 0; return true;
    }
    __device__ __forceinline__ void a_ready(const pg8::Unit&) const {}
    __device__ __forceinline__ void done(const pg8::Unit&) const {}
};
struct MoeSchedBase {
    const int* mt; int G, c, layer; unsigned char* ws;
    __device__ __forceinline__ bool locate(int i, pg8::Unit& u, int& ea, int& eb) const {
        const int ntl = mt[24]; const long L = (long)i * G + c; if (L >= (long)ntl * 4) return false;
        const int tile = (int)(L >> 2), pn = (int)(L & 3), cls = mt[64 + tile], g = cls / 6, pi = cls - g * 6;
        const int ia = pi < 3 ? 0 : (pi < 5 ? 1 : 2), ib = pi < 3 ? pi + 1 : (pi < 5 ? pi - 1 : 3);
        ea = g * 4 + ia; eb = g * 4 + ib;
        const int ti = tile - mt[cls];
        u.pm = tile; u.pn = pn; u.tbo = cls * NROWS + ti * 256; u.nrow = mt[32 + cls] - ti * 256;
        return true;
    }
};
struct MoeSched1 : MoeSchedBase {
    __device__ __forceinline__ bool next(int i, pg8::Unit& u) const { int ea, eb; if (!locate(i, u, ea, eb)) return false;
        const int e = (u.pn >> 1) ? eb : ea; u.a = (const char*)(ws + WS_A); u.b = (const char*)(ws + WS_W13) + ((size_t)e * 512 + (u.pn & 1) * 256) * 1024 * 2; u.bd = 0; return true; }
    __device__ __forceinline__ void a_ready(const pg8::Unit&) const {}
    __device__ __forceinline__ void done(const pg8::Unit& u) const {
        asm volatile("s_waitcnt vmcnt(0)" ::: "memory");
        if ((threadIdx.x & 63) == 0) __hip_atomic_fetch_add((unsigned*)(ws + WS_CTL) + CW_TDONE + layer * 6144 + 64 * u.pm, 1u, __ATOMIC_RELAXED, __HIP_MEMORY_SCOPE_AGENT);
    }
};
struct MoeSched2 : MoeSchedBase {
    __device__ __forceinline__ bool next(int i, pg8::Unit& u) const { int ea, eb; if (!locate(i, u, ea, eb)) return false;
        u.a = (const char*)(ws + WS_Z) + (size_t)u.pm * 256 * 512 * 2; u.b = (const char*)(ws + WS_W2) + ((size_t)ea * 1024 + u.pn * 256) * 256 * 2; u.bd = (long)(eb - ea) * 1024 * 256 * 2 - 4 * 128; return true; }
    __device__ __forceinline__ void a_ready(const pg8::Unit& u) const {
        if (threadIdx.x < 64) {
            unsigned polls = 0;
            unsigned* tw = (unsigned*)(ws + WS_CTL) + CW_TDONE + layer * 6144 + 64 * u.pm;
            while ((unsigned)__builtin_amdgcn_readfirstlane(__hip_atomic_load(tw, __ATOMIC_RELAXED, __HIP_MEMORY_SCOPE_AGENT)) < 32u) {
                if (++polls > (1u << 17)) break;
                __builtin_amdgcn_s_sleep(16); }
            __builtin_amdgcn_fence(__ATOMIC_ACQUIRE, "agent");
            asm volatile("s_waitcnt vmcnt(0)" ::: "memory");
        }
        asm volatile("" ::: "memory"); __builtin_amdgcn_s_barrier(); asm volatile("" ::: "memory");
    }
    __device__ __forceinline__ void done(const pg8::Unit&) const {}
};

struct EpiProj {
    static constexpr bool PERM = true;
    bf16 *d0, *d1, *d2, *d3, *d4, *d5; int e0, e1, e2, e3, e4; int l0, l1, l2, l3, l4, l5; int lastcols;
    __device__ __forceinline__ void operator()(const f32x4 (&acc)[2][2][4][2], const pg8::Unit& u, int wr, int wc, int fr, int fq) const {
        const int pn = u.pn; bf16* base; int ld, tl, ncol = 256;
        if (pn < e0) { base = d0; ld = l0; tl = pn; } else if (pn < e1) { base = d1; ld = l1; tl = pn - e0; } else if (pn < e2) { base = d2; ld = l2; tl = pn - e1; }
        else if (pn < e3) { base = d3; ld = l3; tl = pn - e2; } else if (pn < e4) { base = d4; ld = l4; tl = pn - e3; } else { base = d5; ld = l5; tl = pn - e4; ncol = lastcols; }
        const int row0 = u.pm * 256 + wr * 64 + fr, col0 = wc * 32 + 8 * fq;
#pragma unroll
        for (int ai = 0; ai < 2; ++ai)
#pragma unroll
            for (int m = 0; m < 4; ++m) { bf16* rowp = base + (size_t)(row0 + ai * 128 + m * 16) * ld + tl * 256 + col0;
#pragma unroll
                for (int bj = 0; bj < 2; ++bj) { if (col0 + bj * 128 < ncol) { const f32x4 v0 = acc[ai][bj][m][0], v1 = acc[ai][bj][m][1];
                    u32x4 w; w.x = pg8::cvt_pk_bf16(v0[0], v0[1]); w.y = pg8::cvt_pk_bf16(v0[2], v0[3]); w.z = pg8::cvt_pk_bf16(v1[0], v1[1]); w.w = pg8::cvt_pk_bf16(v1[2], v1[3]);
                    *(u32x4*)(rowp + bj * 128) = w; } } }
    }
};
struct EpiRes {
    static constexpr bool PERM = false;
    float* slab;
    const float* xin_lat; const float* xin_ctx; float* xout_lat; float* xout_ctx; const float* modbase;
    __device__ __forceinline__ void operator()(const f32x4 (&acc)[2][2][4][2], const pg8::Unit& u, int wr, int wc, int fr, int fq) const {
        if (slab) { float* sp = slab + (size_t)u.tbo * 65536 + (size_t)(wr * 64 + fr) * 256 + wc * 32 + 4 * fq;
#pragma unroll
            for (int ai = 0; ai < 2; ++ai)
#pragma unroll
                for (int m = 0; m < 4; ++m)
#pragma unroll
                    for (int bj = 0; bj < 2; ++bj)
#pragma unroll
                        for (int n = 0; n < 2; ++n) *(f32x4*)(sp + (size_t)(ai * 128 + m * 16) * 256 + bj * 128 + n * 16) = acc[ai][bj][m][n];
            return; }
        const int b = u.pm / 33, qt = u.pm - b * 33; const bool isctx = (qt == 0);
        const size_t rbase = isctx ? (size_t)b * CTXL : (size_t)b * SEQL + (size_t)(qt - 1) * 256;
        const float* xi = (isctx ? xin_ctx : xin_lat) + rbase * DM; float* xo = (isctx ? xout_ctx : xout_lat) + rbase * DM;
        const float* gate = modbase + (size_t)(isctx ? 2 : b) * 6144 + 2 * 1024;
        const int row0 = wr * 64 + fr, col0 = u.pn * 256 + wc * 32 + 4 * fq;
        f32x4 gv[2][2];
#pragma unroll
        for (int bj = 0; bj < 2; ++bj)
#pragma unroll
            for (int n = 0; n < 2; ++n) gv[bj][n] = *(const f32x4*)(gate + col0 + bj * 128 + n * 16);
#pragma unroll
        for (int ai = 0; ai < 2; ++ai)
#pragma unroll
            for (int m = 0; m < 4; ++m) { const size_t off = (size_t)(row0 + ai * 128 + m * 16) * DM + col0;
#pragma unroll
                for (int bj = 0; bj < 2; ++bj)
#pragma unroll
                    for (int n = 0; n < 2; ++n) { const f32x4 xv = *(const f32x4*)(xi + off + bj * 128 + n * 16);
                        *(f32x4*)(xo + off + bj * 128 + n * 16) = xv + gv[bj][n] * acc[ai][bj][m][n]; } }
    }
};
struct EpiMoe1 {
    static constexpr bool PERM = true;
    unsigned char* ws;
    __device__ __forceinline__ void operator()(const f32x4 (&acc)[2][2][4][2], const pg8::Unit& u, int wr, int wc, int fr, int fq) const {
        const __amdgpu_buffer_rsrc_t hr = __builtin_amdgcn_make_buffer_rsrc((void*)(ws + WS_Z), 0, MAXSLOT * 512 * 2, 0x00020000);
        const int* TBL = (const int*)(ws + WS_TBL); const int* REC = (const int*)(ws + WS_REC);
        const int rho0 = wr * 64 + fr, colh = (u.pn >> 1) * 256 + (u.pn & 1) * 128 + wc * 32 + 8 * fq, which = u.pn >> 1;
        int rr[8]; float gts[8];
#pragma unroll
        for (int k = 0; k < 8; ++k) { const int rho = rho0 + (k >> 2) * 128 + (k & 3) * 16; const int rc = rho < u.nrow ? rho : u.nrow - 1; rr[k] = TBL[u.tbo + rc]; }
#pragma unroll
        for (int k = 0; k < 8; ++k) gts[k] = __uint_as_float((unsigned)REC[(size_t)rr[k] * 4 + 2 + which]);
#pragma unroll
        for (int ai = 0; ai < 2; ++ai)
#pragma unroll
            for (int m = 0; m < 4; ++m) { const int rho = rho0 + ai * 128 + m * 16; const float gt = gts[ai * 4 + m];
                float hv[8];
#pragma unroll
                for (int n = 0; n < 2; ++n)
#pragma unroll
                    for (int e = 0; e < 4; ++e) { const float a = acc[ai][0][m][n][e], uu = acc[ai][1][m][n][e]; hv[n * 4 + e] = silu_f(a) * uu * gt; }
                u32x4 w; w.x = pg8::cvt_pk_bf16(hv[0], hv[1]); w.y = pg8::cvt_pk_bf16(hv[2], hv[3]); w.z = pg8::cvt_pk_bf16(hv[4], hv[5]); w.w = pg8::cvt_pk_bf16(hv[6], hv[7]);
                __builtin_amdgcn_raw_buffer_store_b128(w, hr, (unsigned)(((size_t)(u.pm * 256 + rho) * 512 + colh) * 2), 0, 16); }
    }
};
struct EpiMoe2 {
    static constexpr bool PERM = false;
    float* out; unsigned char* ws; int layer;
    __device__ __forceinline__ void operator()(const f32x4 (&acc)[2][2][4][2], const pg8::Unit& u, int wr, int wc, int fr, int fq) const {
        const int rho0 = wr * 64 + fr, col0 = u.pn * 256 + wc * 32 + 4 * fq; const int* TBL = (const int*)(ws + WS_TBL); float* xc = (float*)(ws + WS_XC); const float* modbase = (const float*)(ws + WS_MOD) + (size_t)layer * 3 * 6144;
        int rr[8];
#pragma unroll
        for (int k = 0; k < 8; ++k) { const int rho = rho0 + (k >> 2) * 128 + (k & 3) * 16; rr[k] = rho < u.nrow ? TBL[u.tbo + rho] : -1; }
#pragma unroll
        for (int ai = 0; ai < 2; ++ai)
#pragma unroll
            for (int m = 0; m < 4; ++m) { const int r = rr[ai * 4 + m];
                if (r >= 0) { const int b = r / BROWS, q = r - b * BROWS; const bool isctx = q < CTXL;
                    float* xp = isctx ? xc + (size_t)(b * CTXL + q) * DM : out + (size_t)(b * SEQL + (q - CTXL)) * DM;
                    const float* gate = modbase + (size_t)(isctx ? 2 : b) * 6144 + 5 * 1024;
#pragma unroll
                    for (int bj = 0; bj < 2; ++bj)
#pragma unroll
                        for (int n = 0; n < 2; ++n) { const int c = col0 + bj * 128 + n * 16; const f32x4 gv = *(const f32x4*)(gate + c); const f32x4 xv = *(const f32x4*)(xp + c);
                            *(f32x4*)(xp + c) = xv + gv * acc[ai][bj][m][n]; } }
                if (m & 1) asm volatile("" ::: "memory"); }
    }
};

__device__ __forceinline__ void transpose_item(const float* W, int ldw, int k0, int n0src, bf16* WT, int ldt, int drow0, int dk0, LAS float* scr, int lane) {
    float tv[32];
#pragma unroll
    for (int i = 0; i < 32; ++i) { const int kk = 2 * i + (lane >> 5); tv[i] = n0src >= 0 ? W[(size_t)(k0 + kk) * ldw + n0src + (lane & 31)] : 0.f; }
#pragma unroll
    for (int i = 0; i < 32; ++i) { const int kk = 2 * i + (lane >> 5); scr[kk * 33 + (lane & 31)] = tv[i]; }
    asm volatile("s_waitcnt lgkmcnt(0)" ::: "memory");
    const int c = lane & 7;
#pragma unroll
    for (int j = 0; j < 4; ++j) { const int n = (lane >> 3) + 8 * j; const LAS float* s = scr + (8 * c) * 33 + n;
        u32x4 o; o.x = pk2(s[0 * 33], s[1 * 33]); o.y = pk2(s[2 * 33], s[3 * 33]); o.z = pk2(s[4 * 33], s[5 * 33]); o.w = pk2(s[6 * 33], s[7 * 33]);
        *(u32x4*)(WT + (size_t)(drow0 + n) * ldt + dk0 + 8 * c) = o; }
    asm volatile("s_waitcnt lgkmcnt(0)" ::: "memory");
}
__device__ __forceinline__ int ab_src_col(int n) {
    if (n < 2304) return n;
    if (n < 3840) return n + 32;
    if (n < 3872) return n - 3840 + 2304;
    return -1;
}
__device__ __forceinline__ void ph_convert(const Ctx& C, int layer, LAS unsigned char* lds) {
    const TC T = phase_tc();
    LAS float* scr = (LAS float*)(lds + T.wave * 16384);
    const int gw = C.bid * NWAVES + T.wave, NGW = C.G * NWAVES;
    bf16* Win = (bf16*)(C.ws + WS_WIN); bf16* Wout = (bf16*)(C.ws + WS_WOUT); bf16* W13 = (bf16*)(C.ws + WS_W13); bf16* W2 = (bf16*)(C.ws + WS_W2);
    const int nin = layer == 0 ? 3872 : 3584;
    const int I_IN = 16 * (nin / 32), I_OUT = 32 * 32, I_E = 16 * 128;
    const int NIT = I_IN + I_OUT + 3 * I_E;
    const float* win = C.in[layer == 0 ? I_ABIN : I_CDIN]; const float* wout = C.in[layer == 0 ? I_ABOUT : I_CDOUT];
    const int ldin = layer == 0 ? 3872 : 3584;
    for (int it = gw; it < NIT; it += NGW) {
        int r = it;
        if (r < I_IN) { const int nblk = nin / 32, kb = r / nblk, nb = r % nblk; const int src = layer == 0 ? ab_src_col(nb * 32) : nb * 32;
            transpose_item(win, ldin, kb * 64, src, Win, 1024, nb * 32, kb * 64, scr, T.lane); continue; } r -= I_IN;
        if (r < I_OUT) { const int kb = r / 32, nb = r % 32; transpose_item(wout, 1024, kb * 64, nb * 32, Wout, 2048, nb * 32, kb * 64, scr, T.lane); continue; } r -= I_OUT;
        if (r < 2 * I_E) { const int w3 = r >= I_E; if (w3) r -= I_E; const int e = r / 128, q = r % 128, kb = q / 8, nb = q % 8;
            const float* W = C.in[w3 ? I_W3 : I_W1] + (size_t)(layer * 16 + e) * 1024 * 256; const int n0 = nb * 32;
            transpose_item(W, 256, kb * 64, n0, W13 + (size_t)e * 512 * 1024, 1024, (n0 / 128) * 256 + (w3 ? 128 : 0) + (n0 % 128), kb * 64, scr, T.lane); continue; } r -= 2 * I_E;
        { const int e = r / 128, q = r % 128, kb = q / 32, nb = q % 32;
            const float* W = C.in[I_W2] + (size_t)(layer * 16 + e) * 256 * 1024;
            transpose_item(W, 1024, kb * 64, nb * 32, W2 + (size_t)e * 1024 * 256, 256, nb * 32, kb * 64, scr, T.lane); }
    }
}
__device__ __forceinline__ void ph_mod(const Ctx& C, LAS unsigned char* lds) {
    const TC T = phase_tc();
    LAS float* red = (LAS float*)lds;
    LAS float* act = red + 8 * 3 * 256;
    if (C.bid < 48) {
        for (int i = T.tid; i < 3072; i += NTHREADS) { const int v = i >> 10, d = i & 1023; act[i] = silu_f(v < 2 ? C.in[I_C][v * 1024 + d] : C.in[I_CCTX][d]); }
        __syncthreads();
    }
    for (int item = C.bid; item < 48; item += C.G) {
        const int layer = item / 24, chunk = item % 24;
        const float* W = C.in[I_WMOD] + (size_t)layer * 1024 * 6144 + chunk * 256 + T.lane * 4;
        f32x4 a0 = {0, 0, 0, 0}, a1 = a0, a2 = a0;
        const int d0 = T.wave * 128;
        for (int d = d0; d < d0 + 128; d += 8) {
            f32x4 w[8];
#pragma unroll
            for (int u = 0; u < 8; ++u) w[u] = *(const f32x4*)(W + (size_t)(d + u) * 6144);
#pragma unroll
            for (int u = 0; u < 8; ++u) { const float c0 = act[d + u], c1 = act[1024 + d + u], c2 = act[2048 + d + u]; a0 += w[u] * c0; a1 += w[u] * c1; a2 += w[u] * c2; }
        }
        __syncthreads();
#pragma unroll
        for (int e = 0; e < 4; ++e) { red[(T.wave * 3 + 0) * 256 + T.lane * 4 + e] = a0[e]; red[(T.wave * 3 + 1) * 256 + T.lane * 4 + e] = a1[e]; red[(T.wave * 3 + 2) * 256 + T.lane * 4 + e] = a2[e]; }
        __syncthreads();
        for (int o = T.tid; o < 768; o += NTHREADS) { const int v = o >> 8, j = o & 255; float s = 0.f;
#pragma unroll
            for (int w = 0; w < 8; ++w) s += red[(w * 3 + v) * 256 + j];
            C.mod(layer, v)[chunk * 256 + j] = s + C.in[I_BMOD][layer * 6144 + chunk * 256 + j]; }
        asm volatile("s_waitcnt vmcnt(0)" ::: "memory");
        __syncthreads();
        if (T.tid == 0) { __builtin_amdgcn_fence(__ATOMIC_RELEASE, "agent"); asm volatile("s_waitcnt vmcnt(0)" ::: "memory");
            __hip_atomic_fetch_add(C.ctl() + CW_MODDONE, 1u, __ATOMIC_RELAXED, __HIP_MEMORY_SCOPE_AGENT); }
    }
}
__device__ __forceinline__ void mod_wait(const Ctx& C) {
    const TC T = phase_tc();
    if (T.tid < 64) { unsigned polls = 0;
        while ((unsigned)__builtin_amdgcn_readfirstlane(__hip_atomic_load(C.ctl() + CW_MODDONE, __ATOMIC_RELAXED, __HIP_MEMORY_SCOPE_AGENT)) < 48u) { if (++polls > (1u << 17)) break; __builtin_amdgcn_s_sleep(16); }
        __builtin_amdgcn_fence(__ATOMIC_ACQUIRE, "agent"); asm volatile("s_waitcnt vmcnt(0)" ::: "memory"); }
    __syncthreads();
}
__device__ __forceinline__ void ph_prenorm(const Ctx& C, int layer) {
    const TC T = phase_tc();
    bf16* HN = (bf16*)(C.ws + WS_A);
    const float* gm = C.in[I_GMIX] + layer * 1024;
    const int gw = C.bid * NWAVES + T.wave, NGW = C.G * NWAVES;
    for (int r = gw; r < NROWS; r += NGW) {
        const float* xr = layer == 0 ? C.xin_row(r) : C.xrow(r);
        const float* md = C.mod(layer, row_mv(r));
        f32x4 v[4]; float ss = 0.f;
#pragma unroll
        for (int j = 0; j < 4; ++j) { v[j] = *(const f32x4*)(xr + 256 * j + 4 * T.lane); ss += (v[j].x * v[j].x + v[j].y * v[j].y) + (v[j].z * v[j].z + v[j].w * v[j].w); }
        const float rs = rsqrtf(wave_sum(ss) * (1.f / DM) + EPS);
#pragma unroll
        for (int j = 0; j < 4; ++j) { const int c = 256 * j + 4 * T.lane; const f32x4 g = *(const f32x4*)(gm + c), sc = *(const f32x4*)(md + 1024 + c), sh = *(const f32x4*)(md + c);
            const f32x4 h = v[j] * rs * g * (sc + 1.f) + sh;
            u32x2 w; w.x = pk2(h.x, h.y); w.y = pk2(h.z, h.w); *(u32x2*)(HN + (size_t)r * DM + c) = w; }
    }
}
__device__ __forceinline__ bool nb_valid(int r, int dk) { const int b = r / BROWS, q = r - b * BROWS; if (q < CTXL) { const int t = q + dk; return t >= 0 && t < CTXL; } const int t = q - CTXL + dk; return t >= 0 && t < SEQL; }
__device__ __forceinline__ void rope_angle(int r, int lane, float& cs, float& sn, bool& latent) {
    const int b = r / BROWS, q = r - b * BROWS; latent = q >= CTXL; const int t = q - CTXL;
    const int pos = lane < 32 ? (t >> 6) : (t & 63); const int jf = lane & 31;
    const float inv = exp2f(-(float)jf * (13.287712379549449f / 32.f));
    const float ang = (float)pos * inv; sincosf(ang, &sn, &cs);
}
__device__ __forceinline__ void ph_elem0(const Ctx& C) {
    const TC T = phase_tc();
    const bf16* RAW = (const bf16*)(C.ws + WS_RAW); bf16* XBC = (bf16*)C.out;
    float* DT = (float*)(C.ws + WS_DT);
    bf16* Q = (bf16*)(C.ws + WS_YMIX) + 1024; bf16* K = (bf16*)(C.ws + WS_K);
    const float* cw = C.in[I_SCONVW]; const float* cb = C.in[I_SCONVB];
    const int gw = C.bid * NWAVES + T.wave, NGW = C.G * NWAVES, lane = T.lane;
    { const bf16* HN = (const bf16*)(C.ws + WS_A); const bf16* Wd = (const bf16*)(C.ws + WS_WIN) + (size_t)3840 * 1024; const int l15 = lane & 15, lq = lane >> 4;
      const float bias0 = C.in[I_DTBIAS][l15], bias1 = C.in[I_DTBIAS][16 + l15];
      for (int gI = gw; gI < NROWS / 16; gI += NGW) { f32x4 a0 = {0.f, 0.f, 0.f, 0.f}, a1 = a0;
          const bf16* ap = HN + (size_t)(16 * gI + l15) * 1024 + 8 * lq; const bf16* b0p = Wd + (size_t)l15 * 1024 + 8 * lq; const bf16* b1p = Wd + (size_t)(16 + l15) * 1024 + 8 * lq;
#pragma unroll 8
          for (int ks = 0; ks < 32; ++ks) { const bf16x8 af = *(const bf16x8*)(ap + 32 * ks), f0 = *(const bf16x8*)(b0p + 32 * ks), f1 = *(const bf16x8*)(b1p + 32 * ks);
              a0 = __builtin_amdgcn_mfma_f32_16x16x32_bf16(af, f0, a0, 0, 0, 0); a1 = __builtin_amdgcn_mfma_f32_16x16x32_bf16(af, f1, a1, 0, 0, 0); }
#pragma unroll
          for (int rg = 0; rg < 4; ++rg) { const size_t ro = (size_t)(16 * gI + 4 * lq + rg) * 32; DT[ro + l15] = softplus_f(a0[rg] + bias0); DT[ro + 16 + l15] = softplus_f(a1[rg] + bias1); } } }
    for (int r = gw; r < NROWS; r += NGW) {
        for (int ch = lane; ch < 160; ch += 64) { const int c0 = ch * 8; float acc[8];
#pragma unroll
            for (int e = 0; e < 8; ++e) acc[e] = cb[c0 + e];
#pragma unroll
            for (int k = 0; k < 5; ++k) { if (nb_valid(r, k - 2)) { const u32x4 w = *(const u32x4*)(RAW + (size_t)(r + k - 2) * 1280 + c0); float xv[8]; unpack8(w, xv);
#pragma unroll
                for (int e = 0; e < 8; ++e) acc[e] += xv[e] * cw[k * 1280 + c0 + e]; } }
            u32x4 o; o.x = pk2(silu_f(acc[0]), silu_f(acc[1])); o.y = pk2(silu_f(acc[2]), silu_f(acc[3])); o.z = pk2(silu_f(acc[4]), silu_f(acc[5])); o.w = pk2(silu_f(acc[6]), silu_f(acc[7]));
            *(u32x4*)(XBC + (size_t)r * 1280 + c0) = o; }
        float cs, sn; bool latent; rope_angle(r, lane, cs, sn, latent);
        const float qg0 = C.in[I_QG][lane], qg1 = C.in[I_QG][64 + lane], kg0 = C.in[I_KG][lane], kg1 = C.in[I_KG][64 + lane];
#pragma unroll
        for (int h = 8; h < 10; ++h) { bf16* p = K + (size_t)r * 256 + (h - 8) * 128;
            float t1 = bf2f(p[lane]), t2 = bf2f(p[64 + lane]);
            const float rs = rsqrtf(wave_sum(t1 * t1 + t2 * t2) * (1.f / 128.f) + EPS);
            t1 = t1 * rs * (h < 8 ? qg0 : kg0); t2 = t2 * rs * (h < 8 ? qg1 : kg1);
            if (latent) { const float o1 = t1 * cs - t2 * sn, o2 = t1 * sn + t2 * cs; t1 = o1; t2 = o2; }
            p[lane] = (bf16)f2bf(t1); p[64 + lane] = (bf16)f2bf(t2); }
    }
}
__device__ __forceinline__ void ph_elem1(const Ctx& C) {
    const TC T = phase_tc();
    const bf16* RAW = (const bf16*)(C.ws + WS_RAW); bf16* XR = (bf16*)(C.ws + WS_A);
    bf16* Q = (bf16*)(C.ws + WS_YMIX) + 1024; bf16* K = (bf16*)(C.ws + WS_K);
    const float* cw = C.in[I_LCONVW]; const float* cb = C.in[I_LCONVB];
    const int gw = C.bid * NWAVES + T.wave, NGW = C.G * NWAVES, lane = T.lane;
    for (int r = gw; r < NROWS; r += NGW) {
        for (int ch = lane; ch < 128; ch += 64) { const int c0 = ch * 8; float acc[8];
#pragma unroll
            for (int e = 0; e < 8; ++e) acc[e] = cb[c0 + e];
#pragma unroll
            for (int k = 0; k < 5; ++k) { if (nb_valid(r, k - 2)) { const u32x4 w = *(const u32x4*)(RAW + (size_t)(r + k - 2) * 1024 + c0); float xv[8]; unpack8(w, xv);
#pragma unroll
                for (int e = 0; e < 8; ++e) acc[e] += xv[e] * cw[k * 1024 + c0 + e]; } }
            u32x4 o; o.x = pk2(acc[0], acc[1]); o.y = pk2(acc[2], acc[3]); o.z = pk2(acc[4], acc[5]); o.w = pk2(acc[6], acc[7]);
            *(u32x4*)(XR + (size_t)r * 1024 + c0) = o; }
        float cs, sn; bool latent; rope_angle(r, lane, cs, sn, latent);
        if (latent) {
#pragma unroll
            for (int h = 8; h < 10; ++h) { bf16* p = K + (size_t)r * 256 + (h - 8) * 128;
                const float t1 = bf2f(p[lane]), t2 = bf2f(p[64 + lane]);
                p[lane] = (bf16)f2bf(t1 * cs - t2 * sn); p[64 + lane] = (bf16)f2bf(t1 * sn + t2 * cs); }
        }
    }
}
__device__ __forceinline__ int chunk_of(int dir, int ci) { return dir == 0 ? ci : (ci < 2 ? 1 - ci : 67 - ci); }
__device__ __forceinline__ int step_row(int dir, int s) { return dir == 0 ? s : (s < CTXL ? CTXL - 1 - s : BROWS + CTXL - 1 - s); }
__device__ __forceinline__ void ssd_seq_unit(const Ctx& C, int item, LAS unsigned char* lds) {
    const TC T = phase_tc();
    const int b = item >> 5, dir = (item >> 4) & 1, h = item & 15, g = h >> 3, lane = T.lane, wid = T.wave;
    LAS float* part = (LAS float*)lds;
    LAS float* xs = part + 8 * 32 * 64; LAS float* Bs = xs + 32 * 64; LAS float* Cs = Bs + 32 * 64; LAS float* dts = Cs + 32 * 64;
    const float aneg = -__expf(C.in[I_ALOG][dir * 16 + h]);
    const bf16* XBC = (const bf16*)C.out + (size_t)b * BROWS * 1280;
    const float* DT = (const float*)(C.ws + WS_DT) + (size_t)b * BROWS * 32 + dir * 16 + h;
    bf16* Y = dir == 0 ? (bf16*)(C.ws + WS_YMIX) + (size_t)b * BROWS * 2048 + h * 64 : (bf16*)(C.ws + WS_RAW) + (size_t)b * BROWS * 1024 + h * 64;
    const int ldy = dir == 0 ? 2048 : 1024;
    float hs[8];
#pragma unroll
    for (int k = 0; k < 8; ++k) hs[k] = 0.f;
    for (int s0 = 0; s0 < BROWS; s0 += 32) {
        for (int i = T.tid; i < 32 * 192; i += NTHREADS) { const int tt = i / 192, c = i - tt * 192; const int q = step_row(dir, s0 + tt);
            const bf16* row = XBC + (size_t)q * 1280;
            if (c < 64) xs[tt * 64 + c] = bf2f(row[h * 64 + c]); else if (c < 128) Bs[tt * 64 + c - 64] = bf2f(row[1024 + g * 64 + c - 64]); else Cs[tt * 64 + c - 128] = bf2f(row[1152 + g * 64 + c - 128]); }
        if (T.tid < 32) dts[T.tid] = DT[(size_t)step_row(dir, s0 + T.tid) * 32];
        __syncthreads();
        for (int tt = 0; tt < 32; ++tt) {
            const float x = xs[tt * 64 + lane], dt = dts[tt];
            const f32x4 b0 = *(const LAS f32x4*)(Bs + tt * 64 + wid * 8), b1 = *(const LAS f32x4*)(Bs + tt * 64 + wid * 8 + 4);
            const f32x4 c0 = *(const LAS f32x4*)(Cs + tt * 64 + wid * 8), c1 = *(const LAS f32x4*)(Cs + tt * 64 + wid * 8 + 4);
            const float a = __expf(dt * aneg), dx = dt * x; float y = 0.f;
#pragma unroll
            for (int k = 0; k < 4; ++k) { hs[k] = a * hs[k] + dx * b0[k]; y += c0[k] * hs[k]; }
#pragma unroll
            for (int k = 0; k < 4; ++k) { hs[4 + k] = a * hs[4 + k] + dx * b1[k]; y += c1[k] * hs[4 + k]; }
            part[(wid * 32 + tt) * 64 + lane] = y;
        }
        __syncthreads();
        for (int i = T.tid; i < 2048; i += NTHREADS) { const int tt = i >> 6, p = i & 63; float s = 0.f;
#pragma unroll
            for (int w = 0; w < 8; ++w) s += part[(w * 32 + tt) * 64 + p];
            const int q = step_row(dir, s0 + tt); Y[(size_t)q * ldy + p] = (bf16)f2bf(s); }
        __syncthreads();
    }
}

__device__ __forceinline__ int ssd_seg_begin(int s) { return s == 0 ? 0 : (s == 1 ? 17 : (s == 2 ? 34 : (s == 3 ? 50 : 66))); }
__device__ __forceinline__ unsigned short hw_bf16(float x) { unsigned r; asm volatile("v_cvt_pk_bf16_f32 %0, %1, %1" : "=v"(r) : "v"(x)); return (unsigned short)r; }
__device__ __forceinline__ int tswz(int row, int col) { return row * 136 + ((((col >> 3) ^ ((row >> 3) & 7)) << 3) | (col & 7)); }
template <int MODE>
__device__ __forceinline__ void ssd_chunk_unit(const Ctx& C, int item, int seg, LAS unsigned char* lds) {
    const TC T = phase_tc();
    const int b = item >> 5, dir = (item >> 4) & 1, h = item & 15, g = h >> 3, lane = T.lane, wid = T.wave, tid = T.tid;
    const int ci0 = ssd_seg_begin(seg), ci1 = ssd_seg_begin(seg + 1);
    float* SEND = (float*)(C.ws + WS_SSDST) + (size_t)item * 3 * 4096; float* SLD = (float*)(C.ws + WS_SSDLD) + item * 3;
    const int l15 = lane & 15, lq = lane >> 4;
    LAS bf16* Cs = (LAS bf16*)lds;
    LAS bf16* Bs = Cs + 128 * 72;
    LAS bf16* Xt = Bs + 128 * 72;
    LAS bf16* Bwt = Xt + 64 * 136;
    LAS bf16* Ws = Bwt + 64 * 136;
    LAS bf16* Hs = Ws + 128 * 136;
    LAS float* acs = (LAS float*)(Hs + 64 * 72); LAS float* dtv = acs + 128; LAS float* eacs = dtv + 128; LAS float* wend = eacs + 128;
    const float aneg = -__expf(C.in[I_ALOG][dir * 16 + h]);
    const bf16* XBC = (const bf16*)C.out + (size_t)b * BROWS * 1280;
    const float* DT = (const float*)(C.ws + WS_DT) + (size_t)b * BROWS * 32 + dir * 16 + h;
    bf16* Y = dir == 0 ? (bf16*)(C.ws + WS_YMIX) + (size_t)b * BROWS * 2048 + h * 64 : (bf16*)(C.ws + WS_RAW) + (size_t)b * BROWS * 1024 + h * 64;
    const int ldy = dir == 0 ? 2048 : 1024;
    f32x4 Hacc[2]; Hacc[0] = (f32x4){0.f, 0.f, 0.f, 0.f}; Hacc[1] = Hacc[0];
    float ldsum = 0.f;
    if (MODE == 1) {
        for (int sp = 0; sp < seg; ++sp) { const float dseg = __expf(SLD[sp]);
#pragma unroll
            for (int t = 0; t < 2; ++t) { const int tl = 2 * wid + t, nt_ = tl >> 2, pt = tl & 3;
                const f32x4 sv = *(const f32x4*)(SEND + (size_t)sp * 4096 + (16 * pt + l15) * 64 + 16 * nt_ + 4 * lq); Hacc[t] = Hacc[t] * dseg + sv; } }
#pragma unroll
        for (int t = 0; t < 2; ++t) { const int tl = 2 * wid + t, nt_ = tl >> 2, pt = tl & 3;
            u32x2 w; w.x = pg8::cvt_pk_bf16(Hacc[t][0], Hacc[t][1]); w.y = pg8::cvt_pk_bf16(Hacc[t][2], Hacc[t][3]); *(LAS u32x2*)(Hs + (16 * pt + l15) * 72 + 16 * nt_ + 4 * lq) = w; }
    }
    u32x4 xb[4], bb[2], cb[2]; float dt0 = 0.f, dt1 = 0.f;
    const int xtg = tid >> 3, xpg = tid & 7;
#define SSD_ROW(q0_, i_) (XBC + (size_t)(dir == 0 ? (q0_) + (i_) : (q0_) + 127 - (i_)) * 1280)
#define SSD_LOAD(q0_) do { \
        if (tid < 256) { _Pragma("unroll") for (int q_ = 0; q_ < 4; ++q_) xb[q_] = *(const u32x4*)(SSD_ROW(q0_, 4 * xtg + q_) + h * 64 + 8 * xpg); } \
        _Pragma("unroll") for (int k = 0; k < 2; ++k) { const int pidx = tid + 512 * k, i_ = pidx >> 3, c8_ = (pidx & 7) * 8; \
            bb[k] = *(const u32x4*)(SSD_ROW(q0_, i_) + 1024 + g * 64 + c8_); if (MODE == 1) cb[k] = *(const u32x4*)(SSD_ROW(q0_, i_) + 1152 + g * 64 + c8_); } \
        if (wid == 0) { dt0 = DT[(size_t)(dir == 0 ? (q0_) + 2 * lane : (q0_) + 127 - 2 * lane) * 32]; dt1 = DT[(size_t)(dir == 0 ? (q0_) + 2 * lane + 1 : (q0_) + 126 - 2 * lane) * 32]; } } while (0)
    SSD_LOAD(chunk_of(dir, ci0) * 128);
    for (int ci = ci0; ci < ci1; ++ci) {
        const int q0 = chunk_of(dir, ci) * 128;
        __syncthreads();
        if (wid == 0) {
            const float a0 = dt0 * aneg, a1 = dt1 * aneg; float v = a0 + a1;
#pragma unroll
            for (int o = 1; o < 64; o <<= 1) { const float t = __shfl_up(v, o); if (lane >= o) v += t; }
            const float tot = __shfl(v, 63), c0 = v - a1;
            acs[2 * lane] = c0; acs[2 * lane + 1] = v; dtv[2 * lane] = dt0; dtv[2 * lane + 1] = dt1;
            eacs[2 * lane] = __expf(c0); eacs[2 * lane + 1] = __expf(v);
            wend[2 * lane] = __expf(tot - c0) * dt0; wend[2 * lane + 1] = __expf(tot - v) * dt1; }
        if (tid < 256) {
#pragma unroll
            for (int m = 0; m < 4; ++m) { const unsigned w0 = xb[0][m], w1 = xb[1][m], w2 = xb[2][m], w3 = xb[3][m];
                u32x2 lo, hi; lo.x = (w0 & 0xffffu) | (w1 << 16); lo.y = (w2 & 0xffffu) | (w3 << 16); hi.x = (w0 >> 16) | (w1 & 0xffff0000u); hi.y = (w2 >> 16) | (w3 & 0xffff0000u);
                *(LAS u32x2*)(Xt + tswz(8 * xpg + 2 * m, 4 * xtg)) = lo; *(LAS u32x2*)(Xt + tswz(8 * xpg + 2 * m + 1, 4 * xtg)) = hi; } }
#pragma unroll
        for (int k = 0; k < 2; ++k) { const int pidx = tid + 512 * k, i_ = pidx >> 3, c8_ = (pidx & 7) * 8;
            *(LAS u32x4*)(Bs + i_ * 72 + c8_) = bb[k]; if (MODE == 1) *(LAS u32x4*)(Cs + i_ * 72 + c8_) = cb[k]; }
        if (ci + 1 < ci1) SSD_LOAD(chunk_of(dir, ci + 1) * 128);
        __syncthreads();
        const float al = acs[127], dchunk = __expf(al); ldsum += al;
        if (tid < 256) { float f[4][8];
#pragma unroll
            for (int q_ = 0; q_ < 4; ++q_) { const u32x4 w = *(const LAS u32x4*)(Bs + (4 * xtg + q_) * 72 + 8 * xpg); unpack8(w, f[q_]); const float we = wend[4 * xtg + q_];
#pragma unroll
                for (int e = 0; e < 8; ++e) f[q_][e] *= we; }
#pragma unroll
            for (int e = 0; e < 8; ++e) { u32x2 w; w.x = pg8::cvt_pk_bf16(f[0][e], f[1][e]); w.y = pg8::cvt_pk_bf16(f[2][e], f[3][e]); *(LAS u32x2*)(Bwt + tswz(8 * xpg + e, 4 * xtg)) = w; } }
        if (MODE == 1) {
            for (int t = wid; t < 40; t += 8) {
                if (t >= 36) { const int rt = 2 * (t - 36);
                    *(LAS u32x2*)(Ws + (16 * rt + l15) * 136 + 16 * (rt + 1) + 4 * lq) = (u32x2){0u, 0u};
                    continue; }
                int rt = 0, base = 0; while (base + rt + 1 <= t) { base += rt + 1; ++rt; }
                const int ct = t - base;
                f32x4 acc = (f32x4){0.f, 0.f, 0.f, 0.f};
#pragma unroll
                for (int kk = 0; kk < 2; ++kk) { const bf16x8 af = *(const LAS bf16x8*)(Bs + (16 * ct + l15) * 72 + kk * 32 + 8 * lq), bfr = *(const LAS bf16x8*)(Cs + (16 * rt + l15) * 72 + kk * 32 + 8 * lq);
                    acc = __builtin_amdgcn_mfma_f32_16x16x32_bf16(af, bfr, acc, 0, 0, 0); }
                const int i = 16 * rt + l15; const float ai = acs[i];
                const f32x4 aj = *(const LAS f32x4*)(acs + 16 * ct + 4 * lq), dj = *(const LAS f32x4*)(dtv + 16 * ct + 4 * lq);
                float val[4];
#pragma unroll
                for (int rg = 0; rg < 4; ++rg) { const int j = 16 * ct + 4 * lq + rg; val[rg] = j <= i ? acc[rg] * __expf(ai - aj[rg]) * dj[rg] : 0.f; }
                u32x2 w; w.x = pg8::cvt_pk_bf16(val[0], val[1]); w.y = pg8::cvt_pk_bf16(val[2], val[3]); *(LAS u32x2*)(Ws + i * 136 + 16 * ct + 4 * lq) = w; }
        }
        __syncthreads();
        if (MODE == 1) { const int it = wid; f32x4 acc[4];
#pragma unroll
          for (int pt = 0; pt < 4; ++pt) acc[pt] = (f32x4){0.f, 0.f, 0.f, 0.f};
#pragma unroll
          for (int kk = 0; kk < 2; ++kk) { const bf16x8 bfr = *(const LAS bf16x8*)(Cs + (16 * it + l15) * 72 + kk * 32 + 8 * lq);
#pragma unroll
              for (int pt = 0; pt < 4; ++pt) { const bf16x8 af = *(const LAS bf16x8*)(Hs + (16 * pt + l15) * 72 + kk * 32 + 8 * lq); acc[pt] = __builtin_amdgcn_mfma_f32_16x16x32_bf16(af, bfr, acc[pt], 0, 0, 0); } }
          const float ea = eacs[16 * it + l15];
#pragma unroll
          for (int pt = 0; pt < 4; ++pt) acc[pt] = acc[pt] * ea;
          for (int ks = 0; ks <= (it >> 1); ++ks) { const bf16x8 bfr = *(const LAS bf16x8*)(Ws + (16 * it + l15) * 136 + ks * 32 + 8 * lq);
#pragma unroll
              for (int pt = 0; pt < 4; ++pt) { const bf16x8 af = *(const LAS bf16x8*)(Xt + tswz(16 * pt + l15, ks * 32 + 8 * lq)); acc[pt] = __builtin_amdgcn_mfma_f32_16x16x32_bf16(af, bfr, acc[pt], 0, 0, 0); } }
          { const int i = 16 * it + l15; const int q = dir == 0 ? q0 + i : q0 + 127 - i;
#pragma unroll
            for (int pt = 0; pt < 4; ++pt) { u32x2 w; w.x = pg8::cvt_pk_bf16(acc[pt][0], acc[pt][1]); w.y = pg8::cvt_pk_bf16(acc[pt][2], acc[pt][3]); *(u32x2*)(Y + (size_t)q * ldy + 16 * pt + 4 * lq) = w; } } }
#pragma unroll
        for (int t = 0; t < 2; ++t) { const int tl = 2 * wid + t, nt_ = tl >> 2, pt = tl & 3; Hacc[t] = Hacc[t] * dchunk;
#pragma unroll
            for (int ks = 0; ks < 4; ++ks) { const bf16x8 af = *(const LAS bf16x8*)(Bwt + tswz(16 * nt_ + l15, ks * 32 + 8 * lq)), bfr = *(const LAS bf16x8*)(Xt + tswz(16 * pt + l15, ks * 32 + 8 * lq));
                Hacc[t] = __builtin_amdgcn_mfma_f32_16x16x32_bf16(af, bfr, Hacc[t], 0, 0, 0); } }
        if (MODE == 1) {
        __syncthreads();
#pragma unroll
        for (int t = 0; t < 2; ++t) { const int tl = 2 * wid + t, nt_ = tl >> 2, pt = tl & 3;
            u32x2 w; w.x = pg8::cvt_pk_bf16(Hacc[t][0], Hacc[t][1]); w.y = pg8::cvt_pk_bf16(Hacc[t][2], Hacc[t][3]); *(LAS u32x2*)(Hs + (16 * pt + l15) * 72 + 16 * nt_ + 4 * lq) = w; }
        }
    }
    if (MODE == 0) {
#pragma unroll
        for (int t = 0; t < 2; ++t) { const int tl = 2 * wid + t, nt_ = tl >> 2, pt = tl & 3;
            *(f32x4*)(SEND + (size_t)seg * 4096 + (16 * pt + l15) * 64 + 16 * nt_ + 4 * lq) = Hacc[t]; }
        if (tid == 0) SLD[seg] = ldsum;
    }
    __syncthreads();
#undef SSD_ROW
#undef SSD_LOAD
}

__device__ __forceinline__ void lru_seq_unit(const Ctx& C, int item, LAS unsigned char* lds) {
    const TC T = phase_tc();
    const int b = item >> 5, dir = (item >> 4) & 1, hb = item & 15, lane = T.lane, wid = T.wave;
    LAS float* wa = (LAS float*)lds; LAS float* wx = wa + 4096; LAS float* xs = wx + 4096; LAS float* as_ = xs + 512; LAS float* bs_ = as_ + 512;
    const float* gwa = C.in[I_LWA] + (size_t)(dir * 16 + hb) * 4096; const float* gwx = C.in[I_LWX] + (size_t)(dir * 16 + hb) * 4096;
    for (int i = T.tid; i < 4096; i += NTHREADS) { wa[i] = gwa[i]; wx[i] = gwx[i]; }
    const int c = hb * 64 + lane;
    const float ba = C.in[I_LBA][dir * 1024 + c], bx = C.in[I_LBX][dir * 1024 + c], logbase = -8.f * softplus_f(-C.in[I_LAM][dir * 1024 + c]);
    const bf16* XR = (const bf16*)(C.ws + WS_A) + (size_t)b * BROWS * 1024 + hb * 64;
    bf16* Y = dir == 0 ? (bf16*)(C.ws + WS_YMIX) + (size_t)b * BROWS * 2048 + hb * 64 : (bf16*)(C.ws + WS_RAW) + (size_t)b * BROWS * 1024 + hb * 64;
    const int ldy = dir == 0 ? 2048 : 1024;
    float hst = 0.f;
    __syncthreads();
    unsigned short xnext = XR[(size_t)step_row(dir, wid) * 1024 + lane];
    for (int it = 0; it < BROWS / 8; ++it) {
        const float xv = bf2f(xnext);
        if (it + 1 < BROWS / 8) xnext = XR[(size_t)step_row(dir, (it + 1) * 8 + wid) * 1024 + lane];
        xs[wid * 64 + lane] = xv;
        asm volatile("s_waitcnt lgkmcnt(0)" ::: "memory");
        float pa = ba, px = bx;
#pragma unroll 8
        for (int i = 0; i < 64; ++i) { const float xi = xs[wid * 64 + i]; pa += xi * wa[i * 64 + lane]; px += xi * wx[i * 64 + lane]; }
        const float la = logbase * sigmoid_f(pa), a = __expf(la), bc = sqrtf(-expm1f(2.f * la)) * sigmoid_f(px) * xv;
        as_[wid * 64 + lane] = a; bs_[wid * 64 + lane] = bc;
        __syncthreads();
        if (wid == 0) {
#pragma unroll
            for (int tt = 0; tt < 8; ++tt) { hst = as_[tt * 64 + lane] * hst + bs_[tt * 64 + lane]; const int q2 = step_row(dir, it * 8 + tt); Y[(size_t)q2 * ldy + lane] = (bf16)f2bf(hst); }
        }
        __syncthreads();
    }
}

__device__ __forceinline__ float fast_sigmoid(float x) { return __builtin_amdgcn_rcpf(1.f + __expf(-x)); }
__device__ __forceinline__ void lru_chunk_unit(const Ctx& C, int item4, LAS unsigned char* lds) {
    const TC T = phase_tc();
    const int item = item4 >> 2, qc = item4 & 3;
    const int b = item >> 5, dir = (item >> 4) & 1, hb = item & 15, lane = T.lane, wid = T.wave, tid = T.tid;
    LAS bf16* xs0 = (LAS bf16*)lds;
    LAS bf16* wT = (LAS bf16*)(lds + 36864);
    LAS float* sWP = (LAS float*)(lds + 36864 + 4608);
    LAS float* sWH = sWP + 128;
    const float* gwa = C.in[I_LWA] + (size_t)(dir * 16 + hb) * 4096; const float* gwx = C.in[I_LWX] + (size_t)(dir * 16 + hb) * 4096;
    for (int i = tid; i < 1024; i += NTHREADS) { const int ii = i >> 4, j = i & 15; wT[j * 72 + ii] = (bf16)f2bf(gwa[ii * 64 + qc * 16 + j]); wT[16 * 72 + j * 72 + ii] = (bf16)f2bf(gwx[ii * 64 + qc * 16 + j]); }
    const int l15 = lane & 15, lq = lane >> 4;
    const int c = hb * 64 + qc * 16 + l15;
    const float ba = C.in[I_LBA][dir * 1024 + c], bx = C.in[I_LBX][dir * 1024 + c], lb = -8.f * softplus_f(-C.in[I_LAM][dir * 1024 + c]);
    float hst = 0.f;
    const bf16* XR = (const bf16*)(C.ws + WS_A) + (size_t)b * BROWS * 1024 + hb * 64;
    bf16* Y = dir == 0 ? (bf16*)(C.ws + WS_YMIX) + (size_t)b * BROWS * 2048 + hb * 64 + qc * 16 : (bf16*)(C.ws + WS_RAW) + (size_t)b * BROWS * 1024 + hb * 64 + qc * 16;
    const int ldy = dir == 0 ? 2048 : 1024;
    const int pr0 = tid >> 3, pc = (tid & 7) * 8;
    u32x4 st0, st1;
    { const int q0 = chunk_of(dir, 0) * 128; const int qa = dir == 0 ? q0 + pr0 : q0 + 127 - pr0, qb = dir == 0 ? q0 + pr0 + 64 : q0 + 63 - pr0;
      st0 = *(const u32x4*)(XR + (size_t)qa * 1024 + pc); st1 = *(const u32x4*)(XR + (size_t)qb * 1024 + pc); }
    __syncthreads();
    for (int ci = 0; ci < 66; ++ci) {
        const int q0 = chunk_of(dir, ci) * 128;
        LAS bf16* xs = xs0 + (ci & 1) * (128 * 72);
        *(LAS u32x4*)(xs + pr0 * 72 + pc) = st0; *(LAS u32x4*)(xs + (pr0 + 64) * 72 + pc) = st1;
        if (ci + 1 < 66) { const int qn = chunk_of(dir, ci + 1) * 128; const int qa = dir == 0 ? qn + pr0 : qn + 127 - pr0, qb = dir == 0 ? qn + pr0 + 64 : qn + 63 - pr0;
            st0 = *(const u32x4*)(XR + (size_t)qa * 1024 + pc); st1 = *(const u32x4*)(XR + (size_t)qb * 1024 + pc); }
        __syncthreads();
        f32x4 ga = (f32x4){0.f, 0.f, 0.f, 0.f}, gx = ga;
#pragma unroll
        for (int kk = 0; kk < 2; ++kk) { const bf16x8 af = *(const LAS bf16x8*)(xs + (16 * wid + l15) * 72 + kk * 32 + 8 * lq);
            const bf16x8 b0 = *(const LAS bf16x8*)(wT + l15 * 72 + kk * 32 + 8 * lq), b1 = *(const LAS bf16x8*)(wT + 16 * 72 + l15 * 72 + kk * 32 + 8 * lq);
            ga = __builtin_amdgcn_mfma_f32_16x16x32_bf16(af, b0, ga, 0, 0, 0); gx = __builtin_amdgcn_mfma_f32_16x16x32_bf16(af, b1, gx, 0, 0, 0); }
        float p = 1.f, hh = 0.f;
#pragma unroll
        for (int rg = 0; rg < 4; ++rg) { const int i = 16 * wid + 4 * lq + rg;
            const float la = lb * fast_sigmoid(ga[rg] + ba), a = __expf(la), xv = bf2f(xs[i * 72 + qc * 16 + l15]);
            const float x2 = 2.f * la, oms = -x2 * (1.f + 0.5f * x2 * (1.f + (1.f / 3.f) * x2 * (1.f + 0.25f * x2 * (1.f + 0.2f * x2)))), om = x2 < -0.4f ? 1.f - a * a : oms;
            const float bc = __builtin_amdgcn_sqrtf(om) * fast_sigmoid(gx[rg] + bx) * xv;
            hh = a * hh + bc; p *= a; ga[rg] = p; gx[rg] = hh; }
        { const float pp = __shfl_up(p, 16), hp = __shfl_up(hh, 16); if (lq >= 1) { hh = p * hp + hh; p = pp * p; } }
        { const float pp = __shfl_up(p, 32), hp = __shfl_up(hh, 32); if (lq >= 2) { hh = p * hp + hh; p = pp * p; } }
        const float pe_ = __shfl_up(p, 16), he_ = __shfl_up(hh, 16);
        const float Pe = lq >= 1 ? pe_ : 1.f, He = lq >= 1 ? he_ : 0.f;
        if (lq == 3) { sWP[l15 * 8 + wid] = p; sWH[l15 * 8 + wid] = hh; }
        __syncthreads();
        { const f32x4 p0 = *(const LAS f32x4*)(sWP + l15 * 8), p1 = *(const LAS f32x4*)(sWP + l15 * 8 + 4), h0 = *(const LAS f32x4*)(sWH + l15 * 8), h1 = *(const LAS f32x4*)(sWH + l15 * 8 + 4);
            float cin = hst, cw = hst;
#pragma unroll
            for (int w = 0; w < 8; ++w) { if (w == wid) cw = cin; const float pw = w < 4 ? p0[w & 3] : p1[w & 3], hw = w < 4 ? h0[w & 3] : h1[w & 3]; cin = pw * cin + hw; }
            hst = cin;
            const float cl = Pe * cw + He;
#pragma unroll
            for (int rg = 0; rg < 4; ++rg) { const int i = 16 * wid + 4 * lq + rg; const int q = dir == 0 ? q0 + i : q0 + 127 - i;
                Y[(size_t)q * ldy + l15] = hw_bf16(gx[rg] + ga[rg] * cl); } }
    }
    __syncthreads();
}

__device__ __forceinline__ int queue_pop(const Ctx& C, unsigned* qword, LAS unsigned char* lds) {
    const TC T = phase_tc();
    LAS int* slot = (LAS int*)(lds + LDS_BYTES - 64);
    __syncthreads();
    if (T.tid == 0) slot[0] = (int)atomicAdd(qword, 1u);
    __syncthreads();
    const int v = slot[0];
    return __builtin_amdgcn_readfirstlane(v);
}
__device__ __forceinline__ void ph_ssdpre(const Ctx& C, LAS unsigned char* lds) {
    for (int u = C.bid; u < 192; u += C.G) ssd_chunk_unit<0>(C, u / 3, u % 3, lds);
}
__device__ __forceinline__ void ph_mix0(const Ctx& C, LAS unsigned char* lds, char* ldsg) {
    bf16* YM = (bf16*)(C.ws + WS_YMIX); const bf16* K = (const bf16*)(C.ws + WS_K); const bf16* V = (const bf16*)(C.ws + WS_V);
    for (;;) {
        const int item = queue_pop(C, C.ctl() + CW_Q0, lds);
        if (item >= 256 + 512 + 16) break;
#ifdef SPLIT_MIX0
        if (item < 256) continue;
#else
        if (item < 256) { ssd_chunk_unit<1>(C, item >> 2, item & 3, lds); continue; }
#endif
        const int a = item - 256;
        if (a >= 16) { const int a1 = a - 16, hr = a1 & 3, qb = (a1 >> 2) & 31, kvh = (a1 >> 7) & 1, b = a1 >> 8, h = kvh * 4 + hr;
            bf16* Qb = YM + ((size_t)b * BROWS + CTXL + (size_t)qb * 256) * 2048 + 1024 + h * 128;
            att::attn_body<0>(Qb, K + (size_t)b * BROWS * 256 + kvh * 128, V + (size_t)b * BROWS * 256 + kvh * 128, Qb, BROWS / 64, 0, 0, 0.f, ldsg, C.in[I_QG], qb * 256);
        } else { const int b = a >> 3, h = a & 7, kvh = h >> 2;
            bf16* Qb = YM + ((size_t)b * BROWS) * 2048 + 1024 + h * 128;
            att::attn_body<0>(Qb, K + (size_t)b * BROWS * 256 + kvh * 128, V + (size_t)b * BROWS * 256 + kvh * 128, Qb, CTXL / 64, 0, 0, 0.f, ldsg, C.in[I_QG], -1);
        }
    }
}
__device__ __forceinline__ void ph_mix1(const Ctx& C, LAS unsigned char* lds, char* ldsg) {
    bf16* YM = (bf16*)(C.ws + WS_YMIX); const bf16* K = (const bf16*)(C.ws + WS_K); const bf16* V = (const bf16*)(C.ws + WS_V);
    for (;;) {
        const int item = queue_pop(C, C.ctl() + CW_Q1, lds);
        if (item >= 256 + 512) break;
        if (item < 256) { lru_chunk_unit(C, item, lds); continue; }
        const int a = item - 256, hr = a & 3, qb = (a >> 2) & 31, kvh = (a >> 7) & 1, b = a >> 8, h = kvh * 4 + hr;
        const int q0 = qb * 256, lo = q0 - 128 < 0 ? 0 : q0 - 128, hi_ = q0 + 384 > SEQL ? SEQL : q0 + 384;
        bf16* Qb = YM + ((size_t)b * BROWS + CTXL + (size_t)q0) * 2048 + 1024 + h * 128;
        att::attn_body<1>(Qb, K + (size_t)b * BROWS * 256 + kvh * 128, V + (size_t)b * BROWS * 256 + kvh * 128, Qb, 4 + (hi_ - lo) / 64, CTXL + lo, q0, C.in[I_SINK][h], ldsg, nullptr, q0);
    }
}
__device__ __forceinline__ void ph_ssdpost(const Ctx& C) {
    const TC T = phase_tc();
    bf16* YM = (bf16*)(C.ws + WS_YMIX); const bf16* YB = (const bf16*)(C.ws + WS_RAW); const bf16* XBC = (const bf16*)C.out; const bf16* Z = (const bf16*)(C.ws + WS_Z);
    const int gw = C.bid * NWAVES + T.wave, NGW = C.G * NWAVES, lane = T.lane;
    for (int r = gw; r < NROWS; r += NGW) {
        float v[16]; float ss = 0.f;
#pragma unroll
        for (int j = 0; j < 2; ++j) { const int c0 = j * 512 + lane * 8;
            const u32x4 wy = *(const u32x4*)(YM + (size_t)r * 2048 + c0), wb = *(const u32x4*)(YB + (size_t)r * 1024 + c0), wx = *(const u32x4*)(XBC + (size_t)r * 1280 + c0), wz = *(const u32x4*)(Z + (size_t)r * 1024 + c0);
            float fy[8], fb[8], fx[8], fz[8]; unpack8(wy, fy); unpack8(wb, fb); unpack8(wx, fx); unpack8(wz, fz);
            const float dsk = C.in[I_SSDD][c0 >> 6];
#pragma unroll
            for (int e = 0; e < 8; ++e) { const float y = (fy[e] + fb[e] + dsk * fx[e]) * silu_f(fz[e]); v[j * 8 + e] = y; ss += y * y; } }
        const float rs = rsqrtf(wave_sum(ss) * (1.f / 1024.f) + EPS);
#pragma unroll
        for (int j = 0; j < 2; ++j) { const int c0 = j * 512 + lane * 8; const float* ng = C.in[I_SNORMG] + c0;
            u32x4 o; o.x = pk2(v[j * 8 + 0] * rs * ng[0], v[j * 8 + 1] * rs * ng[1]); o.y = pk2(v[j * 8 + 2] * rs * ng[2], v[j * 8 + 3] * rs * ng[3]);
            o.z = pk2(v[j * 8 + 4] * rs * ng[4], v[j * 8 + 5] * rs * ng[5]); o.w = pk2(v[j * 8 + 6] * rs * ng[6], v[j * 8 + 7] * rs * ng[7]);
            *(u32x4*)(YM + (size_t)r * 2048 + c0) = o; }
    }
}
__device__ __forceinline__ void ph_lrupost(const Ctx& C) {
    const TC T = phase_tc();
    bf16* YM = (bf16*)(C.ws + WS_YMIX); const bf16* YB = (const bf16*)(C.ws + WS_RAW); const bf16* GT = (const bf16*)(C.ws + WS_Z);
    const int gw = C.bid * NWAVES + T.wave, NGW = C.G * NWAVES, lane = T.lane;
    for (int r = gw; r < NROWS; r += NGW) {
        if (r % BROWS < CTXL) continue;
#pragma unroll
        for (int j = 0; j < 2; ++j) { const int c0 = j * 512 + lane * 8;
            const u32x4 wy = *(const u32x4*)(YM + (size_t)r * 2048 + c0), wb = *(const u32x4*)(YB + (size_t)r * 1024 + c0), wg = *(const u32x4*)(GT + (size_t)r * 1024 + c0);
            float fy[8], fb[8], fg[8], o[8]; unpack8(wy, fy); unpack8(wb, fb); unpack8(wg, fg);
#pragma unroll
            for (int e = 0; e < 8; ++e) o[e] = gelu_tanh_f(fg[e]) * (fy[e] + fb[e]);
            u32x4 w; w.x = pk2(o[0], o[1]); w.y = pk2(o[2], o[3]); w.z = pk2(o[4], o[5]); w.w = pk2(o[6], o[7]);
            *(u32x4*)(YM + (size_t)r * 2048 + c0) = w; }
    }
}
__device__ __forceinline__ void ph_route(const Ctx& C, int layer, LAS unsigned char* lds) {
    const TC T = phase_tc();
    LAS float* Wt = (LAS float*)lds;
    const float* wg = C.in[I_WGRP] + (size_t)layer * 1024 * 4; const float* wr = C.in[I_WRT] + (size_t)layer * 1024 * 16;
    for (int i = T.tid; i < 4096; i += NTHREADS) Wt[(i & 3) * 1028 + (i >> 2)] = wg[i];
    for (int i = T.tid; i < 16384; i += NTHREADS) Wt[(4 + (i & 15)) * 1028 + (i >> 4)] = wr[i];
    __syncthreads();
    bf16* HN2 = (bf16*)(C.ws + WS_A); int* REC = (int*)(C.ws + WS_REC); int* TBL = (int*)(C.ws + WS_TBL);
    unsigned* cnt = C.ctl() + CW_CNT + layer * 2048;
    const float* gf = C.in[I_GFFN] + layer * 1024;
    const int gw = C.bid * NWAVES + T.wave, NGW = C.G * NWAVES, lane = T.lane;
    for (int r = gw; r < NROWS; r += NGW) {
        if (layer == 1 && (r % BROWS) < CTXL) continue;
        float* xr = C.xrow(r); const float* md = C.mod(layer, row_mv(r));
        f32x4 v[4]; float ss = 0.f;
        if (layer == 0 && (r % BROWS) < CTXL) { const int b_ = r / BROWS, q_ = r - b_ * BROWS; const float* xi = C.in[I_CTX] + (size_t)(b_ * CTXL + q_) * DM; const float* sl = (const float*)(C.ws + WS_RAW);
#pragma unroll
            for (int j = 0; j < 4; ++j) { const float* sp = sl + (size_t)((b_ * 4 + j) * 4) * 65536 + (size_t)q_ * 256 + 4 * lane;
                const f32x4 part = (*(const f32x4*)sp + *(const f32x4*)(sp + 65536)) + (*(const f32x4*)(sp + 2 * 65536) + *(const f32x4*)(sp + 3 * 65536));
                const f32x4 x1 = *(const f32x4*)(xi + 256 * j + 4 * lane) + *(const f32x4*)(md + 2 * 1024 + 256 * j + 4 * lane) * part;
                *(f32x4*)(xr + 256 * j + 4 * lane) = x1; } }
#pragma unroll
        for (int j = 0; j < 4; ++j) { v[j] = *(const f32x4*)(xr + 256 * j + 4 * lane); ss += (v[j].x * v[j].x + v[j].y * v[j].y) + (v[j].z * v[j].z + v[j].w * v[j].w); }
        const float rs = rsqrtf(wave_sum(ss) * (1.f / DM) + EPS);
#pragma unroll
        for (int j = 0; j < 4; ++j) { const int c = 256 * j + 4 * lane; const f32x4 g = *(const f32x4*)(gf + c), sc = *(const f32x4*)(md + 4 * 1024 + c), sh = *(const f32x4*)(md + 3 * 1024 + c);
            v[j] = v[j] * rs * g * (sc + 1.f) + sh;
            u32x2 w; w.x = pk2(v[j].x, v[j].y); w.y = pk2(v[j].z, v[j].w); *(u32x2*)(HN2 + (size_t)r * DM + c) = w; }
        float lg[20];
#pragma unroll
        for (int o = 0; o < 20; ++o) { float s = 0.f;
#pragma unroll
            for (int j = 0; j < 4; ++j) { const f32x4 w = *(const LAS f32x4*)(Wt + o * 1028 + 256 * j + 4 * lane); s += (v[j].x * w.x + v[j].y * w.y) + (v[j].z * w.z + v[j].w * w.w); }
            lg[o] = wave_sum(s); }
        float gl[4];
#pragma unroll
        for (int k = 0; k < 4; ++k) gl[k] = lg[k] + C.in[I_BGRP][layer * 4 + k];
        int gi = 0; float gmx = gl[0];
#pragma unroll
        for (int k = 1; k < 4; ++k) if (gl[k] > gmx) { gmx = gl[k]; gi = k; }
        float den = 0.f;
#pragma unroll
        for (int k = 0; k < 4; ++k) den += __expf(gl[k] - gmx);
        const float pgrp = 1.f / den;
        float el[4];
#pragma unroll
        for (int k = 0; k < 4; ++k) { const float e0 = lg[4 + k] + C.in[I_BRT][layer * 16 + k], e1 = lg[8 + k] + C.in[I_BRT][layer * 16 + 4 + k], e2 = lg[12 + k] + C.in[I_BRT][layer * 16 + 8 + k], e3 = lg[16 + k] + C.in[I_BRT][layer * 16 + 12 + k];
            el[k] = gi == 0 ? e0 : (gi == 1 ? e1 : (gi == 2 ? e2 : e3)); }
        int i1 = 0; float v1 = el[0];
#pragma unroll
        for (int k = 1; k < 4; ++k) if (el[k] > v1) { v1 = el[k]; i1 = k; }
        int i2 = -1; float v2 = -3.4e38f;
#pragma unroll
        for (int k = 0; k < 4; ++k) if (k != i1 && el[k] > v2) { v2 = el[k]; i2 = k; }
        const float w1 = pgrp / (1.f + __expf(v2 - v1)), w2 = pgrp - w1;
        const int ia = i1 < i2 ? i1 : i2, ib = i1 < i2 ? i2 : i1; const float wa = i1 < i2 ? w1 : w2, wb = i1 < i2 ? w2 : w1;
        const int cls = gi * 6 + (ia * (7 - ia)) / 2 + (ib - ia - 1);
        if (lane == 0) { const int pos = (int)atomicAdd(cnt + cls * 64, 1u); TBL[(size_t)cls * NROWS + pos] = r; REC[(size_t)r * 4 + 0] = cls; REC[(size_t)r * 4 + 1] = pos; REC[(size_t)r * 4 + 2] = (int)__float_as_uint(wa); REC[(size_t)r * 4 + 3] = (int)__float_as_uint(wb); }
    }
}
__device__ __forceinline__ void moe_tables(const Ctx& C, int layer, int* mt) {
    unsigned* cnt = C.ctl() + CW_CNT + layer * 2048;
    const TC T = phase_tc();
    { const int t_ = T.tid; if (t_ < 24) mt[32 + t_] = (int)__hip_atomic_load(cnt + t_ * 64, __ATOMIC_RELAXED, __HIP_MEMORY_SCOPE_AGENT); }
    asm volatile("s_waitcnt vmcnt(0)" ::: "memory");
    __syncthreads();
    if (T.tid == 0) { int acc = 0; for (int c = 0; c < 24; ++c) { const int n = mt[32 + c]; mt[c] = acc; const int nt = (n + 255) >> 8; for (int t = 0; t < nt; ++t) mt[64 + acc + t] = c; acc += nt; } mt[24] = acc; }
    asm volatile("s_waitcnt vmcnt(0)" ::: "memory");
    __syncthreads();
}
__device__ __forceinline__ void ph_final(const Ctx& C) {
    const TC T = phase_tc();
    const float* gf = C.in[I_GFINAL];
    const int gw = C.bid * NWAVES + T.wave, NGW = C.G * NWAVES, lane = T.lane;
    for (int r = gw; r < NBATCH * SEQL; r += NGW) {
        float* xr = C.out + (size_t)r * DM;
        f32x4 v[4]; float ss = 0.f;
#pragma unroll
        for (int j = 0; j < 4; ++j) { v[j] = *(const f32x4*)(xr + 256 * j + 4 * lane); ss += (v[j].x * v[j].x + v[j].y * v[j].y) + (v[j].z * v[j].z + v[j].w * v[j].w); }
        const float rs = rsqrtf(wave_sum(ss) * (1.f / DM) + EPS);
#pragma unroll
        for (int j = 0; j < 4; ++j) { const int c = 256 * j + 4 * lane; f32x4 o = v[j] * rs * *(const f32x4*)(gf + c);
#ifdef PROBE_A
            { const unsigned long long* st = (const unsigned long long*)(C.ws + WS_STAMP);
              const float ta = (float)(st[PROBE_A + 1] - st[PROBE_A]) * 0.01f, tb = (float)(st[PROBE_B + 1] - st[PROBE_B]) * 0.01f;
              int na = 0, nb = 0; float th = 15.f;
              for (int i = 0; i < 31; ++i) { na += ta > th; nb += tb > th; th *= 1.2f; }
              o = o * (1.f + 0.02f * (float)na);
              if (r == 0 && c == 0) o.x += 10.f + (float)nb; }
#endif
            *(f32x4*)(xr + c) = o; }
    }
}


#define XB_TMO      128
#define XB_XCNT(j)  (256  + 64 * (j))
#define XB_XSUB(j)  (1280 + 64 * (j))
#define XB_XGEN(j)  (2304 + 64 * (j))
#define XB_TOP      3328
#define XB_TOPGEN   3392
#define XCD_BAR_WORDS 3456
#define XB_SPIN_CAP (1u << 18)
__device__ __forceinline__ unsigned xb_ld(unsigned* p)              { return __hip_atomic_load(p, __ATOMIC_RELAXED, __HIP_MEMORY_SCOPE_AGENT); }
__device__ __forceinline__ unsigned xb_add(unsigned* p, unsigned v) { return __hip_atomic_fetch_add(p, v, __ATOMIC_RELAXED, __HIP_MEMORY_SCOPE_AGENT); }
__device__ __forceinline__ unsigned xb_xcc_id() { return (unsigned)__builtin_amdgcn_s_getreg((3 << 11) | 20) & 0xFu; }
#define XB_SPIN(cond, bar) do { unsigned _sp = 0; while (cond) { __builtin_amdgcn_s_sleep(1); \
    if ((++_sp & 255u) == 0u) { if (xb_ld(&(bar)[XB_TMO])) break; if (_sp > XB_SPIN_CAP) { atomicAdd(&(bar)[XB_TMO], 1u); break; } } } } while (0)
struct XcdBarrier { unsigned* bar; unsigned x; volatile LAS unsigned* st; };
__device__ __forceinline__ XcdBarrier xcd_barrier_post(unsigned* bar, volatile LAS unsigned* st) {
    XcdBarrier b; b.bar = bar; b.x = xb_xcc_id(); b.st = st;
    if (threadIdx.x == 0) (void)xb_add(&bar[XB_XCNT(b.x)], 1u);
    return b;
}
__device__ __forceinline__ void xcd_barrier_complete(unsigned* bar, unsigned x, unsigned& nloc, unsigned& nx) {
    const unsigned G = gridDim.x * gridDim.y * gridDim.z;
    unsigned sum, cnt, mine, sp = 0u;
    for (;;) {
        sum = 0u; cnt = 0u; mine = 0u;
#pragma unroll
        for (unsigned j = 0; j < 16; ++j) { const unsigned c = xb_ld(&bar[XB_XCNT(j)]); sum += c; cnt += (c > 0u) ? 1u : 0u; mine = (j == x) ? c : mine; }
        if (sum == G) break;
        __builtin_amdgcn_s_sleep(1);
        if ((++sp & 255u) == 0u) { if (xb_ld(&bar[XB_TMO])) break; if (sp > XB_SPIN_CAP) { atomicAdd(&bar[XB_TMO], 1u); break; } }
    }
    nloc = mine > 0u ? mine : 1u; nx = cnt > 0u ? cnt : 1u;
}
__device__ __forceinline__ void xcd_barrier(const XcdBarrier& b) {
    asm volatile("s_waitcnt vmcnt(0)" ::: "memory");
    __syncthreads();
    if (threadIdx.x == 0) {
        unsigned* bar = b.bar;
        __builtin_amdgcn_s_waitcnt(0);
        unsigned nloc = b.st[0], nx = b.st[1];
        if (nloc == 0u) { xcd_barrier_complete(bar, b.x, nloc, nx); b.st[0] = nloc; b.st[1] = nx; }
        const unsigned old = xb_add(&bar[XB_XSUB(b.x)], 1u);
        const unsigned gen = old / nloc;
        if (old + 1u == (gen + 1u) * nloc) {
            __builtin_amdgcn_fence(__ATOMIC_RELEASE, "agent");
            asm volatile("s_waitcnt vmcnt(0)" ::: "memory");
            const unsigned og = xb_add(&bar[XB_TOP], 1u);
            const unsigned tg = og / nx;
            if (og + 1u == (tg + 1u) * nx) xb_add(&bar[XB_TOPGEN], 1u);
            else XB_SPIN(xb_ld(&bar[XB_TOPGEN]) == tg, bar);
            __builtin_amdgcn_fence(__ATOMIC_ACQUIRE, "agent");
            xb_add(&bar[XB_XGEN(b.x)], 1u);
            asm volatile("s_waitcnt vmcnt(0)" ::: "memory");
        } else {
            XB_SPIN(xb_ld(&bar[XB_XGEN(b.x)]) == gen, bar);
            __builtin_amdgcn_fence(__ATOMIC_ACQUIRE, "agent");
            asm volatile("s_waitcnt vmcnt(0)" ::: "memory");
        }
    }
    __syncthreads();
}

__global__ void __launch_bounds__(NTHREADS, 2) fwd_kernel(Args args) {
    extern __shared__ __attribute__((aligned(16))) unsigned char lds_raw[];
    LAS unsigned char* lds = (LAS unsigned char*)lds_raw;
    Ctx C; C.in = args.in; C.out = args.out; C.ws = args.ws;
    C.bid = blockIdx.x; C.G = gridDim.x;
    const int lo = args.ph_lo, hi = args.ph_hi;
    int ph = 0;
    volatile LAS unsigned* bst = (volatile LAS unsigned*)(lds + LDS_BYTES - 32);
    if (threadIdx.x < 2) bst[threadIdx.x] = 0u;
    __syncthreads();
    XcdBarrier bar; bar.bar = (unsigned*)(C.ws + WS_CTL) + CW_BAR; bar.x = 0; bar.st = bst;
    if (hi - lo > 1) bar = xcd_barrier_post((unsigned*)(C.ws + WS_CTL) + CW_BAR, bst);
    if (lo < 0) cg::this_grid().sync();
#ifdef PROBE_A
    if (blockIdx.x == 0 && threadIdx.x == 0) ((unsigned long long*)(C.ws + WS_STAMP))[0] = __builtin_amdgcn_s_memrealtime();
#endif
#define IN(k) (lo <= (k) && (k) < hi)
#ifdef PROBE_A
#define STAMP(k) do { if (blockIdx.x == 0 && threadIdx.x == 0) ((unsigned long long*)(C.ws + WS_STAMP))[(k) + 1] = __builtin_amdgcn_s_memrealtime(); } while (0)
#else
#define STAMP(k) do { } while (0)
#endif
#ifdef PROBE_A
#define SEAM(k) do { if (IN(k) && IN((k) + 1)) { cg::this_grid().sync(); STAMP(k); } } while (0)
#else
#define SEAM(k) do { if (IN(k) && IN((k) + 1)) { xcd_barrier(bar); } } while (0)
#endif
    if (EN(0) && IN(0)) { ph_mod(C, lds); ph_convert(C, 0, lds); mod_wait(C); ph_prenorm(C, 0); }
    SEAM(0);
#pragma unroll 1
    for (int layer = 0; layer < 2; ++layer) {
        const int pb = 1 + 10 * layer;
        unsigned char* ws = C.ws;
        if (EN(1) && IN(pb + 0) && layer == 1) { ph_convert(C, 1, lds); ph_prenorm(C, layer); }
        if (layer == 1) SEAM(pb + 0);
        if (EN(2) && IN(pb + 1)) {
            const int nN = layer == 0 ? 15 : 14;
            pg8::Gemm g{1024, 1024, 1024, 1 << 30};
            RowSched S; S.nM = 66; S.nN = nN; S.nwg = 66 * nN; S.G = C.G; S.c = C.bid; S.skipctx = 0; S.A = (const char*)(ws + WS_A); S.Bt = (const char*)(ws + WS_WIN); S.a_tile = (size_t)256 * 1024 * 2; S.b_tile = (size_t)256 * 1024 * 2;
            EpiProj E;
            if (layer == 0) { E.d0 = (bf16*)(ws + WS_Z); E.l0 = 1024; E.e0 = 4; E.d1 = (bf16*)(ws + WS_RAW); E.l1 = 1280; E.e1 = 9; E.d2 = (bf16*)(ws + WS_YMIX) + 1024; E.l2 = 2048; E.e2 = 13;
                E.d3 = (bf16*)(ws + WS_K); E.l3 = 256; E.e3 = 14; E.d4 = (bf16*)(ws + WS_V); E.l4 = 256; E.e4 = 15; E.d5 = (bf16*)(ws + WS_DTR); E.l5 = 32; E.lastcols = 32; }
            else { E.d0 = (bf16*)(ws + WS_Z); E.l0 = 1024; E.e0 = 4; E.d1 = (bf16*)(ws + WS_RAW); E.l1 = 1024; E.e1 = 8; E.d2 = (bf16*)(ws + WS_YMIX) + 1024; E.l2 = 2048; E.e2 = 12;
                E.d3 = (bf16*)(ws + WS_K); E.l3 = 256; E.e3 = 13; E.d4 = (bf16*)(ws + WS_V); E.l4 = 256; E.e4 = 14; E.d5 = (bf16*)(ws + WS_DTR); E.l5 = 32; E.lastcols = 32; }
            pg8::gemm_phase<EpiProj, RowSched>(lds, g, S, E);
        }
        SEAM(pb + 1);
        if (EN(3) && IN(pb + 2)) { if (layer == 0) ph_elem0(C); else ph_elem1(C); }
        SEAM(pb + 2);
        if (IN(pb + 3)) { if (layer == 0) { ph_ssdpre(C, lds);
#ifdef SPLIT_MIX0
            xcd_barrier(bar); for (int u = C.bid; u < 256; u += C.G) ssd_chunk_unit<1>(C, u >> 2, u & 3, lds);
#endif
        } }
        if (layer == 0) SEAM(pb + 3);
        if (IN(pb + 4)) { if (layer == 0) { if (EN(4)) ph_mix0(C, lds, (char*)lds_raw); } else { if (EN(5)) ph_mix1(C, lds, (char*)lds_raw); } }
        SEAM(pb + 4);
        if (EN(6) && IN(pb + 5)) { if (layer == 0) ph_ssdpost(C); else ph_lrupost(C); }
        SEAM(pb + 5);
        if (EN(7) && IN(pb + 6)) {
            for (int pass = 0; pass < (layer == 0 ? 2 : 1); ++pass) {
                pg8::Gemm g{2048, 2048, pass == 0 ? 2048 : 512, 1 << 30};
                RowSched S; S.nM = 64; S.nN = 4; S.nwg = pass == 0 ? 256 : 32; S.G = C.G; S.c = C.bid; S.skipctx = pass == 0 ? 1 : 2; S.A = (const char*)(ws + WS_YMIX); S.Bt = (const char*)(ws + WS_WOUT); S.a_tile = (size_t)256 * 2048 * 2; S.b_tile = (size_t)256 * 2048 * 2;
                EpiRes E; E.slab = pass == 0 ? nullptr : (float*)(ws + WS_RAW); E.xin_lat = layer == 0 ? C.in[I_X] : C.out; E.xin_ctx = layer == 0 ? C.in[I_CTX] : C.xc(); E.xout_lat = C.out; E.xout_ctx = C.xc(); E.modbase = C.mod(layer, 0);
                pg8::gemm_phase<EpiRes, RowSched>(lds, g, S, E);
            }
        }
        SEAM(pb + 6);
        if (EN(8) && IN(pb + 7)) ph_route(C, layer, lds);
        SEAM(pb + 7);
        if (EN(10) && IN(pb + 8)) {
            int* mt = (int*)(ws + WS_MTG) + (size_t)(layer * 256 + C.bid) * 256;
            moe_tables(C, layer, mt);
            { pg8::Gemm g{1024, 1024, 1024, 1 << 30};
              MoeSched1 S; S.mt = mt; S.G = C.G; S.c = C.bid; S.layer = layer; S.ws = ws;
              EpiMoe1 E; E.ws = ws;
              pg8::gemm_phase<EpiMoe1, MoeSched1, true>(lds, g, S, E, (const int*)(ws + WS_TBL)); }
            { pg8::Gemm g{512, 256, 512, 4};
              const int nun = mt[24] * 4, extra = nun > C.G ? nun - C.G : 0;
              MoeSched2 S; S.mt = mt; S.G = C.G; S.c = (C.bid - extra % C.G + C.G) % C.G; S.layer = layer; S.ws = ws;
              EpiMoe2 E; E.out = C.out; E.ws = ws; E.layer = layer;
              pg8::gemm_phase<EpiMoe2, MoeSched2, false>(lds, g, S, E); }
        }
        SEAM(pb + 8);
    }
#ifdef PROBE_A
    cg::this_grid().sync();
#endif
    if (EN(12) && IN(21)) ph_final(C);

    (void)ph;
#undef IN
#undef SEAM
}

extern "C" void kernel_launch(void* const* d_in, const int* in_sizes, int n_in, void* d_out, int out_size, void* d_ws, size_t ws_size, hipStream_t stream) {
    static int grid = 0;
    if (grid == 0) {
        if (n_in != 36 || out_size != NBATCH * SEQL * DM || ws_size < WS_END) { fprintf(stderr, "kernel_launch: unexpected shapes (n_in %d, out %d, ws %zu)\n", n_in, out_size, ws_size); grid = -1; return; }
        int dev = 0, cus = 0, per_cu = 0;
        if (hipGetDevice(&dev) != hipSuccess || hipDeviceGetAttribute(&cus, hipDeviceAttributeMultiprocessorCount, dev) != hipSuccess) { grid = -1; return; }
        if (hipFuncSetAttribute((const void*)fwd_kernel, hipFuncAttributeMaxDynamicSharedMemorySize, LDS_BYTES) != hipSuccess) { fprintf(stderr, "kernel_launch: hipFuncSetAttribute failed\n"); grid = -1; return; }
        if (hipOccupancyMaxActiveBlocksPerMultiprocessor(&per_cu, (const void*)fwd_kernel, NTHREADS, LDS_BYTES) != hipSuccess || per_cu < 1) { fprintf(stderr, "kernel_launch: occupancy query failed (%d)\n", per_cu); (void)hipGetLastError(); per_cu = 1; }
        grid = cus * 1;
    }
    if (grid < 0) return;
    (void)hipMemsetAsync((char*)d_ws + WS_CTL, 0, CTL_ZERO_BYTES, stream);
    Args a{};
    for (int i = 0; i < 36; ++i) a.in[i] = (const float*)d_in[i];
    a.out = (float*)d_out; a.ws = (unsigned char*)d_ws;
#if MK_PER_PHASE
    for (int p = 0; p < N_PHASES; ++p) { a.ph_lo = p; a.ph_hi = p + 1; hipLaunchKernelGGL(fwd_kernel, dim3(grid), dim3(NTHREADS), LDS_BYTES, stream, a); }
#else
    void* kargs[] = {&a};
#ifdef REPEAT_K
    a.ph_lo = 0; a.ph_hi = REPEAT_K + 1;
    (void)hipLaunchCooperativeKernel((const void*)fwd_kernel, dim3(grid), dim3(NTHREADS), kargs, LDS_BYTES, stream);
    (void)hipMemsetAsync((char*)d_ws + WS_CTL, 0, CTL_ZERO_BYTES, stream);
#endif
    a.ph_lo = 0; a.ph_hi = N_PHASES;
    hipError_t e = hipLaunchCooperativeKernel((const void*)fwd_kernel, dim3(grid), dim3(NTHREADS), kargs, LDS_BYTES, stream);
    if (e != hipSuccess) fprintf(stderr, "kernel_launch: cooperative launch failed: %s (grid %d)\n", hipGetErrorString(e), grid);
#endif
}
```

```cpp
#include <hip/hip_runtime.h>
#include <hip/hip_cooperative_groups.h>
#include <cstdio>
#include <cstdint>
namespace cg = cooperative_groups;

#ifndef MK_PER_PHASE
#define MK_PER_PHASE 0
#endif

#ifndef EN_MASK
#define EN_MASK 0xFFFF
#endif
#define EN(k) (((EN_MASK) >> (k)) & 1)
#define LAS __attribute__((address_space(3)))
typedef unsigned short bf16;
typedef short bf16x8 __attribute__((ext_vector_type(8)));
typedef short s16x4 __attribute__((ext_vector_type(4)));
typedef float f32x4 __attribute__((ext_vector_type(4)));
typedef float f32x2 __attribute__((ext_vector_type(2)));
typedef float f32x16 __attribute__((ext_vector_type(16)));
typedef unsigned u32x4 __attribute__((ext_vector_type(4)));
typedef unsigned u32x2 __attribute__((ext_vector_type(2)));

constexpr int DM = 1024, NBATCH = 2, SEQL = 8192, CTXL = 256;
constexpr int BROWS = CTXL + SEQL;
constexpr int NROWS = NBATCH * BROWS;
constexpr float EPS = 1e-6f;
constexpr int NWAVES = 8, NTHREADS = 512;
constexpr int LDS_BYTES = 147456;
constexpr int N_PHASES = 22;

constexpr size_t MiB = 1u << 20;
constexpr size_t WS_CTL = 0, CTL_ZERO_BYTES = 128 * 1024;
constexpr size_t WS_MOD = 1 * MiB;
constexpr size_t WS_REC = 1 * MiB + 256 * 1024;
constexpr size_t WS_TOK = 2 * MiB;
constexpr size_t WS_GAB = 2 * MiB + 128 * 1024;
constexpr size_t WS_MT  = 2 * MiB + 512 * 1024;
constexpr size_t WS_STAMP = 2 * MiB + 768 * 1024;
constexpr size_t WS_XC  = 3 * MiB;
constexpr size_t WS_W   = 5 * MiB;
constexpr size_t WS_WIN = WS_W, WS_WOUT = WS_W + 8 * MiB, WS_W13 = WS_W + 12 * MiB, WS_W2 = WS_W + 28 * MiB;
constexpr size_t WS_A   = 41 * MiB;
constexpr size_t WS_Z   = 83 * MiB;
constexpr size_t WS_RAW = 116 * MiB;
constexpr size_t WS_DTR = 158 * MiB;
constexpr size_t WS_DT  = 160 * MiB;
constexpr size_t WS_K   = 163 * MiB;
constexpr size_t WS_V   = 172 * MiB;
constexpr size_t WS_YMIX = 181 * MiB;
constexpr size_t WS_SSDST = 247 * MiB;
constexpr size_t WS_SSDLD = WS_SSDST + 64 * 3 * 16384;
constexpr size_t WS_TBL = 251 * MiB;
constexpr size_t WS_MTG = 253 * MiB;
constexpr size_t WS_END = 254 * MiB;
constexpr int MAXTILES = 90, MAXSLOT = MAXTILES * 256;
constexpr int CW_MODDONE = 192;
constexpr int CW_Q0 = 64, CW_Q1 = 128, CW_CNT = 256, CW_BAR = 4096, CW_TDONE = 8192;

__device__ __forceinline__ float bf2f(unsigned short b) { return __uint_as_float(((unsigned)b) << 16); }
__device__ __forceinline__ unsigned f2bf(float f) { unsigned u = __float_as_uint(f); return (u + 0x7fffu + ((u >> 16) & 1u)) >> 16; }
__device__ __forceinline__ unsigned pk2(float lo, float hi) { return f2bf(lo) | (f2bf(hi) << 16); }
__device__ __forceinline__ float dpp_add(float v, float src, const int ctrl_unused) { return v + src; }
#define DPP_F(v, ctrl, rmask) __builtin_bit_cast(float, __builtin_amdgcn_update_dpp(0, __builtin_bit_cast(int, v), ctrl, rmask, 0xf, false))
__device__ __forceinline__ float wave_sum(float v) {
    v += DPP_F(v, 0xB1, 0xf);
    v += DPP_F(v, 0x4E, 0xf);
    v += DPP_F(v, 0x141, 0xf);
    v += DPP_F(v, 0x140, 0xf);
    v += DPP_F(v, 0x142, 0xa);
    v += DPP_F(v, 0x143, 0xc);
    return __builtin_bit_cast(float, __builtin_amdgcn_readlane(__builtin_bit_cast(int, v), 63));
}
__device__ __forceinline__ float silu_f(float x) { return x / (1.f + __expf(-x)); }
__device__ __forceinline__ float sigmoid_f(float x) { return 1.f / (1.f + __expf(-x)); }
__device__ __forceinline__ float softplus_f(float x) { return fmaxf(x, 0.f) + log1pf(__expf(-fabsf(x))); }
__device__ __forceinline__ float gelu_tanh_f(float x) { const float u = 0.7978845608028654f * (x + 0.044715f * x * x * x); return 0.5f * x * (1.f + tanhf(u)); }
__device__ __forceinline__ void unpack8(const u32x4 w, float* f) {
    f[0] = __uint_as_float(w.x << 16); f[1] = __uint_as_float(w.x & 0xffff0000u);
    f[2] = __uint_as_float(w.y << 16); f[3] = __uint_as_float(w.y & 0xffff0000u);
    f[4] = __uint_as_float(w.z << 16); f[5] = __uint_as_float(w.z & 0xffff0000u);
    f[6] = __uint_as_float(w.w << 16); f[7] = __uint_as_float(w.w & 0xffff0000u);
}

namespace pg8 {
constexpr int BM = 256, BK = 64, HALF = 128, HTB = HALF * BK * 2, STAGE_BYTES = 8 * HTB, NXCD = 8, WGM = 8;
__host__ __device__ __forceinline__ int lds_byte(int r, int c) { const int st = (r >> 4) * 2 + (c >> 5), rr = r & 15, cc = c & 31, ob = rr * 64 + cc * 2; return st * 1024 + (ob ^ (((ob >> 9) & 1) << 5)); }
__host__ __device__ __forceinline__ void stage_rc(int b, int& R, int& C) { const int st = b / 1024, sb = b % 1024, swz = sb ^ (((sb >> 9) & 1) << 5); R = (st >> 1) * 16 + swz / 64; C = (st & 1) * 32 + (swz % 64) / 2; }
__host__ __device__ __forceinline__ int perm32(int rho) { const int n = rho >> 4, i = rho & 15; return 8 * (i >> 2) + 4 * n + (i & 3); }

struct Unit { int pm, pn; const char* a; const char* b; long bd; int tbo; int nrow; };
struct Gemm { int lda, ldb, K, ksplit; };

__device__ __forceinline__ unsigned cvt_pk_bf16(float lo, float hi) { unsigned r; asm volatile("v_cvt_pk_bf16_f32 %0, %1, %2" : "=v"(r) : "v"(lo), "v"(hi)); return r; }

template <class Epi, class Sched, bool GATHER = false>
__device__ __forceinline__ void gemm_phase(LAS unsigned char* lds, const Gemm g, const Sched& S, const Epi& E, const int* gtbl = nullptr) {
    int tid_ = threadIdx.x; asm volatile("" : "+v"(tid_));
    const int tid = tid_, wid = __builtin_amdgcn_readfirstlane(tid >> 6), lane = tid & 63, wr = wid >> 2, wc = wid & 3, fr = lane & 15, fq = lane >> 4;
    const int nt = g.K / BK;
    unsigned voffA[2][2], nvoffA[2][2], voffB[2];
#pragma unroll
    for (int i = 0; i < 2; ++i) { int R, C; stage_rc(tid * 16 + i * 8192, R, C); const int Rb = Epi::PERM ? ((R & ~31) + perm32(R & 31)) : R;
        voffA[0][i] = (unsigned)(R * g.lda + C) * 2u; voffA[1][i] = (unsigned)((R + HALF) * g.lda + C) * 2u; nvoffA[0][i] = voffA[0][i]; nvoffA[1][i] = voffA[1][i];
        voffB[i] = (unsigned)(Rb * g.ldb + C) * 2u; }
#define PG8_GATHER_OFF(dst, uu) do { if constexpr (GATHER) { int _t = tid; asm volatile("" : "+v"(_t)); _Pragma("unroll") for (int _i = 0; _i < 2; ++_i) { int _R, _C; stage_rc(_t * 16 + _i * 8192, _R, _C); \
        _Pragma("unroll") for (int _h = 0; _h < 2; ++_h) { int _rho = _h * HALF + _R; _rho = _rho < (uu).nrow ? _rho : (uu).nrow - 1; dst[_h][_i] = (unsigned)gtbl[(uu).tbo + _rho] * (unsigned)(g.lda * 2) + (unsigned)_C * 2u; } } } } while (0)
    const size_t kstep = (size_t)(BK * 2);
    const size_t hstepA = (size_t)HALF * g.lda * 2, hstepB = (size_t)HALF * g.ldb * 2;
    const unsigned ldsw = (unsigned)wid * 1024u;
    const int aoff = lds_byte(wr * 64 + fr, fq * 8), boff = lds_byte(wc * 32 + fr, fq * 8);
#define PG8_SA(b, h) (((b) * 2 + (h)) * HTB)
#define PG8_SB(b, h) ((4 + (b) * 2 + (h)) * HTB)
#define PG8_STAGE(bufoff, gbase, voff) do { _Pragma("unroll") for (int _i = 0; _i < 2; ++_i) \
        __builtin_amdgcn_global_load_lds((const unsigned*)((const char*)(gbase) + (voff)[_i]), (LAS unsigned*)(lds + (bufoff) + ldsw + _i * 8192), 16, 0, 0); } while (0)
#define PG8_STAGE_A(bufoff, gbase, hh, usenext) do { _Pragma("unroll") for (int _i = 0; _i < 2; ++_i) { \
        if constexpr (GATHER) { const unsigned _vo = (usenext) ? nvoffA[hh][_i] : voffA[hh][_i]; \
            __builtin_amdgcn_global_load_lds((const unsigned*)((const char*)(gbase) + _vo), (LAS unsigned*)(lds + (bufoff) + ldsw + _i * 8192), 16, 0, 0); } \
        else __builtin_amdgcn_global_load_lds((const unsigned*)((const char*)(gbase) + (hh) * hstepA + voffA[0][_i]), (LAS unsigned*)(lds + (bufoff) + ldsw + _i * 8192), 16, 0, 0); } } while (0)
#define PG8_LDA(dst, b, h) do { _Pragma("unroll") for (int m = 0; m < 4; ++m) _Pragma("unroll") for (int k = 0; k < 2; ++k) dst[m][k] = *(const LAS bf16x8*)(lds + PG8_SA(b, h) + aoff + m * 2048 + k * 1024); } while (0)
#define PG8_LDB(dst, b, h) do { _Pragma("unroll") for (int n = 0; n < 2; ++n) _Pragma("unroll") for (int k = 0; k < 2; ++k) dst[n][k] = *(const LAS bf16x8*)(lds + PG8_SB(b, h) + boff + n * 2048 + k * 1024); } while (0)
#define PG8_MMA(ai, bj, At, Bt) do { __builtin_amdgcn_s_setprio(1); _Pragma("unroll") for (int m = 0; m < 4; ++m) _Pragma("unroll") for (int n = 0; n < 2; ++n) _Pragma("unroll") for (int k = 0; k < 2; ++k) \
        acc[ai][bj][m][n] = __builtin_amdgcn_mfma_f32_16x16x32_bf16(Bt[n][k], At[m][k], acc[ai][bj][m][n], 0, 0, 0); __builtin_amdgcn_s_setprio(0); } while (0)
#define PG8_WAIT_V(n) asm volatile("s_waitcnt vmcnt(" #n ")" ::: "memory")
#define PG8_WAIT_L(n) asm volatile("s_waitcnt lgkmcnt(" #n ")" ::: "memory")
#define PG8_BAR __builtin_amdgcn_s_barrier()
#define PG8_SCHED __builtin_amdgcn_sched_barrier(0)
    Unit cur, nxt; int ui = 0;
    if (!S.next(0, cur)) return;
    f32x4 acc[2][2][4][2];
#pragma unroll
    for (int a = 0; a < 2; ++a)
#pragma unroll
        for (int b = 0; b < 2; ++b)
#pragma unroll
            for (int m = 0; m < 4; ++m)
#pragma unroll
                for (int n = 0; n < 2; ++n) acc[a][b][m][n] = (f32x4){0.f, 0.f, 0.f, 0.f};
    bf16x8 At[4][2], B0[2][2], B1[2][2];
    const char* cA = cur.a; const char* cB = cur.b; long cBd = cur.bd;
    S.a_ready(cur);
    PG8_GATHER_OFF(voffA, cur);
    PG8_STAGE(PG8_SB(0, 0), cB, voffB); PG8_STAGE_A(PG8_SA(0, 0), cA, 0, false); PG8_STAGE(PG8_SB(0, 1), cB + hstepB, voffB); PG8_STAGE_A(PG8_SA(0, 1), cA, 1, false);
    if (wr == 1) PG8_BAR;
    PG8_WAIT_V(4); PG8_BAR;
    PG8_STAGE(PG8_SB(1, 0), cB + kstep, voffB); PG8_STAGE_A(PG8_SA(1, 0), cA + kstep, 0, false); PG8_STAGE(PG8_SB(1, 1), cB + hstepB + kstep, voffB);
    PG8_WAIT_V(6); PG8_BAR;
    for (;;) {
        const bool has_next = S.next(ui + 1, nxt);
        const char* nA = has_next ? nxt.a : cA; const char* nB = has_next ? nxt.b : cB;
        if constexpr (GATHER) { if (has_next) PG8_GATHER_OFF(nvoffA, nxt); else {
#pragma unroll
            for (int _h = 0; _h < 2; ++_h)
#pragma unroll
                for (int _i = 0; _i < 2; ++_i) nvoffA[_h][_i] = voffA[_h][_i]; } }
#pragma unroll 1
        for (int t = 0; t < nt; t += 2) {
            const bool last = (t == nt - 2);
            const char* a1 = cA + (size_t)(t + 1) * kstep;
            const char* a2 = last ? nA : cA + (size_t)(t + 2) * kstep;
            const char* b2 = last ? nB : cB + (size_t)(t + 2) * kstep + ((t + 2) >= g.ksplit ? cBd : 0);
            const char* a3 = a2 + kstep; const char* b3 = b2 + kstep;
            if (last && has_next) S.a_ready(nxt);
            PG8_LDB(B0, 0, 0); PG8_SCHED; PG8_LDA(At, 0, 0); PG8_STAGE_A(PG8_SA(1, 1), a1, 1, false);
            PG8_WAIT_L(8); PG8_BAR; PG8_WAIT_L(0); PG8_MMA(0, 0, At, B0); PG8_BAR; PG8_SCHED;
            PG8_LDB(B1, 0, 1); PG8_STAGE(PG8_SB(0, 0), b2, voffB);
            PG8_BAR; PG8_WAIT_L(0); PG8_MMA(0, 1, At, B1); PG8_BAR;
            PG8_LDA(At, 0, 1); PG8_STAGE_A(PG8_SA(0, 0), a2, 0, last);
            PG8_BAR; PG8_WAIT_L(0); PG8_MMA(1, 0, At, B0); PG8_BAR; PG8_SCHED;
            PG8_STAGE(PG8_SB(0, 1), b2 + hstepB, voffB);
            PG8_WAIT_V(6); PG8_BAR; PG8_MMA(1, 1, At, B1); PG8_BAR;
            PG8_LDB(B0, 1, 0); PG8_SCHED; PG8_LDA(At, 1, 0); PG8_STAGE_A(PG8_SA(0, 1), a2, 1, last);
            PG8_WAIT_L(8); PG8_BAR; PG8_WAIT_L(0); PG8_MMA(0, 0, At, B0); PG8_BAR; PG8_SCHED;
            PG8_LDB(B1, 1, 1); PG8_STAGE(PG8_SB(1, 0), b3, voffB);
            PG8_BAR; PG8_WAIT_L(0); PG8_MMA(0, 1, At, B1); PG8_BAR;
            PG8_LDA(At, 1, 1); PG8_STAGE_A(PG8_SA(1, 0), a3, 0, last);
            PG8_BAR; PG8_WAIT_L(0); PG8_MMA(1, 0, At, B0); PG8_BAR; PG8_SCHED;
            PG8_STAGE(PG8_SB(1, 1), b3 + hstepB, voffB);
            PG8_WAIT_V(6); PG8_BAR; PG8_MMA(1, 1, At, B1); PG8_BAR;
        }
        if (!(Epi::AFTER_DRAIN && !has_next)) { E(acc, cur, wr, wc, fr, fq); S.done(cur); }
        if (!has_next) break;
#pragma unroll
        for (int a = 0; a < 2; ++a)
#pragma unroll
            for (int b = 0; b < 2; ++b)
#pragma unroll
                for (int m = 0; m < 4; ++m)
#pragma unroll
                    for (int n = 0; n < 2; ++n) acc[a][b][m][n] = (f32x4){0.f, 0.f, 0.f, 0.f};
        cur = nxt; cA = nA; cB = nB; cBd = cur.bd; ++ui;
        if constexpr (GATHER) {
#pragma unroll
            for (int _h = 0; _h < 2; ++_h)
#pragma unroll
                for (int _i = 0; _i < 2; ++_i) voffA[_h][_i] = nvoffA[_h][_i]; }
    }
    PG8_WAIT_V(0);
    if (wr == 0) PG8_BAR;
    PG8_BAR;
    if constexpr (Epi::AFTER_DRAIN) { E.fused(acc, cur, wr, wc, fr, fq, lds, wid, lane); S.done(cur); }
#undef PG8_SA
#undef PG8_SB
#undef PG8_STAGE
#undef PG8_STAGE_A
#undef PG8_GATHER_OFF
#undef PG8_LDA
#undef PG8_LDB
#undef PG8_MMA
#undef PG8_WAIT_V
#undef PG8_WAIT_L
#undef PG8_BAR
#undef PG8_SCHED
}
}

namespace att {
constexpr int D = 128, NW = 8, QBLK = 32, KVBLK = 64;
constexpr float SCALE = 0.088388347648318440f;
constexpr float THR = 8.f;
constexpr int LDQ = 2048, LDK = 256, LDO = 2048;
constexpr size_t SHM_V = KVBLK * D * 2, SHM_K = KVBLK * D * 2, SHM_ATTN = 2 * SHM_V + 2 * SHM_K + NW * 64 * 4;
#define KSWZ(row, colB) ((row) * 256 + ((colB) ^ (((row) & 7) << 4)))
#define SBAR() __builtin_amdgcn_sched_barrier(0)
__device__ __forceinline__ int crow(int r, int hi) { return (r & 3) + 8 * (r >> 2) + 4 * hi; }
__device__ __forceinline__ unsigned cvtpk(float lo, float hi) { unsigned r; asm volatile("v_cvt_pk_bf16_f32 %0, %1, %2" : "=v"(r) : "v"(lo), "v"(hi)); return r; }

__device__ __forceinline__ void partialSM(f32x16& p0, f32x16& p1, float& m_reg, float& mn, float& alpha) {
  constexpr float C = SCALE * 1.4426950408889634f;
  float pmax = p0[0]; for (int r = 1; r < 16; ++r) pmax = fmaxf(pmax, p0[r]); for (int r = 0; r < 16; ++r) pmax = fmaxf(pmax, p1[r]);
  { auto rr = __builtin_amdgcn_permlane32_swap(__float_as_uint(pmax), __float_as_uint(pmax), false, false);
    pmax = fmaxf(__uint_as_float(rr[0]), __uint_as_float(rr[1])); }
  if (__builtin_expect(__all(pmax - m_reg <= THR / SCALE), 1)) { mn = m_reg; alpha = 1.f; }
  else { mn = fmaxf(m_reg, pmax); alpha = __builtin_amdgcn_exp2f((m_reg - mn) * C); m_reg = mn; }
  float mnC = -mn * C;
  for (int r = 0; r < 16; ++r) p0[r] = fmaf(p0[r], C, mnC); for (int r = 0; r < 16; ++r) p1[r] = fmaf(p1[r], C, mnC);
  for (int r = 0; r < 16; ++r) p0[r] = __builtin_amdgcn_exp2f(p0[r]);
}
__device__ __forceinline__ void finishSM(f32x16& p0, f32x16& p1, float alpha, float& l_reg, bf16x8& pa0, bf16x8& pa1, bf16x8& pa2, bf16x8& pa3) {
  for (int r = 0; r < 16; ++r) p1[r] = __builtin_amdgcn_exp2f(p1[r]);
  float ps = 0; for (int r = 0; r < 16; ++r) ps += p0[r]; for (int r = 0; r < 16; ++r) ps += p1[r];
  { auto rr = __builtin_amdgcn_permlane32_swap(__float_as_uint(ps), __float_as_uint(ps), false, false);
    ps = __uint_as_float(rr[0]) + __uint_as_float(rr[1]); }
  l_reg = l_reg * alpha + ps;
#define PK4(P, BASE, OUT) do { unsigned a0 = cvtpk(P[BASE + 0], P[BASE + 1]), a1 = cvtpk(P[BASE + 2], P[BASE + 3]);   \
    unsigned b0 = cvtpk(P[BASE + 4], P[BASE + 5]), b1 = cvtpk(P[BASE + 6], P[BASE + 7]);                              \
    auto r0 = __builtin_amdgcn_permlane32_swap(a0, b0, false, false); auto r1 = __builtin_amdgcn_permlane32_swap(a1, b1, false, false); \
    u32x4 w = {r0[0], r1[0], r0[1], r1[1]}; OUT = *reinterpret_cast<bf16x8*>(&w); } while (0)
  PK4(p0, 0, pa0); PK4(p0, 8, pa1); PK4(p1, 0, pa2); PK4(p1, 8, pa3);
#undef PK4
}
__device__ __forceinline__ void qkt(f32x16& p0, f32x16& p1, const bf16* Ks, const bf16x8* qr, int r32, int hi) {
  p0 = f32x16{}; p1 = f32x16{};
  for (int d0 = 0; d0 < 8; ++d0) { int cb = (d0 * 16 + hi * 8) * 2;
    bf16x8 b0 = *reinterpret_cast<const bf16x8*>((const char*)Ks + KSWZ(r32, cb));
    bf16x8 b1 = *reinterpret_cast<const bf16x8*>((const char*)Ks + KSWZ(32 + r32, cb));
    p0 = __builtin_amdgcn_mfma_f32_32x32x16_bf16(b0, qr[d0], p0, 0, 0, 0);
    p1 = __builtin_amdgcn_mfma_f32_32x32x16_bf16(b1, qr[d0], p1, 0, 0, 0); }
}
__device__ __forceinline__ int v_st(int k, int c) { const int kk = (k & ~0xC) | ((k & 4) << 1) | ((k & 8) >> 1); return ((kk >> 3) * 4 + (c >> 5)) * 512 + ((kk & 7) * 32 + (c & 31)) * 2; }
__device__ __forceinline__ int v_rd_base(int lane) { return ((lane & 3) << 3) | (((lane >> 2) & 3) << 6) | (((lane >> 4) & 1) << 5) | (((lane >> 5) & 1) << 8); }
constexpr int v_rd_off(int d0, int ks, int half) { return d0 * 512 + ks * 4096 + half * 2048; }
template <int OFF> __device__ __forceinline__ s16x4 tr_read(int vb) {
  s16x4 r; asm volatile("ds_read_b64_tr_b16 %0, %1 offset:%2" : "=&v"(r) : "v"(vb), "i"(OFF) : "memory"); return r;
}
template <int D0> __device__ __forceinline__ void pv_one(f32x16& od, int vb, bf16x8 pa0, bf16x8 pa1, bf16x8 pa2, bf16x8 pa3) {
  const s16x4 l0 = tr_read<v_rd_off(D0, 0, 0)>(vb), h0 = tr_read<v_rd_off(D0, 0, 1)>(vb), l1 = tr_read<v_rd_off(D0, 1, 0)>(vb), h1 = tr_read<v_rd_off(D0, 1, 1)>(vb);
  const s16x4 l2 = tr_read<v_rd_off(D0, 2, 0)>(vb), h2 = tr_read<v_rd_off(D0, 2, 1)>(vb), l3 = tr_read<v_rd_off(D0, 3, 0)>(vb), h3 = tr_read<v_rd_off(D0, 3, 1)>(vb);
  asm volatile("s_waitcnt lgkmcnt(0)" ::: "memory"); SBAR();
#define PK(L, H) (bf16x8){L[0], L[1], L[2], L[3], H[0], H[1], H[2], H[3]}
  od = __builtin_amdgcn_mfma_f32_32x32x16_bf16(pa0, PK(l0, h0), od, 0, 0, 0);
  od = __builtin_amdgcn_mfma_f32_32x32x16_bf16(pa1, PK(l1, h1), od, 0, 0, 0);
  od = __builtin_amdgcn_mfma_f32_32x32x16_bf16(pa2, PK(l2, h2), od, 0, 0, 0);
  od = __builtin_amdgcn_mfma_f32_32x32x16_bf16(pa3, PK(l3, h3), od, 0, 0, 0);
#undef PK
}
__device__ __forceinline__ void pv_d0(f32x16* o, int vb, bf16x8 pa0, bf16x8 pa1, bf16x8 pa2, bf16x8 pa3) {
  pv_one<0>(o[0], vb, pa0, pa1, pa2, pa3); pv_one<1>(o[1], vb, pa0, pa1, pa2, pa3); pv_one<2>(o[2], vb, pa0, pa1, pa2, pa3); pv_one<3>(o[3], vb, pa0, pa1, pa2, pa3);
}
__device__ __forceinline__ void band_mask(f32x16& p0, f32x16& p1, int dbase, int hi) {
#pragma unroll
  for (int r = 0; r < 16; ++r) { const int d = dbase + crow(r, hi);
    if (d < -128 || d > 128) p0[r] = -1e30f;
    if (d + 32 < -128 || d + 32 > 128) p1[r] = -1e30f; }
}
template <int MODE>
__device__ __forceinline__ void attn_body(const bf16* Qb, const bf16* Kh, const bf16* Vh, bf16* Ob, int NT, int kb0, int q0, float sink, char* lds, const float* qg, int tq0) {
  int tid_ = threadIdx.x; asm volatile("" : "+v"(tid_));
  const int tid = tid_, wid = tid >> 6, lane = tid & 63, r32 = lane & 31, hi = lane >> 5;
  bf16* V_lds = (bf16*)lds; bf16* K_lds = (bf16*)(lds + 3 * SHM_V);
  float* ws = (float*)(lds + 3 * SHM_V + 3 * SHM_K) + wid * 64; float* li_l = ws; float* al_l = ws + 32;
  bf16x8 qr[8];
  const bf16* Qw = Qb + (long)(wid * QBLK + r32) * LDQ + hi * 8;
  { u32x4 raw[8];
#pragma unroll
    for (int d0 = 0; d0 < 8; ++d0) raw[d0] = *reinterpret_cast<const u32x4*>(Qw + d0 * 16);
    float rs = 1.f;
    if (qg != nullptr) { float ssq = 0.f;
#pragma unroll
      for (int d0 = 0; d0 < 8; ++d0) { float f[8]; unpack8(raw[d0], f);
#pragma unroll
        for (int e = 0; e < 8; ++e) ssq += f[e] * f[e]; }
      ssq += __shfl_xor(ssq, 32);
      rs = rsqrtf(ssq * (1.f / 128.f) + 1e-6f); }
    const int t = tq0 + wid * QBLK + r32;
#pragma unroll
    for (int d0 = 0; d0 < 4; ++d0) { float fa[8], fb[8]; unpack8(raw[d0], fa); unpack8(raw[d0 + 4], fb);
      if (qg != nullptr) { const f32x4 ga0 = *reinterpret_cast<const f32x4*>(qg + 16 * d0 + 8 * hi), ga1 = *reinterpret_cast<const f32x4*>(qg + 16 * d0 + 8 * hi + 4);
        const f32x4 gb0 = *reinterpret_cast<const f32x4*>(qg + 64 + 16 * d0 + 8 * hi), gb1 = *reinterpret_cast<const f32x4*>(qg + 64 + 16 * d0 + 8 * hi + 4);
#pragma unroll
        for (int e = 0; e < 4; ++e) { fa[e] *= rs * ga0[e]; fa[4 + e] *= rs * ga1[e]; fb[e] *= rs * gb0[e]; fb[4 + e] *= rs * gb1[e]; } }
      if (tq0 >= 0) {
#pragma unroll
        for (int e = 0; e < 8; ++e) { const int j = 16 * d0 + 8 * hi + e; const int pos = j < 32 ? (t >> 6) : (t & 63);
          const float inv = exp2f(-(float)(j & 31) * (13.287712379549449f / 32.f)); float sn, cs; sincosf((float)pos * inv, &sn, &cs);
          const float a = fa[e], b2 = fb[e]; fa[e] = a * cs - b2 * sn; fb[e] = a * sn + b2 * cs; } }
      u32x4 wa, wb; wa.x = cvtpk(fa[0], fa[1]); wa.y = cvtpk(fa[2], fa[3]); wa.z = cvtpk(fa[4], fa[5]); wa.w = cvtpk(fa[6], fa[7]);
      wb.x = cvtpk(fb[0], fb[1]); wb.y = cvtpk(fb[2], fb[3]); wb.z = cvtpk(fb[4], fb[5]); wb.w = cvtpk(fb[6], fb[7]);
      qr[d0] = *reinterpret_cast<bf16x8*>(&wa); qr[d0 + 4] = *reinterpret_cast<bf16x8*>(&wb); } }
  float m_reg = -1e30f, l_reg = 0; f32x16 o[4] = {};
  const int sr = tid >> 4, sc = (tid & 15) * 8, vst0 = v_st(sr, sc), vst1 = v_st(32 + sr, sc);
  const int vb0 = (int)(uintptr_t)V_lds + v_rd_base(lane);
  struct { bf16x8 vs0, vs1, ks0, ks1; } sr_;
#define TK0(j) ((MODE == 0 || (j) < 4) ? (j) * KVBLK : kb0 + ((j) - 4) * KVBLK)
#define SLOAD(k0) do { sr_.vs0 = *reinterpret_cast<const bf16x8*>(&Vh[(long)((k0) + sr) * LDK + sc]); sr_.vs1 = *reinterpret_cast<const bf16x8*>(&Vh[(long)((k0) + 32 + sr) * LDK + sc]); \
    sr_.ks0 = *reinterpret_cast<const bf16x8*>(&Kh[(long)((k0) + sr) * LDK + sc]); sr_.ks1 = *reinterpret_cast<const bf16x8*>(&Kh[(long)((k0) + 32 + sr) * LDK + sc]); } while (0)
#define SWRITE(b) do { *(bf16x8*)((char*)V_lds + (b) * (int)SHM_V + vst0) = sr_.vs0;          \
    *(bf16x8*)((char*)V_lds + (b) * (int)SHM_V + vst1) = sr_.vs1; int kc = sc * 2;               \
    *(bf16x8*)((char*)K_lds + (b) * (int)SHM_K + KSWZ(sr, kc)) = sr_.ks0;                       \
    *(bf16x8*)((char*)K_lds + (b) * (int)SHM_K + KSWZ(32 + sr, kc)) = sr_.ks1; } while (0)
#define SWAIT() asm volatile("s_waitcnt vmcnt(0)" ::: "memory")
#define RESC(a) do { if (__any((a) < 1.f)) { if (hi == 0) al_l[r32] = (a); asm volatile("s_waitcnt lgkmcnt(0)" ::: "memory"); \
    for (int d = 0; d < 4; ++d) for (int r = 0; r < 16; ++r) o[d][r] *= al_l[crow(r, hi)]; } } while (0)
#define MASKT(P0, P1, j) do { if (MODE == 1 && (j) >= 4) { const int s0_ = kb0 - 256 + ((j) - 4) * KVBLK, tw_ = q0 + wid * QBLK; \
    if (!(s0_ - (tw_ + 31) >= -128 && (s0_ + 63) - tw_ <= 128)) band_mask(P0, P1, s0_ - tw_ - r32, hi); } } while (0)
  f32x16 pA0, pA1, pB0, pB1; float mnA, mnB, alA, alB; bf16x8 pa0, pa1, pa2, pa3;
  int bp = 0, bq = 1;
  SLOAD(TK0(0)); SWAIT(); SWRITE(0); __syncthreads();
  qkt(pA0, pA1, K_lds, qr, r32, hi); partialSM(pA0, pA1, m_reg, mnA, alA);
  SLOAD(TK0(1));
  SWAIT(); SWRITE(1); __syncthreads();
  for (int j = 1; j + 1 < NT; j += 2) {
    { const int bw = 3 - bp - bq;
      SBAR(); qkt(pB0, pB1, (bf16*)((char*)K_lds + bq * (int)SHM_K), qr, r32, hi);
      finishSM(pA0, pA1, alA, l_reg, pa0, pa1, pa2, pa3); SBAR();
      SLOAD(TK0(j + 1)); SBAR();
      pv_d0(o, vb0 + bp * (int)SHM_V, pa0, pa1, pa2, pa3); MASKT(pB0, pB1, j); partialSM(pB0, pB1, m_reg, mnB, alB);
      SWAIT(); SWRITE(bw);
      RESC(alB); __syncthreads();
      bp = bq; bq = bw; }
    { const int bw = 3 - bp - bq;
      SBAR(); qkt(pA0, pA1, (bf16*)((char*)K_lds + bq * (int)SHM_K), qr, r32, hi);
      finishSM(pB0, pB1, alB, l_reg, pa0, pa1, pa2, pa3); SBAR();
      SLOAD(TK0(j + 2)); SBAR();
      pv_d0(o, vb0 + bp * (int)SHM_V, pa0, pa1, pa2, pa3); MASKT(pA0, pA1, j + 1); partialSM(pA0, pA1, m_reg, mnA, alA);
      SWAIT(); SWRITE(bw);
      RESC(alA); __syncthreads();
      bp = bq; bq = bw; }
  }
  SBAR(); qkt(pB0, pB1, (bf16*)((char*)K_lds + bq * (int)SHM_K), qr, r32, hi);
  finishSM(pA0, pA1, alA, l_reg, pa0, pa1, pa2, pa3); SBAR();
  pv_d0(o, vb0 + bp * (int)SHM_V, pa0, pa1, pa2, pa3); MASKT(pB0, pB1, NT - 1); partialSM(pB0, pB1, m_reg, mnB, alB);
  RESC(alB);
  finishSM(pB0, pB1, alB, l_reg, pa0, pa1, pa2, pa3); SBAR();
  pv_d0(o, vb0 + bq * (int)SHM_V, pa0, pa1, pa2, pa3);
  if (MODE == 1) { constexpr float C = SCALE * 1.4426950408889634f; l_reg += __builtin_amdgcn_exp2f(sink * 1.4426950408889634f - m_reg * C); }
  if (hi == 0) li_l[r32] = l_reg; asm volatile("s_waitcnt lgkmcnt(0)" ::: "memory");
  float rli[16];
#pragma unroll
  for (int r = 0; r < 16; ++r) rli[r] = __builtin_amdgcn_rcpf(li_l[crow(r, hi)]);
  bf16* Ow = Ob + (long)(wid * QBLK) * LDO;
#pragma unroll
  for (int r = 0; r < 16; ++r) { int orow = crow(r, hi);
    for (int d0 = 0; d0 < 4; ++d0) Ow[(long)orow * LDO + d0 * 32 + r32] = (bf16)f2bf(o[d0][r] * rli[r]); }
  asm volatile("s_waitcnt vmcnt(0) lgkmcnt(0)" ::: "memory");
  __syncthreads();
#undef TK0
#undef SLOAD
#undef SWRITE
#undef SWAIT
#undef RESC
#undef MASKT
}
#undef KSWZ
#undef SBAR
}

struct Args { const float* in[36]; float* out; unsigned char* ws; int ph_lo, ph_hi; };
enum { I_X = 0, I_C, I_CTX, I_CCTX, I_WMOD, I_BMOD, I_GMIX, I_GFFN, I_WGRP, I_BGRP, I_WRT, I_BRT, I_W1, I_W3, I_W2, I_ABIN, I_ABOUT, I_SCONVW, I_SCONVB,
       I_DTBIAS, I_ALOG, I_SSDD, I_SNORMG, I_QG, I_KG, I_CDIN, I_CDOUT, I_LCONVW, I_LCONVB, I_LWA, I_LBA, I_LWX, I_LBX, I_LAM, I_SINK, I_GFINAL };

struct Ctx {
    const float* const* in; float* out; unsigned char* ws;
    int bid, G;
    __device__ __forceinline__ unsigned* ctl() const { return (unsigned*)(ws + WS_CTL); }
    __device__ __forceinline__ float* mod(int layer, int mv) const { return (float*)(ws + WS_MOD) + (size_t)(layer * 3 + mv) * 6144; }
    __device__ __forceinline__ float* xc() const { return (float*)(ws + WS_XC); }
    __device__ __forceinline__ float* xrow(int r) const { const int b = r / BROWS, q = r - b * BROWS; return q < CTXL ? xc() + (size_t)(b * CTXL + q) * DM : out + (size_t)(b * SEQL + (q - CTXL)) * DM; }
    __device__ __forceinline__ const float* xin_row(int r) const { const int b = r / BROWS, q = r - b * BROWS; return q < CTXL ? in[I_CTX] + (size_t)(b * CTXL + q) * DM : in[I_X] + (size_t)(b * SEQL + (q - CTXL)) * DM; }
};
struct TC { int tid, lane, wave; };
__device__ __forceinline__ TC phase_tc() { TC t; int x = threadIdx.x; asm volatile("" : "+v"(x)); t.tid = x; t.lane = x & 63; t.wave = __builtin_amdgcn_readfirstlane(x >> 6); return t; }
__device__ __forceinline__ int row_mv(int r) { const int b = r / BROWS, q = r - b * BROWS; return q < CTXL ? 2 : b; }

struct RowSched {
    int nM, nN, nwg, G, c, skipctx; const char* A; const char* Bt; size_t a_tile, b_tile;
    __device__ __forceinline__ bool next(int i, pg8::Unit& u) const {
        const long L = (long)i * G + c; if (L >= nwg) return false;
        if (skipctx == 2) { const int t8 = (int)L >> 2, ks = (int)L & 3; u.pm = (t8 >> 2) * 33; u.pn = t8 & 3;
            u.a = A + (size_t)u.pm * a_tile + (size_t)ks * 1024; u.b = Bt + (size_t)u.pn * b_tile + (size_t)ks * 1024; u.bd = 0; u.tbo = (int)L; u.nrow = 0; return true; }
        int wgid = (int)L; { const int q = nwg / 8, r = nwg % 8, xcd = wgid % 8, off = wgid / 8; wgid = (xcd < r ? xcd * (q + 1) : r * (q + 1) + (xcd - r) * q) + off; }
        const int nig = 8 * nN, gid = wgid / nig, fm = gid * 8, gsz = (nM - fm) < 8 ? (nM - fm) : 8;
        const int pmi = fm + ((wgid % nig) % gsz); u.pn = (wgid % nig) / gsz;
        u.pm = skipctx ? (pmi / 32) * 33 + 1 + (pmi % 32) : pmi;
        u.a = A + (size_t)u.pm * a_tile; u.b = Bt + (size_t)u.pn * b_tile; u.bd = 0; u.tbo = 0; u.nrow = 0; return true;
    }
    __device__ __forceinline__ void a_ready(const pg8::Unit&) const {}
    __device__ __forceinline__ void done(const pg8::Unit&) const {}
};
struct MoeSchedBase {
    const int* mt; int G, c, layer; unsigned char* ws;
    __device__ __forceinline__ bool locate(int i, pg8::Unit& u, int& ea, int& eb) const {
        const int ntl = mt[24]; const long L = (long)i * G + c; if (L >= (long)ntl * 4) return false;
        const int tile = (int)(L >> 2), pn = (int)(L & 3), cls = mt[64 + tile], g = cls / 6, pi = cls - g * 6;
        const int ia = pi < 3 ? 0 : (pi < 5 ? 1 : 2), ib = pi < 3 ? pi + 1 : (pi < 5 ? pi - 1 : 3);
        ea = g * 4 + ia; eb = g * 4 + ib;
        const int ti = tile - mt[cls];
        u.pm = tile; u.pn = pn; u.tbo = cls * NROWS + ti * 256; u.nrow = mt[32 + cls] - ti * 256;
        return true;
    }
};
struct MoeSched1 : MoeSchedBase {
    __device__ __forceinline__ bool next(int i, pg8::Unit& u) const { int ea, eb; if (!locate(i, u, ea, eb)) return false;
        const int e = (u.pn >> 1) ? eb : ea; u.a = (const char*)(ws + WS_A); u.b = (const char*)(ws + WS_W13) + ((size_t)e * 512 + (u.pn & 1) * 256) * 1024 * 2; u.bd = 0; return true; }
    __device__ __forceinline__ void a_ready(const pg8::Unit&) const {}
    __device__ __forceinline__ void done(const pg8::Unit& u) const {
        asm volatile("s_waitcnt vmcnt(0)" ::: "memory");
        if ((threadIdx.x & 63) == 0) __hip_atomic_fetch_add((unsigned*)(ws + WS_CTL) + CW_TDONE + layer * 6144 + 64 * u.pm, 1u, __ATOMIC_RELAXED, __HIP_MEMORY_SCOPE_AGENT);
    }
};
struct MoeSched2 : MoeSchedBase {
    __device__ __forceinline__ bool next(int i, pg8::Unit& u) const { int ea, eb; if (!locate(i, u, ea, eb)) return false;
        u.a = (const char*)(ws + WS_Z) + (size_t)u.pm * 256 * 512 * 2; u.b = (const char*)(ws + WS_W2) + ((size_t)ea * 1024 + u.pn * 256) * 256 * 2; u.bd = (long)(eb - ea) * 1024 * 256 * 2 - 4 * 128; return true; }
    __device__ __forceinline__ void a_ready(const pg8::Unit& u) const {
        if (threadIdx.x < 64) {
            unsigned polls = 0;
            unsigned* tw = (unsigned*)(ws + WS_CTL) + CW_TDONE + layer * 6144 + 64 * u.pm;
            while ((unsigned)__builtin_amdgcn_readfirstlane(__hip_atomic_load(tw, __ATOMIC_RELAXED, __HIP_MEMORY_SCOPE_AGENT)) < 32u) {
                if (++polls > (1u << 17)) break;
                __builtin_amdgcn_s_sleep(16); }
            __builtin_amdgcn_fence(__ATOMIC_ACQUIRE, "agent");
            asm volatile("s_waitcnt vmcnt(0)" ::: "memory");
        }
        asm volatile("" ::: "memory"); __builtin_amdgcn_s_barrier(); asm volatile("" ::: "memory");
    }
    __device__ __forceinline__ void done(const pg8::Unit&) const {}
};

struct EpiProj {
    static constexpr bool PERM = true, AFTER_DRAIN = false;
    bf16 *d0, *d1, *d2, *d3, *d4, *d5; int e0, e1, e2, e3, e4; int l0, l1, l2, l3, l4, l5; int lastcols;
    __device__ __forceinline__ void operator()(const f32x4 (&acc)[2][2][4][2], const pg8::Unit& u, int wr, int wc, int fr, int fq) const {
        const int pn = u.pn; bf16* base; int ld, tl, ncol = 256;
        if (pn < e0) { base = d0; ld = l0; tl = pn; } else if (pn < e1) { base = d1; ld = l1; tl = pn - e0; } else if (pn < e2) { base = d2; ld = l2; tl = pn - e1; }
        else if (pn < e3) { base = d3; ld = l3; tl = pn - e2; } else if (pn < e4) { base = d4; ld = l4; tl = pn - e3; } else { base = d5; ld = l5; tl = pn - e4; ncol = lastcols; }
        const int row0 = u.pm * 256 + wr * 64 + fr, col0 = wc * 32 + 8 * fq;
#pragma unroll
        for (int ai = 0; ai < 2; ++ai)
#pragma unroll
            for (int m = 0; m < 4; ++m) { bf16* rowp = base + (size_t)(row0 + ai * 128 + m * 16) * ld + tl * 256 + col0;
#pragma unroll
                for (int bj = 0; bj < 2; ++bj) { if (col0 + bj * 128 < ncol) { const f32x4 v0 = acc[ai][bj][m][0], v1 = acc[ai][bj][m][1];
                    u32x4 w; w.x = pg8::cvt_pk_bf16(v0[0], v0[1]); w.y = pg8::cvt_pk_bf16(v0[2], v0[3]); w.z = pg8::cvt_pk_bf16(v1[0], v1[1]); w.w = pg8::cvt_pk_bf16(v1[2], v1[3]);
                    *(u32x4*)(rowp + bj * 128) = w; } } }
    }
};
struct EpiRes {
    static constexpr bool PERM = false, AFTER_DRAIN = true;
    float* slab;
    const float* xin_lat; const float* xin_ctx; float* xout_lat; float* xout_ctx; const float* modbase;
    __device__ __forceinline__ void operator()(const f32x4 (&acc)[2][2][4][2], const pg8::Unit& u, int wr, int wc, int fr, int fq) const {
        if (slab) { float* sp = slab + (size_t)u.tbo * 65536 + (size_t)(wr * 64 + fr) * 256 + wc * 32 + 4 * fq;
#pragma unroll
            for (int ai = 0; ai < 2; ++ai)
#pragma unroll
                for (int m = 0; m < 4; ++m)
#pragma unroll
                    for (int bj = 0; bj < 2; ++bj)
#pragma unroll
                        for (int n = 0; n < 2; ++n) *(f32x4*)(sp + (size_t)(ai * 128 + m * 16) * 256 + bj * 128 + n * 16) = acc[ai][bj][m][n];
            return; }
        const int b = u.pm / 33, qt = u.pm - b * 33; const bool isctx = (qt == 0);
        const size_t rbase = isctx ? (size_t)b * CTXL : (size_t)b * SEQL + (size_t)(qt - 1) * 256;
        const float* xi = (isctx ? xin_ctx : xin_lat) + rbase * DM; float* xo = (isctx ? xout_ctx : xout_lat) + rbase * DM;
        const float* gate = modbase + (size_t)(isctx ? 2 : b) * 6144 + 2 * 1024;
        const int row0 = wr * 64 + fr, col0 = u.pn * 256 + wc * 32 + 4 * fq;
        f32x4 gv[2][2];
#pragma unroll
        for (int bj = 0; bj < 2; ++bj)
#pragma unroll
            for (int n = 0; n < 2; ++n) gv[bj][n] = *(const f32x4*)(gate + col0 + bj * 128 + n * 16);
#pragma unroll
        for (int ai = 0; ai < 2; ++ai)
#pragma unroll
            for (int m = 0; m < 4; ++m) { const size_t off = (size_t)(row0 + ai * 128 + m * 16) * DM + col0;
#pragma unroll
                for (int bj = 0; bj < 2; ++bj)
#pragma unroll
                    for (int n = 0; n < 2; ++n) { const f32x4 xv = *(const f32x4*)(xi + off + bj * 128 + n * 16);
                        *(f32x4*)(xo + off + bj * 128 + n * 16) = xv + gv[bj][n] * acc[ai][bj][m][n]; } }
    }
    __device__ __forceinline__ void fused(const f32x4 (&acc)[2][2][4][2], const pg8::Unit& u, int wr, int wc, int fr, int fq, LAS unsigned char* lds, int wid, int lane) const {
        if (slab) { (*this)(acc, u, wr, wc, fr, fq); return; }
        const int b = u.pm / 33, qt = u.pm - b * 33; const bool isctx = (qt == 0);
        const size_t rbase = isctx ? (size_t)b * CTXL : (size_t)b * SEQL + (size_t)(qt - 1) * 256;
        const float* xi = (isctx ? xin_ctx : xin_lat) + rbase * DM + u.pn * 256 + 4 * lane; float* xo = (isctx ? xout_ctx : xout_lat) + rbase * DM + u.pn * 256 + 4 * lane;
        const f32x4 gv = *(const f32x4*)(modbase + (size_t)(isctx ? 2 : b) * 6144 + 2 * 1024 + u.pn * 256 + 4 * lane);
        LAS float* T = (LAS float*)lds;
#pragma unroll
        for (int ai = 0; ai < 2; ++ai) {
#pragma unroll
            for (int m = 0; m < 4; ++m)
#pragma unroll
                for (int bj = 0; bj < 2; ++bj)
#pragma unroll
                    for (int n = 0; n < 2; ++n) *(LAS f32x4*)(T + (wr * 64 + m * 16 + fr) * 260 + bj * 128 + wc * 32 + n * 16 + 4 * fq) = acc[ai][bj][m][n];
            __syncthreads();
            f32x4 xv[16];
#pragma unroll
            for (int k = 0; k < 16; ++k) xv[k] = *(const f32x4*)(xi + (size_t)(ai * 128 + wid * 16 + k) * DM);
#pragma unroll
            for (int k = 0; k < 16; ++k) { const f32x4 t = *(const LAS f32x4*)(T + (wid * 16 + k) * 260 + 4 * lane); *(f32x4*)(xo + (size_t)(ai * 128 + wid * 16 + k) * DM) = xv[k] + gv * t; }
            __syncthreads();
        }
    }
};
struct EpiMoe1 {
    static constexpr bool PERM = true, AFTER_DRAIN = false;
    unsigned char* ws;
    __device__ __forceinline__ void operator()(const f32x4 (&acc)[2][2][4][2], const pg8::Unit& u, int wr, int wc, int fr, int fq) const {
        const __amdgpu_buffer_rsrc_t hr = __builtin_amdgcn_make_buffer_rsrc((void*)(ws + WS_Z), 0, MAXSLOT * 512 * 2, 0x00020000);
        const int* TBL = (const int*)(ws + WS_TBL); const int* REC = (const int*)(ws + WS_REC);
        const int rho0 = wr * 64 + fr, colh = (u.pn >> 1) * 256 + (u.pn & 1) * 128 + wc * 32 + 8 * fq, which = u.pn >> 1;
        int rr[8]; float gts[8];
#pragma unroll
        for (int k = 0; k < 8; ++k) { const int rho = rho0 + (k >> 2) * 128 + (k & 3) * 16; const int rc = rho < u.nrow ? rho : u.nrow - 1; rr[k] = TBL[u.tbo + rc]; }
#pragma unroll
        for (int k = 0; k < 8; ++k) gts[k] = __uint_as_float((unsigned)REC[(size_t)rr[k] * 4 + 2 + which]);
#pragma unroll
        for (int ai = 0; ai < 2; ++ai)
#pragma unroll
            for (int m = 0; m < 4; ++m) { const int rho = rho0 + ai * 128 + m * 16; const float gt = gts[ai * 4 + m];
                float hv[8];
#pragma unroll
                for (int n = 0; n < 2; ++n)
#pragma unroll
                    for (int e = 0; e < 4; ++e) { const float a = acc[ai][0][m][n][e], uu = acc[ai][1][m][n][e]; hv[n * 4 + e] = silu_f(a) * uu * gt; }
                u32x4 w; w.x = pg8::cvt_pk_bf16(hv[0], hv[1]); w.y = pg8::cvt_pk_bf16(hv[2], hv[3]); w.z = pg8::cvt_pk_bf16(hv[4], hv[5]); w.w = pg8::cvt_pk_bf16(hv[6], hv[7]);
                __builtin_amdgcn_raw_buffer_store_b128(w, hr, (unsigned)(((size_t)(u.pm * 256 + rho) * 512 + colh) * 2), 0, 16); }
    }
};
struct EpiMoe2 {
    static constexpr bool PERM = false, AFTER_DRAIN = false;
    float* out; unsigned char* ws; int layer;
    __device__ __forceinline__ void operator()(const f32x4 (&acc)[2][2][4][2], const pg8::Unit& u, int wr, int wc, int fr, int fq) const {
        const int rho0 = wr * 64 + fr, col0 = u.pn * 256 + wc * 32 + 4 * fq; const int* TBL = (const int*)(ws + WS_TBL); float* xc = (float*)(ws + WS_XC); const float* modbase = (const float*)(ws + WS_MOD) + (size_t)layer * 3 * 6144;
        int rr[8];
#pragma unroll
        for (int k = 0; k < 8; ++k) { const int rho = rho0 + (k >> 2) * 128 + (k & 3) * 16; rr[k] = rho < u.nrow ? TBL[u.tbo + rho] : -1; }
#pragma unroll
        for (int ai = 0; ai < 2; ++ai)
#pragma unroll
            for (int m = 0; m < 4; ++m) { const int r = rr[ai * 4 + m];
                if (r >= 0) { const int b = r / BROWS, q = r - b * BROWS; const bool isctx = q < CTXL;
                    float* xp = isctx ? xc + (size_t)(b * CTXL + q) * DM : out + (size_t)(b * SEQL + (q - CTXL)) * DM;
                    const float* gate = modbase + (size_t)(isctx ? 2 : b) * 6144 + 5 * 1024;
#pragma unroll
                    for (int bj = 0; bj < 2; ++bj)
#pragma unroll
                        for (int n = 0; n < 2; ++n) { const int c = col0 + bj * 128 + n * 16; const f32x4 gv = *(const f32x4*)(gate + c); const f32x4 xv = *(const f32x4*)(xp + c);
                            *(f32x4*)(xp + c) = xv + gv * acc[ai][bj][m][n]; } }
                if (m & 1) asm volatile("" ::: "memory"); }
    }
};

__device__ __forceinline__ void transpose_item(const float* W, int ldw, int k0, int n0src, bf16* WT, int ldt, int drow0, int dk0, LAS float* scr, int lane) {
    float tv[32];
#pragma unroll
    for (int i = 0; i < 32; ++i) { const int kk = 2 * i + (lane >> 5); tv[i] = n0src >= 0 ? W[(size_t)(k0 + kk) * ldw + n0src + (lane & 31)] : 0.f; }
#pragma unroll
    for (int i = 0; i < 32; ++i) { const int kk = 2 * i + (lane >> 5); scr[kk * 33 + (lane & 31)] = tv[i]; }
    asm volatile("s_waitcnt lgkmcnt(0)" ::: "memory");
    const int c = lane & 7;
#pragma unroll
    for (int j = 0; j < 4; ++j) { const int n = (lane >> 3) + 8 * j; const LAS float* s = scr + (8 * c) * 33 + n;
        u32x4 o; o.x = pk2(s[0 * 33], s[1 * 33]); o.y = pk2(s[2 * 33], s[3 * 33]); o.z = pk2(s[4 * 33], s[5 * 33]); o.w = pk2(s[6 * 33], s[7 * 33]);
        *(u32x4*)(WT + (size_t)(drow0 + n) * ldt + dk0 + 8 * c) = o; }
    asm volatile("s_waitcnt lgkmcnt(0)" ::: "memory");
}
__device__ __forceinline__ int ab_src_col(int n) {
    if (n < 2304) return n;
    if (n < 3840) return n + 32;
    if (n < 3872) return n - 3840 + 2304;
    return -1;
}
__device__ __forceinline__ void ph_convert(const Ctx& C, int layer, LAS unsigned char* lds) {
    const TC T = phase_tc();
    LAS float* scr = (LAS float*)(lds + T.wave * 16384);
    const int gw = C.bid * NWAVES + T.wave, NGW = C.G * NWAVES;
    bf16* Win = (bf16*)(C.ws + WS_WIN); bf16* Wout = (bf16*)(C.ws + WS_WOUT); bf16* W13 = (bf16*)(C.ws + WS_W13); bf16* W2 = (bf16*)(C.ws + WS_W2);
    const int nin = layer == 0 ? 3872 : 3584;
    const int I_IN = 16 * (nin / 32), I_OUT = 32 * 32, I_E = 16 * 128;
    const int NIT = I_IN + I_OUT + 3 * I_E;
    const float* win = C.in[layer == 0 ? I_ABIN : I_CDIN]; const float* wout = C.in[layer == 0 ? I_ABOUT : I_CDOUT];
    const int ldin = layer == 0 ? 3872 : 3584;
    for (int it = gw; it < NIT; it += NGW) {
        int r = it;
        if (r < I_IN) { const int nblk = nin / 32, kb = r / nblk, nb = r % nblk; const int src = layer == 0 ? ab_src_col(nb * 32) : nb * 32;
            transpose_item(win, ldin, kb * 64, src, Win, 1024, nb * 32, kb * 64, scr, T.lane); continue; } r -= I_IN;
        if (r < I_OUT) { const int kb = r / 32, nb = r % 32; transpose_item(wout, 1024, kb * 64, nb * 32, Wout, 2048, nb * 32, kb * 64, scr, T.lane); continue; } r -= I_OUT;
        if (r < 2 * I_E) { const int w3 = r >= I_E; if (w3) r -= I_E; const int e = r / 128, q = r % 128, kb = q / 8, nb = q % 8;
            const float* W = C.in[w3 ? I_W3 : I_W1] + (size_t)(layer * 16 + e) * 1024 * 256; const int n0 = nb * 32;
            transpose_item(W, 256, kb * 64, n0, W13 + (size_t)e * 512 * 1024, 1024, (n0 / 128) * 256 + (w3 ? 128 : 0) + (n0 % 128), kb * 64, scr, T.lane); continue; } r -= 2 * I_E;
        { const int e = r / 128, q = r % 128, kb = q / 32, nb = q % 32;
            const float* W = C.in[I_W2] + (size_t)(layer * 16 + e) * 256 * 1024;
            transpose_item(W, 1024, kb * 64, nb * 32, W2 + (size_t)e * 1024 * 256, 256, nb * 32, kb * 64, scr, T.lane); }
    }
}
__device__ __forceinline__ void ph_mod(const Ctx& C, LAS unsigned char* lds) {
    const TC T = phase_tc();
    LAS float* red = (LAS float*)lds;
    LAS float* act = red + 8 * 3 * 256;
    if (C.bid < 48) {
        for (int i = T.tid; i < 3072; i += NTHREADS) { const int v = i >> 10, d = i & 1023; act[i] = silu_f(v < 2 ? C.in[I_C][v * 1024 + d] : C.in[I_CCTX][d]); }
        __syncthreads();
    }
    for (int item = C.bid; item < 48; item += C.G) {
        const int layer = item / 24, chunk = item % 24;
        const float* W = C.in[I_WMOD] + (size_t)layer * 1024 * 6144 + chunk * 256 + T.lane * 4;
        f32x4 a0 = {0, 0, 0, 0}, a1 = a0, a2 = a0;
        const int d0 = T.wave * 128;
        for (int d = d0; d < d0 + 128; d += 8) {
            f32x4 w[8];
#pragma unroll
            for (int u = 0; u < 8; ++u) w[u] = *(const f32x4*)(W + (size_t)(d + u) * 6144);
#pragma unroll
            for (int u = 0; u < 8; ++u) { const float c0 = act[d + u], c1 = act[1024 + d + u], c2 = act[2048 + d + u]; a0 += w[u] * c0; a1 += w[u] * c1; a2 += w[u] * c2; }
        }
        __syncthreads();
#pragma unroll
        for (int e = 0; e < 4; ++e) { red[(T.wave * 3 + 0) * 256 + T.lane * 4 + e] = a0[e]; red[(T.wave * 3 + 1) * 256 + T.lane * 4 + e] = a1[e]; red[(T.wave * 3 + 2) * 256 + T.lane * 4 + e] = a2[e]; }
        __syncthreads();
        for (int o = T.tid; o < 768; o += NTHREADS) { const int v = o >> 8, j = o & 255; float s = 0.f;
#pragma unroll
            for (int w = 0; w < 8; ++w) s += red[(w * 3 + v) * 256 + j];
            C.mod(layer, v)[chunk * 256 + j] = s + C.in[I_BMOD][layer * 6144 + chunk * 256 + j]; }
        asm volatile("s_waitcnt vmcnt(0)" ::: "memory");
        __syncthreads();
        if (T.tid == 0) { __builtin_amdgcn_fence(__ATOMIC_RELEASE, "agent"); asm volatile("s_waitcnt vmcnt(0)" ::: "memory");
            __hip_atomic_fetch_add(C.ctl() + CW_MODDONE, 1u, __ATOMIC_RELAXED, __HIP_MEMORY_SCOPE_AGENT); }
    }
}
__device__ __forceinline__ void mod_wait(const Ctx& C) {
    const TC T = phase_tc();
    if (T.tid < 64) { unsigned polls = 0;
        while ((unsigned)__builtin_amdgcn_readfirstlane(__hip_atomic_load(C.ctl() + CW_MODDONE, __ATOMIC_RELAXED, __HIP_MEMORY_SCOPE_AGENT)) < 48u) { if (++polls > (1u << 17)) break; __builtin_amdgcn_s_sleep(16); }
        __builtin_amdgcn_fence(__ATOMIC_ACQUIRE, "agent"); asm volatile("s_waitcnt vmcnt(0)" ::: "memory"); }
    __syncthreads();
}
__device__ __forceinline__ void ph_prenorm(const Ctx& C, int layer) {
    const TC T = phase_tc();
    bf16* HN = (bf16*)(C.ws + WS_A);
    const float* gm = C.in[I_GMIX] + layer * 1024;
    const int gw = C.bid * NWAVES + T.wave, NGW = C.G * NWAVES;
    for (int r = gw; r < NROWS; r += NGW) {
        const float* xr = layer == 0 ? C.xin_row(r) : C.xrow(r);
        const float* md = C.mod(layer, row_mv(r));
        f32x4 v[4]; float ss = 0.f;
#pragma unroll
        for (int j = 0; j < 4; ++j) { v[j] = *(const f32x4*)(xr + 256 * j + 4 * T.lane); ss += (v[j].x * v[j].x + v[j].y * v[j].y) + (v[j].z * v[j].z + v[j].w * v[j].w); }
        const float rs = rsqrtf(wave_sum(ss) * (1.f / DM) + EPS);
#pragma unroll
        for (int j = 0; j < 4; ++j) { const int c = 256 * j + 4 * T.lane; const f32x4 g = *(const f32x4*)(gm + c), sc = *(const f32x4*)(md + 1024 + c), sh = *(const f32x4*)(md + c);
            const f32x4 h = v[j] * rs * g * (sc + 1.f) + sh;
            u32x2 w; w.x = pk2(h.x, h.y); w.y = pk2(h.z, h.w); *(u32x2*)(HN + (size_t)r * DM + c) = w; }
    }
}
__device__ __forceinline__ bool nb_valid(int r, int dk) { const int b = r / BROWS, q = r - b * BROWS; if (q < CTXL) { const int t = q + dk; return t >= 0 && t < CTXL; } const int t = q - CTXL + dk; return t >= 0 && t < SEQL; }
__device__ __forceinline__ void rope_angle(int r, int lane, float& cs, float& sn, bool& latent) {
    const int b = r / BROWS, q = r - b * BROWS; latent = q >= CTXL; const int t = q - CTXL;
    const int pos = lane < 32 ? (t >> 6) : (t & 63); const int jf = lane & 31;
    const float inv = exp2f(-(float)jf * (13.287712379549449f / 32.f));
    const float ang = (float)pos * inv; sincosf(ang, &sn, &cs);
}
__device__ __forceinline__ void ph_elem0(const Ctx& C) {
    const TC T = phase_tc();
    const bf16* RAW = (const bf16*)(C.ws + WS_RAW); bf16* XBC = (bf16*)C.out;
    float* DT = (float*)(C.ws + WS_DT);
    bf16* Q = (bf16*)(C.ws + WS_YMIX) + 1024; bf16* K = (bf16*)(C.ws + WS_K);
    const float* cw = C.in[I_SCONVW]; const float* cb = C.in[I_SCONVB];
    const int gw = C.bid * NWAVES + T.wave, NGW = C.G * NWAVES, lane = T.lane;
    { const bf16* HN = (const bf16*)(C.ws + WS_A); const bf16* Wd = (const bf16*)(C.ws + WS_WIN) + (size_t)3840 * 1024; const int l15 = lane & 15, lq = lane >> 4;
      const float bias0 = C.in[I_DTBIAS][l15], bias1 = C.in[I_DTBIAS][16 + l15];
      for (int gI = gw; gI < NROWS / 16; gI += NGW) { f32x4 a0 = {0.f, 0.f, 0.f, 0.f}, a1 = a0;
          const bf16* ap = HN + (size_t)(16 * gI + l15) * 1024 + 8 * lq; const bf16* b0p = Wd + (size_t)l15 * 1024 + 8 * lq; const bf16* b1p = Wd + (size_t)(16 + l15) * 1024 + 8 * lq;
#pragma unroll 8
          for (int ks = 0; ks < 32; ++ks) { const bf16x8 af = *(const bf16x8*)(ap + 32 * ks), f0 = *(const bf16x8*)(b0p + 32 * ks), f1 = *(const bf16x8*)(b1p + 32 * ks);
              a0 = __builtin_amdgcn_mfma_f32_16x16x32_bf16(af, f0, a0, 0, 0, 0); a1 = __builtin_amdgcn_mfma_f32_16x16x32_bf16(af, f1, a1, 0, 0, 0); }
#pragma unroll
          for (int rg = 0; rg < 4; ++rg) { const size_t ro = (size_t)(16 * gI + 4 * lq + rg) * 32; DT[ro + l15] = softplus_f(a0[rg] + bias0); DT[ro + 16 + l15] = softplus_f(a1[rg] + bias1); } } }
    for (int r = gw; r < NROWS; r += NGW) {
        for (int ch = lane; ch < 160; ch += 64) { const int c0 = ch * 8; float acc[8];
#pragma unroll
            for (int e = 0; e < 8; ++e) acc[e] = cb[c0 + e];
#pragma unroll
            for (int k = 0; k < 5; ++k) { if (nb_valid(r, k - 2)) { const u32x4 w = *(const u32x4*)(RAW + (size_t)(r + k - 2) * 1280 + c0); float xv[8]; unpack8(w, xv);
#pragma unroll
                for (int e = 0; e < 8; ++e) acc[e] += xv[e] * cw[k * 1280 + c0 + e]; } }
            u32x4 o; o.x = pk2(silu_f(acc[0]), silu_f(acc[1])); o.y = pk2(silu_f(acc[2]), silu_f(acc[3])); o.z = pk2(silu_f(acc[4]), silu_f(acc[5])); o.w = pk2(silu_f(acc[6]), silu_f(acc[7]));
            *(u32x4*)(XBC + (size_t)r * 1280 + c0) = o; }
        float cs, sn; bool latent; rope_angle(r, lane, cs, sn, latent);
        const float qg0 = C.in[I_QG][lane], qg1 = C.in[I_QG][64 + lane], kg0 = C.in[I_KG][lane], kg1 = C.in[I_KG][64 + lane];
#pragma unroll
        for (int h = 8; h < 10; ++h) { bf16* p = K + (size_t)r * 256 + (h - 8) * 128;
            float t1 = bf2f(p[lane]), t2 = bf2f(p[64 + lane]);
            const float rs = rsqrtf(wave_sum(t1 * t1 + t2 * t2) * (1.f / 128.f) + EPS);
            t1 = t1 * rs * (h < 8 ? qg0 : kg0); t2 = t2 * rs * (h < 8 ? qg1 : kg1);
            if (latent) { const float o1 = t1 * cs - t2 * sn, o2 = t1 * sn + t2 * cs; t1 = o1; t2 = o2; }
            p[lane] = (bf16)f2bf(t1); p[64 + lane] = (bf16)f2bf(t2); }
    }
}
__device__ __forceinline__ void ph_elem1(const Ctx& C) {
    const TC T = phase_tc();
    const bf16* RAW = (const bf16*)(C.ws + WS_RAW); bf16* XR = (bf16*)(C.ws + WS_A);
    bf16* Q = (bf16*)(C.ws + WS_YMIX) + 1024; bf16* K = (bf16*)(C.ws + WS_K);
    const float* cw = C.in[I_LCONVW]; const float* cb = C.in[I_LCONVB];
    const int gw = C.bid * NWAVES + T.wave, NGW = C.G * NWAVES, lane = T.lane;
    for (int r = gw; r < NROWS; r += NGW) {
        for (int ch = lane; ch < 128; ch += 64) { const int c0 = ch * 8; float acc[8];
#pragma unroll
            for (int e = 0; e < 8; ++e) acc[e] = cb[c0 + e];
#pragma unroll
            for (int k = 0; k < 5; ++k) { if (nb_valid(r, k - 2)) { const u32x4 w = *(const u32x4*)(RAW + (size_t)(r + k - 2) * 1024 + c0); float xv[8]; unpack8(w, xv);
#pragma unroll
                for (int e = 0; e < 8; ++e) acc[e] += xv[e] * cw[k * 1024 + c0 + e]; } }
            u32x4 o; o.x = pk2(acc[0], acc[1]); o.y = pk2(acc[2], acc[3]); o.z = pk2(acc[4], acc[5]); o.w = pk2(acc[6], acc[7]);
            *(u32x4*)(XR + (size_t)r * 1024 + c0) = o; }
        float cs, sn; bool latent; rope_angle(r, lane, cs, sn, latent);
        if (latent) {
#pragma unroll
            for (int h = 8; h < 10; ++h) { bf16* p = K + (size_t)r * 256 + (h - 8) * 128;
                const float t1 = bf2f(p[lane]), t2 = bf2f(p[64 + lane]);
                p[lane] = (bf16)f2bf(t1 * cs - t2 * sn); p[64 + lane] = (bf16)f2bf(t1 * sn + t2 * cs); }
        }
    }
}
__device__ __forceinline__ int chunk_of(int dir, int ci) { return dir == 0 ? ci : (ci < 2 ? 1 - ci : 67 - ci); }
__device__ __forceinline__ int step_row(int dir, int s) { return dir == 0 ? s : (s < CTXL ? CTXL - 1 - s : BROWS + CTXL - 1 - s); }
__device__ __forceinline__ void ssd_seq_unit(const Ctx& C, int item, LAS unsigned char* lds) {
    const TC T = phase_tc();
    const int b = item >> 5, dir = (item >> 4) & 1, h = item & 15, g = h >> 3, lane = T.lane, wid = T.wave;
    LAS float* part = (LAS float*)lds;
    LAS float* xs = part + 8 * 32 * 64; LAS float* Bs = xs + 32 * 64; LAS float* Cs = Bs + 32 * 64; LAS float* dts = Cs + 32 * 64;
    const float aneg = -__expf(C.in[I_ALOG][dir * 16 + h]);
    const bf16* XBC = (const bf16*)C.out + (size_t)b * BROWS * 1280;
    const float* DT = (const float*)(C.ws + WS_DT) + (size_t)b * BROWS * 32 + dir * 16 + h;
    bf16* Y = dir == 0 ? (bf16*)(C.ws + WS_YMIX) + (size_t)b * BROWS * 2048 + h * 64 : (bf16*)(C.ws + WS_RAW) + (size_t)b * BROWS * 1024 + h * 64;
    const int ldy = dir == 0 ? 2048 : 1024;
    float hs[8];
#pragma unroll
    for (int k = 0; k < 8; ++k) hs[k] = 0.f;
    for (int s0 = 0; s0 < BROWS; s0 += 32) {
        for (int i = T.tid; i < 32 * 192; i += NTHREADS) { const int tt = i / 192, c = i - tt * 192; const int q = step_row(dir, s0 + tt);
            const bf16* row = XBC + (size_t)q * 1280;
            if (c < 64) xs[tt * 64 + c] = bf2f(row[h * 64 + c]); else if (c < 128) Bs[tt * 64 + c - 64] = bf2f(row[1024 + g * 64 + c - 64]); else Cs[tt * 64 + c - 128] = bf2f(row[1152 + g * 64 + c - 128]); }
        if (T.tid < 32) dts[T.tid] = DT[(size_t)step_row(dir, s0 + T.tid) * 32];
        __syncthreads();
        for (int tt = 0; tt < 32; ++tt) {
            const float x = xs[tt * 64 + lane], dt = dts[tt];
            const f32x4 b0 = *(const LAS f32x4*)(Bs + tt * 64 + wid * 8), b1 = *(const LAS f32x4*)(Bs + tt * 64 + wid * 8 + 4);
            const f32x4 c0 = *(const LAS f32x4*)(Cs + tt * 64 + wid * 8), c1 = *(const LAS f32x4*)(Cs + tt * 64 + wid * 8 + 4);
            const float a = __expf(dt * aneg), dx = dt * x; float y = 0.f;
#pragma unroll
            for (int k = 0; k < 4; ++k) { hs[k] = a * hs[k] + dx * b0[k]; y += c0[k] * hs[k]; }
#pragma unroll
            for (int k = 0; k < 4; ++k) { hs[4 + k] = a * hs[4 + k] + dx * b1[k]; y += c1[k] * hs[4 + k]; }
            part[(wid * 32 + tt) * 64 + lane] = y;
        }
        __syncthreads();
        for (int i = T.tid; i < 2048; i += NTHREADS) { const int tt = i >> 6, p = i & 63; float s = 0.f;
#pragma unroll
            for (int w = 0; w < 8; ++w) s += part[(w * 32 + tt) * 64 + p];
            const int q = step_row(dir, s0 + tt); Y[(size_t)q * ldy + p] = (bf16)f2bf(s); }
        __syncthreads();
    }
}

__device__ __forceinline__ int ssd_seg_begin(int s) { return s == 0 ? 0 : (s == 1 ? 17 : (s == 2 ? 34 : (s == 3 ? 50 : 66))); }
__device__ __forceinline__ unsigned short hw_bf16(float x) { unsigned r; asm volatile("v_cvt_pk_bf16_f32 %0, %1, %1" : "=v"(r) : "v"(x)); return (unsigned short)r; }
__device__ __forceinline__ int tswz(int row, int col) { return row * 136 + ((((col >> 3) ^ ((row >> 3) & 7)) << 3) | (col & 7)); }
template <int MODE>
__device__ __forceinline__ void ssd_chunk_unit(const Ctx& C, int item, int seg, LAS unsigned char* lds) {
    const TC T = phase_tc();
    const int b = item >> 5, dir = (item >> 4) & 1, h = item & 15, g = h >> 3, lane = T.lane, wid = T.wave, tid = T.tid;
    const int ci0 = ssd_seg_begin(seg), ci1 = ssd_seg_begin(seg + 1);
    float* SEND = (float*)(C.ws + WS_SSDST) + (size_t)item * 3 * 4096; float* SLD = (float*)(C.ws + WS_SSDLD) + item * 3;
    const int l15 = lane & 15, lq = lane >> 4;
    LAS bf16* Cs = (LAS bf16*)lds;
    LAS bf16* Bs = Cs + 128 * 72;
    LAS bf16* Xt = Bs + 128 * 72;
    LAS bf16* Bwt = Xt + 64 * 136;
    LAS bf16* Ws = Bwt + 64 * 136;
    LAS bf16* Hs = Ws + 128 * 136;
    LAS float* acs = (LAS float*)(Hs + 64 * 72); LAS float* dtv = acs + 128; LAS float* eacs = dtv + 128; LAS float* wend = eacs + 128;
    const float aneg = -__expf(C.in[I_ALOG][dir * 16 + h]);
    const bf16* XBC = (const bf16*)C.out + (size_t)b * BROWS * 1280;
    const float* DT = (const float*)(C.ws + WS_DT) + (size_t)b * BROWS * 32 + dir * 16 + h;
    bf16* Y = dir == 0 ? (bf16*)(C.ws + WS_YMIX) + (size_t)b * BROWS * 2048 + h * 64 : (bf16*)(C.ws + WS_RAW) + (size_t)b * BROWS * 1024 + h * 64;
    const int ldy = dir == 0 ? 2048 : 1024;
    f32x4 Hacc[2]; Hacc[0] = (f32x4){0.f, 0.f, 0.f, 0.f}; Hacc[1] = Hacc[0];
    float ldsum = 0.f;
    if (MODE == 1) {
        for (int sp = 0; sp < seg; ++sp) { const float dseg = __expf(SLD[sp]);
#pragma unroll
            for (int t = 0; t < 2; ++t) { const int tl = 2 * wid + t, nt_ = tl >> 2, pt = tl & 3;
                const f32x4 sv = *(const f32x4*)(SEND + (size_t)sp * 4096 + (16 * pt + l15) * 64 + 16 * nt_ + 4 * lq); Hacc[t] = Hacc[t] * dseg + sv; } }
#pragma unroll
        for (int t = 0; t < 2; ++t) { const int tl = 2 * wid + t, nt_ = tl >> 2, pt = tl & 3;
            u32x2 w; w.x = pg8::cvt_pk_bf16(Hacc[t][0], Hacc[t][1]); w.y = pg8::cvt_pk_bf16(Hacc[t][2], Hacc[t][3]); *(LAS u32x2*)(Hs + (16 * pt + l15) * 72 + 16 * nt_ + 4 * lq) = w; }
    }
    u32x4 xb[4], bb[2], cb[2]; float dt0 = 0.f, dt1 = 0.f;
    const int xtg = tid >> 3, xpg = tid & 7;
#define SSD_ROW(q0_, i_) (XBC + (size_t)(dir == 0 ? (q0_) + (i_) : (q0_) + 127 - (i_)) * 1280)
#define SSD_LOAD(q0_) do { \
        if (tid < 256) { _Pragma("unroll") for (int q_ = 0; q_ < 4; ++q_) xb[q_] = *(const u32x4*)(SSD_ROW(q0_, 4 * xtg + q_) + h * 64 + 8 * xpg); } \
        _Pragma("unroll") for (int k = 0; k < 2; ++k) { const int pidx = tid + 512 * k, i_ = pidx >> 3, c8_ = (pidx & 7) * 8; \
            bb[k] = *(const u32x4*)(SSD_ROW(q0_, i_) + 1024 + g * 64 + c8_); if (MODE == 1) cb[k] = *(const u32x4*)(SSD_ROW(q0_, i_) + 1152 + g * 64 + c8_); } \
        if (wid == 0) { dt0 = DT[(size_t)(dir == 0 ? (q0_) + 2 * lane : (q0_) + 127 - 2 * lane) * 32]; dt1 = DT[(size_t)(dir == 0 ? (q0_) + 2 * lane + 1 : (q0_) + 126 - 2 * lane) * 32]; } } while (0)
    SSD_LOAD(chunk_of(dir, ci0) * 128);
    for (int ci = ci0; ci < ci1; ++ci) {
        const int q0 = chunk_of(dir, ci) * 128;
        __syncthreads();
        if (wid == 0) {
            const float a0 = dt0 * aneg, a1 = dt1 * aneg; float v = a0 + a1;
#pragma unroll
            for (int o = 1; o < 64; o <<= 1) { const float t = __shfl_up(v, o); if (lane >= o) v += t; }
            const float tot = __shfl(v, 63), c0 = v - a1;
            acs[2 * lane] = c0; acs[2 * lane + 1] = v; dtv[2 * lane] = dt0; dtv[2 * lane + 1] = dt1;
            eacs[2 * lane] = __expf(c0); eacs[2 * lane + 1] = __expf(v);
            wend[2 * lane] = __expf(tot - c0) * dt0; wend[2 * lane + 1] = __expf(tot - v) * dt1; }
        if (tid < 256) {
#pragma unroll
            for (int m = 0; m < 4; ++m) { const unsigned w0 = xb[0][m], w1 = xb[1][m], w2 = xb[2][m], w3 = xb[3][m];
                u32x2 lo, hi; lo.x = (w0 & 0xffffu) | (w1 << 16); lo.y = (w2 & 0xffffu) | (w3 << 16); hi.x = (w0 >> 16) | (w1 & 0xffff0000u); hi.y = (w2 >> 16) | (w3 & 0xffff0000u);
                *(LAS u32x2*)(Xt + tswz(8 * xpg + 2 * m, 4 * xtg)) = lo; *(LAS u32x2*)(Xt + tswz(8 * xpg + 2 * m + 1, 4 * xtg)) = hi; } }
#pragma unroll
        for (int k = 0; k < 2; ++k) { const int pidx = tid + 512 * k, i_ = pidx >> 3, c8_ = (pidx & 7) * 8;
            *(LAS u32x4*)(Bs + i_ * 72 + c8_) = bb[k]; if (MODE == 1) *(LAS u32x4*)(Cs + i_ * 72 + c8_) = cb[k]; }
        if (ci + 1 < ci1) SSD_LOAD(chunk_of(dir, ci + 1) * 128);
        __syncthreads();
        const float al = acs[127], dchunk = __expf(al); ldsum += al;
        if (tid < 256) { float f[4][8];
#pragma unroll
            for (int q_ = 0; q_ < 4; ++q_) { const u32x4 w = *(const LAS u32x4*)(Bs + (4 * xtg + q_) * 72 + 8 * xpg); unpack8(w, f[q_]); const float we = wend[4 * xtg + q_];
#pragma unroll
                for (int e = 0; e < 8; ++e) f[q_][e] *= we; }
#pragma unroll
            for (int e = 0; e < 8; ++e) { u32x2 w; w.x = pg8::cvt_pk_bf16(f[0][e], f[1][e]); w.y = pg8::cvt_pk_bf16(f[2][e], f[3][e]); *(LAS u32x2*)(Bwt + tswz(8 * xpg + e, 4 * xtg)) = w; } }
        if (MODE == 1) {
            for (int t = wid; t < 40; t += 8) {
                if (t >= 36) { const int rt = 2 * (t - 36);
                    *(LAS u32x2*)(Ws + (16 * rt + l15) * 136 + 16 * (rt + 1) + 4 * lq) = (u32x2){0u, 0u};
                    continue; }
                int rt = 0, base = 0; while (base + rt + 1 <= t) { base += rt + 1; ++rt; }
                const int ct = t - base;
                f32x4 acc = (f32x4){0.f, 0.f, 0.f, 0.f};
#pragma unroll
                for (int kk = 0; kk < 2; ++kk) { const bf16x8 af = *(const LAS bf16x8*)(Bs + (16 * ct + l15) * 72 + kk * 32 + 8 * lq), bfr = *(const LAS bf16x8*)(Cs + (16 * rt + l15) * 72 + kk * 32 + 8 * lq);
                    acc = __builtin_amdgcn_mfma_f32_16x16x32_bf16(af, bfr, acc, 0, 0, 0); }
                const int i = 16 * rt + l15; const float ai = acs[i];
                const f32x4 aj = *(const LAS f32x4*)(acs + 16 * ct + 4 * lq), dj = *(const LAS f32x4*)(dtv + 16 * ct + 4 * lq);
                float val[4];
#pragma unroll
                for (int rg = 0; rg < 4; ++rg) { const int j = 16 * ct + 4 * lq + rg; val[rg] = j <= i ? acc[rg] * __expf(ai - aj[rg]) * dj[rg] : 0.f; }
                u32x2 w; w.x = pg8::cvt_pk_bf16(val[0], val[1]); w.y = pg8::cvt_pk_bf16(val[2], val[3]); *(LAS u32x2*)(Ws + i * 136 + 16 * ct + 4 * lq) = w; }
        }
        __syncthreads();
        if (MODE == 1) { const int it = wid; f32x4 acc[4];
#pragma unroll
          for (int pt = 0; pt < 4; ++pt) acc[pt] = (f32x4){0.f, 0.f, 0.f, 0.f};
#pragma unroll
          for (int kk = 0; kk < 2; ++kk) { const bf16x8 bfr = *(const LAS bf16x8*)(Cs + (16 * it + l15) * 72 + kk * 32 + 8 * lq);
#pragma unroll
              for (int pt = 0; pt < 4; ++pt) { const bf16x8 af = *(const LAS bf16x8*)(Hs + (16 * pt + l15) * 72 + kk * 32 + 8 * lq); acc[pt] = __builtin_amdgcn_mfma_f32_16x16x32_bf16(af, bfr, acc[pt], 0, 0, 0); } }
          const float ea = eacs[16 * it + l15];
#pragma unroll
          for (int pt = 0; pt < 4; ++pt) acc[pt] = acc[pt] * ea;
          for (int ks = 0; ks <= (it >> 1); ++ks) { const bf16x8 bfr = *(const LAS bf16x8*)(Ws + (16 * it + l15) * 136 + ks * 32 + 8 * lq);
#pragma unroll
              for (int pt = 0; pt < 4; ++pt) { const bf16x8 af = *(const LAS bf16x8*)(Xt + tswz(16 * pt + l15, ks * 32 + 8 * lq)); acc[pt] = __builtin_amdgcn_mfma_f32_16x16x32_bf16(af, bfr, acc[pt], 0, 0, 0); } }
          { const int i = 16 * it + l15; const int q = dir == 0 ? q0 + i : q0 + 127 - i;
#pragma unroll
            for (int pt = 0; pt < 4; ++pt) { u32x2 w; w.x = pg8::cvt_pk_bf16(acc[pt][0], acc[pt][1]); w.y = pg8::cvt_pk_bf16(acc[pt][2], acc[pt][3]); *(u32x2*)(Y + (size_t)q * ldy + 16 * pt + 4 * lq) = w; } } }
#pragma unroll
        for (int t = 0; t < 2; ++t) { const int tl = 2 * wid + t, nt_ = tl >> 2, pt = tl & 3; Hacc[t] = Hacc[t] * dchunk;
#pragma unroll
            for (int ks = 0; ks < 4; ++ks) { const bf16x8 af = *(const LAS bf16x8*)(Bwt + tswz(16 * nt_ + l15, ks * 32 + 8 * lq)), bfr = *(const LAS bf16x8*)(Xt + tswz(16 * pt + l15, ks * 32 + 8 * lq));
                Hacc[t] = __builtin_amdgcn_mfma_f32_16x16x32_bf16(af, bfr, Hacc[t], 0, 0, 0); } }
        if (MODE == 1) {
        __syncthreads();
#pragma unroll
        for (int t = 0; t < 2; ++t) { const int tl = 2 * wid + t, nt_ = tl >> 2, pt = tl & 3;
            u32x2 w; w.x = pg8::cvt_pk_bf16(Hacc[t][0], Hacc[t][1]); w.y = pg8::cvt_pk_bf16(Hacc[t][2], Hacc[t][3]); *(LAS u32x2*)(Hs + (16 * pt + l15) * 72 + 16 * nt_ + 4 * lq) = w; }
        }
    }
    if (MODE == 0) {
#pragma unroll
        for (int t = 0; t < 2; ++t) { const int tl = 2 * wid + t, nt_ = tl >> 2, pt = tl & 3;
            *(f32x4*)(SEND + (size_t)seg * 4096 + (16 * pt + l15) * 64 + 16 * nt_ + 4 * lq) = Hacc[t]; }
        if (tid == 0) SLD[seg] = ldsum;
    }
    __syncthreads();
#undef SSD_ROW
#undef SSD_LOAD
}

__device__ __forceinline__ void lru_seq_unit(const Ctx& C, int item, LAS unsigned char* lds) {
    const TC T = phase_tc();
    const int b = item >> 5, dir = (item >> 4) & 1, hb = item & 15, lane = T.lane, wid = T.wave;
    LAS float* wa = (LAS float*)lds; LAS float* wx = wa + 4096; LAS float* xs = wx + 4096; LAS float* as_ = xs + 512; LAS float* bs_ = as_ + 512;
    const float* gwa = C.in[I_LWA] + (size_t)(dir * 16 + hb) * 4096; const float* gwx = C.in[I_LWX] + (size_t)(dir * 16 + hb) * 4096;
    for (int i = T.tid; i < 4096; i += NTHREADS) { wa[i] = gwa[i]; wx[i] = gwx[i]; }
    const int c = hb * 64 + lane;
    const float ba = C.in[I_LBA][dir * 1024 + c], bx = C.in[I_LBX][dir * 1024 + c], logbase = -8.f * softplus_f(-C.in[I_LAM][dir * 1024 + c]);
    const bf16* XR = (const bf16*)(C.ws + WS_A) + (size_t)b * BROWS * 1024 + hb * 64;
    bf16* Y = dir == 0 ? (bf16*)(C.ws + WS_YMIX) + (size_t)b * BROWS * 2048 + hb * 64 : (bf16*)(C.ws + WS_RAW) + (size_t)b * BROWS * 1024 + hb * 64;
    const int ldy = dir == 0 ? 2048 : 1024;
    float hst = 0.f;
    __syncthreads();
    unsigned short xnext = XR[(size_t)step_row(dir, wid) * 1024 + lane];
    for (int it = 0; it < BROWS / 8; ++it) {
        const float xv = bf2f(xnext);
        if (it + 1 < BROWS / 8) xnext = XR[(size_t)step_row(dir, (it + 1) * 8 + wid) * 1024 + lane];
        xs[wid * 64 + lane] = xv;
        asm volatile("s_waitcnt lgkmcnt(0)" ::: "memory");
        float pa = ba, px = bx;
#pragma unroll 8
        for (int i = 0; i < 64; ++i) { const float xi = xs[wid * 64 + i]; pa += xi * wa[i * 64 + lane]; px += xi * wx[i * 64 + lane]; }
        const float la = logbase * sigmoid_f(pa), a = __expf(la), bc = sqrtf(-expm1f(2.f * la)) * sigmoid_f(px) * xv;
        as_[wid * 64 + lane] = a; bs_[wid * 64 + lane] = bc;
        __syncthreads();
        if (wid == 0) {
#pragma unroll
            for (int tt = 0; tt < 8; ++tt) { hst = as_[tt * 64 + lane] * hst + bs_[tt * 64 + lane]; const int q2 = step_row(dir, it * 8 + tt); Y[(size_t)q2 * ldy + lane] = (bf16)f2bf(hst); }
        }
        __syncthreads();
    }
}

__device__ __forceinline__ float fast_sigmoid(float x) { return __builtin_amdgcn_rcpf(1.f + __expf(-x)); }
__device__ __forceinline__ void lru_chunk_unit(const Ctx& C, int item4, LAS unsigned char* lds) {
    const TC T = phase_tc();
    const int item = item4 >> 2, qc = item4 & 3;
    const int b = item >> 5, dir = (item >> 4) & 1, hb = item & 15, lane = T.lane, wid = T.wave, tid = T.tid;
    LAS bf16* xs0 = (LAS bf16*)lds;
    LAS bf16* wT = (LAS bf16*)(lds + 36864);
    LAS float* sWP = (LAS float*)(lds + 36864 + 4608);
    LAS float* sWH = sWP + 128;
    const float* gwa = C.in[I_LWA] + (size_t)(dir * 16 + hb) * 4096; const float* gwx = C.in[I_LWX] + (size_t)(dir * 16 + hb) * 4096;
    for (int i = tid; i < 1024; i += NTHREADS) { const int ii = i >> 4, j = i & 15; wT[j * 72 + ii] = (bf16)f2bf(gwa[ii * 64 + qc * 16 + j]); wT[16 * 72 + j * 72 + ii] = (bf16)f2bf(gwx[ii * 64 + qc * 16 + j]); }
    const int l15 = lane & 15, lq = lane >> 4;
    const int c = hb * 64 + qc * 16 + l15;
    const float ba = C.in[I_LBA][dir * 1024 + c], bx = C.in[I_LBX][dir * 1024 + c], lb = -8.f * softplus_f(-C.in[I_LAM][dir * 1024 + c]);
    float hst = 0.f;
    const bf16* XR = (const bf16*)(C.ws + WS_A) + (size_t)b * BROWS * 1024 + hb * 64;
    bf16* Y = dir == 0 ? (bf16*)(C.ws + WS_YMIX) + (size_t)b * BROWS * 2048 + hb * 64 + qc * 16 : (bf16*)(C.ws + WS_RAW) + (size_t)b * BROWS * 1024 + hb * 64 + qc * 16;
    const int ldy = dir == 0 ? 2048 : 1024;
    const int pr0 = tid >> 3, pc = (tid & 7) * 8;
    u32x4 st0, st1;
    { const int q0 = chunk_of(dir, 0) * 128; const int qa = dir == 0 ? q0 + pr0 : q0 + 127 - pr0, qb = dir == 0 ? q0 + pr0 + 64 : q0 + 63 - pr0;
      st0 = *(const u32x4*)(XR + (size_t)qa * 1024 + pc); st1 = *(const u32x4*)(XR + (size_t)qb * 1024 + pc); }
    __syncthreads();
    for (int ci = 0; ci < 66; ++ci) {
        const int q0 = chunk_of(dir, ci) * 128;
        LAS bf16* xs = xs0 + (ci & 1) * (128 * 72);
        *(LAS u32x4*)(xs + pr0 * 72 + pc) = st0; *(LAS u32x4*)(xs + (pr0 + 64) * 72 + pc) = st1;
        if (ci + 1 < 66) { const int qn = chunk_of(dir, ci + 1) * 128; const int qa = dir == 0 ? qn + pr0 : qn + 127 - pr0, qb = dir == 0 ? qn + pr0 + 64 : qn + 63 - pr0;
            st0 = *(const u32x4*)(XR + (size_t)qa * 1024 + pc); st1 = *(const u32x4*)(XR + (size_t)qb * 1024 + pc); }
        __syncthreads();
        f32x4 ga = (f32x4){0.f, 0.f, 0.f, 0.f}, gx = ga;
#pragma unroll
        for (int kk = 0; kk < 2; ++kk) { const bf16x8 af = *(const LAS bf16x8*)(xs + (16 * wid + l15) * 72 + kk * 32 + 8 * lq);
            const bf16x8 b0 = *(const LAS bf16x8*)(wT + l15 * 72 + kk * 32 + 8 * lq), b1 = *(const LAS bf16x8*)(wT + 16 * 72 + l15 * 72 + kk * 32 + 8 * lq);
            ga = __builtin_amdgcn_mfma_f32_16x16x32_bf16(af, b0, ga, 0, 0, 0); gx = __builtin_amdgcn_mfma_f32_16x16x32_bf16(af, b1, gx, 0, 0, 0); }
        float p = 1.f, hh = 0.f;
#pragma unroll
        for (int rg = 0; rg < 4; ++rg) { const int i = 16 * wid + 4 * lq + rg;
            const float la = lb * fast_sigmoid(ga[rg] + ba), a = __expf(la), xv = bf2f(xs[i * 72 + qc * 16 + l15]);
            const float x2 = 2.f * la, oms = -x2 * (1.f + 0.5f * x2 * (1.f + (1.f / 3.f) * x2 * (1.f + 0.25f * x2 * (1.f + 0.2f * x2)))), om = x2 < -0.4f ? 1.f - a * a : oms;
            const float bc = __builtin_amdgcn_sqrtf(om) * fast_sigmoid(gx[rg] + bx) * xv;
            hh = a * hh + bc; p *= a; ga[rg] = p; gx[rg] = hh; }
        { const float pp = __shfl_up(p, 16), hp = __shfl_up(hh, 16); if (lq >= 1) { hh = p * hp + hh; p = pp * p; } }
        { const float pp = __shfl_up(p, 32), hp = __shfl_up(hh, 32); if (lq >= 2) { hh = p * hp + hh; p = pp * p; } }
        const float pe_ = __shfl_up(p, 16), he_ = __shfl_up(hh, 16);
        const float Pe = lq >= 1 ? pe_ : 1.f, He = lq >= 1 ? he_ : 0.f;
        if (lq == 3) { sWP[l15 * 8 + wid] = p; sWH[l15 * 8 + wid] = hh; }
        __syncthreads();
        { const f32x4 p0 = *(const LAS f32x4*)(sWP + l15 * 8), p1 = *(const LAS f32x4*)(sWP + l15 * 8 + 4), h0 = *(const LAS f32x4*)(sWH + l15 * 8), h1 = *(const LAS f32x4*)(sWH + l15 * 8 + 4);
            float cin = hst, cw = hst;
#pragma unroll
            for (int w = 0; w < 8; ++w) { if (w == wid) cw = cin; const float pw = w < 4 ? p0[w & 3] : p1[w & 3], hw = w < 4 ? h0[w & 3] : h1[w & 3]; cin = pw * cin + hw; }
            hst = cin;
            const float cl = Pe * cw + He;
#pragma unroll
            for (int rg = 0; rg < 4; ++rg) { const int i = 16 * wid + 4 * lq + rg; const int q = dir == 0 ? q0 + i : q0 + 127 - i;
                Y[(size_t)q * ldy + l15] = hw_bf16(gx[rg] + ga[rg] * cl); } }
    }
    __syncthreads();
}

__device__ __forceinline__ int queue_pop(const Ctx& C, unsigned* qword, LAS unsigned char* lds) {
    const TC T = phase_tc();
    LAS int* slot = (LAS int*)(lds + LDS_BYTES - 64);
    __syncthreads();
    if (T.tid == 0) slot[0] = (int)atomicAdd(qword, 1u);
    __syncthreads();
    const int v = slot[0];
    return __builtin_amdgcn_readfirstlane(v);
}
__device__ __forceinline__ void ph_ssdpre(const Ctx& C, LAS unsigned char* lds) {
    for (int u = C.bid; u < 192; u += C.G) ssd_chunk_unit<0>(C, u / 3, u % 3, lds);
}
__device__ __forceinline__ void ph_mix0(const Ctx& C, LAS unsigned char* lds, char* ldsg) {
    bf16* YM = (bf16*)(C.ws + WS_YMIX); const bf16* K = (const bf16*)(C.ws + WS_K); const bf16* V = (const bf16*)(C.ws + WS_V);
    for (;;) {
        const int item = queue_pop(C, C.ctl() + CW_Q0, lds);
        if (item >= 256 + 512 + 16) break;
#ifdef SPLIT_MIX0
        if (item < 256) continue;
#else
        if (item < 256) { ssd_chunk_unit<1>(C, item >> 2, item & 3, lds); continue; }
#endif
        const int a = item - 256;
        if (a >= 16) { const int a1 = a - 16, hr = a1 & 3, qb = (a1 >> 2) & 31, kvh = (a1 >> 7) & 1, b = a1 >> 8, h = kvh * 4 + hr;
            bf16* Qb = YM + ((size_t)b * BROWS + CTXL + (size_t)qb * 256) * 2048 + 1024 + h * 128;
            att::attn_body<0>(Qb, K + (size_t)b * BROWS * 256 + kvh * 128, V + (size_t)b * BROWS * 256 + kvh * 128, Qb, BROWS / 64, 0, 0, 0.f, ldsg, C.in[I_QG], qb * 256);
        } else { const int b = a >> 3, h = a & 7, kvh = h >> 2;
            bf16* Qb = YM + ((size_t)b * BROWS) * 2048 + 1024 + h * 128;
            att::attn_body<0>(Qb, K + (size_t)b * BROWS * 256 + kvh * 128, V + (size_t)b * BROWS * 256 + kvh * 128, Qb, CTXL / 64, 0, 0, 0.f, ldsg, C.in[I_QG], -1);
        }
    }
}
__device__ __forceinline__ void ph_mix1(const Ctx& C, LAS unsigned char* lds, char* ldsg) {
    bf16* YM = (bf16*)(C.ws + WS_YMIX); const bf16* K = (const bf16*)(C.ws + WS_K); const bf16* V = (const bf16*)(C.ws + WS_V);
    for (;;) {
        const int item = queue_pop(C, C.ctl() + CW_Q1, lds);
        if (item >= 256 + 512) break;
        if (item < 256) { lru_chunk_unit(C, item, lds); continue; }
        const int a = item - 256, hr = a & 3, qb = (a >> 2) & 31, kvh = (a >> 7) & 1, b = a >> 8, h = kvh * 4 + hr;
        const int q0 = qb * 256, lo = q0 - 128 < 0 ? 0 : q0 - 128, hi_ = q0 + 384 > SEQL ? SEQL : q0 + 384;
        bf16* Qb = YM + ((size_t)b * BROWS + CTXL + (size_t)q0) * 2048 + 1024 + h * 128;
        att::attn_body<1>(Qb, K + (size_t)b * BROWS * 256 + kvh * 128, V + (size_t)b * BROWS * 256 + kvh * 128, Qb, 4 + (hi_ - lo) / 64, CTXL + lo, q0, C.in[I_SINK][h], ldsg, nullptr, q0);
    }
}
__device__ __forceinline__ void ph_ssdpost(const Ctx& C) {
    const TC T = phase_tc();
    bf16* YM = (bf16*)(C.ws + WS_YMIX); const bf16* YB = (const bf16*)(C.ws + WS_RAW); const bf16* XBC = (const bf16*)C.out; const bf16* Z = (const bf16*)(C.ws + WS_Z);
    const int gw = C.bid * NWAVES + T.wave, NGW = C.G * NWAVES, lane = T.lane;
    for (int r = gw; r < NROWS; r += NGW) {
        float v[16]; float ss = 0.f;
#pragma unroll
        for (int j = 0; j < 2; ++j) { const int c0 = j * 512 + lane * 8;
            const u32x4 wy = *(const u32x4*)(YM + (size_t)r * 2048 + c0), wb = *(const u32x4*)(YB + (size_t)r * 1024 + c0), wx = *(const u32x4*)(XBC + (size_t)r * 1280 + c0), wz = *(const u32x4*)(Z + (size_t)r * 1024 + c0);
            float fy[8], fb[8], fx[8], fz[8]; unpack8(wy, fy); unpack8(wb, fb); unpack8(wx, fx); unpack8(wz, fz);
            const float dsk = C.in[I_SSDD][c0 >> 6];
#pragma unroll
            for (int e = 0; e < 8; ++e) { const float y = (fy[e] + fb[e] + dsk * fx[e]) * silu_f(fz[e]); v[j * 8 + e] = y; ss += y * y; } }
        const float rs = rsqrtf(wave_sum(ss) * (1.f / 1024.f) + EPS);
#pragma unroll
        for (int j = 0; j < 2; ++j) { const int c0 = j * 512 + lane * 8; const float* ng = C.in[I_SNORMG] + c0;
            u32x4 o; o.x = pk2(v[j * 8 + 0] * rs * ng[0], v[j * 8 + 1] * rs * ng[1]); o.y = pk2(v[j * 8 + 2] * rs * ng[2], v[j * 8 + 3] * rs * ng[3]);
            o.z = pk2(v[j * 8 + 4] * rs * ng[4], v[j * 8 + 5] * rs * ng[5]); o.w = pk2(v[j * 8 + 6] * rs * ng[6], v[j * 8 + 7] * rs * ng[7]);
            *(u32x4*)(YM + (size_t)r * 2048 + c0) = o; }
    }
}
__device__ __forceinline__ void ph_lrupost(const Ctx& C) {
    const TC T = phase_tc();
    bf16* YM = (bf16*)(C.ws + WS_YMIX); const bf16* YB = (const bf16*)(C.ws + WS_RAW); const bf16* GT = (const bf16*)(C.ws + WS_Z);
    const int gw = C.bid * NWAVES + T.wave, NGW = C.G * NWAVES, lane = T.lane;
    for (int r = gw; r < NROWS; r += NGW) {
        if (r % BROWS < CTXL) continue;
#pragma unroll
        for (int j = 0; j < 2; ++j) { const int c0 = j * 512 + lane * 8;
            const u32x4 wy = *(const u32x4*)(YM + (size_t)r * 2048 + c0), wb = *(const u32x4*)(YB + (size_t)r * 1024 + c0), wg = *(const u32x4*)(GT + (size_t)r * 1024 + c0);
            float fy[8], fb[8], fg[8], o[8]; unpack8(wy, fy); unpack8(wb, fb); unpack8(wg, fg);
#pragma unroll
            for (int e = 0; e < 8; ++e) o[e] = gelu_tanh_f(fg[e]) * (fy[e] + fb[e]);
            u32x4 w; w.x = pk2(o[0], o[1]); w.y = pk2(o[2], o[3]); w.z = pk2(o[4], o[5]); w.w = pk2(o[6], o[7]);
            *(u32x4*)(YM + (size_t)r * 2048 + c0) = w; }
    }
}
__device__ __forceinline__ void ph_route(const Ctx& C, int layer, LAS unsigned char* lds) {
    const TC T = phase_tc();
    LAS float* Wt = (LAS float*)lds;
    const float* wg = C.in[I_WGRP] + (size_t)layer * 1024 * 4; const float* wr = C.in[I_WRT] + (size_t)layer * 1024 * 16;
    for (int i = T.tid; i < 4096; i += NTHREADS) Wt[(i & 3) * 1028 + (i >> 2)] = wg[i];
    for (int i = T.tid; i < 16384; i += NTHREADS) Wt[(4 + (i & 15)) * 1028 + (i >> 4)] = wr[i];
    __syncthreads();
    bf16* HN2 = (bf16*)(C.ws + WS_A); int* REC = (int*)(C.ws + WS_REC); int* TBL = (int*)(C.ws + WS_TBL);
    unsigned* cnt = C.ctl() + CW_CNT + layer * 2048;
    const float* gf = C.in[I_GFFN] + layer * 1024;
    const int gw = C.bid * NWAVES + T.wave, NGW = C.G * NWAVES, lane = T.lane;
    for (int r = gw; r < NROWS; r += NGW) {
        if (layer == 1 && (r % BROWS) < CTXL) continue;
        float* xr = C.xrow(r); const float* md = C.mod(layer, row_mv(r));
        f32x4 v[4]; float ss = 0.f;
        if (layer == 0 && (r % BROWS) < CTXL) { const int b_ = r / BROWS, q_ = r - b_ * BROWS; const float* xi = C.in[I_CTX] + (size_t)(b_ * CTXL + q_) * DM; const float* sl = (const float*)(C.ws + WS_RAW);
#pragma unroll
            for (int j = 0; j < 4; ++j) { const float* sp = sl + (size_t)((b_ * 4 + j) * 4) * 65536 + (size_t)q_ * 256 + 4 * lane;
                const f32x4 part = (*(const f32x4*)sp + *(const f32x4*)(sp + 65536)) + (*(const f32x4*)(sp + 2 * 65536) + *(const f32x4*)(sp + 3 * 65536));
                const f32x4 x1 = *(const f32x4*)(xi + 256 * j + 4 * lane) + *(const f32x4*)(md + 2 * 1024 + 256 * j + 4 * lane) * part;
                *(f32x4*)(xr + 256 * j + 4 * lane) = x1; } }
#pragma unroll
        for (int j = 0; j < 4; ++j) { v[j] = *(const f32x4*)(xr + 256 * j + 4 * lane); ss += (v[j].x * v[j].x + v[j].y * v[j].y) + (v[j].z * v[j].z + v[j].w * v[j].w); }
        const float rs = rsqrtf(wave_sum(ss) * (1.f / DM) + EPS);
#pragma unroll
        for (int j = 0; j < 4; ++j) { const int c = 256 * j + 4 * lane; const f32x4 g = *(const f32x4*)(gf + c), sc = *(const f32x4*)(md + 4 * 1024 + c), sh = *(const f32x4*)(md + 3 * 1024 + c);
            v[j] = v[j] * rs * g * (sc + 1.f) + sh;
            u32x2 w; w.x = pk2(v[j].x, v[j].y); w.y = pk2(v[j].z, v[j].w); *(u32x2*)(HN2 + (size_t)r * DM + c) = w; }
        float lg[20];
#pragma unroll
        for (int o = 0; o < 20; ++o) { float s = 0.f;
#pragma unroll
            for (int j = 0; j < 4; ++j) { const f32x4 w = *(const LAS f32x4*)(Wt + o * 1028 + 256 * j + 4 * lane); s += (v[j].x * w.x + v[j].y * w.y) + (v[j].z * w.z + v[j].w * w.w); }
            lg[o] = wave_sum(s); }
        float gl[4];
#pragma unroll
        for (int k = 0; k < 4; ++k) gl[k] = lg[k] + C.in[I_BGRP][layer * 4 + k];
        int gi = 0; float gmx = gl[0];
#pragma unroll
        for (int k = 1; k < 4; ++k) if (gl[k] > gmx) { gmx = gl[k]; gi = k; }
        float den = 0.f;
#pragma unroll
        for (int k = 0; k < 4; ++k) den += __expf(gl[k] - gmx);
        const float pgrp = 1.f / den;
        float el[4];
#pragma unroll
        for (int k = 0; k < 4; ++k) { const float e0 = lg[4 + k] + C.in[I_BRT][layer * 16 + k], e1 = lg[8 + k] + C.in[I_BRT][layer * 16 + 4 + k], e2 = lg[12 + k] + C.in[I_BRT][layer * 16 + 8 + k], e3 = lg[16 + k] + C.in[I_BRT][layer * 16 + 12 + k];
            el[k] = gi == 0 ? e0 : (gi == 1 ? e1 : (gi == 2 ? e2 : e3)); }
        int i1 = 0; float v1 = el[0];
#pragma unroll
        for (int k = 1; k < 4; ++k) if (el[k] > v1) { v1 = el[k]; i1 = k; }
        int i2 = -1; float v2 = -3.4e38f;
#pragma unroll
        for (int k = 0; k < 4; ++k) if (k != i1 && el[k] > v2) { v2 = el[k]; i2 = k; }
        const float w1 = pgrp / (1.f + __expf(v2 - v1)), w2 = pgrp - w1;
        const int ia = i1 < i2 ? i1 : i2, ib = i1 < i2 ? i2 : i1; const float wa = i1 < i2 ? w1 : w2, wb = i1 < i2 ? w2 : w1;
        const int cls = gi * 6 + (ia * (7 - ia)) / 2 + (ib - ia - 1);
        if (lane == 0) { const int pos = (int)atomicAdd(cnt + cls * 64, 1u); TBL[(size_t)cls * NROWS + pos] = r; REC[(size_t)r * 4 + 0] = cls; REC[(size_t)r * 4 + 1] = pos; REC[(size_t)r * 4 + 2] = (int)__float_as_uint(wa); REC[(size_t)r * 4 + 3] = (int)__float_as_uint(wb); }
    }
}
__device__ __forceinline__ void moe_tables(const Ctx& C, int layer, int* mt) {
    unsigned* cnt = C.ctl() + CW_CNT + layer * 2048;
    const TC T = phase_tc();
    { const int t_ = T.tid; if (t_ < 24) mt[32 + t_] = (int)__hip_atomic_load(cnt + t_ * 64, __ATOMIC_RELAXED, __HIP_MEMORY_SCOPE_AGENT); }
    asm volatile("s_waitcnt vmcnt(0)" ::: "memory");
    __syncthreads();
    if (T.tid == 0) { int acc = 0; for (int c = 0; c < 24; ++c) { const int n = mt[32 + c]; mt[c] = acc; const int nt = (n + 255) >> 8; for (int t = 0; t < nt; ++t) mt[64 + acc + t] = c; acc += nt; } mt[24] = acc; }
    asm volatile("s_waitcnt vmcnt(0)" ::: "memory");
    __syncthreads();
}
__device__ __forceinline__ void ph_final(const Ctx& C) {
    const TC T = phase_tc();
    const float* gf = C.in[I_GFINAL];
    const int gw = C.bid * NWAVES + T.wave, NGW = C.G * NWAVES, lane = T.lane;
    for (int r = gw; r < NBATCH * SEQL; r += NGW) {
        float* xr = C.out + (size_t)r * DM;
        f32x4 v[4]; float ss = 0.f;
#pragma unroll
        for (int j = 0; j < 4; ++j) { v[j] = *(const f32x4*)(xr + 256 * j + 4 * lane); ss += (v[j].x * v[j].x + v[j].y * v[j].y) + (v[j].z * v[j].z + v[j].w * v[j].w); }
        const float rs = rsqrtf(wave_sum(ss) * (1.f / DM) + EPS);
#pragma unroll
        for (int j = 0; j < 4; ++j) { const int c = 256 * j + 4 * lane; f32x4 o = v[j] * rs * *(const f32x4*)(gf + c);
#ifdef PROBE_A
            { const unsigned long long* st = (const unsigned long long*)(C.ws + WS_STAMP);
              const float ta = (float)(st[PROBE_A + 1] - st[PROBE_A]) * 0.01f, tb = (float)(st[PROBE_B + 1] - st[PROBE_B]) * 0.01f;
              int na = 0, nb = 0; float th = 15.f;
              for (int i = 0; i < 31; ++i) { na += ta > th; nb += tb > th; th *= 1.2f; }
              o = o * (1.f + 0.02f * (float)na);
              if (r == 0 && c == 0) o.x += 10.f + (float)nb; }
#endif
            *(f32x4*)(xr + c) = o; }
    }
}


#define XB_TMO      128
#define XB_XCNT(j)  (256  + 64 * (j))
#define XB_XSUB(j)  (1280 + 64 * (j))
#define XB_XGEN(j)  (2304 + 64 * (j))
#define XB_TOP      3328
#define XB_TOPGEN   3392
#define XCD_BAR_WORDS 3456
#define XB_SPIN_CAP (1u << 18)
__device__ __forceinline__ unsigned xb_ld(unsigned* p)              { return __hip_atomic_load(p, __ATOMIC_RELAXED, __HIP_MEMORY_SCOPE_AGENT); }
__device__ __forceinline__ unsigned xb_add(unsigned* p, unsigned v) { return __hip_atomic_fetch_add(p, v, __ATOMIC_RELAXED, __HIP_MEMORY_SCOPE_AGENT); }
__device__ __forceinline__ unsigned xb_xcc_id() { return (unsigned)__builtin_amdgcn_s_getreg((3 << 11) | 20) & 0xFu; }
#define XB_SPIN(cond, bar) do { unsigned _sp = 0; while (cond) { __builtin_amdgcn_s_sleep(1); \
    if ((++_sp & 255u) == 0u) { if (xb_ld(&(bar)[XB_TMO])) break; if (_sp > XB_SPIN_CAP) { atomicAdd(&(bar)[XB_TMO], 1u); break; } } } } while (0)
struct XcdBarrier { unsigned* bar; unsigned x; volatile LAS unsigned* st; };
__device__ __forceinline__ XcdBarrier xcd_barrier_post(unsigned* bar, volatile LAS unsigned* st) {
    XcdBarrier b; b.bar = bar; b.x = xb_xcc_id(); b.st = st;
    if (threadIdx.x == 0) (void)xb_add(&bar[XB_XCNT(b.x)], 1u);
    return b;
}
__device__ __forceinline__ void xcd_barrier_complete(unsigned* bar, unsigned x, unsigned& nloc, unsigned& nx) {
    const unsigned G = gridDim.x * gridDim.y * gridDim.z;
    unsigned sum, cnt, mine, sp = 0u;
    for (;;) {
        sum = 0u; cnt = 0u; mine = 0u;
#pragma unroll
        for (unsigned j = 0; j < 16; ++j) { const unsigned c = xb_ld(&bar[XB_XCNT(j)]); sum += c; cnt += (c > 0u) ? 1u : 0u; mine = (j == x) ? c : mine; }
        if (sum == G) break;
        __builtin_amdgcn_s_sleep(1);
        if ((++sp & 255u) == 0u) { if (xb_ld(&bar[XB_TMO])) break; if (sp > XB_SPIN_CAP) { atomicAdd(&bar[XB_TMO], 1u); break; } }
    }
    nloc = mine > 0u ? mine : 1u; nx = cnt > 0u ? cnt : 1u;
}
__device__ __forceinline__ void xcd_barrier(const XcdBarrier& b) {
    asm volatile("s_waitcnt vmcnt(0)" ::: "memory");
    __syncthreads();
    if (threadIdx.x == 0) {
        unsigned* bar = b.bar;
        __builtin_amdgcn_s_waitcnt(0);
        unsigned nloc = b.st[0], nx = b.st[1];
        if (nloc == 0u) { xcd_barrier_complete(bar, b.x, nloc, nx); b.st[0] = nloc; b.st[1] = nx; }
        const unsigned old = xb_add(&bar[XB_XSUB(b.x)], 1u);
        const unsigned gen = old / nloc;
        if (old + 1u == (gen + 1u) * nloc) {
            __builtin_amdgcn_fence(__ATOMIC_RELEASE, "agent");
            asm volatile("s_waitcnt vmcnt(0)" ::: "memory");
            const unsigned og = xb_add(&bar[XB_TOP], 1u);
            const unsigned tg = og / nx;
            if (og + 1u == (tg + 1u) * nx) xb_add(&bar[XB_TOPGEN], 1u);
            else XB_SPIN(xb_ld(&bar[XB_TOPGEN]) == tg, bar);
            __builtin_amdgcn_fence(__ATOMIC_ACQUIRE, "agent");
            xb_add(&bar[XB_XGEN(b.x)], 1u);
            asm volatile("s_waitcnt vmcnt(0)" ::: "memory");
        } else {
            XB_SPIN(xb_ld(&bar[XB_XGEN(b.x)]) == gen, bar);
            __builtin_amdgcn_fence(__ATOMIC_ACQUIRE, "agent");
            asm volatile("s_waitcnt vmcnt(0)" ::: "memory");
        }
    }
    __syncthreads();
}

__global__ void __launch_bounds__(NTHREADS, 2) fwd_kernel(Args args) {
    extern __shared__ __attribute__((aligned(16))) unsigned char lds_raw[];
    LAS unsigned char* lds = (LAS unsigned char*)lds_raw;
    Ctx C; C.in = args.in; C.out = args.out; C.ws = args.ws;
    C.bid = blockIdx.x; C.G = gridDim.x;
    const int lo = args.ph_lo, hi = args.ph_hi;
    int ph = 0;
    volatile LAS unsigned* bst = (volatile LAS unsigned*)(lds + LDS_BYTES - 32);
    if (threadIdx.x < 2) bst[threadIdx.x] = 0u;
    __syncthreads();
    XcdBarrier bar; bar.bar = (unsigned*)(C.ws + WS_CTL) + CW_BAR; bar.x = 0; bar.st = bst;
    if (hi - lo > 1) bar = xcd_barrier_post((unsigned*)(C.ws + WS_CTL) + CW_BAR, bst);
    if (lo < 0) cg::this_grid().sync();
#ifdef PROBE_A
    if (blockIdx.x == 0 && threadIdx.x == 0) ((unsigned long long*)(C.ws + WS_STAMP))[0] = __builtin_amdgcn_s_memrealtime();
#endif
#define IN(k) (lo <= (k) && (k) < hi)
#ifdef PROBE_A
#define STAMP(k) do { if (blockIdx.x == 0 && threadIdx.x == 0) ((unsigned long long*)(C.ws + WS_STAMP))[(k) + 1] = __builtin_amdgcn_s_memrealtime(); } while (0)
#else
#define STAMP(k) do { } while (0)
#endif
#ifdef PROBE_A
#define SEAM(k) do { if (IN(k) && IN((k) + 1)) { cg::this_grid().sync(); STAMP(k); } } while (0)
#else
#define SEAM(k) do { if (IN(k) && IN((k) + 1)) { xcd_barrier(bar); } } while (0)
#endif
    if (EN(0) && IN(0)) { ph_mod(C, lds); ph_convert(C, 0, lds); mod_wait(C); ph_prenorm(C, 0); }
    SEAM(0);
#pragma unroll 1
    for (int layer = 0; layer < 2; ++layer) {
        const int pb = 1 + 10 * layer;
        unsigned char* ws = C.ws;
        if (EN(1) && IN(pb + 0) && layer == 1) { ph_convert(C, 1, lds); ph_prenorm(C, layer); }
        if (layer == 1) SEAM(pb + 0);
        if (EN(2) && IN(pb + 1)) {
            const int nN = layer == 0 ? 15 : 14;
            pg8::Gemm g{1024, 1024, 1024, 1 << 30};
            RowSched S; S.nM = 66; S.nN = nN; S.nwg = 66 * nN; S.G = C.G; S.c = C.bid; S.skipctx = 0; S.A = (const char*)(ws + WS_A); S.Bt = (const char*)(ws + WS_WIN); S.a_tile = (size_t)256 * 1024 * 2; S.b_tile = (size_t)256 * 1024 * 2;
            EpiProj E;
            if (layer == 0) { E.d0 = (bf16*)(ws + WS_Z); E.l0 = 1024; E.e0 = 4; E.d1 = (bf16*)(ws + WS_RAW); E.l1 = 1280; E.e1 = 9; E.d2 = (bf16*)(ws + WS_YMIX) + 1024; E.l2 = 2048; E.e2 = 13;
                E.d3 = (bf16*)(ws + WS_K); E.l3 = 256; E.e3 = 14; E.d4 = (bf16*)(ws + WS_V); E.l4 = 256; E.e4 = 15; E.d5 = (bf16*)(ws + WS_DTR); E.l5 = 32; E.lastcols = 32; }
            else { E.d0 = (bf16*)(ws + WS_Z); E.l0 = 1024; E.e0 = 4; E.d1 = (bf16*)(ws + WS_RAW); E.l1 = 1024; E.e1 = 8; E.d2 = (bf16*)(ws + WS_YMIX) + 1024; E.l2 = 2048; E.e2 = 12;
                E.d3 = (bf16*)(ws + WS_K); E.l3 = 256; E.e3 = 13; E.d4 = (bf16*)(ws + WS_V); E.l4 = 256; E.e4 = 14; E.d5 = (bf16*)(ws + WS_DTR); E.l5 = 32; E.lastcols = 32; }
            pg8::gemm_phase<EpiProj, RowSched>(lds, g, S, E);
        }
        SEAM(pb + 1);
        if (EN(3) && IN(pb + 2)) { if (layer == 0) ph_elem0(C); else ph_elem1(C); }
        SEAM(pb + 2);
        if (IN(pb + 3)) { if (layer == 0) { ph_ssdpre(C, lds);
#ifdef SPLIT_MIX0
            xcd_barrier(bar); for (int u = C.bid; u < 256; u += C.G) ssd_chunk_unit<1>(C, u >> 2, u & 3, lds);
#endif
        } }
        if (layer == 0) SEAM(pb + 3);
        if (IN(pb + 4)) { if (layer == 0) { if (EN(4)) ph_mix0(C, lds, (char*)lds_raw); } else { if (EN(5)) ph_mix1(C, lds, (char*)lds_raw); } }
        SEAM(pb + 4);
        if (EN(6) && IN(pb + 5)) { if (layer == 0) ph_ssdpost(C); else ph_lrupost(C); }
        SEAM(pb + 5);
        if (EN(7) && IN(pb + 6)) {
            for (int pass = 0; pass < (layer == 0 ? 2 : 1); ++pass) {
                pg8::Gemm g{2048, 2048, pass == 0 ? 2048 : 512, 1 << 30};
                RowSched S; S.nM = 64; S.nN = 4; S.nwg = pass == 0 ? 256 : 32; S.G = C.G; S.c = C.bid; S.skipctx = pass == 0 ? 1 : 2; S.A = (const char*)(ws + WS_YMIX); S.Bt = (const char*)(ws + WS_WOUT); S.a_tile = (size_t)256 * 2048 * 2; S.b_tile = (size_t)256 * 2048 * 2;
                EpiRes E; E.slab = pass == 0 ? nullptr : (float*)(ws + WS_RAW); E.xin_lat = layer == 0 ? C.in[I_X] : C.out; E.xin_ctx = layer == 0 ? C.in[I_CTX] : C.xc(); E.xout_lat = C.out; E.xout_ctx = C.xc(); E.modbase = C.mod(layer, 0);
                pg8::gemm_phase<EpiRes, RowSched>(lds, g, S, E);
            }
        }
        SEAM(pb + 6);
        if (EN(8) && IN(pb + 7)) ph_route(C, layer, lds);
        SEAM(pb + 7);
        if (EN(10) && IN(pb + 8)) {
            int* mt = (int*)(ws + WS_MTG) + (size_t)(layer * 256 + C.bid) * 256;
            moe_tables(C, layer, mt);
            { pg8::Gemm g{1024, 1024, 1024, 1 << 30};
              MoeSched1 S; S.mt = mt; S.G = C.G; S.c = C.bid; S.layer = layer; S.ws = ws;
              EpiMoe1 E; E.ws = ws;
              pg8::gemm_phase<EpiMoe1, MoeSched1, true>(lds, g, S, E, (const int*)(ws + WS_TBL)); }
            { pg8::Gemm g{512, 256, 512, 4};
              const int nun = mt[24] * 4, extra = nun > C.G ? nun - C.G : 0;
              MoeSched2 S; S.mt = mt; S.G = C.G; S.c = (C.bid - extra % C.G + C.G) % C.G; S.layer = layer; S.ws = ws;
              EpiMoe2 E; E.out = C.out; E.ws = ws; E.layer = layer;
              pg8::gemm_phase<EpiMoe2, MoeSched2, false>(lds, g, S, E); }
        }
        SEAM(pb + 8);
    }
#ifdef PROBE_A
    cg::this_grid().sync();
#endif
    if (EN(12) && IN(21)) ph_final(C);

    (void)ph;
#undef IN
#undef SEAM
}

extern "C" void kernel_launch(void* const* d_in, const int* in_sizes, int n_in, void* d_out, int out_size, void* d_ws, size_t ws_size, hipStream_t stream) {
    static int grid = 0;
    if (grid == 0) {
        if (n_in != 36 || out_size != NBATCH * SEQL * DM || ws_size < WS_END) { fprintf(stderr, "kernel_launch: unexpected shapes (n_in %d, out %d, ws %zu)\n", n_in, out_size, ws_size); grid = -1; return; }
        int dev = 0, cus = 0, per_cu = 0;
        if (hipGetDevice(&dev) != hipSuccess || hipDeviceGetAttribute(&cus, hipDeviceAttributeMultiprocessorCount, dev) != hipSuccess) { grid = -1; return; }
        if (hipFuncSetAttribute((const void*)fwd_kernel, hipFuncAttributeMaxDynamicSharedMemorySize, LDS_BYTES) != hipSuccess) { fprintf(stderr, "kernel_launch: hipFuncSetAttribute failed\n"); grid = -1; return; }
        if (hipOccupancyMaxActiveBlocksPerMultiprocessor(&per_cu, (const void*)fwd_kernel, NTHREADS, LDS_BYTES) != hipSuccess || per_cu < 1) { fprintf(stderr, "kernel_launch: occupancy query failed (%d)\n", per_cu); (void)hipGetLastError(); per_cu = 1; }
        grid = cus * 1;
    }
    if (grid < 0) return;
    (void)hipMemsetAsync((char*)d_ws + WS_CTL, 0, CTL_ZERO_BYTES, stream);
    Args a{};
    for (int i = 0; i < 36; ++i) a.in[i] = (const float*)d_in[i];
    a.out = (float*)d_out; a.ws = (unsigned char*)d_ws;
#if MK_PER_PHASE
    for (int p = 0; p < N_PHASES; ++p) { a.ph_lo = p; a.ph_hi = p + 1; hipLaunchKernelGGL(fwd_kernel, dim3(grid), dim3(NTHREADS), LDS_BYTES, stream, a); }
#else
    void* kargs[] = {&a};
#ifdef REPEAT_K
    a.ph_lo = 0; a.ph_hi = REPEAT_K + 1;
    (void)hipLaunchCooperativeKernel((const void*)fwd_kernel, dim3(grid), dim3(NTHREADS), kargs, LDS_BYTES, stream);
    (void)hipMemsetAsync((char*)d_ws + WS_CTL, 0, CTL_ZERO_BYTES, stream);
#endif
    a.ph_lo = 0; a.ph_hi = N_PHASES;
    hipError_t e = hipLaunchCooperativeKernel((const void*)fwd_kernel, dim3(grid), dim3(NTHREADS), kargs, LDS_BYTES, stream);
    if (e != hipSuccess) fprintf(stderr, "kernel_launch: cooperative launch failed: %s (grid %d)\n", hipGetErrorString(e), grid);
#endif
}
```

```cpp
#include <hip/hip_runtime.h>
#include <hip/hip_cooperative_groups.h>
#include <cstdio>
#include <cstdint>
namespace cg = cooperative_groups;

#ifndef MK_PER_PHASE
#define MK_PER_PHASE 0
#endif

#ifndef EN_MASK
#define EN_MASK 0xFFFF
#endif
#define EN(k) (((EN_MASK) >> (k)) & 1)
#define LAS __attribute__((address_space(3)))
typedef unsigned short bf16;
typedef short bf16x8 __attribute__((ext_vector_type(8)));
typedef short s16x4 __attribute__((ext_vector_type(4)));
typedef float f32x4 __attribute__((ext_vector_type(4)));
typedef float f32x2 __attribute__((ext_vector_type(2)));
typedef float f32x16 __attribute__((ext_vector_type(16)));
typedef unsigned u32x4 __attribute__((ext_vector_type(4)));
typedef unsigned u32x2 __attribute__((ext_vector_type(2)));

constexpr int DM = 1024, NBATCH = 2, SEQL = 8192, CTXL = 256;
constexpr int BROWS = CTXL + SEQL;
constexpr int NROWS = NBATCH * BROWS;
constexpr float EPS = 1e-6f;
constexpr int NWAVES = 8, NTHREADS = 512;
constexpr int LDS_BYTES = 147456;
constexpr int N_PHASES = 22;

constexpr size_t MiB = 1u << 20;
constexpr size_t WS_CTL = 0, CTL_ZERO_BYTES = 128 * 1024;
constexpr size_t WS_MOD = 1 * MiB;
constexpr size_t WS_REC = 1 * MiB + 256 * 1024;
constexpr size_t WS_TOK = 2 * MiB;
constexpr size_t WS_GAB = 2 * MiB + 128 * 1024;
constexpr size_t WS_MT  = 2 * MiB + 512 * 1024;
constexpr size_t WS_STAMP = 2 * MiB + 768 * 1024;
constexpr size_t WS_XC  = 3 * MiB;
constexpr size_t WS_W   = 5 * MiB;
constexpr size_t WS_WIN = WS_W, WS_WOUT = WS_W + 8 * MiB, WS_W13 = WS_W + 12 * MiB, WS_W2 = WS_W + 28 * MiB;
constexpr size_t WS_A   = 41 * MiB;
constexpr size_t WS_Z   = 83 * MiB;
constexpr size_t WS_RAW = 116 * MiB;
constexpr size_t WS_DTR = 158 * MiB;
constexpr size_t WS_DT  = 160 * MiB;
constexpr size_t WS_K   = 163 * MiB;
constexpr size_t WS_V   = 172 * MiB;
constexpr size_t WS_YMIX = 181 * MiB;
constexpr size_t WS_SSDST = 247 * MiB;
constexpr size_t WS_SSDLD = WS_SSDST + 64 * 3 * 16384;
constexpr size_t WS_TBL = 251 * MiB;
constexpr size_t WS_MTG = 253 * MiB;
constexpr size_t WS_END = 254 * MiB;
constexpr int MAXTILES = 90, MAXSLOT = MAXTILES * 256;
constexpr int CW_MODDONE = 192;
constexpr int CW_Q0 = 64, CW_Q1 = 128, CW_CNT = 256, CW_BAR = 4096, CW_TDONE = 8192;

__device__ __forceinline__ float bf2f(unsigned short b) { return __uint_as_float(((unsigned)b) << 16); }
__device__ __forceinline__ unsigned f2bf(float f) { unsigned u = __float_as_uint(f); return (u + 0x7fffu + ((u >> 16) & 1u)) >> 16; }
__device__ __forceinline__ unsigned pk2(float lo, float hi) { return f2bf(lo) | (f2bf(hi) << 16); }
__device__ __forceinline__ float dpp_add(float v, float src, const int ctrl_unused) { return v + src; }
#define DPP_F(v, ctrl, rmask) __builtin_bit_cast(float, __builtin_amdgcn_update_dpp(0, __builtin_bit_cast(int, v), ctrl, rmask, 0xf, false))
__device__ __forceinline__ float wave_sum(float v) {
    v += DPP_F(v, 0xB1, 0xf);
    v += DPP_F(v, 0x4E, 0xf);
    v += DPP_F(v, 0x141, 0xf);
    v += DPP_F(v, 0x140, 0xf);
    v += DPP_F(v, 0x142, 0xa);
    v += DPP_F(v, 0x143, 0xc);
    return __builtin_bit_cast(float, __builtin_amdgcn_readlane(__builtin_bit_cast(int, v), 63));
}
__device__ __forceinline__ float silu_f(float x) { return x / (1.f + __expf(-x)); }
__device__ __forceinline__ float sigmoid_f(float x) { return 1.f / (1.f + __expf(-x)); }
__device__ __forceinline__ float softplus_f(float x) { return fmaxf(x, 0.f) + log1pf(__expf(-fabsf(x))); }
__device__ __forceinline__ float gelu_tanh_f(float x) { const float u = 0.7978845608028654f * (x + 0.044715f * x * x * x); return 0.5f * x * (1.f + tanhf(u)); }
__device__ __forceinline__ void unpack8(const u32x4 w, float* f) {
    f[0] = __uint_as_float(w.x << 16); f[1] = __uint_as_float(w.x & 0xffff0000u);
    f[2] = __uint_as_float(w.y << 16); f[3] = __uint_as_float(w.y & 0xffff0000u);
    f[4] = __uint_as_float(w.z << 16); f[5] = __uint_as_float(w.z & 0xffff0000u);
    f[6] = __uint_as_float(w.w << 16); f[7] = __uint_as_float(w.w & 0xffff0000u);
}

namespace pg8 {
constexpr int BM = 256, BK = 64, HALF = 128, HTB = HALF * BK * 2, STAGE_BYTES = 8 * HTB, NXCD = 8, WGM = 8;
__host__ __device__ __forceinline__ int lds_byte(int r, int c) { const int st = (r >> 4) * 2 + (c >> 5), rr = r & 15, cc = c & 31, ob = rr * 64 + cc * 2; return st * 1024 + (ob ^ (((ob >> 9) & 1) << 5)); }
__host__ __device__ __forceinline__ void stage_rc(int b, int& R, int& C) { const int st = b / 1024, sb = b % 1024, swz = sb ^ (((sb >> 9) & 1) << 5); R = (st >> 1) * 16 + swz / 64; C = (st & 1) * 32 + (swz % 64) / 2; }
__host__ __device__ __forceinline__ int perm32(int rho) { const int n = rho >> 4, i = rho & 15; return 8 * (i >> 2) + 4 * n + (i & 3); }

struct Unit { int pm, pn; const char* a; const char* b; long bd; int tbo; int nrow; };
struct Gemm { int lda, ldb, K, ksplit; };

__device__ __forceinline__ unsigned cvt_pk_bf16(float lo, float hi) { unsigned r; asm volatile("v_cvt_pk_bf16_f32 %0, %1, %2" : "=v"(r) : "v"(lo), "v"(hi)); return r; }

template <class Epi, class Sched, bool GATHER = false>
__device__ __forceinline__ void gemm_phase(LAS unsigned char* lds, const Gemm g, const Sched& S, const Epi& E, const int* gtbl = nullptr) {
    int tid_ = threadIdx.x; asm volatile("" : "+v"(tid_));
    const int tid = tid_, wid = __builtin_amdgcn_readfirstlane(tid >> 6), lane = tid & 63, wr = wid >> 2, wc = wid & 3, fr = lane & 15, fq = lane >> 4;
    const int nt = g.K / BK;
    unsigned voffA[2][2], nvoffA[2][2], voffB[2];
#pragma unroll
    for (int i = 0; i < 2; ++i) { int R, C; stage_rc(tid * 16 + i * 8192, R, C); const int Rb = Epi::PERM ? ((R & ~31) + perm32(R & 31)) : R;
        voffA[0][i] = (unsigned)(R * g.lda + C) * 2u; voffA[1][i] = (unsigned)((R + HALF) * g.lda + C) * 2u; nvoffA[0][i] = voffA[0][i]; nvoffA[1][i] = voffA[1][i];
        voffB[i] = (unsigned)(Rb * g.ldb + C) * 2u; }
#define PG8_GATHER_OFF(dst, uu) do { if constexpr (GATHER) { int _t = tid; asm volatile("" : "+v"(_t)); _Pragma("unroll") for (int _i = 0; _i < 2; ++_i) { int _R, _C; stage_rc(_t * 16 + _i * 8192, _R, _C); \
        _Pragma("unroll") for (int _h = 0; _h < 2; ++_h) { int _rho = _h * HALF + _R; _rho = _rho < (uu).nrow ? _rho : (uu).nrow - 1; dst[_h][_i] = (unsigned)gtbl[(uu).tbo + _rho] * (unsigned)(g.lda * 2) + (unsigned)_C * 2u; } } } } while (0)
    const size_t kstep = (size_t)(BK * 2);
    const size_t hstepA = (size_t)HALF * g.lda * 2, hstepB = (size_t)HALF * g.ldb * 2;
    const unsigned ldsw = (unsigned)wid * 1024u;
    const int aoff = lds_byte(wr * 64 + fr, fq * 8), boff = lds_byte(wc * 32 + fr, fq * 8);
#define PG8_SA(b, h) (((b) * 2 + (h)) * HTB)
#define PG8_SB(b, h) ((4 + (b) * 2 + (h)) * HTB)
#define PG8_STAGE(bufoff, gbase, voff) do { _Pragma("unroll") for (int _i = 0; _i < 2; ++_i) \
        __builtin_amdgcn_global_load_lds((const unsigned*)((const char*)(gbase) + (voff)[_i]), (LAS unsigned*)(lds + (bufoff) + ldsw + _i * 8192), 16, 0, 0); } while (0)
#define PG8_STAGE_A(bufoff, gbase, hh, usenext) do { _Pragma("unroll") for (int _i = 0; _i < 2; ++_i) { \
        if constexpr (GATHER) { const unsigned _vo = (usenext) ? nvoffA[hh][_i] : voffA[hh][_i]; \
            __builtin_amdgcn_global_load_lds((const unsigned*)((const char*)(gbase) + _vo), (LAS unsigned*)(lds + (bufoff) + ldsw + _i * 8192), 16, 0, 0); } \
        else __builtin_amdgcn_global_load_lds((const unsigned*)((const char*)(gbase) + (hh) * hstepA + voffA[0][_i]), (LAS unsigned*)(lds + (bufoff) + ldsw + _i * 8192), 16, 0, 0); } } while (0)
#define PG8_LDA(dst, b, h) do { _Pragma("unroll") for (int m = 0; m < 4; ++m) _Pragma("unroll") for (int k = 0; k < 2; ++k) dst[m][k] = *(const LAS bf16x8*)(lds + PG8_SA(b, h) + aoff + m * 2048 + k * 1024); } while (0)
#define PG8_LDB(dst, b, h) do { _Pragma("unroll") for (int n = 0; n < 2; ++n) _Pragma("unroll") for (int k = 0; k < 2; ++k) dst[n][k] = *(const LAS bf16x8*)(lds + PG8_SB(b, h) + boff + n * 2048 + k * 1024); } while (0)
#define PG8_MMA(ai, bj, At, Bt) do { __builtin_amdgcn_s_setprio(1); _Pragma("unroll") for (int m = 0; m < 4; ++m) _Pragma("unroll") for (int n = 0; n < 2; ++n) _Pragma("unroll") for (int k = 0; k < 2; ++k) \
        acc[ai][bj][m][n] = __builtin_amdgcn_mfma_f32_16x16x32_bf16(Bt[n][k], At[m][k], acc[ai][bj][m][n], 0, 0, 0); __builtin_amdgcn_s_setprio(0); } while (0)
#define PG8_WAIT_V(n) asm volatile("s_waitcnt vmcnt(" #n ")" ::: "memory")
#define PG8_WAIT_L(n) asm volatile("s_waitcnt lgkmcnt(" #n ")" ::: "memory")
#define PG8_BAR __builtin_amdgcn_s_barrier()
#define PG8_SCHED __builtin_amdgcn_sched_barrier(0)
    Unit cur, nxt; int ui = 0;
    if (!S.next(0, cur)) return;
    f32x4 acc[2][2][4][2];
#pragma unroll
    for (int a = 0; a < 2; ++a)
#pragma unroll
        for (int b = 0; b < 2; ++b)
#pragma unroll
            for (int m = 0; m < 4; ++m)
#pragma unroll
                for (int n = 0; n < 2; ++n) acc[a][b][m][n] = (f32x4){0.f, 0.f, 0.f, 0.f};
    bf16x8 At[4][2], B0[2][2], B1[2][2];
    const char* cA = cur.a; const char* cB = cur.b; long cBd = cur.bd;
    S.a_ready(cur);
    PG8_GATHER_OFF(voffA, cur);
    PG8_STAGE(PG8_SB(0, 0), cB, voffB); PG8_STAGE_A(PG8_SA(0, 0), cA, 0, false); PG8_STAGE(PG8_SB(0, 1), cB + hstepB, voffB); PG8_STAGE_A(PG8_SA(0, 1), cA, 1, false);
    if (wr == 1) PG8_BAR;
    PG8_WAIT_V(4); PG8_BAR;
    PG8_STAGE(PG8_SB(1, 0), cB + kstep, voffB); PG8_STAGE_A(PG8_SA(1, 0), cA + kstep, 0, false); PG8_STAGE(PG8_SB(1, 1), cB + hstepB + kstep, voffB);
    PG8_WAIT_V(6); PG8_BAR;
    for (;;) {
        const bool has_next = S.next(ui + 1, nxt);
        const char* nA = has_next ? nxt.a : cA; const char* nB = has_next ? nxt.b : cB;
        if constexpr (GATHER) { if (has_next) PG8_GATHER_OFF(nvoffA, nxt); else {
#pragma unroll
            for (int _h = 0; _h < 2; ++_h)
#pragma unroll
                for (int _i = 0; _i < 2; ++_i) nvoffA[_h][_i] = voffA[_h][_i]; } }
#pragma unroll 1
        for (int t = 0; t < nt; t += 2) {
            const bool last = (t == nt - 2);
            const char* a1 = cA + (size_t)(t + 1) * kstep;
            const char* a2 = last ? nA : cA + (size_t)(t + 2) * kstep;
            const char* b2 = last ? nB : cB + (size_t)(t + 2) * kstep + ((t + 2) >= g.ksplit ? cBd : 0);
            const char* a3 = a2 + kstep; const char* b3 = b2 + kstep;
            if (last && has_next) S.a_ready(nxt);
            PG8_LDB(B0, 0, 0); PG8_SCHED; PG8_LDA(At, 0, 0); PG8_STAGE_A(PG8_SA(1, 1), a1, 1, false);
            PG8_WAIT_L(8); PG8_BAR; PG8_WAIT_L(0); PG8_MMA(0, 0, At, B0); PG8_BAR; PG8_SCHED;
            PG8_LDB(B1, 0, 1); PG8_STAGE(PG8_SB(0, 0), b2, voffB);
            PG8_BAR; PG8_WAIT_L(0); PG8_MMA(0, 1, At, B1); PG8_BAR;
            PG8_LDA(At, 0, 1); PG8_STAGE_A(PG8_SA(0, 0), a2, 0, last);
            PG8_BAR; PG8_WAIT_L(0); PG8_MMA(1, 0, At, B0); PG8_BAR; PG8_SCHED;
            PG8_STAGE(PG8_SB(0, 1), b2 + hstepB, voffB);
            PG8_WAIT_V(6); PG8_BAR; PG8_MMA(1, 1, At, B1); PG8_BAR;
            PG8_LDB(B0, 1, 0); PG8_SCHED; PG8_LDA(At, 1, 0); PG8_STAGE_A(PG8_SA(0, 1), a2, 1, last);
            PG8_WAIT_L(8); PG8_BAR; PG8_WAIT_L(0); PG8_MMA(0, 0, At, B0); PG8_BAR; PG8_SCHED;
            PG8_LDB(B1, 1, 1); PG8_STAGE(PG8_SB(1, 0), b3, voffB);
            PG8_BAR; PG8_WAIT_L(0); PG8_MMA(0, 1, At, B1); PG8_BAR;
            PG8_LDA(At, 1, 1); PG8_STAGE_A(PG8_SA(1, 0), a3, 0, last);
            PG8_BAR; PG8_WAIT_L(0); PG8_MMA(1, 0, At, B0); PG8_BAR; PG8_SCHED;
            PG8_STAGE(PG8_SB(1, 1), b3 + hstepB, voffB);
            PG8_WAIT_V(6); PG8_BAR; PG8_MMA(1, 1, At, B1); PG8_BAR;
        }
        if (!(Epi::AFTER_DRAIN && !has_next)) { E(acc, cur, wr, wc, fr, fq); S.done(cur); }
        if (!has_next) break;
#pragma unroll
        for (int a = 0; a < 2; ++a)
#pragma unroll
            for (int b = 0; b < 2; ++b)
#pragma unroll
                for (int m = 0; m < 4; ++m)
#pragma unroll
                    for (int n = 0; n < 2; ++n) acc[a][b][m][n] = (f32x4){0.f, 0.f, 0.f, 0.f};
        cur = nxt; cA = nA; cB = nB; cBd = cur.bd; ++ui;
        if constexpr (GATHER) {
#pragma unroll
            for (int _h = 0; _h < 2; ++_h)
#pragma unroll
                for (int _i = 0; _i < 2; ++_i) voffA[_h][_i] = nvoffA[_h][_i]; }
    }
    PG8_WAIT_V(0);
    if (wr == 0) PG8_BAR;
    PG8_BAR;
    if constexpr (Epi::AFTER_DRAIN) { E.fused(acc, cur, wr, wc, fr, fq, lds, wid, lane); S.done(cur); }
#undef PG8_SA
#undef PG8_SB
#undef PG8_STAGE
#undef PG8_STAGE_A
#undef PG8_GATHER_OFF
#undef PG8_LDA
#undef PG8_LDB
#undef PG8_MMA
#undef PG8_WAIT_V
#undef PG8_WAIT_L
#undef PG8_BAR
#undef PG8_SCHED
}
}

namespace att {
constexpr int D = 128, NW = 8, QBLK = 32, KVBLK = 64;
constexpr float SCALE = 0.088388347648318440f;
constexpr float THR = 8.f;
constexpr int LDQ = 2048, LDK = 256, LDO = 2048;
constexpr size_t SHM_V = KVBLK * D * 2, SHM_K = KVBLK * D * 2, SHM_ATTN = 2 * SHM_V + 2 * SHM_K + NW * 64 * 4;
#define KSWZ(row, colB) ((row) * 256 + ((colB) ^ (((row) & 7) << 4)))
#define SBAR() __builtin_amdgcn_sched_barrier(0)
__device__ __forceinline__ int crow(int r, int hi) { return (r & 3) + 8 * (r >> 2) + 4 * hi; }
__device__ __forceinline__ unsigned cvtpk(float lo, float hi) { unsigned r; asm volatile("v_cvt_pk_bf16_f32 %0, %1, %2" : "=v"(r) : "v"(lo), "v"(hi)); return r; }

__device__ __forceinline__ void partialSM(f32x16& p0, f32x16& p1, float& m_reg, float& mn, float& alpha) {
  constexpr float C = SCALE * 1.4426950408889634f;
  float pmax = p0[0]; for (int r = 1; r < 16; ++r) pmax = fmaxf(pmax, p0[r]); for (int r = 0; r < 16; ++r) pmax = fmaxf(pmax, p1[r]);
  { auto rr = __builtin_amdgcn_permlane32_swap(__float_as_uint(pmax), __float_as_uint(pmax), false, false);
    pmax = fmaxf(__uint_as_float(rr[0]), __uint_as_float(rr[1])); }
  if (__builtin_expect(__all(pmax - m_reg <= THR / SCALE), 1)) { mn = m_reg; alpha = 1.f; }
  else { mn = fmaxf(m_reg, pmax); alpha = __builtin_amdgcn_exp2f((m_reg - mn) * C); m_reg = mn; }
  float mnC = -mn * C;
  for (int r = 0; r < 16; ++r) p0[r] = fmaf(p0[r], C, mnC); for (int r = 0; r < 16; ++r) p1[r] = fmaf(p1[r], C, mnC);
  for (int r = 0; r < 16; ++r) p0[r] = __builtin_amdgcn_exp2f(p0[r]);
}
__device__ __forceinline__ void finishSM(f32x16& p0, f32x16& p1, float alpha, float& l_reg, bf16x8& pa0, bf16x8& pa1, bf16x8& pa2, bf16x8& pa3) {
  for (int r = 0; r < 16; ++r) p1[r] = __builtin_amdgcn_exp2f(p1[r]);
  float ps = 0; for (int r = 0; r < 16; ++r) ps += p0[r]; for (int r = 0; r < 16; ++r) ps += p1[r];
  { auto rr = __builtin_amdgcn_permlane32_swap(__float_as_uint(ps), __float_as_uint(ps), false, false);
    ps = __uint_as_float(rr[0]) + __uint_as_float(rr[1]); }
  l_reg = l_reg * alpha + ps;
#define PK4(P, BASE, OUT) do { unsigned a0 = cvtpk(P[BASE + 0], P[BASE + 1]), a1 = cvtpk(P[BASE + 2], P[BASE + 3]);   \
    unsigned b0 = cvtpk(P[BASE + 4], P[BASE + 5]), b1 = cvtpk(P[BASE + 6], P[BASE + 7]);                              \
    auto r0 = __builtin_amdgcn_permlane32_swap(a0, b0, false, false); auto r1 = __builtin_amdgcn_permlane32_swap(a1, b1, false, false); \
    u32x4 w = {r0[0], r1[0], r0[1], r1[1]}; OUT = *reinterpret_cast<bf16x8*>(&w); } while (0)
  PK4(p0, 0, pa0); PK4(p0, 8, pa1); PK4(p1, 0, pa2); PK4(p1, 8, pa3);
#undef PK4
}
__device__ __forceinline__ void qkt(f32x16& p0, f32x16& p1, const bf16* Ks, const bf16x8* qr, int r32, int hi) {
  p0 = f32x16{}; p1 = f32x16{};
  for (int d0 = 0; d0 < 8; ++d0) { int cb = (d0 * 16 + hi * 8) * 2;
    bf16x8 b0 = *reinterpret_cast<const bf16x8*>((const char*)Ks + KSWZ(r32, cb));
    bf16x8 b1 = *reinterpret_cast<const bf16x8*>((const char*)Ks + KSWZ(32 + r32, cb));
    p0 = __builtin_amdgcn_mfma_f32_32x32x16_bf16(b0, qr[d0], p0, 0, 0, 0);
    p1 = __builtin_amdgcn_mfma_f32_32x32x16_bf16(b1, qr[d0], p1, 0, 0, 0); }
}
__device__ __forceinline__ int v_st(int k, int c) { const int kk = (k & ~0xC) | ((k & 4) << 1) | ((k & 8) >> 1); return ((kk >> 3) * 4 + (c >> 5)) * 512 + ((kk & 7) * 32 + (c & 31)) * 2; }
__device__ __forceinline__ int v_rd_base(int lane) { return ((lane & 3) << 3) | (((lane >> 2) & 3) << 6) | (((lane >> 4) & 1) << 5) | (((lane >> 5) & 1) << 8); }
constexpr int v_rd_off(int d0, int ks, int half) { return d0 * 512 + ks * 4096 + half * 2048; }
template <int OFF> __device__ __forceinline__ s16x4 tr_read(int vb) {
  s16x4 r; asm volatile("ds_read_b64_tr_b16 %0, %1 offset:%2" : "=&v"(r) : "v"(vb), "i"(OFF) : "memory"); return r;
}
template <int D0> __device__ __forceinline__ void pv_one(f32x16& od, int vb, bf16x8 pa0, bf16x8 pa1, bf16x8 pa2, bf16x8 pa3) {
  const s16x4 l0 = tr_read<v_rd_off(D0, 0, 0)>(vb), h0 = tr_read<v_rd_off(D0, 0, 1)>(vb), l1 = tr_read<v_rd_off(D0, 1, 0)>(vb), h1 = tr_read<v_rd_off(D0, 1, 1)>(vb);
  const s16x4 l2 = tr_read<v_rd_off(D0, 2, 0)>(vb), h2 = tr_read<v_rd_off(D0, 2, 1)>(vb), l3 = tr_read<v_rd_off(D0, 3, 0)>(vb), h3 = tr_read<v_rd_off(D0, 3, 1)>(vb);
  asm volatile("s_waitcnt lgkmcnt(0)" ::: "memory"); SBAR();
#define PK(L, H) (bf16x8){L[0], L[1], L[2], L[3], H[0], H[1], H[2], H[3]}
  od = __builtin_amdgcn_mfma_f32_32x32x16_bf16(pa0, PK(l0, h0), od, 0, 0, 0);
  od = __builtin_amdgcn_mfma_f32_32x32x16_bf16(pa1, PK(l1, h1), od, 0, 0, 0);
  od = __builtin_amdgcn_mfma_f32_32x32x16_bf16(pa2, PK(l2, h2), od, 0, 0, 0);
  od = __builtin_amdgcn_mfma_f32_32x32x16_bf16(pa3, PK(l3, h3), od, 0, 0, 0);
#undef PK
}
__device__ __forceinline__ void pv_d0(f32x16* o, int vb, bf16x8 pa0, bf16x8 pa1, bf16x8 pa2, bf16x8 pa3) {
  pv_one<0>(o[0], vb, pa0, pa1, pa2, pa3); pv_one<1>(o[1], vb, pa0, pa1, pa2, pa3); pv_one<2>(o[2], vb, pa0, pa1, pa2, pa3); pv_one<3>(o[3], vb, pa0, pa1, pa2, pa3);
}
__device__ __forceinline__ void band_mask(f32x16& p0, f32x16& p1, int dbase, int hi) {
#pragma unroll
  for (int r = 0; r < 16; ++r) { const int d = dbase + crow(r, hi);
    if (d < -128 || d > 128) p0[r] = -1e30f;
    if (d + 32 < -128 || d + 32 > 128) p1[r] = -1e30f; }
}
template <int MODE>
__device__ __forceinline__ void attn_body(const bf16* Qb, const bf16* Kh, const bf16* Vh, bf16* Ob, int NT, int kb0, int q0, float sink, char* lds, const float* qg, int tq0) {
  int tid_ = threadIdx.x; asm volatile("" : "+v"(tid_));
  const int tid = tid_, wid = tid >> 6, lane = tid & 63, r32 = lane & 31, hi = lane >> 5;
  bf16* V_lds = (bf16*)lds; bf16* K_lds = (bf16*)(lds + 3 * SHM_V);
  float* ws = (float*)(lds + 3 * SHM_V + 3 * SHM_K) + wid * 64; float* li_l = ws; float* al_l = ws + 32;
  bf16x8 qr[8];
  const bf16* Qw = Qb + (long)(wid * QBLK + r32) * LDQ + hi * 8;
  { u32x4 raw[8];
#pragma unroll
    for (int d0 = 0; d0 < 8; ++d0) raw[d0] = *reinterpret_cast<const u32x4*>(Qw + d0 * 16);
    float rs = 1.f;
    if (qg != nullptr) { float ssq = 0.f;
#pragma unroll
      for (int d0 = 0; d0 < 8; ++d0) { float f[8]; unpack8(raw[d0], f);
#pragma unroll
        for (int e = 0; e < 8; ++e) ssq += f[e] * f[e]; }
      ssq += __shfl_xor(ssq, 32);
      rs = rsqrtf(ssq * (1.f / 128.f) + 1e-6f); }
    const int t = tq0 + wid * QBLK + r32;
#pragma unroll
    for (int d0 = 0; d0 < 4; ++d0) { float fa[8], fb[8]; unpack8(raw[d0], fa); unpack8(raw[d0 + 4], fb);
      if (qg != nullptr) { const f32x4 ga0 = *reinterpret_cast<const f32x4*>(qg + 16 * d0 + 8 * hi), ga1 = *reinterpret_cast<const f32x4*>(qg + 16 * d0 + 8 * hi + 4);
        const f32x4 gb0 = *reinterpret_cast<const f32x4*>(qg + 64 + 16 * d0 + 8 * hi), gb1 = *reinterpret_cast<const f32x4*>(qg + 64 + 16 * d0 + 8 * hi + 4);
#pragma unroll
        for (int e = 0; e < 4; ++e) { fa[e] *= rs * ga0[e]; fa[4 + e] *= rs * ga1[e]; fb[e] *= rs * gb0[e]; fb[4 + e] *= rs * gb1[e]; } }
      if (tq0 >= 0) {
#pragma unroll
        for (int e = 0; e < 8; ++e) { const int j = 16 * d0 + 8 * hi + e; const int pos = j < 32 ? (t >> 6) : (t & 63);
          const float inv = exp2f(-(float)(j & 31) * (13.287712379549449f / 32.f)); float sn, cs; sincosf((float)pos * inv, &sn, &cs);
          const float a = fa[e], b2 = fb[e]; fa[e] = a * cs - b2 * sn; fb[e] = a * sn + b2 * cs; } }
      u32x4 wa, wb; wa.x = cvtpk(fa[0], fa[1]); wa.y = cvtpk(fa[2], fa[3]); wa.z = cvtpk(fa[4], fa[5]); wa.w = cvtpk(fa[6], fa[7]);
      wb.x = cvtpk(fb[0], fb[1]); wb.y = cvtpk(fb[2], fb[3]); wb.z = cvtpk(fb[4], fb[5]); wb.w = cvtpk(fb[6], fb[7]);
      qr[d0] = *reinterpret_cast<bf16x8*>(&wa); qr[d0 + 4] = *reinterpret_cast<bf16x8*>(&wb); } }
  float m_reg = -1e30f, l_reg = 0; f32x16 o[4] = {};
  const int sr = tid >> 4, sc = (tid & 15) * 8, vst0 = v_st(sr, sc), vst1 = v_st(32 + sr, sc);
  const int vb0 = (int)(uintptr_t)V_lds + v_rd_base(lane);
  struct { bf16x8 vs0, vs1, ks0, ks1; } sr_;
#define TK0(j) ((MODE == 0 || (j) < 4) ? (j) * KVBLK : kb0 + ((j) - 4) * KVBLK)
#define SLOAD(k0) do { sr_.vs0 = *reinterpret_cast<const bf16x8*>(&Vh[(long)((k0) + sr) * LDK + sc]); sr_.vs1 = *reinterpret_cast<const bf16x8*>(&Vh[(long)((k0) + 32 + sr) * LDK + sc]); \
    sr_.ks0 = *reinterpret_cast<const bf16x8*>(&Kh[(long)((k0) + sr) * LDK + sc]); sr_.ks1 = *reinterpret_cast<const bf16x8*>(&Kh[(long)((k0) + 32 + sr) * LDK + sc]); } while (0)
#define SWRITE(b) do { *(bf16x8*)((char*)V_lds + (b) * (int)SHM_V + vst0) = sr_.vs0;          \
    *(bf16x8*)((char*)V_lds + (b) * (int)SHM_V + vst1) = sr_.vs1; int kc = sc * 2;               \
    *(bf16x8*)((char*)K_lds + (b) * (int)SHM_K + KSWZ(sr, kc)) = sr_.ks0;                       \
    *(bf16x8*)((char*)K_lds + (b) * (int)SHM_K + KSWZ(32 + sr, kc)) = sr_.ks1; } while (0)
#define SWAIT() asm volatile("s_waitcnt vmcnt(0)" ::: "memory")
#define RESC(a) do { if (__any((a) < 1.f)) { if (hi == 0) al_l[r32] = (a); asm volatile("s_waitcnt lgkmcnt(0)" ::: "memory"); \
    for (int d = 0; d < 4; ++d) for (int r = 0; r < 16; ++r) o[d][r] *= al_l[crow(r, hi)]; } } while (0)
#define MASKT(P0, P1, j) do { if (MODE == 1 && (j) >= 4) { const int s0_ = kb0 - 256 + ((j) - 4) * KVBLK, tw_ = q0 + wid * QBLK; \
    if (!(s0_ - (tw_ + 31) >= -128 && (s0_ + 63) - tw_ <= 128)) band_mask(P0, P1, s0_ - tw_ - r32, hi); } } while (0)
  f32x16 pA0, pA1, pB0, pB1; float mnA, mnB, alA, alB; bf16x8 pa0, pa1, pa2, pa3;
  int bp = 0, bq = 1;
  SLOAD(TK0(0)); SWAIT(); SWRITE(0); __syncthreads();
  qkt(pA0, pA1, K_lds, qr, r32, hi); partialSM(pA0, pA1, m_reg, mnA, alA);
  SLOAD(TK0(1));
  SWAIT(); SWRITE(1); __syncthreads();
  for (int j = 1; j + 1 < NT; j += 2) {
    { const int bw = 3 - bp - bq;
      SBAR(); qkt(pB0, pB1, (bf16*)((char*)K_lds + bq * (int)SHM_K), qr, r32, hi);
      finishSM(pA0, pA1, alA, l_reg, pa0, pa1, pa2, pa3); SBAR();
      SLOAD(TK0(j + 1)); SBAR();
      pv_d0(o, vb0 + bp * (int)SHM_V, pa0, pa1, pa2, pa3); MASKT(pB0, pB1, j); partialSM(pB0, pB1, m_reg, mnB, alB);
      SWAIT(); SWRITE(bw);
      RESC(alB); __syncthreads();
      bp = bq; bq = bw; }
    { const int bw = 3 - bp - bq;
      SBAR(); qkt(pA0, pA1, (bf16*)((char*)K_lds + bq * (int)SHM_K), qr, r32, hi);
      finishSM(pB0, pB1, alB, l_reg, pa0, pa1, pa2, pa3); SBAR();
      SLOAD(TK0(j + 2)); SBAR();
      pv_d0(o, vb0 + bp * (int)SHM_V, pa0, pa1, pa2, pa3); MASKT(pA0, pA1, j + 1); partialSM(pA0, pA1, m_reg, mnA, alA);
      SWAIT(); SWRITE(bw);
      RESC(alA); __syncthreads();
      bp = bq; bq = bw; }
  }
  SBAR(); qkt(pB0, pB1, (bf16*)((char*)K_lds + bq * (int)SHM_K), qr, r32, hi);
  finishSM(pA0, pA1, alA, l_reg, pa0, pa1, pa2, pa3); SBAR();
  pv_d0(o, vb0 + bp * (int)SHM_V, pa0, pa1, pa2, pa3); MASKT(pB0, pB1, NT - 1); partialSM(pB0, pB1, m_reg, mnB, alB);
  RESC(alB);
  finishSM(pB0, pB1, alB, l_reg, pa0, pa1, pa2, pa3); SBAR();
  pv_d0(o, vb0 + bq * (int)SHM_V, pa0, pa1, pa2, pa3);
  if (MODE == 1) { constexpr float C = SCALE * 1.4426950408889634f; l_reg += __builtin_amdgcn_exp2f(sink * 1.4426950408889634f - m_reg * C); }
  if (hi == 0) li_l[r32] = l_reg; asm volatile("s_waitcnt lgkmcnt(0)" ::: "memory");
  float rli[16];
#pragma unroll
  for (int r = 0; r < 16; ++r) rli[r] = __builtin_amdgcn_rcpf(li_l[crow(r, hi)]);
  bf16* Ow = Ob + (long)(wid * QBLK) * LDO;
#pragma unroll
  for (int r = 0; r < 16; ++r) { int orow = crow(r, hi);
    for (int d0 = 0; d0 < 4; ++d0) Ow[(long)orow * LDO + d0 * 32 + r32] = (bf16)f2bf(o[d0][r] * rli[r]); }
  asm volatile("s_waitcnt vmcnt(0) lgkmcnt(0)" ::: "memory");
  __syncthreads();
#undef TK0
#undef SLOAD
#undef SWRITE
#undef SWAIT
#undef RESC
#undef MASKT
}
#undef KSWZ
#undef SBAR
}

struct Args { const float* in[36]; float* out; unsigned char* ws; int ph_lo, ph_hi; };
enum { I_X = 0, I_C, I_CTX, I_CCTX, I_WMOD, I_BMOD, I_GMIX, I_GFFN, I_WGRP, I_BGRP, I_WRT, I_BRT, I_W1, I_W3, I_W2, I_ABIN, I_ABOUT, I_SCONVW, I_SCONVB,
       I_DTBIAS, I_ALOG, I_SSDD, I_SNORMG, I_QG, I_KG, I_CDIN, I_CDOUT, I_LCONVW, I_LCONVB, I_LWA, I_LBA, I_LWX, I_LBX, I_LAM, I_SINK, I_GFINAL };

struct Ctx {
    const float* const* in; float* out; unsigned char* ws;
    int bid, G;
    __device__ __forceinline__ unsigned* ctl() const { return (unsigned*)(ws + WS_CTL); }
    __device__ __forceinline__ float* mod(int layer, int mv) const { return (float*)(ws + WS_MOD) + (size_t)(layer * 3 + mv) * 6144; }
    __device__ __forceinline__ float* xc() const { return (float*)(ws + WS_XC); }
    __device__ __forceinline__ float* xrow(int r) const { const int b = r / BROWS, q = r - b * BROWS; return q < CTXL ? xc() + (size_t)(b * CTXL + q) * DM : out + (size_t)(b * SEQL + (q - CTXL)) * DM; }
    __device__ __forceinline__ const float* xin_row(int r) const { const int b = r / BROWS, q = r - b * BROWS; return q < CTXL ? in[I_CTX] + (size_t)(b * CTXL + q) * DM : in[I_X] + (size_t)(b * SEQL + (q - CTXL)) * DM; }
};
struct TC { int tid, lane, wave; };
__device__ __forceinline__ TC phase_tc() { TC t; int x = threadIdx.x; asm volatile("" : "+v"(x)); t.tid = x; t.lane = x & 63; t.wave = __builtin_amdgcn_readfirstlane(x >> 6); return t; }
__device__ __forceinline__ int row_mv(int r) { const int b = r / BROWS, q = r - b * BROWS; return q < CTXL ? 2 : b; }

struct RowSched {
    int nM, nN, nwg, G, c, skipctx; const char* A; const char* Bt; size_t a_tile, b_tile;
    __device__ __forceinline__ bool next(int i, pg8::Unit& u) const {
        const long L = (long)i * G + c; if (L >= nwg) return false;
        if (skipctx == 2) { const int t8 = (int)L >> 2, ks = (int)L & 3; u.pm = (t8 >> 2) * 33; u.pn = t8 & 3;
            u.a = A + (size_t)u.pm * a_tile + (size_t)ks * 1024; u.b = Bt + (size_t)u.pn * b_tile + (size_t)ks * 1024; u.bd = 0; u.tbo = (int)L; u.nrow = 0; return true; }
        int wgid = (int)L; { const int q = nwg / 8, r = nwg % 8, xcd = wgid % 8, off = wgid / 8; wgid = (xcd < r ? xcd * (q + 1) : r * (q + 1) + (xcd - r) * q) + off; }
        const int nig = 8 * nN, gid = wgid / nig, fm = gid * 8, gsz = (nM - fm) < 8 ? (nM - fm) : 8;
        const int pmi = fm + ((wgid % nig) % gsz); u.pn = (wgid % nig) / gsz;
        u.pm = skipctx ? (pmi / 32) * 33 + 1 + (pmi % 32) : pmi;
        u.a = A + (size_t)u.pm * a_tile; u.b = Bt + (size_t)u.pn * b_tile; u.bd = 0; u.tbo = 0; u.nrow = 0; return true;
    }
    __device__ __forceinline__ void a_ready(const pg8::Unit&) const {}
    __device__ __forceinline__ void done(const pg8::Unit&) const {}
};
struct MoeSchedBase {
    const int* mt; int G, c, layer; unsigned char* ws;
    __device__ __forceinline__ bool locate(int i, pg8::Unit& u, int& ea, int& eb) const {
        const int ntl = mt[24]; const long L = (long)i * G + c; if (L >= (long)ntl * 4) return false;
        const int tile = (int)(L >> 2), pn = (int)(L & 3), cls = mt[64 + tile], g = cls / 6, pi = cls - g * 6;
        const int ia = pi < 3 ? 0 : (pi < 5 ? 1 : 2), ib = pi < 3 ? pi + 1 : (pi < 5 ? pi - 1 : 3);
        ea = g * 4 + ia; eb = g * 4 + ib;
        const int ti = tile - mt[cls];
        u.pm = tile; u.pn = pn; u.tbo = cls * NROWS + ti * 256; u.nrow = mt[32 + cls] - ti * 256;
        return true;
    }
};
struct MoeSched1 : MoeSchedBase {
    __device__ __forceinline__ bool next(int i, pg8::Unit& u) const { int ea, eb; if (!locate(i, u, ea, eb)) return false;
        const int e = (u.pn >> 1) ? eb : ea; u.a = (const char*)(ws + WS_A); u.b = (const char*)(ws + WS_W13) + ((size_t)e * 512 + (u.pn & 1) * 256) * 1024 * 2; u.bd = 0; return true; }
    __device__ __forceinline__ void a_ready(const pg8::Unit&) const {}
    __device__ __forceinline__ void done(const pg8::Unit& u) const {
        asm volatile("s_waitcnt vmcnt(0)" ::: "memory");
        if ((threadIdx.x & 63) == 0) __hip_atomic_fetch_add((unsigned*)(ws + WS_CTL) + CW_TDONE + layer * 6144 + 64 * u.pm, 1u, __ATOMIC_RELAXED, __HIP_MEMORY_SCOPE_AGENT);
    }
};
struct MoeSched2 : MoeSchedBase {
    __device__ __forceinline__ bool next(int i, pg8::Unit& u) const { int ea, eb; if (!locate(i, u, ea, eb)) return false;
        u.a = (const char*)(ws + WS_Z) + (size_t)u.pm * 256 * 512 * 2; u.b = (const char*)(ws + WS_W2) + ((size_t)ea * 1024 + u.pn * 256) * 256 * 2; u.bd = (long)(eb - ea) * 1024 * 256 * 2 - 4 * 128; return true; }
    __device__ __forceinline__ void a_ready(const pg8::Unit& u) const {
        if (threadIdx.x < 64) {
            unsigned polls = 0;
            unsigned* tw = (unsigned*)(ws + WS_CTL) + CW_TDONE + layer * 6144 + 64 * u.pm;
            while ((unsigned)__builtin_amdgcn_readfirstlane(__hip_atomic_load(tw, __ATOMIC_RELAXED, __HIP_MEMORY_SCOPE_AGENT)) < 32u) {
                if (++polls > (1u << 17)) break;
                __builtin_amdgcn_s_sleep(16); }
            __builtin_amdgcn_fence(__ATOMIC_ACQUIRE, "agent");
            asm volatile("s_waitcnt vmcnt(0)" ::: "memory");
        }
        asm volatile("" ::: "memory"); __builtin_amdgcn_s_barrier(); asm volatile("" ::: "memory");
    }
    __device__ __forceinline__ void done(const pg8::Unit&) const {}
};

struct EpiProj {
    static constexpr bool PERM = true, AFTER_DRAIN = false;
    bf16 *d0, *d1, *d2, *d3, *d4, *d5; int e0, e1, e2, e3, e4; int l0, l1, l2, l3, l4, l5; int lastcols;
    __device__ __forceinline__ void operator()(const f32x4 (&acc)[2][2][4][2], const pg8::Unit& u, int wr, int wc, int fr, int fq) const {
        const int pn = u.pn; bf16* base; int ld, tl, ncol = 256;
        if (pn < e0) { base = d0; ld = l0; tl = pn; } else if (pn < e1) { base = d1; ld = l1; tl = pn - e0; } else if (pn < e2) { base = d2; ld = l2; tl = pn - e1; }
        else if (pn < e3) { base = d3; ld = l3; tl = pn - e2; } else if (pn < e4) { base = d4; ld = l4; tl = pn - e3; } else { base = d5; ld = l5; tl = pn - e4; ncol = lastcols; }
        const int row0 = u.pm * 256 + wr * 64 + fr, col0 = wc * 32 + 8 * fq;
#pragma unroll
        for (int ai = 0; ai < 2; ++ai)
#pragma unroll
            for (int m = 0; m < 4; ++m) { bf16* rowp = base + (size_t)(row0 + ai * 128 + m * 16) * ld + tl * 256 + col0;
#pragma unroll
                for (int bj = 0; bj < 2; ++bj) { if (col0 + bj * 128 < ncol) { const f32x4 v0 = acc[ai][bj][m][0], v1 = acc[ai][bj][m][1];
                    u32x4 w; w.x = pg8::cvt_pk_bf16(v0[0], v0[1]); w.y = pg8::cvt_pk_bf16(v0[2], v0[3]); w.z = pg8::cvt_pk_bf16(v1[0], v1[1]); w.w = pg8::cvt_pk_bf16(v1[2], v1[3]);
                    *(u32x4*)(rowp + bj * 128) = w; } } }
    }
};
struct EpiRes {
    static constexpr bool PERM = false, AFTER_DRAIN = true;
    float* slab;
    const float* xin_lat; const float* xin_ctx; float* xout_lat; float* xout_ctx; const float* modbase;
    __device__ __forceinline__ void operator()(const f32x4 (&acc)[2][2][4][2], const pg8::Unit& u, int wr, int wc, int fr, int fq) const {
        if (slab) { float* sp = slab + (size_t)u.tbo * 65536 + (size_t)(wr * 64 + fr) * 256 + wc * 32 + 4 * fq;
#pragma unroll
            for (int ai = 0; ai < 2; ++ai)
#pragma unroll
                for (int m = 0; m < 4; ++m)
#pragma unroll
                    for (int bj = 0; bj < 2; ++bj)
#pragma unroll
                        for (int n = 0; n < 2; ++n) *(f32x4*)(sp + (size_t)(ai * 128 + m * 16) * 256 + bj * 128 + n * 16) = acc[ai][bj][m][n];
            return; }
        const int b = u.pm / 33, qt = u.pm - b * 33; const bool isctx = (qt == 0);
        const size_t rbase = isctx ? (size_t)b * CTXL : (size_t)b * SEQL + (size_t)(qt - 1) * 256;
        const float* xi = (isctx ? xin_ctx : xin_lat) + rbase * DM; float* xo = (isctx ? xout_ctx : xout_lat) + rbase * DM;
        const float* gate = modbase + (size_t)(isctx ? 2 : b) * 6144 + 2 * 1024;
        const int row0 = wr * 64 + fr, col0 = u.pn * 256 + wc * 32 + 4 * fq;
        f32x4 gv[2][2];
#pragma unroll
        for (int bj = 0; bj < 2; ++bj)
#pragma unroll
            for (int n = 0; n < 2; ++n) gv[bj][n] = *(const f32x4*)(gate + col0 + bj * 128 + n * 16);
#pragma unroll
        for (int ai = 0; ai < 2; ++ai)
#pragma unroll
            for (int m = 0; m < 4; ++m) { const size_t off = (size_t)(row0 + ai * 128 + m * 16) * DM + col0;
#pragma unroll
                for (int bj = 0; bj < 2; ++bj)
#pragma unroll
                    for (int n = 0; n < 2; ++n) { const f32x4 xv = *(const f32x4*)(xi + off + bj * 128 + n * 16);
                        *(f32x4*)(xo + off + bj * 128 + n * 16) = xv + gv[bj][n] * acc[ai][bj][m][n]; } }
    }
    __device__ __forceinline__ void fused(const f32x4 (&acc)[2][2][4][2], const pg8::Unit& u, int wr, int wc, int fr, int fq, LAS unsigned char* lds, int wid, int lane) const {
        if (slab) { (*this)(acc, u, wr, wc, fr, fq); return; }
        const int b = u.pm / 33, qt = u.pm - b * 33; const bool isctx = (qt == 0);
        const size_t rbase = isctx ? (size_t)b * CTXL : (size_t)b * SEQL + (size_t)(qt - 1) * 256;
        const float* xi = (isctx ? xin_ctx : xin_lat) + rbase * DM + u.pn * 256 + 4 * lane; float* xo = (isctx ? xout_ctx : xout_lat) + rbase * DM + u.pn * 256 + 4 * lane;
        const f32x4 gv = *(const f32x4*)(modbase + (size_t)(isctx ? 2 : b) * 6144 + 2 * 1024 + u.pn * 256 + 4 * lane);
        LAS float* T = (LAS float*)lds;
#pragma unroll
        for (int ai = 0; ai < 2; ++ai) {
#pragma unroll
            for (int m = 0; m < 4; ++m)
#pragma unroll
                for (int bj = 0; bj < 2; ++bj)
#pragma unroll
                    for (int n = 0; n < 2; ++n) *(LAS f32x4*)(T + (wr * 64 + m * 16 + fr) * 260 + bj * 128 + wc * 32 + n * 16 + 4 * fq) = acc[ai][bj][m][n];
            __syncthreads();
            f32x4 xv[16];
#pragma unroll
            for (int k = 0; k < 16; ++k) xv[k] = *(const f32x4*)(xi + (size_t)(ai * 128 + wid * 16 + k) * DM);
#pragma unroll
            for (int k = 0; k < 16; ++k) { const f32x4 t = *(const LAS f32x4*)(T + (wid * 16 + k) * 260 + 4 * lane); *(f32x4*)(xo + (size_t)(ai * 128 + wid * 16 + k) * DM) = xv[k] + gv * t; }
            __syncthreads();
        }
    }
};
struct EpiMoe1 {
    static constexpr bool PERM = true, AFTER_DRAIN = false;
    unsigned char* ws;
    __device__ __forceinline__ void operator()(const f32x4 (&acc)[2][2][4][2], const pg8::Unit& u, int wr, int wc, int fr, int fq) const {
        const __amdgpu_buffer_rsrc_t hr = __builtin_amdgcn_make_buffer_rsrc((void*)(ws + WS_Z), 0, MAXSLOT * 512 * 2, 0x00020000);
        const int* TBL = (const int*)(ws + WS_TBL); const int* REC = (const int*)(ws + WS_REC);
        const int rho0 = wr * 64 + fr, colh = (u.pn >> 1) * 256 + (u.pn & 1) * 128 + wc * 32 + 8 * fq, which = u.pn >> 1;
        int rr[8]; float gts[8];
#pragma unroll
        for (int k = 0; k < 8; ++k) { const int rho = rho0 + (k >> 2) * 128 + (k & 3) * 16; const int rc = rho < u.nrow ? rho : u.nrow - 1; rr[k] = TBL[u.tbo + rc]; }
#pragma unroll
        for (int k = 0; k < 8; ++k) gts[k] = __uint_as_float((unsigned)REC[(size_t)rr[k] * 4 + 2 + which]);
#pragma unroll
        for (int ai = 0; ai < 2; ++ai)
#pragma unroll
            for (int m = 0; m < 4; ++m) { const int rho = rho0 + ai * 128 + m * 16; const float gt = gts[ai * 4 + m];
                float hv[8];
#pragma unroll
                for (int n = 0; n < 2; ++n)
#pragma unroll
                    for (int e = 0; e < 4; ++e) { const float a = acc[ai][0][m][n][e], uu = acc[ai][1][m][n][e]; hv[n * 4 + e] = silu_f(a) * uu * gt; }
                u32x4 w; w.x = pg8::cvt_pk_bf16(hv[0], hv[1]); w.y = pg8::cvt_pk_bf16(hv[2], hv[3]); w.z = pg8::cvt_pk_bf16(hv[4], hv[5]); w.w = pg8::cvt_pk_bf16(hv[6], hv[7]);
                __builtin_amdgcn_raw_buffer_store_b128(w, hr, (unsigned)(((size_t)(u.pm * 256 + rho) * 512 + colh) * 2), 0, 16); }
    }
};
struct EpiMoe2 {
    static constexpr bool PERM = false, AFTER_DRAIN = true;
    float* out; unsigned char* ws; int layer;
    __device__ __forceinline__ void operator()(const f32x4 (&acc)[2][2][4][2], const pg8::Unit& u, int wr, int wc, int fr, int fq) const {
        const int rho0 = wr * 64 + fr, col0 = u.pn * 256 + wc * 32 + 4 * fq; const int* TBL = (const int*)(ws + WS_TBL); float* xc = (float*)(ws + WS_XC); const float* modbase = (const float*)(ws + WS_MOD) + (size_t)layer * 3 * 6144;
        int rr[8];
#pragma unroll
        for (int k = 0; k < 8; ++k) { const int rho = rho0 + (k >> 2) * 128 + (k & 3) * 16; rr[k] = rho < u.nrow ? TBL[u.tbo + rho] : -1; }
#pragma unroll
        for (int ai = 0; ai < 2; ++ai)
#pragma unroll
            for (int m = 0; m < 4; ++m) { const int r = rr[ai * 4 + m];
                if (r >= 0) { const int b = r / BROWS, q = r - b * BROWS; const bool isctx = q < CTXL;
                    float* xp = isctx ? xc + (size_t)(b * CTXL + q) * DM : out + (size_t)(b * SEQL + (q - CTXL)) * DM;
                    const float* gate = modbase + (size_t)(isctx ? 2 : b) * 6144 + 5 * 1024;
#pragma unroll
                    for (int bj = 0; bj < 2; ++bj)
#pragma unroll
                        for (int n = 0; n < 2; ++n) { const int c = col0 + bj * 128 + n * 16; const f32x4 gv = *(const f32x4*)(gate + c); const f32x4 xv = *(const f32x4*)(xp + c);
                            *(f32x4*)(xp + c) = xv + gv * acc[ai][bj][m][n]; } }
                if (m & 1) asm volatile("" ::: "memory"); }
    }
    __device__ __forceinline__ void fused(const f32x4 (&acc)[2][2][4][2], const pg8::Unit& u, int wr, int wc, int fr, int fq, LAS unsigned char* lds, int wid, int lane) const {
        const int* TBL = (const int*)(ws + WS_TBL); float* xc = (float*)(ws + WS_XC); const float* modbase = (const float*)(ws + WS_MOD) + (size_t)layer * 3 * 6144;
        LAS float* T = (LAS float*)lds;
#pragma unroll
        for (int ai = 0; ai < 2; ++ai) {
#pragma unroll
            for (int m = 0; m < 4; ++m)
#pragma unroll
                for (int bj = 0; bj < 2; ++bj)
#pragma unroll
                    for (int n = 0; n < 2; ++n) *(LAS f32x4*)(T + (wr * 64 + m * 16 + fr) * 260 + bj * 128 + wc * 32 + n * 16 + 4 * fq) = acc[ai][bj][m][n];
            __syncthreads();
            int rr[16];
#pragma unroll
            for (int k = 0; k < 16; ++k) { const int rho = ai * 128 + wid * 16 + k; rr[k] = rho < u.nrow ? TBL[u.tbo + rho] : -1; }
#pragma unroll
            for (int kp = 0; kp < 16; kp += 4) { f32x4 xv[4]; float* xp[4]; f32x4 gv[4];
#pragma unroll
                for (int k = 0; k < 4; ++k) { const int r = rr[kp + k]; const int rc = r < 0 ? 0 : r; const int b = rc / BROWS, q = rc - b * BROWS; const bool isctx = q < CTXL;
                    xp[k] = (isctx ? xc + (size_t)(b * CTXL + q) * DM : out + (size_t)(b * SEQL + (q - CTXL)) * DM) + u.pn * 256 + 4 * lane;
                    gv[k] = *(const f32x4*)(modbase + (size_t)(isctx ? 2 : b) * 6144 + 5 * 1024 + u.pn * 256 + 4 * lane);
                    if (r >= 0) xv[k] = *(const f32x4*)xp[k]; }
#pragma unroll
                for (int k = 0; k < 4; ++k) { if (rr[kp + k] >= 0) { const f32x4 t = *(const LAS f32x4*)(T + (wid * 16 + kp + k) * 260 + 4 * lane); *(f32x4*)xp[k] = xv[k] + gv[k] * t; } } }
            __syncthreads();
        }
    }
};

__device__ __forceinline__ void transpose_item(const float* W, int ldw, int k0, int n0src, bf16* WT, int ldt, int drow0, int dk0, LAS float* scr, int lane) {
    float tv[32];
#pragma unroll
    for (int i = 0; i < 32; ++i) { const int kk = 2 * i + (lane >> 5); tv[i] = n0src >= 0 ? W[(size_t)(k0 + kk) * ldw + n0src + (lane & 31)] : 0.f; }
#pragma unroll
    for (int i = 0; i < 32; ++i) { const int kk = 2 * i + (lane >> 5); scr[kk * 33 + (lane & 31)] = tv[i]; }
    asm volatile("s_waitcnt lgkmcnt(0)" ::: "memory");
    const int c = lane & 7;
#pragma unroll
    for (int j = 0; j < 4; ++j) { const int n = (lane >> 3) + 8 * j; const LAS float* s = scr + (8 * c) * 33 + n;
        u32x4 o; o.x = pk2(s[0 * 33], s[1 * 33]); o.y = pk2(s[2 * 33], s[3 * 33]); o.z = pk2(s[4 * 33], s[5 * 33]); o.w = pk2(s[6 * 33], s[7 * 33]);
        *(u32x4*)(WT + (size_t)(drow0 + n) * ldt + dk0 + 8 * c) = o; }
    asm volatile("s_waitcnt lgkmcnt(0)" ::: "memory");
}
__device__ __forceinline__ int ab_src_col(int n) {
    if (n < 2304) return n;
    if (n < 3840) return n + 32;
    if (n < 3872) return n - 3840 + 2304;
    return -1;
}
__device__ __forceinline__ void ph_convert(const Ctx& C, int layer, LAS unsigned char* lds) {
    const TC T = phase_tc();
    LAS float* scr = (LAS float*)(lds + T.wave * 16384);
    const int gw = C.bid * NWAVES + T.wave, NGW = C.G * NWAVES;
    bf16* Win = (bf16*)(C.ws + WS_WIN); bf16* Wout = (bf16*)(C.ws + WS_WOUT); bf16* W13 = (bf16*)(C.ws + WS_W13); bf16* W2 = (bf16*)(C.ws + WS_W2);
    const int nin = layer == 0 ? 3872 : 3584;
    const int I_IN = 16 * (nin / 32), I_OUT = 32 * 32, I_E = 16 * 128;
    const int NIT = I_IN + I_OUT + 3 * I_E;
    const float* win = C.in[layer == 0 ? I_ABIN : I_CDIN]; const float* wout = C.in[layer == 0 ? I_ABOUT : I_CDOUT];
    const int ldin = layer == 0 ? 3872 : 3584;
    for (int it = gw; it < NIT; it += NGW) {
        int r = it;
        if (r < I_IN) { const int nblk = nin / 32, kb = r / nblk, nb = r % nblk; const int src = layer == 0 ? ab_src_col(nb * 32) : nb * 32;
            transpose_item(win, ldin, kb * 64, src, Win, 1024, nb * 32, kb * 64, scr, T.lane); continue; } r -= I_IN;
        if (r < I_OUT) { const int kb = r / 32, nb = r % 32; transpose_item(wout, 1024, kb * 64, nb * 32, Wout, 2048, nb * 32, kb * 64, scr, T.lane); continue; } r -= I_OUT;
        if (r < 2 * I_E) { const int w3 = r >= I_E; if (w3) r -= I_E; const int e = r / 128, q = r % 128, kb = q / 8, nb = q % 8;
            const float* W = C.in[w3 ? I_W3 : I_W1] + (size_t)(layer * 16 + e) * 1024 * 256; const int n0 = nb * 32;
            transpose_item(W, 256, kb * 64, n0, W13 + (size_t)e * 512 * 1024, 1024, (n0 / 128) * 256 + (w3 ? 128 : 0) + (n0 % 128), kb * 64, scr, T.lane); continue; } r -= 2 * I_E;
        { const int e = r / 128, q = r % 128, kb = q / 32, nb = q % 32;
            const float* W = C.in[I_W2] + (size_t)(layer * 16 + e) * 256 * 1024;
            transpose_item(W, 1024, kb * 64, nb * 32, W2 + (size_t)e * 1024 * 256, 256, nb * 32, kb * 64, scr, T.lane); }
    }
}
__device__ __forceinline__ void ph_mod(const Ctx& C, LAS unsigned char* lds) {
    const TC T = phase_tc();
    LAS float* red = (LAS float*)lds;
    LAS float* act = red + 8 * 3 * 256;
    if (C.bid < 48) {
        for (int i = T.tid; i < 3072; i += NTHREADS) { const int v = i >> 10, d = i & 1023; act[i] = silu_f(v < 2 ? C.in[I_C][v * 1024 + d] : C.in[I_CCTX][d]); }
        __syncthreads();
    }
    for (int item = C.bid; item < 48; item += C.G) {
        const int layer = item / 24, chunk = item % 24;
        const float* W = C.in[I_WMOD] + (size_t)layer * 1024 * 6144 + chunk * 256 + T.lane * 4;
        f32x4 a0 = {0, 0, 0, 0}, a1 = a0, a2 = a0;
        const int d0 = T.wave * 128;
        for (int d = d0; d < d0 + 128; d += 8) {
            f32x4 w[8];
#pragma unroll
            for (int u = 0; u < 8; ++u) w[u] = *(const f32x4*)(W + (size_t)(d + u) * 6144);
#pragma unroll
            for (int u = 0; u < 8; ++u) { const float c0 = act[d + u], c1 = act[1024 + d + u], c2 = act[2048 + d + u]; a0 += w[u] * c0; a1 += w[u] * c1; a2 += w[u] * c2; }
        }
        __syncthreads();
#pragma unroll
        for (int e = 0; e < 4; ++e) { red[(T.wave * 3 + 0) * 256 + T.lane * 4 + e] = a0[e]; red[(T.wave * 3 + 1) * 256 + T.lane * 4 + e] = a1[e]; red[(T.wave * 3 + 2) * 256 + T.lane * 4 + e] = a2[e]; }
        __syncthreads();
        for (int o = T.tid; o < 768; o += NTHREADS) { const int v = o >> 8, j = o & 255; float s = 0.f;
#pragma unroll
            for (int w = 0; w < 8; ++w) s += red[(w * 3 + v) * 256 + j];
            C.mod(layer, v)[chunk * 256 + j] = s + C.in[I_BMOD][layer * 6144 + chunk * 256 + j]; }
        asm volatile("s_waitcnt vmcnt(0)" ::: "memory");
        __syncthreads();
        if (T.tid == 0) { __builtin_amdgcn_fence(__ATOMIC_RELEASE, "agent"); asm volatile("s_waitcnt vmcnt(0)" ::: "memory");
            __hip_atomic_fetch_add(C.ctl() + CW_MODDONE, 1u, __ATOMIC_RELAXED, __HIP_MEMORY_SCOPE_AGENT); }
    }
}
__device__ __forceinline__ void mod_wait(const Ctx& C) {
    const TC T = phase_tc();
    if (T.tid < 64) { unsigned polls = 0;
        while ((unsigned)__builtin_amdgcn_readfirstlane(__hip_atomic_load(C.ctl() + CW_MODDONE, __ATOMIC_RELAXED, __HIP_MEMORY_SCOPE_AGENT)) < 48u) { if (++polls > (1u << 17)) break; __builtin_amdgcn_s_sleep(16); }
        __builtin_amdgcn_fence(__ATOMIC_ACQUIRE, "agent"); asm volatile("s_waitcnt vmcnt(0)" ::: "memory"); }
    __syncthreads();
}
__device__ __forceinline__ void ph_prenorm(const Ctx& C, int layer) {
    const TC T = phase_tc();
    bf16* HN = (bf16*)(C.ws + WS_A);
    const float* gm = C.in[I_GMIX] + layer * 1024;
    const int gw = C.bid * NWAVES + T.wave, NGW = C.G * NWAVES;
    for (int r = gw; r < NROWS; r += NGW) {
        const float* xr = layer == 0 ? C.xin_row(r) : C.xrow(r);
        const float* md = C.mod(layer, row_mv(r));
        f32x4 v[4]; float ss = 0.f;
#pragma unroll
        for (int j = 0; j < 4; ++j) { v[j] = *(const f32x4*)(xr + 256 * j + 4 * T.lane); ss += (v[j].x * v[j].x + v[j].y * v[j].y) + (v[j].z * v[j].z + v[j].w * v[j].w); }
        const float rs = rsqrtf(wave_sum(ss) * (1.f / DM) + EPS);
#pragma unroll
        for (int j = 0; j < 4; ++j) { const int c = 256 * j + 4 * T.lane; const f32x4 g = *(const f32x4*)(gm + c), sc = *(const f32x4*)(md + 1024 + c), sh = *(const f32x4*)(md + c);
            const f32x4 h = v[j] * rs * g * (sc + 1.f) + sh;
            u32x2 w; w.x = pk2(h.x, h.y); w.y = pk2(h.z, h.w); *(u32x2*)(HN + (size_t)r * DM + c) = w; }
    }
}
__device__ __forceinline__ bool nb_valid(int r, int dk) { const int b = r / BROWS, q = r - b * BROWS; if (q < CTXL) { const int t = q + dk; return t >= 0 && t < CTXL; } const int t = q - CTXL + dk; return t >= 0 && t < SEQL; }
__device__ __forceinline__ void rope_angle(int r, int lane, float& cs, float& sn, bool& latent) {
    const int b = r / BROWS, q = r - b * BROWS; latent = q >= CTXL; const int t = q - CTXL;
    const int pos = lane < 32 ? (t >> 6) : (t & 63); const int jf = lane & 31;
    const float inv = exp2f(-(float)jf * (13.287712379549449f / 32.f));
    const float ang = (float)pos * inv; sincosf(ang, &sn, &cs);
}
__device__ __forceinline__ void ph_elem0(const Ctx& C) {
    const TC T = phase_tc();
    const bf16* RAW = (const bf16*)(C.ws + WS_RAW); bf16* XBC = (bf16*)C.out;
    float* DT = (float*)(C.ws + WS_DT);
    bf16* Q = (bf16*)(C.ws + WS_YMIX) + 1024; bf16* K = (bf16*)(C.ws + WS_K);
    const float* cw = C.in[I_SCONVW]; const float* cb = C.in[I_SCONVB];
    const int gw = C.bid * NWAVES + T.wave, NGW = C.G * NWAVES, lane = T.lane;
    { const bf16* HN = (const bf16*)(C.ws + WS_A); const bf16* Wd = (const bf16*)(C.ws + WS_WIN) + (size_t)3840 * 1024; const int l15 = lane & 15, lq = lane >> 4;
      const float bias0 = C.in[I_DTBIAS][l15], bias1 = C.in[I_DTBIAS][16 + l15];
      for (int gI = gw; gI < NROWS / 16; gI += NGW) { f32x4 a0 = {0.f, 0.f, 0.f, 0.f}, a1 = a0;
          const bf16* ap = HN + (size_t)(16 * gI + l15) * 1024 + 8 * lq; const bf16* b0p = Wd + (size_t)l15 * 1024 + 8 * lq; const bf16* b1p = Wd + (size_t)(16 + l15) * 1024 + 8 * lq;
#pragma unroll 8
          for (int ks = 0; ks < 32; ++ks) { const bf16x8 af = *(const bf16x8*)(ap + 32 * ks), f0 = *(const bf16x8*)(b0p + 32 * ks), f1 = *(const bf16x8*)(b1p + 32 * ks);
              a0 = __builtin_amdgcn_mfma_f32_16x16x32_bf16(af, f0, a0, 0, 0, 0); a1 = __builtin_amdgcn_mfma_f32_16x16x32_bf16(af, f1, a1, 0, 0, 0); }
#pragma unroll
          for (int rg = 0; rg < 4; ++rg) { const size_t ro = (size_t)(16 * gI + 4 * lq + rg) * 32; DT[ro + l15] = softplus_f(a0[rg] + bias0); DT[ro + 16 + l15] = softplus_f(a1[rg] + bias1); } } }
    for (int r = gw; r < NROWS; r += NGW) {
        for (int ch = lane; ch < 160; ch += 64) { const int c0 = ch * 8; float acc[8];
#pragma unroll
            for (int e = 0; e < 8; ++e) acc[e] = cb[c0 + e];
#pragma unroll
            for (int k = 0; k < 5; ++k) { if (nb_valid(r, k - 2)) { const u32x4 w = *(const u32x4*)(RAW + (size_t)(r + k - 2) * 1280 + c0); float xv[8]; unpack8(w, xv);
#pragma unroll
                for (int e = 0; e < 8; ++e) acc[e] += xv[e] * cw[k * 1280 + c0 + e]; } }
            u32x4 o; o.x = pk2(silu_f(acc[0]), silu_f(acc[1])); o.y = pk2(silu_f(acc[2]), silu_f(acc[3])); o.z = pk2(silu_f(acc[4]), silu_f(acc[5])); o.w = pk2(silu_f(acc[6]), silu_f(acc[7]));
            *(u32x4*)(XBC + (size_t)r * 1280 + c0) = o; }
        float cs, sn; bool latent; rope_angle(r, lane, cs, sn, latent);
        const float qg0 = C.in[I_QG][lane], qg1 = C.in[I_QG][64 + lane], kg0 = C.in[I_KG][lane], kg1 = C.in[I_KG][64 + lane];
#pragma unroll
        for (int h = 8; h < 10; ++h) { bf16* p = K + (size_t)r * 256 + (h - 8) * 128;
            float t1 = bf2f(p[lane]), t2 = bf2f(p[64 + lane]);
            const float rs = rsqrtf(wave_sum(t1 * t1 + t2 * t2) * (1.f / 128.f) + EPS);
            t1 = t1 * rs * (h < 8 ? qg0 : kg0); t2 = t2 * rs * (h < 8 ? qg1 : kg1);
            if (latent) { const float o1 = t1 * cs - t2 * sn, o2 = t1 * sn + t2 * cs; t1 = o1; t2 = o2; }
            p[lane] = (bf16)f2bf(t1); p[64 + lane] = (bf16)f2bf(t2); }
    }
}
__device__ __forceinline__ void ph_elem1(const Ctx& C) {
    const TC T = phase_tc();
    const bf16* RAW = (const bf16*)(C.ws + WS_RAW); bf16* XR = (bf16*)(C.ws + WS_A);
    bf16* Q = (bf16*)(C.ws + WS_YMIX) + 1024; bf16* K = (bf16*)(C.ws + WS_K);
    const float* cw = C.in[I_LCONVW]; const float* cb = C.in[I_LCONVB];
    const int gw = C.bid * NWAVES + T.wave, NGW = C.G * NWAVES, lane = T.lane;
    for (int r = gw; r < NROWS; r += NGW) {
        for (int ch = lane; ch < 128; ch += 64) { const int c0 = ch * 8; float acc[8];
#pragma unroll
            for (int e = 0; e < 8; ++e) acc[e] = cb[c0 + e];
#pragma unroll
            for (int k = 0; k < 5; ++k) { if (nb_valid(r, k - 2)) { const u32x4 w = *(const u32x4*)(RAW + (size_t)(r + k - 2) * 1024 + c0); float xv[8]; unpack8(w, xv);
#pragma unroll
                for (int e = 0; e < 8; ++e) acc[e] += xv[e] * cw[k * 1024 + c0 + e]; } }
            u32x4 o; o.x = pk2(acc[0], acc[1]); o.y = pk2(acc[2], acc[3]); o.z = pk2(acc[4], acc[5]); o.w = pk2(acc[6], acc[7]);
            *(u32x4*)(XR + (size_t)r * 1024 + c0) = o; }
        float cs, sn; bool latent; rope_angle(r, lane, cs, sn, latent);
        if (latent) {
#pragma unroll
            for (int h = 8; h < 10; ++h) { bf16* p = K + (size_t)r * 256 + (h - 8) * 128;
                const float t1 = bf2f(p[lane]), t2 = bf2f(p[64 + lane]);
                p[lane] = (bf16)f2bf(t1 * cs - t2 * sn); p[64 + lane] = (bf16)f2bf(t1 * sn + t2 * cs); }
        }
    }
}
__device__ __forceinline__ int chunk_of(int dir, int ci) { return dir == 0 ? ci : (ci < 2 ? 1 - ci : 67 - ci); }
__device__ __forceinline__ int step_row(int dir, int s) { return dir == 0 ? s : (s < CTXL ? CTXL - 1 - s : BROWS + CTXL - 1 - s); }
__device__ __forceinline__ void ssd_seq_unit(const Ctx& C, int item, LAS unsigned char* lds) {
    const TC T = phase_tc();
    const int b = item >> 5, dir = (item >> 4) & 1, h = item & 15, g = h >> 3, lane = T.lane, wid = T.wave;
    LAS float* part = (LAS float*)lds;
    LAS float* xs = part + 8 * 32 * 64; LAS float* Bs = xs + 32 * 64; LAS float* Cs = Bs + 32 * 64; LAS float* dts = Cs + 32 * 64;
    const float aneg = -__expf(C.in[I_ALOG][dir * 16 + h]);
    const bf16* XBC = (const bf16*)C.out + (size_t)b * BROWS * 1280;
    const float* DT = (const float*)(C.ws + WS_DT) + (size_t)b * BROWS * 32 + dir * 16 + h;
    bf16* Y = dir == 0 ? (bf16*)(C.ws + WS_YMIX) + (size_t)b * BROWS * 2048 + h * 64 : (bf16*)(C.ws + WS_RAW) + (size_t)b * BROWS * 1024 + h * 64;
    const int ldy = dir == 0 ? 2048 : 1024;
    float hs[8];
#pragma unroll
    for (int k = 0; k < 8; ++k) hs[k] = 0.f;
    for (int s0 = 0; s0 < BROWS; s0 += 32) {
        for (int i = T.tid; i < 32 * 192; i += NTHREADS) { const int tt = i / 192, c = i - tt * 192; const int q = step_row(dir, s0 + tt);
            const bf16* row = XBC + (size_t)q * 1280;
            if (c < 64) xs[tt * 64 + c] = bf2f(row[h * 64 + c]); else if (c < 128) Bs[tt * 64 + c - 64] = bf2f(row[1024 + g * 64 + c - 64]); else Cs[tt * 64 + c - 128] = bf2f(row[1152 + g * 64 + c - 128]); }
        if (T.tid < 32) dts[T.tid] = DT[(size_t)step_row(dir, s0 + T.tid) * 32];
        __syncthreads();
        for (int tt = 0; tt < 32; ++tt) {
            const float x = xs[tt * 64 + lane], dt = dts[tt];
            const f32x4 b0 = *(const LAS f32x4*)(Bs + tt * 64 + wid * 8), b1 = *(const LAS f32x4*)(Bs + tt * 64 + wid * 8 + 4);
            const f32x4 c0 = *(const LAS f32x4*)(Cs + tt * 64 + wid * 8), c1 = *(const LAS f32x4*)(Cs + tt * 64 + wid * 8 + 4);
            const float a = __expf(dt * aneg), dx = dt * x; float y = 0.f;
#pragma unroll
            for (int k = 0; k < 4; ++k) { hs[k] = a * hs[k] + dx * b0[k]; y += c0[k] * hs[k]; }
#pragma unroll
            for (int k = 0; k < 4; ++k) { hs[4 + k] = a * hs[4 + k] + dx * b1[k]; y += c1[k] * hs[4 + k]; }
            part[(wid * 32 + tt) * 64 + lane] = y;
        }
        __syncthreads();
        for (int i = T.tid; i < 2048; i += NTHREADS) { const int tt = i >> 6, p = i & 63; float s = 0.f;
#pragma unroll
            for (int w = 0; w < 8; ++w) s += part[(w * 32 + tt) * 64 + p];
            const int q = step_row(dir, s0 + tt); Y[(size_t)q * ldy + p] = (bf16)f2bf(s); }
        __syncthreads();
    }
}

__device__ __forceinline__ int ssd_seg_begin(int s) { return s == 0 ? 0 : (s == 1 ? 17 : (s == 2 ? 34 : (s == 3 ? 50 : 66))); }
__device__ __forceinline__ unsigned short hw_bf16(float x) { unsigned r; asm volatile("v_cvt_pk_bf16_f32 %0, %1, %1" : "=v"(r) : "v"(x)); return (unsigned short)r; }
__device__ __forceinline__ int tswz(int row, int col) { return row * 136 + ((((col >> 3) ^ ((row >> 3) & 7)) << 3) | (col & 7)); }
template <int MODE>
__device__ __forceinline__ void ssd_chunk_unit(const Ctx& C, int item, int seg, LAS unsigned char* lds) {
    const TC T = phase_tc();
    const int b = item >> 5, dir = (item >> 4) & 1, h = item & 15, g = h >> 3, lane = T.lane, wid = T.wave, tid = T.tid;
    const int ci0 = ssd_seg_begin(seg), ci1 = ssd_seg_begin(seg + 1);
    float* SEND = (float*)(C.ws + WS_SSDST) + (size_t)item * 3 * 4096; float* SLD = (float*)(C.ws + WS_SSDLD) + item * 3;
    const int l15 = lane & 15, lq = lane >> 4;
    LAS bf16* Cs = (LAS bf16*)lds;
    LAS bf16* Bs = Cs + 128 * 72;
    LAS bf16* Xt = Bs + 128 * 72;
    LAS bf16* Bwt = Xt + 64 * 136;
    LAS bf16* Ws = Bwt + 64 * 136;
    LAS bf16* Hs = Ws + 128 * 136;
    LAS float* acs = (LAS float*)(Hs + 64 * 72); LAS float* dtv = acs + 128; LAS float* eacs = dtv + 128; LAS float* wend = eacs + 128;
    const float aneg = -__expf(C.in[I_ALOG][dir * 16 + h]);
    const bf16* XBC = (const bf16*)C.out + (size_t)b * BROWS * 1280;
    const float* DT = (const float*)(C.ws + WS_DT) + (size_t)b * BROWS * 32 + dir * 16 + h;
    bf16* Y = dir == 0 ? (bf16*)(C.ws + WS_YMIX) + (size_t)b * BROWS * 2048 + h * 64 : (bf16*)(C.ws + WS_RAW) + (size_t)b * BROWS * 1024 + h * 64;
    const int ldy = dir == 0 ? 2048 : 1024;
    f32x4 Hacc[2]; Hacc[0] = (f32x4){0.f, 0.f, 0.f, 0.f}; Hacc[1] = Hacc[0];
    float ldsum = 0.f;
    if (MODE == 1) {
        for (int sp = 0; sp < seg; ++sp) { const float dseg = __expf(SLD[sp]);
#pragma unroll
            for (int t = 0; t < 2; ++t) { const int tl = 2 * wid + t, nt_ = tl >> 2, pt = tl & 3;
                const f32x4 sv = *(const f32x4*)(SEND + (size_t)sp * 4096 + (16 * pt + l15) * 64 + 16 * nt_ + 4 * lq); Hacc[t] = Hacc[t] * dseg + sv; } }
#pragma unroll
        for (int t = 0; t < 2; ++t) { const int tl = 2 * wid + t, nt_ = tl >> 2, pt = tl & 3;
            u32x2 w; w.x = pg8::cvt_pk_bf16(Hacc[t][0], Hacc[t][1]); w.y = pg8::cvt_pk_bf16(Hacc[t][2], Hacc[t][3]); *(LAS u32x2*)(Hs + (16 * pt + l15) * 72 + 16 * nt_ + 4 * lq) = w; }
    }
    u32x4 xb[4], bb[2], cb[2]; float dt0 = 0.f, dt1 = 0.f;
    const int xtg = tid >> 3, xpg = tid & 7;
#define SSD_ROW(q0_, i_) (XBC + (size_t)(dir == 0 ? (q0_) + (i_) : (q0_) + 127 - (i_)) * 1280)
#define SSD_LOAD(q0_) do { \
        if (tid < 256) { _Pragma("unroll") for (int q_ = 0; q_ < 4; ++q_) xb[q_] = *(const u32x4*)(SSD_ROW(q0_, 4 * xtg + q_) + h * 64 + 8 * xpg); } \
        _Pragma("unroll") for (int k = 0; k < 2; ++k) { const int pidx = tid + 512 * k, i_ = pidx >> 3, c8_ = (pidx & 7) * 8; \
            bb[k] = *(const u32x4*)(SSD_ROW(q0_, i_) + 1024 + g * 64 + c8_); if (MODE == 1) cb[k] = *(const u32x4*)(SSD_ROW(q0_, i_) + 1152 + g * 64 + c8_); } \
        if (wid == 0) { dt0 = DT[(size_t)(dir == 0 ? (q0_) + 2 * lane : (q0_) + 127 - 2 * lane) * 32]; dt1 = DT[(size_t)(dir == 0 ? (q0_) + 2 * lane + 1 : (q0_) + 126 - 2 * lane) * 32]; } } while (0)
    SSD_LOAD(chunk_of(dir, ci0) * 128);
    for (int ci = ci0; ci < ci1; ++ci) {
        const int q0 = chunk_of(dir, ci) * 128;
        __syncthreads();
        if (wid == 0) {
            const float a0 = dt0 * aneg, a1 = dt1 * aneg; float v = a0 + a1;
#pragma unroll
            for (int o = 1; o < 64; o <<= 1) { const float t = __shfl_up(v, o); if (lane >= o) v += t; }
            const float tot = __shfl(v, 63), c0 = v - a1;
            acs[2 * lane] = c0; acs[2 * lane + 1] = v; dtv[2 * lane] = dt0; dtv[2 * lane + 1] = dt1;
            eacs[2 * lane] = __expf(c0); eacs[2 * lane + 1] = __expf(v);
            wend[2 * lane] = __expf(tot - c0) * dt0; wend[2 * lane + 1] = __expf(tot - v) * dt1; }
        if (tid < 256) {
#pragma unroll
            for (int m = 0; m < 4; ++m) { const unsigned w0 = xb[0][m], w1 = xb[1][m], w2 = xb[2][m], w3 = xb[3][m];
                u32x2 lo, hi; lo.x = (w0 & 0xffffu) | (w1 << 16); lo.y = (w2 & 0xffffu) | (w3 << 16); hi.x = (w0 >> 16) | (w1 & 0xffff0000u); hi.y = (w2 >> 16) | (w3 & 0xffff0000u);
                *(LAS u32x2*)(Xt + tswz(8 * xpg + 2 * m, 4 * xtg)) = lo; *(LAS u32x2*)(Xt + tswz(8 * xpg + 2 * m + 1, 4 * xtg)) = hi; } }
#pragma unroll
        for (int k = 0; k < 2; ++k) { const int pidx = tid + 512 * k, i_ = pidx >> 3, c8_ = (pidx & 7) * 8;
            *(LAS u32x4*)(Bs + i_ * 72 + c8_) = bb[k]; if (MODE == 1) *(LAS u32x4*)(Cs + i_ * 72 + c8_) = cb[k]; }
        if (ci + 1 < ci1) SSD_LOAD(chunk_of(dir, ci + 1) * 128);
        __syncthreads();
        const float al = acs[127], dchunk = __expf(al); ldsum += al;
        if (tid < 256) { float f[4][8];
#pragma unroll
            for (int q_ = 0; q_ < 4; ++q_) { const u32x4 w = *(const LAS u32x4*)(Bs + (4 * xtg + q_) * 72 + 8 * xpg); unpack8(w, f[q_]); const float we = wend[4 * xtg + q_];
#pragma unroll
                for (int e = 0; e < 8; ++e) f[q_][e] *= we; }
#pragma unroll
            for (int e = 0; e < 8; ++e) { u32x2 w; w.x = pg8::cvt_pk_bf16(f[0][e], f[1][e]); w.y = pg8::cvt_pk_bf16(f[2][e], f[3][e]); *(LAS u32x2*)(Bwt + tswz(8 * xpg + e, 4 * xtg)) = w; } }
        if (MODE == 1) {
            for (int t = wid; t < 40; t += 8) {
                if (t >= 36) { const int rt = 2 * (t - 36);
                    *(LAS u32x2*)(Ws + (16 * rt + l15) * 136 + 16 * (rt + 1) + 4 * lq) = (u32x2){0u, 0u};
                    continue; }
                int rt = 0, base = 0; while (base + rt + 1 <= t) { base += rt + 1; ++rt; }
                const int ct = t - base;
                f32x4 acc = (f32x4){0.f, 0.f, 0.f, 0.f};
#pragma unroll
                for (int kk = 0; kk < 2; ++kk) { const bf16x8 af = *(const LAS bf16x8*)(Bs + (16 * ct + l15) * 72 + kk * 32 + 8 * lq), bfr = *(const LAS bf16x8*)(Cs + (16 * rt + l15) * 72 + kk * 32 + 8 * lq);
                    acc = __builtin_amdgcn_mfma_f32_16x16x32_bf16(af, bfr, acc, 0, 0, 0); }
                const int i = 16 * rt + l15; const float ai = acs[i];
                const f32x4 aj = *(const LAS f32x4*)(acs + 16 * ct + 4 * lq), dj = *(const LAS f32x4*)(dtv + 16 * ct + 4 * lq);
                float val[4];
#pragma unroll
                for (int rg = 0; rg < 4; ++rg) { const int j = 16 * ct + 4 * lq + rg; val[rg] = j <= i ? acc[rg] * __expf(ai - aj[rg]) * dj[rg] : 0.f; }
                u32x2 w; w.x = pg8::cvt_pk_bf16(val[0], val[1]); w.y = pg8::cvt_pk_bf16(val[2], val[3]); *(LAS u32x2*)(Ws + i * 136 + 16 * ct + 4 * lq) = w; }
        }
        __syncthreads();
        if (MODE == 1) { const int it = wid; f32x4 acc[4];
#pragma unroll
          for (int pt = 0; pt < 4; ++pt) acc[pt] = (f32x4){0.f, 0.f, 0.f, 0.f};
#pragma unroll
          for (int kk = 0; kk < 2; ++kk) { const bf16x8 bfr = *(const LAS bf16x8*)(Cs + (16 * it + l15) * 72 + kk * 32 + 8 * lq);
#pragma unroll
              for (int pt = 0; pt < 4; ++pt) { const bf16x8 af = *(const LAS bf16x8*)(Hs + (16 * pt + l15) * 72 + kk * 32 + 8 * lq); acc[pt] = __builtin_amdgcn_mfma_f32_16x16x32_bf16(af, bfr, acc[pt], 0, 0, 0); } }
          const float ea = eacs[16 * it + l15];
#pragma unroll
          for (int pt = 0; pt < 4; ++pt) acc[pt] = acc[pt] * ea;
          for (int ks = 0; ks <= (it >> 1); ++ks) { const bf16x8 bfr = *(const LAS bf16x8*)(Ws + (16 * it + l15) * 136 + ks * 32 + 8 * lq);
#pragma unroll
              for (int pt = 0; pt < 4; ++pt) { const bf16x8 af = *(const LAS bf16x8*)(Xt + tswz(16 * pt + l15, ks * 32 + 8 * lq)); acc[pt] = __builtin_amdgcn_mfma_f32_16x16x32_bf16(af, bfr, acc[pt], 0, 0, 0); } }
          { const int i = 16 * it + l15; const int q = dir == 0 ? q0 + i : q0 + 127 - i;
#pragma unroll
            for (int pt = 0; pt < 4; ++pt) { u32x2 w; w.x = pg8::cvt_pk_bf16(acc[pt][0], acc[pt][1]); w.y = pg8::cvt_pk_bf16(acc[pt][2], acc[pt][3]); *(u32x2*)(Y + (size_t)q * ldy + 16 * pt + 4 * lq) = w; } } }
#pragma unroll
        for (int t = 0; t < 2; ++t) { const int tl = 2 * wid + t, nt_ = tl >> 2, pt = tl & 3; Hacc[t] = Hacc[t] * dchunk;
#pragma unroll
            for (int ks = 0; ks < 4; ++ks) { const bf16x8 af = *(const LAS bf16x8*)(Bwt + tswz(16 * nt_ + l15, ks * 32 + 8 * lq)), bfr = *(const LAS bf16x8*)(Xt + tswz(16 * pt + l15, ks * 32 + 8 * lq));
                Hacc[t] = __builtin_amdgcn_mfma_f32_16x16x32_bf16(af, bfr, Hacc[t], 0, 0, 0); } }
        if (MODE == 1) {
        __syncthreads();
#pragma unroll
        for (int t = 0; t < 2; ++t) { const int tl = 2 * wid + t, nt_ = tl >> 2, pt = tl & 3;
            u32x2 w; w.x = pg8::cvt_pk_bf16(Hacc[t][0], Hacc[t][1]); w.y = pg8::cvt_pk_bf16(Hacc[t][2], Hacc[t][3]); *(LAS u32x2*)(Hs + (16 * pt + l15) * 72 + 16 * nt_ + 4 * lq) = w; }
        }
    }
    if (MODE == 0) {
#pragma unroll
        for (int t = 0; t < 2; ++t) { const int tl = 2 * wid + t, nt_ = tl >> 2, pt = tl & 3;
            *(f32x4*)(SEND + (size_t)seg * 4096 + (16 * pt + l15) * 64 + 16 * nt_ + 4 * lq) = Hacc[t]; }
        if (tid == 0) SLD[seg] = ldsum;
    }
    __syncthreads();
#undef SSD_ROW
#undef SSD_LOAD
}

__device__ __forceinline__ void lru_seq_unit(const Ctx& C, int item, LAS unsigned char* lds) {
    const TC T = phase_tc();
    const int b = item >> 5, dir = (item >> 4) & 1, hb = item & 15, lane = T.lane, wid = T.wave;
    LAS float* wa = (LAS float*)lds; LAS float* wx = wa + 4096; LAS float* xs = wx + 4096; LAS float* as_ = xs + 512; LAS float* bs_ = as_ + 512;
    const float* gwa = C.in[I_LWA] + (size_t)(dir * 16 + hb) * 4096; const float* gwx = C.in[I_LWX] + (size_t)(dir * 16 + hb) * 4096;
    for (int i = T.tid; i < 4096; i += NTHREADS) { wa[i] = gwa[i]; wx[i] = gwx[i]; }
    const int c = hb * 64 + lane;
    const float ba = C.in[I_LBA][dir * 1024 + c], bx = C.in[I_LBX][dir * 1024 + c], logbase = -8.f * softplus_f(-C.in[I_LAM][dir * 1024 + c]);
    const bf16* XR = (const bf16*)(C.ws + WS_A) + (size_t)b * BROWS * 1024 + hb * 64;
    bf16* Y = dir == 0 ? (bf16*)(C.ws + WS_YMIX) + (size_t)b * BROWS * 2048 + hb * 64 : (bf16*)(C.ws + WS_RAW) + (size_t)b * BROWS * 1024 + hb * 64;
    const int ldy = dir == 0 ? 2048 : 1024;
    float hst = 0.f;
    __syncthreads();
    unsigned short xnext = XR[(size_t)step_row(dir, wid) * 1024 + lane];
    for (int it = 0; it < BROWS / 8; ++it) {
        const float xv = bf2f(xnext);
        if (it + 1 < BROWS / 8) xnext = XR[(size_t)step_row(dir, (it + 1) * 8 + wid) * 1024 + lane];
        xs[wid * 64 + lane] = xv;
        asm volatile("s_waitcnt lgkmcnt(0)" ::: "memory");
        float pa = ba, px = bx;
#pragma unroll 8
        for (int i = 0; i < 64; ++i) { const float xi = xs[wid * 64 + i]; pa += xi * wa[i * 64 + lane]; px += xi * wx[i * 64 + lane]; }
        const float la = logbase * sigmoid_f(pa), a = __expf(la), bc = sqrtf(-expm1f(2.f * la)) * sigmoid_f(px) * xv;
        as_[wid * 64 + lane] = a; bs_[wid * 64 + lane] = bc;
        __syncthreads();
        if (wid == 0) {
#pragma unroll
            for (int tt = 0; tt < 8; ++tt) { hst = as_[tt * 64 + lane] * hst + bs_[tt * 64 + lane]; const int q2 = step_row(dir, it * 8 + tt); Y[(size_t)q2 * ldy + lane] = (bf16)f2bf(hst); }
        }
        __syncthreads();
    }
}

__device__ __forceinline__ float fast_sigmoid(float x) { return __builtin_amdgcn_rcpf(1.f + __expf(-x)); }
__device__ __forceinline__ void lru_chunk_unit(const Ctx& C, int item4, LAS unsigned char* lds) {
    const TC T = phase_tc();
    const int item = item4 >> 2, qc = item4 & 3;
    const int b = item >> 5, dir = (item >> 4) & 1, hb = item & 15, lane = T.lane, wid = T.wave, tid = T.tid;
    LAS bf16* xs0 = (LAS bf16*)lds;
    LAS bf16* wT = (LAS bf16*)(lds + 36864);
    LAS float* sWP = (LAS float*)(lds + 36864 + 4608);
    LAS float* sWH = sWP + 128;
    const float* gwa = C.in[I_LWA] + (size_t)(dir * 16 + hb) * 4096; const float* gwx = C.in[I_LWX] + (size_t)(dir * 16 + hb) * 4096;
    for (int i = tid; i < 1024; i += NTHREADS) { const int ii = i >> 4, j = i & 15; wT[j * 72 + ii] = (bf16)f2bf(gwa[ii * 64 + qc * 16 + j]); wT[16 * 72 + j * 72 + ii] = (bf16)f2bf(gwx[ii * 64 + qc * 16 + j]); }
    const int l15 = lane & 15, lq = lane >> 4;
    const int c = hb * 64 + qc * 16 + l15;
    const float ba = C.in[I_LBA][dir * 1024 + c], bx = C.in[I_LBX][dir * 1024 + c], lb = -8.f * softplus_f(-C.in[I_LAM][dir * 1024 + c]);
    float hst = 0.f;
    const bf16* XR = (const bf16*)(C.ws + WS_A) + (size_t)b * BROWS * 1024 + hb * 64;
    bf16* Y = dir == 0 ? (bf16*)(C.ws + WS_YMIX) + (size_t)b * BROWS * 2048 + hb * 64 + qc * 16 : (bf16*)(C.ws + WS_RAW) + (size_t)b * BROWS * 1024 + hb * 64 + qc * 16;
    const int ldy = dir == 0 ? 2048 : 1024;
    const int pr0 = tid >> 3, pc = (tid & 7) * 8;
    u32x4 st0, st1;
    { const int q0 = chunk_of(dir, 0) * 128; const int qa = dir == 0 ? q0 + pr0 : q0 + 127 - pr0, qb = dir == 0 ? q0 + pr0 + 64 : q0 + 63 - pr0;
      st0 = *(const u32x4*)(XR + (size_t)qa * 1024 + pc); st1 = *(const u32x4*)(XR + (size_t)qb * 1024 + pc); }
    __syncthreads();
    for (int ci = 0; ci < 66; ++ci) {
        const int q0 = chunk_of(dir, ci) * 128;
        LAS bf16* xs = xs0 + (ci & 1) * (128 * 72);
        *(LAS u32x4*)(xs + pr0 * 72 + pc) = st0; *(LAS u32x4*)(xs + (pr0 + 64) * 72 + pc) = st1;
        if (ci + 1 < 66) { const int qn = chunk_of(dir, ci + 1) * 128; const int qa = dir == 0 ? qn + pr0 : qn + 127 - pr0, qb = dir == 0 ? qn + pr0 + 64 : qn + 63 - pr0;
            st0 = *(const u32x4*)(XR + (size_t)qa * 1024 + pc); st1 = *(const u32x4*)(XR + (size_t)qb * 1024 + pc); }
        __syncthreads();
        f32x4 ga = (f32x4){0.f, 0.f, 0.f, 0.f}, gx = ga;
#pragma unroll
        for (int kk = 0; kk < 2; ++kk) { const bf16x8 af = *(const LAS bf16x8*)(xs + (16 * wid + l15) * 72 + kk * 32 + 8 * lq);
            const bf16x8 b0 = *(const LAS bf16x8*)(wT + l15 * 72 + kk * 32 + 8 * lq), b1 = *(const LAS bf16x8*)(wT + 16 * 72 + l15 * 72 + kk * 32 + 8 * lq);
            ga = __builtin_amdgcn_mfma_f32_16x16x32_bf16(af, b0, ga, 0, 0, 0); gx = __builtin_amdgcn_mfma_f32_16x16x32_bf16(af, b1, gx, 0, 0, 0); }
        float p = 1.f, hh = 0.f;
#pragma unroll
        for (int rg = 0; rg < 4; ++rg) { const int i = 16 * wid + 4 * lq + rg;
            const float la = lb * fast_sigmoid(ga[rg] + ba), a = __expf(la), xv = bf2f(xs[i * 72 + qc * 16 + l15]);
            const float x2 = 2.f * la, oms = -x2 * (1.f + 0.5f * x2 * (1.f + (1.f / 3.f) * x2 * (1.f + 0.25f * x2 * (1.f + 0.2f * x2)))), om = x2 < -0.4f ? 1.f - a * a : oms;
            const float bc = __builtin_amdgcn_sqrtf(om) * fast_sigmoid(gx[rg] + bx) * xv;
            hh = a * hh + bc; p *= a; ga[rg] = p; gx[rg] = hh; }
        { const float pp = __shfl_up(p, 16), hp = __shfl_up(hh, 16); if (lq >= 1) { hh = p * hp + hh; p = pp * p; } }
        { const float pp = __shfl_up(p, 32), hp = __shfl_up(hh, 32); if (lq >= 2) { hh = p * hp + hh; p = pp * p; } }
        const float pe_ = __shfl_up(p, 16), he_ = __shfl_up(hh, 16);
        const float Pe = lq >= 1 ? pe_ : 1.f, He = lq >= 1 ? he_ : 0.f;
        if (lq == 3) { sWP[l15 * 8 + wid] = p; sWH[l15 * 8 + wid] = hh; }
        __syncthreads();
        { const f32x4 p0 = *(const LAS f32x4*)(sWP + l15 * 8), p1 = *(const LAS f32x4*)(sWP + l15 * 8 + 4), h0 = *(const LAS f32x4*)(sWH + l15 * 8), h1 = *(const LAS f32x4*)(sWH + l15 * 8 + 4);
            float cin = hst, cw = hst;
#pragma unroll
            for (int w = 0; w < 8; ++w) { if (w == wid) cw = cin; const float pw = w < 4 ? p0[w & 3] : p1[w & 3], hw = w < 4 ? h0[w & 3] : h1[w & 3]; cin = pw * cin + hw; }
            hst = cin;
            const float cl = Pe * cw + He;
#pragma unroll
            for (int rg = 0; rg < 4; ++rg) { const int i = 16 * wid + 4 * lq + rg; const int q = dir == 0 ? q0 + i : q0 + 127 - i;
                Y[(size_t)q * ldy + l15] = hw_bf16(gx[rg] + ga[rg] * cl); } }
    }
    __syncthreads();
}

__device__ __forceinline__ int queue_pop(const Ctx& C, unsigned* qword, LAS unsigned char* lds) {
    const TC T = phase_tc();
    LAS int* slot = (LAS int*)(lds + LDS_BYTES - 64);
    __syncthreads();
    if (T.tid == 0) slot[0] = (int)atomicAdd(qword, 1u);
    __syncthreads();
    const int v = slot[0];
    return __builtin_amdgcn_readfirstlane(v);
}
__device__ __forceinline__ void ph_ssdpre(const Ctx& C, LAS unsigned char* lds) {
    for (int u = C.bid; u < 192; u += C.G) ssd_chunk_unit<0>(C, u / 3, u % 3, lds);
}
__device__ __forceinline__ void ph_mix0(const Ctx& C, LAS unsigned char* lds, char* ldsg) {
    bf16* YM = (bf16*)(C.ws + WS_YMIX); const bf16* K = (const bf16*)(C.ws + WS_K); const bf16* V = (const bf16*)(C.ws + WS_V);
    for (;;) {
        const int item = queue_pop(C, C.ctl() + CW_Q0, lds);
        if (item >= 256 + 512 + 16) break;
#ifdef SPLIT_MIX0
        if (item < 256) continue;
#else
        if (item < 256) { ssd_chunk_unit<1>(C, item >> 2, item & 3, lds); continue; }
#endif
        const int a = item - 256;
        if (a >= 16) { const int a1 = a - 16, hr = a1 & 3, qb = (a1 >> 2) & 31, kvh = (a1 >> 7) & 1, b = a1 >> 8, h = kvh * 4 + hr;
            bf16* Qb = YM + ((size_t)b * BROWS + CTXL + (size_t)qb * 256) * 2048 + 1024 + h * 128;
            att::attn_body<0>(Qb, K + (size_t)b * BROWS * 256 + kvh * 128, V + (size_t)b * BROWS * 256 + kvh * 128, Qb, BROWS / 64, 0, 0, 0.f, ldsg, C.in[I_QG], qb * 256);
        } else { const int b = a >> 3, h = a & 7, kvh = h >> 2;
            bf16* Qb = YM + ((size_t)b * BROWS) * 2048 + 1024 + h * 128;
            att::attn_body<0>(Qb, K + (size_t)b * BROWS * 256 + kvh * 128, V + (size_t)b * BROWS * 256 + kvh * 128, Qb, CTXL / 64, 0, 0, 0.f, ldsg, C.in[I_QG], -1);
        }
    }
}
__device__ __forceinline__ void ph_mix1(const Ctx& C, LAS unsigned char* lds, char* ldsg) {
    bf16* YM = (bf16*)(C.ws + WS_YMIX); const bf16* K = (const bf16*)(C.ws + WS_K); const bf16* V = (const bf16*)(C.ws + WS_V);
    for (;;) {
        const int item = queue_pop(C, C.ctl() + CW_Q1, lds);
        if (item >= 256 + 512) break;
        if (item < 256) { lru_chunk_unit(C, item, lds); continue; }
        const int a = item - 256, hr = a & 3, qb = (a >> 2) & 31, kvh = (a >> 7) & 1, b = a >> 8, h = kvh * 4 + hr;
        const int q0 = qb * 256, lo = q0 - 128 < 0 ? 0 : q0 - 128, hi_ = q0 + 384 > SEQL ? SEQL : q0 + 384;
        bf16* Qb = YM + ((size_t)b * BROWS + CTXL + (size_t)q0) * 2048 + 1024 + h * 128;
        att::attn_body<1>(Qb, K + (size_t)b * BROWS * 256 + kvh * 128, V + (size_t)b * BROWS * 256 + kvh * 128, Qb, 4 + (hi_ - lo) / 64, CTXL + lo, q0, C.in[I_SINK][h], ldsg, nullptr, q0);
    }
}
__device__ __forceinline__ void ph_ssdpost(const Ctx& C) {
    const TC T = phase_tc();
    bf16* YM = (bf16*)(C.ws + WS_YMIX); const bf16* YB = (const bf16*)(C.ws + WS_RAW); const bf16* XBC = (const bf16*)C.out; const bf16* Z = (const bf16*)(C.ws + WS_Z);
    const int gw = C.bid * NWAVES + T.wave, NGW = C.G * NWAVES, lane = T.lane;
    for (int r = gw; r < NROWS; r += NGW) {
        float v[16]; float ss = 0.f;
#pragma unroll
        for (int j = 0; j < 2; ++j) { const int c0 = j * 512 + lane * 8;
            const u32x4 wy = *(const u32x4*)(YM + (size_t)r * 2048 + c0), wb = *(const u32x4*)(YB + (size_t)r * 1024 + c0), wx = *(const u32x4*)(XBC + (size_t)r * 1280 + c0), wz = *(const u32x4*)(Z + (size_t)r * 1024 + c0);
            float fy[8], fb[8], fx[8], fz[8]; unpack8(wy, fy); unpack8(wb, fb); unpack8(wx, fx); unpack8(wz, fz);
            const float dsk = C.in[I_SSDD][c0 >> 6];
#pragma unroll
            for (int e = 0; e < 8; ++e) { const float y = (fy[e] + fb[e] + dsk * fx[e]) * silu_f(fz[e]); v[j * 8 + e] = y; ss += y * y; } }
        const float rs = rsqrtf(wave_sum(ss) * (1.f / 1024.f) + EPS);
#pragma unroll
        for (int j = 0; j < 2; ++j) { const int c0 = j * 512 + lane * 8; const float* ng = C.in[I_SNORMG] + c0;
            u32x4 o; o.x = pk2(v[j * 8 + 0] * rs * ng[0], v[j * 8 + 1] * rs * ng[1]); o.y = pk2(v[j * 8 + 2] * rs * ng[2], v[j * 8 + 3] * rs * ng[3]);
            o.z = pk2(v[j * 8 + 4] * rs * ng[4], v[j * 8 + 5] * rs * ng[5]); o.w = pk2(v[j * 8 + 6] * rs * ng[6], v[j * 8 + 7] * rs * ng[7]);
            *(u32x4*)(YM + (size_t)r * 2048 + c0) = o; }
    }
}
__device__ __forceinline__ void ph_lrupost(const Ctx& C) {
    const TC T = phase_tc();
    bf16* YM = (bf16*)(C.ws + WS_YMIX); const bf16* YB = (const bf16*)(C.ws + WS_RAW); const bf16* GT = (const bf16*)(C.ws + WS_Z);
    const int gw = C.bid * NWAVES + T.wave, NGW = C.G * NWAVES, lane = T.lane;
    for (int r = gw; r < NROWS; r += NGW) {
        if (r % BROWS < CTXL) continue;
#pragma unroll
        for (int j = 0; j < 2; ++j) { const int c0 = j * 512 + lane * 8;
            const u32x4 wy = *(const u32x4*)(YM + (size_t)r * 2048 + c0), wb = *(const u32x4*)(YB + (size_t)r * 1024 + c0), wg = *(const u32x4*)(GT + (size_t)r * 1024 + c0);
            float fy[8], fb[8], fg[8], o[8]; unpack8(wy, fy); unpack8(wb, fb); unpack8(wg, fg);
#pragma unroll
            for (int e = 0; e < 8; ++e) o[e] = gelu_tanh_f(fg[e]) * (fy[e] + fb[e]);
            u32x4 w; w.x = pk2(o[0], o[1]); w.y = pk2(o[2], o[3]); w.z = pk2(o[4], o[5]); w.w = pk2(o[6], o[7]);
            *(u32x4*)(YM + (size_t)r * 2048 + c0) = w; }
    }
}
__device__ __forceinline__ void ph_route(const Ctx& C, int layer, LAS unsigned char* lds) {
    const TC T = phase_tc();
    LAS float* Wt = (LAS float*)lds;
    const float* wg = C.in[I_WGRP] + (size_t)layer * 1024 * 4; const float* wr = C.in[I_WRT] + (size_t)layer * 1024 * 16;
    for (int i = T.tid; i < 4096; i += NTHREADS) Wt[(i & 3) * 1028 + (i >> 2)] = wg[i];
    for (int i = T.tid; i < 16384; i += NTHREADS) Wt[(4 + (i & 15)) * 1028 + (i >> 4)] = wr[i];
    __syncthreads();
    bf16* HN2 = (bf16*)(C.ws + WS_A); int* REC = (int*)(C.ws + WS_REC); int* TBL = (int*)(C.ws + WS_TBL);
    unsigned* cnt = C.ctl() + CW_CNT + layer * 2048;
    const float* gf = C.in[I_GFFN] + layer * 1024;
    const int gw = C.bid * NWAVES + T.wave, NGW = C.G * NWAVES, lane = T.lane;
    for (int r = gw; r < NROWS; r += NGW) {
        if (layer == 1 && (r % BROWS) < CTXL) continue;
        float* xr = C.xrow(r); const float* md = C.mod(layer, row_mv(r));
        f32x4 v[4]; float ss = 0.f;
        if (layer == 0 && (r % BROWS) < CTXL) { const int b_ = r / BROWS, q_ = r - b_ * BROWS; const float* xi = C.in[I_CTX] + (size_t)(b_ * CTXL + q_) * DM; const float* sl = (const float*)(C.ws + WS_RAW);
#pragma unroll
            for (int j = 0; j < 4; ++j) { const float* sp = sl + (size_t)((b_ * 4 + j) * 4) * 65536 + (size_t)q_ * 256 + 4 * lane;
                const f32x4 part = (*(const f32x4*)sp + *(const f32x4*)(sp + 65536)) + (*(const f32x4*)(sp + 2 * 65536) + *(const f32x4*)(sp + 3 * 65536));
                const f32x4 x1 = *(const f32x4*)(xi + 256 * j + 4 * lane) + *(const f32x4*)(md + 2 * 1024 + 256 * j + 4 * lane) * part;
                *(f32x4*)(xr + 256 * j + 4 * lane) = x1; } }
#pragma unroll
        for (int j = 0; j < 4; ++j) { v[j] = *(const f32x4*)(xr + 256 * j + 4 * lane); ss += (v[j].x * v[j].x + v[j].y * v[j].y) + (v[j].z * v[j].z + v[j].w * v[j].w); }
        const float rs = rsqrtf(wave_sum(ss) * (1.f / DM) + EPS);
#pragma unroll
        for (int j = 0; j < 4; ++j) { const int c = 256 * j + 4 * lane; const f32x4 g = *(const f32x4*)(gf + c), sc = *(const f32x4*)(md + 4 * 1024 + c), sh = *(const f32x4*)(md + 3 * 1024 + c);
            v[j] = v[j] * rs * g * (sc + 1.f) + sh;
            u32x2 w; w.x = pk2(v[j].x, v[j].y); w.y = pk2(v[j].z, v[j].w); *(u32x2*)(HN2 + (size_t)r * DM + c) = w; }
        float lg[20];
#pragma unroll
        for (int o = 0; o < 20; ++o) { float s = 0.f;
#pragma unroll
            for (int j = 0; j < 4; ++j) { const f32x4 w = *(const LAS f32x4*)(Wt + o * 1028 + 256 * j + 4 * lane); s += (v[j].x * w.x + v[j].y * w.y) + (v[j].z * w.z + v[j].w * w.w); }
            lg[o] = wave_sum(s); }
        float gl[4];
#pragma unroll
        for (int k = 0; k < 4; ++k) gl[k] = lg[k] + C.in[I_BGRP][layer * 4 + k];
        int gi = 0; float gmx = gl[0];
#pragma unroll
        for (int k = 1; k < 4; ++k) if (gl[k] > gmx) { gmx = gl[k]; gi = k; }
        float den = 0.f;
#pragma unroll
        for (int k = 0; k < 4; ++k) den += __expf(gl[k] - gmx);
        const float pgrp = 1.f / den;
        float el[4];
#pragma unroll
        for (int k = 0; k < 4; ++k) { const float e0 = lg[4 + k] + C.in[I_BRT][layer * 16 + k], e1 = lg[8 + k] + C.in[I_BRT][layer * 16 + 4 + k], e2 = lg[12 + k] + C.in[I_BRT][layer * 16 + 8 + k], e3 = lg[16 + k] + C.in[I_BRT][layer * 16 + 12 + k];
            el[k] = gi == 0 ? e0 : (gi == 1 ? e1 : (gi == 2 ? e2 : e3)); }
        int i1 = 0; float v1 = el[0];
#pragma unroll
        for (int k = 1; k < 4; ++k) if (el[k] > v1) { v1 = el[k]; i1 = k; }
        int i2 = -1; float v2 = -3.4e38f;
#pragma unroll
        for (int k = 0; k < 4; ++k) if (k != i1 && el[k] > v2) { v2 = el[k]; i2 = k; }
        const float w1 = pgrp / (1.f + __expf(v2 - v1)), w2 = pgrp - w1;
        const int ia = i1 < i2 ? i1 : i2, ib = i1 < i2 ? i2 : i1; const float wa = i1 < i2 ? w1 : w2, wb = i1 < i2 ? w2 : w1;
        const int cls = gi * 6 + (ia * (7 - ia)) / 2 + (ib - ia - 1);
        if (lane == 0) { const int pos = (int)atomicAdd(cnt + cls * 64, 1u); TBL[(size_t)cls * NROWS + pos] = r; REC[(size_t)r * 4 + 0] = cls; REC[(size_t)r * 4 + 1] = pos; REC[(size_t)r * 4 + 2] = (int)__float_as_uint(wa); REC[(size_t)r * 4 + 3] = (int)__float_as_uint(wb); }
    }
}
__device__ __forceinline__ void moe_tables(const Ctx& C, int layer, int* mt) {
    unsigned* cnt = C.ctl() + CW_CNT + layer * 2048;
    const TC T = phase_tc();
    { const int t_ = T.tid; if (t_ < 24) mt[32 + t_] = (int)__hip_atomic_load(cnt + t_ * 64, __ATOMIC_RELAXED, __HIP_MEMORY_SCOPE_AGENT); }
    asm volatile("s_waitcnt vmcnt(0)" ::: "memory");
    __syncthreads();
    if (T.tid == 0) { int acc = 0; for (int c = 0; c < 24; ++c) { const int n = mt[32 + c]; mt[c] = acc; const int nt = (n + 255) >> 8; for (int t = 0; t < nt; ++t) mt[64 + acc + t] = c; acc += nt; } mt[24] = acc; }
    asm volatile("s_waitcnt vmcnt(0)" ::: "memory");
    __syncthreads();
}
__device__ __forceinline__ void ph_final(const Ctx& C) {
    const TC T = phase_tc();
    const float* gf = C.in[I_GFINAL];
    const int gw = C.bid * NWAVES + T.wave, NGW = C.G * NWAVES, lane = T.lane;
    for (int r = gw; r < NBATCH * SEQL; r += NGW) {
        float* xr = C.out + (size_t)r * DM;
        f32x4 v[4]; float ss = 0.f;
#pragma unroll
        for (int j = 0; j < 4; ++j) { v[j] = *(const f32x4*)(xr + 256 * j + 4 * lane); ss += (v[j].x * v[j].x + v[j].y * v[j].y) + (v[j].z * v[j].z + v[j].w * v[j].w); }
        const float rs = rsqrtf(wave_sum(ss) * (1.f / DM) + EPS);
#pragma unroll
        for (int j = 0; j < 4; ++j) { const int c = 256 * j + 4 * lane; f32x4 o = v[j] * rs * *(const f32x4*)(gf + c);
#ifdef PROBE_A
            { const unsigned long long* st = (const unsigned long long*)(C.ws + WS_STAMP);
              const float ta = (float)(st[PROBE_A + 1] - st[PROBE_A]) * 0.01f, tb = (float)(st[PROBE_B + 1] - st[PROBE_B]) * 0.01f;
              int na = 0, nb = 0; float th = 15.f;
              for (int i = 0; i < 31; ++i) { na += ta > th; nb += tb > th; th *= 1.2f; }
              o = o * (1.f + 0.02f * (float)na);
              if (r == 0 && c == 0) o.x += 10.f + (float)nb; }
#endif
            *(f32x4*)(xr + c) = o; }
    }
}


#define XB_TMO      128
#define XB_XCNT(j)  (256  + 64 * (j))
#define XB_XSUB(j)  (1280 + 64 * (j))
#define XB_XGEN(j)  (2304 + 64 * (j))
#define XB_TOP      3328
#define XB_TOPGEN   3392
#define XCD_BAR_WORDS 3456
#define XB_SPIN_CAP (1u << 18)
__device__ __forceinline__ unsigned xb_ld(unsigned* p)              { return __hip_atomic_load(p, __ATOMIC_RELAXED, __HIP_MEMORY_SCOPE_AGENT); }
__device__ __forceinline__ unsigned xb_add(unsigned* p, unsigned v) { return __hip_atomic_fetch_add(p, v, __ATOMIC_RELAXED, __HIP_MEMORY_SCOPE_AGENT); }
__device__ __forceinline__ unsigned xb_xcc_id() { return (unsigned)__builtin_amdgcn_s_getreg((3 << 11) | 20) & 0xFu; }
#define XB_SPIN(cond, bar) do { unsigned _sp = 0; while (cond) { __builtin_amdgcn_s_sleep(1); \
    if ((++_sp & 255u) == 0u) { if (xb_ld(&(bar)[XB_TMO])) break; if (_sp > XB_SPIN_CAP) { atomicAdd(&(bar)[XB_TMO], 1u); break; } } } } while (0)
struct XcdBarrier { unsigned* bar; unsigned x; volatile LAS unsigned* st; };
__device__ __forceinline__ XcdBarrier xcd_barrier_post(unsigned* bar, volatile LAS unsigned* st) {
    XcdBarrier b; b.bar = bar; b.x = xb_xcc_id(); b.st = st;
    if (threadIdx.x == 0) (void)xb_add(&bar[XB_XCNT(b.x)], 1u);
    return b;
}
__device__ __forceinline__ void xcd_barrier_complete(unsigned* bar, unsigned x, unsigned& nloc, unsigned& nx) {
    const unsigned G = gridDim.x * gridDim.y * gridDim.z;
    unsigned sum, cnt, mine, sp = 0u;
    for (;;) {
        sum = 0u; cnt = 0u; mine = 0u;
#pragma unroll
        for (unsigned j = 0; j < 16; ++j) { const unsigned c = xb_ld(&bar[XB_XCNT(j)]); sum += c; cnt += (c > 0u) ? 1u : 0u; mine = (j == x) ? c : mine; }
        if (sum == G) break;
        __builtin_amdgcn_s_sleep(1);
        if ((++sp & 255u) == 0u) { if (xb_ld(&bar[XB_TMO])) break; if (sp > XB_SPIN_CAP) { atomicAdd(&bar[XB_TMO], 1u); break; } }
    }
    nloc = mine > 0u ? mine : 1u; nx = cnt > 0u ? cnt : 1u;
}
__device__ __forceinline__ void xcd_barrier(const XcdBarrier& b) {
    asm volatile("s_waitcnt vmcnt(0)" ::: "memory");
    __syncthreads();
    if (threadIdx.x == 0) {
        unsigned* bar = b.bar;
        __builtin_amdgcn_s_waitcnt(0);
        unsigned nloc = b.st[0], nx = b.st[1];
        if (nloc == 0u) { xcd_barrier_complete(bar, b.x, nloc, nx); b.st[0] = nloc; b.st[1] = nx; }
        const unsigned old = xb_add(&bar[XB_XSUB(b.x)], 1u);
        const unsigned gen = old / nloc;
        if (old + 1u == (gen + 1u) * nloc) {
            __builtin_amdgcn_fence(__ATOMIC_RELEASE, "agent");
            asm volatile("s_waitcnt vmcnt(0)" ::: "memory");
            const unsigned og = xb_add(&bar[XB_TOP], 1u);
            const unsigned tg = og / nx;
            if (og + 1u == (tg + 1u) * nx) xb_add(&bar[XB_TOPGEN], 1u);
            else XB_SPIN(xb_ld(&bar[XB_TOPGEN]) == tg, bar);
            __builtin_amdgcn_fence(__ATOMIC_ACQUIRE, "agent");
            xb_add(&bar[XB_XGEN(b.x)], 1u);
            asm volatile("s_waitcnt vmcnt(0)" ::: "memory");
        } else {
            XB_SPIN(xb_ld(&bar[XB_XGEN(b.x)]) == gen, bar);
            __builtin_amdgcn_fence(__ATOMIC_ACQUIRE, "agent");
            asm volatile("s_waitcnt vmcnt(0)" ::: "memory");
        }
    }
    __syncthreads();
}

__global__ void __launch_bounds__(NTHREADS, 2) fwd_kernel(Args args) {
    extern __shared__ __attribute__((aligned(16))) unsigned char lds_raw[];
    LAS unsigned char* lds = (LAS unsigned char*)lds_raw;
    Ctx C; C.in = args.in; C.out = args.out; C.ws = args.ws;
    C.bid = blockIdx.x; C.G = gridDim.x;
    const int lo = args.ph_lo, hi = args.ph_hi;
    int ph = 0;
    volatile LAS unsigned* bst = (volatile LAS unsigned*)(lds + LDS_BYTES - 32);
    if (threadIdx.x < 2) bst[threadIdx.x] = 0u;
    __syncthreads();
    XcdBarrier bar; bar.bar = (unsigned*)(C.ws + WS_CTL) + CW_BAR; bar.x = 0; bar.st = bst;
    if (hi - lo > 1) bar = xcd_barrier_post((unsigned*)(C.ws + WS_CTL) + CW_BAR, bst);
    if (lo < 0) cg::this_grid().sync();
#ifdef PROBE_A
    if (blockIdx.x == 0 && threadIdx.x == 0) ((unsigned long long*)(C.ws + WS_STAMP))[0] = __builtin_amdgcn_s_memrealtime();
#endif
#define IN(k) (lo <= (k) && (k) < hi)
#ifdef PROBE_A
#define STAMP(k) do { if (blockIdx.x == 0 && threadIdx.x == 0) ((unsigned long long*)(C.ws + WS_STAMP))[(k) + 1] = __builtin_amdgcn_s_memrealtime(); } while (0)
#else
#define STAMP(k) do { } while (0)
#endif
#ifdef PROBE_A
#define SEAM(k) do { if (IN(k) && IN((k) + 1)) { cg::this_grid().sync(); STAMP(k); } } while (0)
#else
#define SEAM(k) do { if (IN(k) && IN((k) + 1)) { xcd_barrier(bar); } } while (0)
#endif
    if (EN(0) && IN(0)) { ph_mod(C, lds); ph_convert(C, 0, lds); mod_wait(C); ph_prenorm(C, 0); }
    SEAM(0);
#pragma unroll 1
    for (int layer = 0; layer < 2; ++layer) {
        const int pb = 1 + 10 * layer;
        unsigned char* ws = C.ws;
        if (EN(1) && IN(pb + 0) && layer == 1) { ph_convert(C, 1, lds); ph_prenorm(C, layer); }
        if (layer == 1) SEAM(pb + 0);
        if (EN(2) && IN(pb + 1)) {
            const int nN = layer == 0 ? 15 : 14;
            pg8::Gemm g{1024, 1024, 1024, 1 << 30};
            RowSched S; S.nM = 66; S.nN = nN; S.nwg = 66 * nN; S.G = C.G; S.c = C.bid; S.skipctx = 0; S.A = (const char*)(ws + WS_A); S.Bt = (const char*)(ws + WS_WIN); S.a_tile = (size_t)256 * 1024 * 2; S.b_tile = (size_t)256 * 1024 * 2;
            EpiProj E;
            if (layer == 0) { E.d0 = (bf16*)(ws + WS_Z); E.l0 = 1024; E.e0 = 4; E.d1 = (bf16*)(ws + WS_RAW); E.l1 = 1280; E.e1 = 9; E.d2 = (bf16*)(ws + WS_YMIX) + 1024; E.l2 = 2048; E.e2 = 13;
                E.d3 = (bf16*)(ws + WS_K); E.l3 = 256; E.e3 = 14; E.d4 = (bf16*)(ws + WS_V); E.l4 = 256; E.e4 = 15; E.d5 = (bf16*)(ws + WS_DTR); E.l5 = 32; E.lastcols = 32; }
            else { E.d0 = (bf16*)(ws + WS_Z); E.l0 = 1024; E.e0 = 4; E.d1 = (bf16*)(ws + WS_RAW); E.l1 = 1024; E.e1 = 8; E.d2 = (bf16*)(ws + WS_YMIX) + 1024; E.l2 = 2048; E.e2 = 12;
                E.d3 = (bf16*)(ws + WS_K); E.l3 = 256; E.e3 = 13; E.d4 = (bf16*)(ws + WS_V); E.l4 = 256; E.e4 = 14; E.d5 = (bf16*)(ws + WS_DTR); E.l5 = 32; E.lastcols = 32; }
            pg8::gemm_phase<EpiProj, RowSched>(lds, g, S, E);
        }
        SEAM(pb + 1);
        if (EN(3) && IN(pb + 2)) { if (layer == 0) ph_elem0(C); else ph_elem1(C); }
        SEAM(pb + 2);
        if (IN(pb + 3)) { if (layer == 0) { ph_ssdpre(C, lds);
#ifdef SPLIT_MIX0
            xcd_barrier(bar); for (int u = C.bid; u < 256; u += C.G) ssd_chunk_unit<1>(C, u >> 2, u & 3, lds);
#endif
        } }
        if (layer == 0) SEAM(pb + 3);
        if (IN(pb + 4)) { if (layer == 0) { if (EN(4)) ph_mix0(C, lds, (char*)lds_raw); } else { if (EN(5)) ph_mix1(C, lds, (char*)lds_raw); } }
        SEAM(pb + 4);
        if (EN(6) && IN(pb + 5)) { if (layer == 0) ph_ssdpost(C); else ph_lrupost(C); }
        SEAM(pb + 5);
        if (EN(7) && IN(pb + 6)) {
            for (int pass = 0; pass < (layer == 0 ? 2 : 1); ++pass) {
                pg8::Gemm g{2048, 2048, pass == 0 ? 2048 : 512, 1 << 30};
                RowSched S; S.nM = 64; S.nN = 4; S.nwg = pass == 0 ? 256 : 32; S.G = C.G; S.c = C.bid; S.skipctx = pass == 0 ? 1 : 2; S.A = (const char*)(ws + WS_YMIX); S.Bt = (const char*)(ws + WS_WOUT); S.a_tile = (size_t)256 * 2048 * 2; S.b_tile = (size_t)256 * 2048 * 2;
                EpiRes E; E.slab = pass == 0 ? nullptr : (float*)(ws + WS_RAW); E.xin_lat = layer == 0 ? C.in[I_X] : C.out; E.xin_ctx = layer == 0 ? C.in[I_CTX] : C.xc(); E.xout_lat = C.out; E.xout_ctx = C.xc(); E.modbase = C.mod(layer, 0);
                pg8::gemm_phase<EpiRes, RowSched>(lds, g, S, E);
            }
        }
        SEAM(pb + 6);
        if (EN(8) && IN(pb + 7)) ph_route(C, layer, lds);
        SEAM(pb + 7);
        if (EN(10) && IN(pb + 8)) {
            int* mt = (int*)(ws + WS_MTG) + (size_t)(layer * 256 + C.bid) * 256;
            moe_tables(C, layer, mt);
            { pg8::Gemm g{1024, 1024, 1024, 1 << 30};
              MoeSched1 S; S.mt = mt; S.G = C.G; S.c = C.bid; S.layer = layer; S.ws = ws;
              EpiMoe1 E; E.ws = ws;
              pg8::gemm_phase<EpiMoe1, MoeSched1, true>(lds, g, S, E, (const int*)(ws + WS_TBL)); }
            { pg8::Gemm g{512, 256, 512, 4};
              const int nun = mt[24] * 4, extra = nun > C.G ? nun - C.G : 0;
              MoeSched2 S; S.mt = mt; S.G = C.G; S.c = (C.bid - extra % C.G + C.G) % C.G; S.layer = layer; S.ws = ws;
              EpiMoe2 E; E.out = C.out; E.ws = ws; E.layer = layer;
              pg8::gemm_phase<EpiMoe2, MoeSched2, false>(lds, g, S, E); }
        }
        SEAM(pb + 8);
    }
#ifdef PROBE_A
    cg::this_grid().sync();
#endif
    if (EN(12) && IN(21)) ph_final(C);

    (void)ph;
#undef IN
#undef SEAM
}

extern "C" void kernel_launch(void* const* d_in, const int* in_sizes, int n_in, void* d_out, int out_size, void* d_ws, size_t ws_size, hipStream_t stream) {
    static int grid = 0;
    if (grid == 0) {
        if (n_in != 36 || out_size != NBATCH * SEQL * DM || ws_size < WS_END) { fprintf(stderr, "kernel_launch: unexpected shapes (n_in %d, out %d, ws %zu)\n", n_in, out_size, ws_size); grid = -1; return; }
        int dev = 0, cus = 0, per_cu = 0;
        if (hipGetDevice(&dev) != hipSuccess || hipDeviceGetAttribute(&cus, hipDeviceAttributeMultiprocessorCount, dev) != hipSuccess) { grid = -1; return; }
        if (hipFuncSetAttribute((const void*)fwd_kernel, hipFuncAttributeMaxDynamicSharedMemorySize, LDS_BYTES) != hipSuccess) { fprintf(stderr, "kernel_launch: hipFuncSetAttribute failed\n"); grid = -1; return; }
        if (hipOccupancyMaxActiveBlocksPerMultiprocessor(&per_cu, (const void*)fwd_kernel, NTHREADS, LDS_BYTES) != hipSuccess || per_cu < 1) { fprintf(stderr, "kernel_launch: occupancy query failed (%d)\n", per_cu); (void)hipGetLastError(); per_cu = 1; }
        grid = cus * 1;
    }
    if (grid < 0) return;
    (void)hipMemsetAsync((char*)d_ws + WS_CTL, 0, CTL_ZERO_BYTES, stream);
    Args a{};
    for (int i = 0; i < 36; ++i) a.in[i] = (const float*)d_in[i];
    a.out = (float*)d_out; a.ws = (unsigned char*)d_ws;
#if MK_PER_PHASE
    for (int p = 0; p < N_PHASES; ++p) { a.ph_lo = p; a.ph_hi = p + 1; hipLaunchKernelGGL(fwd_kernel, dim3(grid), dim3(NTHREADS), LDS_BYTES, stream, a); }
#else
    void* kargs[] = {&a};
#ifdef REPEAT_K
    a.ph_lo = 0; a.ph_hi = REPEAT_K + 1;
    (void)hipLaunchCooperativeKernel((const void*)fwd_kernel, dim3(grid), dim3(NTHREADS), kargs, LDS_BYTES, stream);
    (void)hipMemsetAsync((char*)d_ws + WS_CTL, 0, CTL_ZERO_BYTES, stream);
#endif
    a.ph_lo = 0; a.ph_hi = N_PHASES;
    hipError_t e = hipLaunchCooperativeKernel((const void*)fwd_kernel, dim3(grid), dim3(NTHREADS), kargs, LDS_BYTES, stream);
    if (e != hipSuccess) fprintf(stderr, "kernel_launch: cooperative launch failed: %s (grid %d)\n", hipGetErrorString(e), grid);
#endif
}
```

```cpp
#include <hip/hip_runtime.h>
#include <hip/hip_cooperative_groups.h>
#include <cstdio>
#include <cstdint>
namespace cg = cooperative_groups;

#ifndef MK_PER_PHASE
#define MK_PER_PHASE 0
#endif

#ifndef EN_MASK
#define EN_MASK 0xFFFF
#endif
#define EN(k) (((EN_MASK) >> (k)) & 1)
#define LAS __attribute__((address_space(3)))
typedef unsigned short bf16;
typedef short bf16x8 __attribute__((ext_vector_type(8)));
typedef short s16x4 __attribute__((ext_vector_type(4)));
typedef float f32x4 __attribute__((ext_vector_type(4)));
typedef float f32x2 __attribute__((ext_vector_type(2)));
typedef float f32x16 __attribute__((ext_vector_type(16)));
typedef unsigned u32x4 __attribute__((ext_vector_type(4)));
typedef unsigned u32x2 __attribute__((ext_vector_type(2)));

constexpr int DM = 1024, NBATCH = 2, SEQL = 8192, CTXL = 256;
constexpr int BROWS = CTXL + SEQL;
constexpr int NROWS = NBATCH * BROWS;
constexpr float EPS = 1e-6f;
constexpr int NWAVES = 8, NTHREADS = 512;
constexpr int LDS_BYTES = 147456;
constexpr int N_PHASES = 22;

constexpr size_t MiB = 1u << 20;
constexpr size_t WS_CTL = 0, CTL_ZERO_BYTES = 128 * 1024;
constexpr size_t WS_MOD = 1 * MiB;
constexpr size_t WS_REC = 1 * MiB + 256 * 1024;
constexpr size_t WS_TOK = 2 * MiB;
constexpr size_t WS_GAB = 2 * MiB + 128 * 1024;
constexpr size_t WS_MT  = 2 * MiB + 512 * 1024;
constexpr size_t WS_STAMP = 2 * MiB + 768 * 1024;
constexpr size_t WS_XC  = 3 * MiB;
constexpr size_t WS_W   = 5 * MiB;
constexpr size_t WS_WIN = WS_W, WS_WOUT = WS_W + 8 * MiB, WS_W13 = WS_W + 12 * MiB, WS_W2 = WS_W + 28 * MiB;
constexpr size_t WS_A   = 41 * MiB;
constexpr size_t WS_Z   = 83 * MiB;
constexpr size_t WS_RAW = 116 * MiB;
constexpr size_t WS_DTR = 158 * MiB;
constexpr size_t WS_DT  = 160 * MiB;
constexpr size_t WS_K   = 163 * MiB;
constexpr size_t WS_V   = 172 * MiB;
constexpr size_t WS_YMIX = 181 * MiB;
constexpr size_t WS_SSDST = 247 * MiB;
constexpr size_t WS_SSDLD = WS_SSDST + 64 * 3 * 16384;
constexpr size_t WS_TBL = 251 * MiB;
constexpr size_t WS_MTG = 253 * MiB;
constexpr size_t WS_END = 254 * MiB;
constexpr int MAXTILES = 90, MAXSLOT = MAXTILES * 256;
constexpr int CW_MODDONE = 192;
constexpr int CW_Q0 = 64, CW_Q1 = 128, CW_CNT = 256, CW_BAR = 4096, CW_TDONE = 8192;

__device__ __forceinline__ float bf2f(unsigned short b) { return __uint_as_float(((unsigned)b) << 16); }
__device__ __forceinline__ unsigned f2bf(float f) { unsigned u = __float_as_uint(f); return (u + 0x7fffu + ((u >> 16) & 1u)) >> 16; }
__device__ __forceinline__ unsigned pk2(float lo, float hi) { return f2bf(lo) | (f2bf(hi) << 16); }
__device__ __forceinline__ float dpp_add(float v, float src, const int ctrl_unused) { return v + src; }
#define DPP_F(v, ctrl, rmask) __builtin_bit_cast(float, __builtin_amdgcn_update_dpp(0, __builtin_bit_cast(int, v), ctrl, rmask, 0xf, false))
__device__ __forceinline__ float wave_sum(float v) {
    v += DPP_F(v, 0xB1, 0xf);
    v += DPP_F(v, 0x4E, 0xf);
    v += DPP_F(v, 0x141, 0xf);
    v += DPP_F(v, 0x140, 0xf);
    v += DPP_F(v, 0x142, 0xa);
    v += DPP_F(v, 0x143, 0xc);
    return __builtin_bit_cast(float, __builtin_amdgcn_readlane(__builtin_bit_cast(int, v), 63));
}
__device__ __forceinline__ float silu_f(float x) { return x / (1.f + __expf(-x)); }
__device__ __forceinline__ float sigmoid_f(float x) { return 1.f / (1.f + __expf(-x)); }
__device__ __forceinline__ float softplus_f(float x) { return fmaxf(x, 0.f) + log1pf(__expf(-fabsf(x))); }
__device__ __forceinline__ float gelu_tanh_f(float x) { const float u = 0.7978845608028654f * (x + 0.044715f * x * x * x); return 0.5f * x * (1.f + tanhf(u)); }
__device__ __forceinline__ void unpack8(const u32x4 w, float* f) {
    f[0] = __uint_as_float(w.x << 16); f[1] = __uint_as_float(w.x & 0xffff0000u);
    f[2] = __uint_as_float(w.y << 16); f[3] = __uint_as_float(w.y & 0xffff0000u);
    f[4] = __uint_as_float(w.z << 16); f[5] = __uint_as_float(w.z & 0xffff0000u);
    f[6] = __uint_as_float(w.w << 16); f[7] = __uint_as_float(w.w & 0xffff0000u);
}

namespace pg8 {
constexpr int BM = 256, BK = 64, HALF = 128, HTB = HALF * BK * 2, STAGE_BYTES = 8 * HTB, NXCD = 8, WGM = 8;
__host__ __device__ __forceinline__ int lds_byte(int r, int c) { const int st = (r >> 4) * 2 + (c >> 5), rr = r & 15, cc = c & 31, ob = rr * 64 + cc * 2; return st * 1024 + (ob ^ (((ob >> 9) & 1) << 5)); }
__host__ __device__ __forceinline__ void stage_rc(int b, int& R, int& C) { const int st = b / 1024, sb = b % 1024, swz = sb ^ (((sb >> 9) & 1) << 5); R = (st >> 1) * 16 + swz / 64; C = (st & 1) * 32 + (swz % 64) / 2; }
__host__ __device__ __forceinline__ int perm32(int rho) { const int n = rho >> 4, i = rho & 15; return 8 * (i >> 2) + 4 * n + (i & 3); }

struct Unit { int pm, pn; const char* a; const char* b; long bd; int tbo; int nrow; };
struct Gemm { int lda, ldb, K, ksplit; };

__device__ __forceinline__ unsigned cvt_pk_bf16(float lo, float hi) { unsigned r; asm volatile("v_cvt_pk_bf16_f32 %0, %1, %2" : "=v"(r) : "v"(lo), "v"(hi)); return r; }

template <class Epi, class Sched, bool GATHER = false>
__device__ __forceinline__ void gemm_phase(LAS unsigned char* lds, const Gemm g, const Sched& S, const Epi& E, const int* gtbl = nullptr) {
    int tid_ = threadIdx.x; asm volatile("" : "+v"(tid_));
    const int tid = tid_, wid = __builtin_amdgcn_readfirstlane(tid >> 6), lane = tid & 63, wr = wid >> 2, wc = wid & 3, fr = lane & 15, fq = lane >> 4;
    const int nt = g.K / BK;
    unsigned voffA[2][2], nvoffA[2][2], voffB[2];
#pragma unroll
    for (int i = 0; i < 2; ++i) { int R, C; stage_rc(tid * 16 + i * 8192, R, C); const int Rb = Epi::PERM ? ((R & ~31) + perm32(R & 31)) : R;
        voffA[0][i] = (unsigned)(R * g.lda + C) * 2u; voffA[1][i] = (unsigned)((R + HALF) * g.lda + C) * 2u; nvoffA[0][i] = voffA[0][i]; nvoffA[1][i] = voffA[1][i];
        voffB[i] = (unsigned)(Rb * g.ldb + C) * 2u; }
#define PG8_GATHER_OFF(dst, uu) do { if constexpr (GATHER) { int _t = tid; asm volatile("" : "+v"(_t)); _Pragma("unroll") for (int _i = 0; _i < 2; ++_i) { int _R, _C; stage_rc(_t * 16 + _i * 8192, _R, _C); \
        _Pragma("unroll") for (int _h = 0; _h < 2; ++_h) { int _rho = _h * HALF + _R; _rho = _rho < (uu).nrow ? _rho : (uu).nrow - 1; dst[_h][_i] = (unsigned)gtbl[(uu).tbo + _rho] * (unsigned)(g.lda * 2) + (unsigned)_C * 2u; } } } } while (0)
    const size_t kstep = (size_t)(BK * 2);
    const size_t hstepA = (size_t)HALF * g.lda * 2, hstepB = (size_t)HALF * g.ldb * 2;
    const unsigned ldsw = (unsigned)wid * 1024u;
    const int aoff = lds_byte(wr * 64 + fr, fq * 8), boff = lds_byte(wc * 32 + fr, fq * 8);
#define PG8_SA(b, h) (((b) * 2 + (h)) * HTB)
#define PG8_SB(b, h) ((4 + (b) * 2 + (h)) * HTB)
#define PG8_STAGE(bufoff, gbase, voff) do { _Pragma("unroll") for (int _i = 0; _i < 2; ++_i) \
        __builtin_amdgcn_global_load_lds((const unsigned*)((const char*)(gbase) + (voff)[_i]), (LAS unsigned*)(lds + (bufoff) + ldsw + _i * 8192), 16, 0, 0); } while (0)
#define PG8_STAGE_A(bufoff, gbase, hh, usenext) do { _Pragma("unroll") for (int _i = 0; _i < 2; ++_i) { \
        if constexpr (GATHER) { const unsigned _vo = (usenext) ? nvoffA[hh][_i] : voffA[hh][_i]; \
            __builtin_amdgcn_global_load_lds((const unsigned*)((const char*)(gbase) + _vo), (LAS unsigned*)(lds + (bufoff) + ldsw + _i * 8192), 16, 0, 0); } \
        else __builtin_amdgcn_global_load_lds((const unsigned*)((const char*)(gbase) + (hh) * hstepA + voffA[0][_i]), (LAS unsigned*)(lds + (bufoff) + ldsw + _i * 8192), 16, 0, 0); } } while (0)
#define PG8_LDA(dst, b, h) do { _Pragma("unroll") for (int m = 0; m < 4; ++m) _Pragma("unroll") for (int k = 0; k < 2; ++k) dst[m][k] = *(const LAS bf16x8*)(lds + PG8_SA(b, h) + aoff + m * 2048 + k * 1024); } while (0)
#define PG8_LDB(dst, b, h) do { _Pragma("unroll") for (int n = 0; n < 2; ++n) _Pragma("unroll") for (int k = 0; k < 2; ++k) dst[n][k] = *(const LAS bf16x8*)(lds + PG8_SB(b, h) + boff + n * 2048 + k * 1024); } while (0)
#define PG8_MMA(ai, bj, At, Bt) do { __builtin_amdgcn_s_setprio(1); _Pragma("unroll") for (int m = 0; m < 4; ++m) _Pragma("unroll") for (int n = 0; n < 2; ++n) _Pragma("unroll") for (int k = 0; k < 2; ++k) \
        acc[ai][bj][m][n] = __builtin_amdgcn_mfma_f32_16x16x32_bf16(Bt[n][k], At[m][k], acc[ai][bj][m][n], 0, 0, 0); __builtin_amdgcn_s_setprio(0); } while (0)
#define PG8_WAIT_V(n) asm volatile("s_waitcnt vmcnt(" #n ")" ::: "memory")
#define PG8_WAIT_L(n) asm volatile("s_waitcnt lgkmcnt(" #n ")" ::: "memory")
#define PG8_BAR __builtin_amdgcn_s_barrier()
#define PG8_SCHED __builtin_amdgcn_sched_barrier(0)
    Unit cur, nxt; int ui = 0;
    if (!S.next(0, cur)) return;
    f32x4 acc[2][2][4][2];
#pragma unroll
    for (int a = 0; a < 2; ++a)
#pragma unroll
        for (int b = 0; b < 2; ++b)
#pragma unroll
            for (int m = 0; m < 4; ++m)
#pragma unroll
                for (int n = 0; n < 2; ++n) acc[a][b][m][n] = (f32x4){0.f, 0.f, 0.f, 0.f};
    bf16x8 At[4][2], B0[2][2], B1[2][2];
    const char* cA = cur.a; const char* cB = cur.b; long cBd = cur.bd;
    S.a_ready(cur);
    PG8_GATHER_OFF(voffA, cur);
    PG8_STAGE(PG8_SB(0, 0), cB, voffB); PG8_STAGE_A(PG8_SA(0, 0), cA, 0, false); PG8_STAGE(PG8_SB(0, 1), cB + hstepB, voffB); PG8_STAGE_A(PG8_SA(0, 1), cA, 1, false);
    if (wr == 1) PG8_BAR;
    PG8_WAIT_V(4); PG8_BAR;
    PG8_STAGE(PG8_SB(1, 0), cB + kstep, voffB); PG8_STAGE_A(PG8_SA(1, 0), cA + kstep, 0, false); PG8_STAGE(PG8_SB(1, 1), cB + hstepB + kstep, voffB);
    PG8_WAIT_V(6); PG8_BAR;
    for (;;) {
        const bool has_next = S.next(ui + 1, nxt);
        const char* nA = has_next ? nxt.a : cA; const char* nB = has_next ? nxt.b : cB;
        if constexpr (GATHER) { if (has_next) PG8_GATHER_OFF(nvoffA, nxt); else {
#pragma unroll
            for (int _h = 0; _h < 2; ++_h)
#pragma unroll
                for (int _i = 0; _i < 2; ++_i) nvoffA[_h][_i] = voffA[_h][_i]; } }
#pragma unroll 1
        for (int t = 0; t < nt; t += 2) {
            const bool last = (t == nt - 2);
            const char* a1 = cA + (size_t)(t + 1) * kstep;
            const char* a2 = last ? nA : cA + (size_t)(t + 2) * kstep;
            const char* b2 = last ? nB : cB + (size_t)(t + 2) * kstep + ((t + 2) >= g.ksplit ? cBd : 0);
            const char* a3 = a2 + kstep; const char* b3 = b2 + kstep;
            if (last && has_next) S.a_ready(nxt);
            PG8_LDB(B0, 0, 0); PG8_SCHED; PG8_LDA(At, 0, 0); PG8_STAGE_A(PG8_SA(1, 1), a1, 1, false);
            PG8_WAIT_L(8); PG8_BAR; PG8_WAIT_L(0); PG8_MMA(0, 0, At, B0); PG8_BAR; PG8_SCHED;
            PG8_LDB(B1, 0, 1); PG8_STAGE(PG8_SB(0, 0), b2, voffB);
            PG8_BAR; PG8_WAIT_L(0); PG8_MMA(0, 1, At, B1); PG8_BAR;
            PG8_LDA(At, 0, 1); PG8_STAGE_A(PG8_SA(0, 0), a2, 0, last);
            PG8_BAR; PG8_WAIT_L(0); PG8_MMA(1, 0, At, B0); PG8_BAR; PG8_SCHED;
            PG8_STAGE(PG8_SB(0, 1), b2 + hstepB, voffB);
            PG8_WAIT_V(6); PG8_BAR; PG8_MMA(1, 1, At, B1); PG8_BAR;
            PG8_LDB(B0, 1, 0); PG8_SCHED; PG8_LDA(At, 1, 0); PG8_STAGE_A(PG8_SA(0, 1), a2, 1, last);
            PG8_WAIT_L(8); PG8_BAR; PG8_WAIT_L(0); PG8_MMA(0, 0, At, B0); PG8_BAR; PG8_SCHED;
            PG8_LDB(B1, 1, 1); PG8_STAGE(PG8_SB(1, 0), b3, voffB);
            PG8_BAR; PG8_WAIT_L(0); PG8_MMA(0, 1, At, B1); PG8_BAR;
            PG8_LDA(At, 1, 1); PG8_STAGE_A(PG8_SA(1, 0), a3, 0, last);
            PG8_BAR; PG8_WAIT_L(0); PG8_MMA(1, 0, At, B0); PG8_BAR; PG8_SCHED;
            PG8_STAGE(PG8_SB(1, 1), b3 + hstepB, voffB);
            PG8_WAIT_V(6); PG8_BAR; PG8_MMA(1, 1, At, B1); PG8_BAR;
        }
        if (!(Epi::AFTER_DRAIN && !has_next)) { E(acc, cur, wr, wc, fr, fq); S.done(cur); }
        if (!has_next) break;
#pragma unroll
        for (int a = 0; a < 2; ++a)
#pragma unroll
            for (int b = 0; b < 2; ++b)
#pragma unroll
                for (int m = 0; m < 4; ++m)
#pragma unroll
                    for (int n = 0; n < 2; ++n) acc[a][b][m][n] = (f32x4){0.f, 0.f, 0.f, 0.f};
        cur = nxt; cA = nA; cB = nB; cBd = cur.bd; ++ui;
        if constexpr (GATHER) {
#pragma unroll
            for (int _h = 0; _h < 2; ++_h)
#pragma unroll
                for (int _i = 0; _i < 2; ++_i) voffA[_h][_i] = nvoffA[_h][_i]; }
    }
    PG8_WAIT_V(0);
    if (wr == 0) PG8_BAR;
    PG8_BAR;
    if constexpr (Epi::AFTER_DRAIN) { E.fused(acc, cur, wr, wc, fr, fq, lds, wid, lane); S.done(cur); }
#undef PG8_SA
#undef PG8_SB
#undef PG8_STAGE
#undef PG8_STAGE_A
#undef PG8_GATHER_OFF
#undef PG8_LDA
#undef PG8_LDB
#undef PG8_MMA
#undef PG8_WAIT_V
#undef PG8_WAIT_L
#undef PG8_BAR
#undef PG8_SCHED
}
}

namespace att {
constexpr int D = 128, NW = 8, QBLK = 32, KVBLK = 64;
constexpr float SCALE = 0.088388347648318440f;
constexpr float THR = 8.f;
constexpr int LDQ = 2048, LDK = 256, LDO = 2048;
constexpr size_t SHM_V = KVBLK * D * 2, SHM_K = KVBLK * D * 2, SHM_ATTN = 2 * SHM_V + 2 * SHM_K + NW * 64 * 4;
#define KSWZ(row, colB) ((row) * 256 + ((colB) ^ (((row) & 7) << 4)))
#define SBAR() __builtin_amdgcn_sched_barrier(0)
__device__ __forceinline__ int crow(int r, int hi) { return (r & 3) + 8 * (r >> 2) + 4 * hi; }
__device__ __forceinline__ unsigned cvtpk(float lo, float hi) { unsigned r; asm volatile("v_cvt_pk_bf16_f32 %0, %1, %2" : "=v"(r) : "v"(lo), "v"(hi)); return r; }

__device__ __forceinline__ void partialSM(f32x16& p0, f32x16& p1, float& m_reg, float& mn, float& alpha) {
  constexpr float C = SCALE * 1.4426950408889634f;
  float pmax = p0[0]; for (int r = 1; r < 16; ++r) pmax = fmaxf(pmax, p0[r]); for (int r = 0; r < 16; ++r) pmax = fmaxf(pmax, p1[r]);
  { auto rr = __builtin_amdgcn_permlane32_swap(__float_as_uint(pmax), __float_as_uint(pmax), false, false);
    pmax = fmaxf(__uint_as_float(rr[0]), __uint_as_float(rr[1])); }
  if (__builtin_expect(__all(pmax - m_reg <= THR / SCALE), 1)) { mn = m_reg; alpha = 1.f; }
  else { mn = fmaxf(m_reg, pmax); alpha = __builtin_amdgcn_exp2f((m_reg - mn) * C); m_reg = mn; }
  float mnC = -mn * C;
  for (int r = 0; r < 16; ++r) p0[r] = fmaf(p0[r], C, mnC); for (int r = 0; r < 16; ++r) p1[r] = fmaf(p1[r], C, mnC);
  for (int r = 0; r < 16; ++r) p0[r] = __builtin_amdgcn_exp2f(p0[r]);
}
__device__ __forceinline__ void finishSM(f32x16& p0, f32x16& p1, float alpha, float& l_reg, bf16x8& pa0, bf16x8& pa1, bf16x8& pa2, bf16x8& pa3) {
  for (int r = 0; r < 16; ++r) p1[r] = __builtin_amdgcn_exp2f(p1[r]);
  float ps = 0; for (int r = 0; r < 16; ++r) ps += p0[r]; for (int r = 0; r < 16; ++r) ps += p1[r];
  { auto rr = __builtin_amdgcn_permlane32_swap(__float_as_uint(ps), __float_as_uint(ps), false, false);
    ps = __uint_as_float(rr[0]) + __uint_as_float(rr[1]); }
  l_reg = l_reg * alpha + ps;
#define PK4(P, BASE, OUT) do { unsigned a0 = cvtpk(P[BASE + 0], P[BASE + 1]), a1 = cvtpk(P[BASE + 2], P[BASE + 3]);   \
    unsigned b0 = cvtpk(P[BASE + 4], P[BASE + 5]), b1 = cvtpk(P[BASE + 6], P[BASE + 7]);                              \
    auto r0 = __builtin_amdgcn_permlane32_swap(a0, b0, false, false); auto r1 = __builtin_amdgcn_permlane32_swap(a1, b1, false, false); \
    u32x4 w = {r0[0], r1[0], r0[1], r1[1]}; OUT = *reinterpret_cast<bf16x8*>(&w); } while (0)
  PK4(p0, 0, pa0); PK4(p0, 8, pa1); PK4(p1, 0, pa2); PK4(p1, 8, pa3);
#undef PK4
}
__device__ __forceinline__ void qkt(f32x16& p0, f32x16& p1, const bf16* Ks, const bf16x8* qr, int r32, int hi) {
  p0 = f32x16{}; p1 = f32x16{};
  for (int d0 = 0; d0 < 8; ++d0) { int cb = (d0 * 16 + hi * 8) * 2;
    bf16x8 b0 = *reinterpret_cast<const bf16x8*>((const char*)Ks + KSWZ(r32, cb));
    bf16x8 b1 = *reinterpret_cast<const bf16x8*>((const char*)Ks + KSWZ(32 + r32, cb));
    p0 = __builtin_amdgcn_mfma_f32_32x32x16_bf16(b0, qr[d0], p0, 0, 0, 0);
    p1 = __builtin_amdgcn_mfma_f32_32x32x16_bf16(b1, qr[d0], p1, 0, 0, 0); }
}
__device__ __forceinline__ int v_st(int k, int c) { const int kk = (k & ~0xC) | ((k & 4) << 1) | ((k & 8) >> 1); return ((kk >> 3) * 4 + (c >> 5)) * 512 + ((kk & 7) * 32 + (c & 31)) * 2; }
__device__ __forceinline__ int v_rd_base(int lane) { return ((lane & 3) << 3) | (((lane >> 2) & 3) << 6) | (((lane >> 4) & 1) << 5) | (((lane >> 5) & 1) << 8); }
constexpr int v_rd_off(int d0, int ks, int half) { return d0 * 512 + ks * 4096 + half * 2048; }
template <int OFF> __device__ __forceinline__ s16x4 tr_read(int vb) {
  s16x4 r; asm volatile("ds_read_b64_tr_b16 %0, %1 offset:%2" : "=&v"(r) : "v"(vb), "i"(OFF) : "memory"); return r;
}
template <int D0> __device__ __forceinline__ void pv_one(f32x16& od, int vb, bf16x8 pa0, bf16x8 pa1, bf16x8 pa2, bf16x8 pa3) {
  const s16x4 l0 = tr_read<v_rd_off(D0, 0, 0)>(vb), h0 = tr_read<v_rd_off(D0, 0, 1)>(vb), l1 = tr_read<v_rd_off(D0, 1, 0)>(vb), h1 = tr_read<v_rd_off(D0, 1, 1)>(vb);
  const s16x4 l2 = tr_read<v_rd_off(D0, 2, 0)>(vb), h2 = tr_read<v_rd_off(D0, 2, 1)>(vb), l3 = tr_read<v_rd_off(D0, 3, 0)>(vb), h3 = tr_read<v_rd_off(D0, 3, 1)>(vb);
  asm volatile("s_waitcnt lgkmcnt(0)" ::: "memory"); SBAR();
#define PK(L, H) (bf16x8){L[0], L[1], L[2], L[3], H[0], H[1], H[2], H[3]}
  od = __builtin_amdgcn_mfma_f32_32x32x16_bf16(pa0, PK(l0, h0), od, 0, 0, 0);
  od = __builtin_amdgcn_mfma_f32_32x32x16_bf16(pa1, PK(l1, h1), od, 0, 0, 0);
  od = __builtin_amdgcn_mfma_f32_32x32x16_bf16(pa2, PK(l2, h2), od, 0, 0, 0);
  od = __builtin_amdgcn_mfma_f32_32x32x16_bf16(pa3, PK(l3, h3), od, 0, 0, 0);
#undef PK
}
__device__ __forceinline__ void pv_d0(f32x16* o, int vb, bf16x8 pa0, bf16x8 pa1, bf16x8 pa2, bf16x8 pa3) {
  pv_one<0>(o[0], vb, pa0, pa1, pa2, pa3); pv_one<1>(o[1], vb, pa0, pa1, pa2, pa3); pv_one<2>(o[2], vb, pa0, pa1, pa2, pa3); pv_one<3>(o[3], vb, pa0, pa1, pa2, pa3);
}
__device__ __forceinline__ void band_mask(f32x16& p0, f32x16& p1, int dbase, int hi) {
#pragma unroll
  for (int r = 0; r < 16; ++r) { const int d = dbase + crow(r, hi);
    if (d < -128 || d > 128) p0[r] = -1e30f;
    if (d + 32 < -128 || d + 32 > 128) p1[r] = -1e30f; }
}
template <int MODE>
__device__ __forceinline__ void attn_body(const bf16* Qb, const bf16* Kh, const bf16* Vh, bf16* Ob, int NT, int kb0, int q0, float sink, char* lds, const float* qg, int tq0) {
  int tid_ = threadIdx.x; asm volatile("" : "+v"(tid_));
  const int tid = tid_, wid = tid >> 6, lane = tid & 63, r32 = lane & 31, hi = lane >> 5;
  bf16* V_lds = (bf16*)lds; bf16* K_lds = (bf16*)(lds + 3 * SHM_V);
  float* ws = (float*)(lds + 3 * SHM_V + 3 * SHM_K) + wid * 64; float* li_l = ws; float* al_l = ws + 32;
  bf16x8 qr[8];
  const bf16* Qw = Qb + (long)(wid * QBLK + r32) * LDQ + hi * 8;
  { u32x4 raw[8];
#pragma unroll
    for (int d0 = 0; d0 < 8; ++d0) raw[d0] = *reinterpret_cast<const u32x4*>(Qw + d0 * 16);
    float rs = 1.f;
    if (qg != nullptr) { float ssq = 0.f;
#pragma unroll
      for (int d0 = 0; d0 < 8; ++d0) { float f[8]; unpack8(raw[d0], f);
#pragma unroll
        for (int e = 0; e < 8; ++e) ssq += f[e] * f[e]; }
      ssq += __shfl_xor(ssq, 32);
      rs = rsqrtf(ssq * (1.f / 128.f) + 1e-6f); }
    const int t = tq0 + wid * QBLK + r32;
#pragma unroll
    for (int d0 = 0; d0 < 4; ++d0) { float fa[8], fb[8]; unpack8(raw[d0], fa); unpack8(raw[d0 + 4], fb);
      if (qg != nullptr) { const f32x4 ga0 = *reinterpret_cast<const f32x4*>(qg + 16 * d0 + 8 * hi), ga1 = *reinterpret_cast<const f32x4*>(qg + 16 * d0 + 8 * hi + 4);
        const f32x4 gb0 = *reinterpret_cast<const f32x4*>(qg + 64 + 16 * d0 + 8 * hi), gb1 = *reinterpret_cast<const f32x4*>(qg + 64 + 16 * d0 + 8 * hi + 4);
#pragma unroll
        for (int e = 0; e < 4; ++e) { fa[e] *= rs * ga0[e]; fa[4 + e] *= rs * ga1[e]; fb[e] *= rs * gb0[e]; fb[4 + e] *= rs * gb1[e]; } }
      if (tq0 >= 0) {
#pragma unroll
        for (int e = 0; e < 8; ++e) { const int j = 16 * d0 + 8 * hi + e; const int pos = j < 32 ? (t >> 6) : (t & 63);
          const float inv = exp2f(-(float)(j & 31) * (13.287712379549449f / 32.f)); float sn, cs; sincosf((float)pos * inv, &sn, &cs);
          const float a = fa[e], b2 = fb[e]; fa[e] = a * cs - b2 * sn; fb[e] = a * sn + b2 * cs; } }
      u32x4 wa, wb; wa.x = cvtpk(fa[0], fa[1]); wa.y = cvtpk(fa[2], fa[3]); wa.z = cvtpk(fa[4], fa[5]); wa.w = cvtpk(fa[6], fa[7]);
      wb.x = cvtpk(fb[0], fb[1]); wb.y = cvtpk(fb[2], fb[3]); wb.z = cvtpk(fb[4], fb[5]); wb.w = cvtpk(fb[6], fb[7]);
      qr[d0] = *reinterpret_cast<bf16x8*>(&wa); qr[d0 + 4] = *reinterpret_cast<bf16x8*>(&wb); } }
  float m_reg = -1e30f, l_reg = 0; f32x16 o[4] = {};
  const int sr = tid >> 4, sc = (tid & 15) * 8, vst0 = v_st(sr, sc), vst1 = v_st(32 + sr, sc);
  const int vb0 = (int)(uintptr_t)V_lds + v_rd_base(lane);
  struct { bf16x8 vs0, vs1, ks0, ks1; } sr_;
#define TK0(j) ((MODE == 0 || (j) < 4) ? (j) * KVBLK : kb0 + ((j) - 4) * KVBLK)
#define SLOAD(k0) do { sr_.vs0 = *reinterpret_cast<const bf16x8*>(&Vh[(long)((k0) + sr) * LDK + sc]); sr_.vs1 = *reinterpret_cast<const bf16x8*>(&Vh[(long)((k0) + 32 + sr) * LDK + sc]); \
    sr_.ks0 = *reinterpret_cast<const bf16x8*>(&Kh[(long)((k0) + sr) * LDK + sc]); sr_.ks1 = *reinterpret_cast<const bf16x8*>(&Kh[(long)((k0) + 32 + sr) * LDK + sc]); } while (0)
#define SWRITE(b) do { *(bf16x8*)((char*)V_lds + (b) * (int)SHM_V + vst0) = sr_.vs0;          \
    *(bf16x8*)((char*)V_lds + (b) * (int)SHM_V + vst1) = sr_.vs1; int kc = sc * 2;               \
    *(bf16x8*)((char*)K_lds + (b) * (int)SHM_K + KSWZ(sr, kc)) = sr_.ks0;                       \
    *(bf16x8*)((char*)K_lds + (b) * (int)SHM_K + KSWZ(32 + sr, kc)) = sr_.ks1; } while (0)
#define SWAIT() asm volatile("s_waitcnt vmcnt(0)" ::: "memory")
#define RESC(a) do { if (__any((a) < 1.f)) { if (hi == 0) al_l[r32] = (a); asm volatile("s_waitcnt lgkmcnt(0)" ::: "memory"); \
    for (int d = 0; d < 4; ++d) for (int r = 0; r < 16; ++r) o[d][r] *= al_l[crow(r, hi)]; } } while (0)
#define MASKT(P0, P1, j) do { if (MODE == 1 && (j) >= 4) { const int s0_ = kb0 - 256 + ((j) - 4) * KVBLK, tw_ = q0 + wid * QBLK; \
    if (!(s0_ - (tw_ + 31) >= -128 && (s0_ + 63) - tw_ <= 128)) band_mask(P0, P1, s0_ - tw_ - r32, hi); } } while (0)
  f32x16 pA0, pA1, pB0, pB1; float mnA, mnB, alA, alB; bf16x8 pa0, pa1, pa2, pa3;
  int bp = 0, bq = 1;
  SLOAD(TK0(0)); SWAIT(); SWRITE(0); __syncthreads();
  qkt(pA0, pA1, K_lds, qr, r32, hi); partialSM(pA0, pA1, m_reg, mnA, alA);
  SLOAD(TK0(1));
  SWAIT(); SWRITE(1); __syncthreads();
  for (int j = 1; j + 1 < NT; j += 2) {
    { const int bw = 3 - bp - bq;
      SBAR(); qkt(pB0, pB1, (bf16*)((char*)K_lds + bq * (int)SHM_K), qr, r32, hi);
      finishSM(pA0, pA1, alA, l_reg, pa0, pa1, pa2, pa3); SBAR();
      SLOAD(TK0(j + 1)); SBAR();
      pv_d0(o, vb0 + bp * (int)SHM_V, pa0, pa1, pa2, pa3); MASKT(pB0, pB1, j); partialSM(pB0, pB1, m_reg, mnB, alB);
      SWAIT(); SWRITE(bw);
      RESC(alB); __syncthreads();
      bp = bq; bq = bw; }
    { const int bw = 3 - bp - bq;
      SBAR(); qkt(pA0, pA1, (bf16*)((char*)K_lds + bq * (int)SHM_K), qr, r32, hi);
      finishSM(pB0, pB1, alB, l_reg, pa0, pa1, pa2, pa3); SBAR();
      SLOAD(TK0(j + 2)); SBAR();
      pv_d0(o, vb0 + bp * (int)SHM_V, pa0, pa1, pa2, pa3); MASKT(pA0, pA1, j + 1); partialSM(pA0, pA1, m_reg, mnA, alA);
      SWAIT(); SWRITE(bw);
      RESC(alA); __syncthreads();
      bp = bq; bq = bw; }
  }
  SBAR(); qkt(pB0, pB1, (bf16*)((char*)K_lds + bq * (int)SHM_K), qr, r32, hi);
  finishSM(pA0, pA1, alA, l_reg, pa0, pa1, pa2, pa3); SBAR();
  pv_d0(o, vb0 + bp * (int)SHM_V, pa0, pa1, pa2, pa3); MASKT(pB0, pB1, NT - 1); partialSM(pB0, pB1, m_reg, mnB, alB);
  RESC(alB);
  finishSM(pB0, pB1, alB, l_reg, pa0, pa1, pa2, pa3); SBAR();
  pv_d0(o, vb0 + bq * (int)SHM_V, pa0, pa1, pa2, pa3);
  if (MODE == 1) { constexpr float C = SCALE * 1.4426950408889634f; l_reg += __builtin_amdgcn_exp2f(sink * 1.4426950408889634f - m_reg * C); }
  if (hi == 0) li_l[r32] = l_reg; asm volatile("s_waitcnt lgkmcnt(0)" ::: "memory");
  float rli[16];
#pragma unroll
  for (int r = 0; r < 16; ++r) rli[r] = __builtin_amdgcn_rcpf(li_l[crow(r, hi)]);
  bf16* Ow = Ob + (long)(wid * QBLK) * LDO;
#pragma unroll
  for (int r = 0; r < 16; ++r) { int orow = crow(r, hi);
    for (int d0 = 0; d0 < 4; ++d0) Ow[(long)orow * LDO + d0 * 32 + r32] = (bf16)f2bf(o[d0][r] * rli[r]); }
  asm volatile("s_waitcnt vmcnt(0) lgkmcnt(0)" ::: "memory");
  __syncthreads();
#undef TK0
#undef SLOAD
#undef SWRITE
#undef SWAIT
#undef RESC
#undef MASKT
}
#undef KSWZ
#undef SBAR
}

struct Args { const float* in[36]; float* out; unsigned char* ws; int ph_lo, ph_hi; };
enum { I_X = 0, I_C, I_CTX, I_CCTX, I_WMOD, I_BMOD, I_GMIX, I_GFFN, I_WGRP, I_BGRP, I_WRT, I_BRT, I_W1, I_W3, I_W2, I_ABIN, I_ABOUT, I_SCONVW, I_SCONVB,
       I_DTBIAS, I_ALOG, I_SSDD, I_SNORMG, I_QG, I_KG, I_CDIN, I_CDOUT, I_LCONVW, I_LCONVB, I_LWA, I_LBA, I_LWX, I_LBX, I_LAM, I_SINK, I_GFINAL };

struct Ctx {
    const float* const* in; float* out; unsigned char* ws;
    int bid, G;
    __device__ __forceinline__ unsigned* ctl() const { return (unsigned*)(ws + WS_CTL); }
    __device__ __forceinline__ float* mod(int layer, int mv) const { return (float*)(ws + WS_MOD) + (size_t)(layer * 3 + mv) * 6144; }
    __device__ __forceinline__ float* xc() const { return (float*)(ws + WS_XC); }
    __device__ __forceinline__ float* xrow(int r) const { const int b = r / BROWS, q = r - b * BROWS; return q < CTXL ? xc() + (size_t)(b * CTXL + q) * DM : out + (size_t)(b * SEQL + (q - CTXL)) * DM; }
    __device__ __forceinline__ const float* xin_row(int r) const { const int b = r / BROWS, q = r - b * BROWS; return q < CTXL ? in[I_CTX] + (size_t)(b * CTXL + q) * DM : in[I_X] + (size_t)(b * SEQL + (q - CTXL)) * DM; }
};
struct TC { int tid, lane, wave; };
__device__ __forceinline__ TC phase_tc() { TC t; int x = threadIdx.x; asm volatile("" : "+v"(x)); t.tid = x; t.lane = x & 63; t.wave = __builtin_amdgcn_readfirstlane(x >> 6); return t; }
__device__ __forceinline__ int row_mv(int r) { const int b = r / BROWS, q = r - b * BROWS; return q < CTXL ? 2 : b; }

struct RowSched {
    int nM, nN, nwg, G, c, skipctx; const char* A; const char* Bt; size_t a_tile, b_tile;
    __device__ __forceinline__ bool next(int i, pg8::Unit& u) const {
        const long L = (long)i * G + c; if (L >= nwg) return false;
        if (skipctx == 2) { const int t8 = (int)L >> 2, ks = (int)L & 3; u.pm = (t8 >> 2) * 33; u.pn = t8 & 3;
            u.a = A + (size_t)u.pm * a_tile + (size_t)ks * 1024; u.b = Bt + (size_t)u.pn * b_tile + (size_t)ks * 1024; u.bd = 0; u.tbo = (int)L; u.nrow = 0; return true; }
        int wgid = (int)L; { const int q = nwg / 8, r = nwg % 8, xcd = wgid % 8, off = wgid / 8; wgid = (xcd < r ? xcd * (q + 1) : r * (q + 1) + (xcd - r) * q) + off; }
        const int nig = 8 * nN, gid = wgid / nig, fm = gid * 8, gsz = (nM - fm) < 8 ? (nM - fm) : 8;
        const int pmi = fm + ((wgid % nig) % gsz); u.pn = (wgid % nig) / gsz;
        u.pm = skipctx ? (pmi / 32) * 33 + 1 + (pmi % 32) : pmi;
        u.a = A + (size_t)u.pm * a_tile; u.b = Bt + (size_t)u.pn * b_tile; u.bd = 0; u.tbo = 0; u.nrow = 0; return true;
    }
    __device__ __forceinline__ void a_ready(const pg8::Unit&) const {}
    __device__ __forceinline__ void done(const pg8::Unit&) const {}
};
struct MoeSchedBase {
    const int* mt; int G, c, layer; unsigned char* ws;
    __device__ __forceinline__ bool locate(int i, pg8::Unit& u, int& ea, int& eb) const {
        const int ntl = mt[24]; const long L = (long)i * G + c; if (L >= (long)ntl * 4) return false;
        const int tile = (int)(L >> 2), pn = (int)(L & 3), cls = mt[64 + tile], g = cls / 6, pi = cls - g * 6;
        const int ia = pi < 3 ? 0 : (pi < 5 ? 1 : 2), ib = pi < 3 ? pi + 1 : (pi < 5 ? pi - 1 : 3);
        ea = g * 4 + ia; eb = g * 4 + ib;
        const int ti = tile - mt[cls];
        u.pm = tile; u.pn = pn; u.tbo = cls * NROWS + ti * 256; u.nrow = mt[32 + cls] - ti * 256;
        return true;
    }
};
struct MoeSched1 : MoeSchedBase {
    __device__ __forceinline__ bool next(int i, pg8::Unit& u) const { int ea, eb; if (!locate(i, u, ea, eb)) return false;
        const int e = (u.pn >> 1) ? eb : ea; u.a = (const char*)(ws + WS_A); u.b = (const char*)(ws + WS_W13) + ((size_t)e * 512 + (u.pn & 1) * 256) * 1024 * 2; u.bd = 0; return true; }
    __device__ __forceinline__ void a_ready(const pg8::Unit&) const {}
    __device__ __forceinline__ void done(const pg8::Unit& u) const {
        asm volatile("s_waitcnt vmcnt(0)" ::: "memory");
        if ((threadIdx.x & 63) == 0) __hip_atomic_fetch_add((unsigned*)(ws + WS_CTL) + CW_TDONE + layer * 6144 + 64 * u.pm, 1u, __ATOMIC_RELAXED, __HIP_MEMORY_SCOPE_AGENT);
    }
};
struct MoeSched2 : MoeSchedBase {
    __device__ __forceinline__ bool next(int i, pg8::Unit& u) const { int ea, eb; if (!locate(i, u, ea, eb)) return false;
        u.a = (const char*)(ws + WS_Z) + (size_t)u.pm * 256 * 512 * 2; u.b = (const char*)(ws + WS_W2) + ((size_t)ea * 1024 + u.pn * 256) * 256 * 2; u.bd = (long)(eb - ea) * 1024 * 256 * 2 - 4 * 128; return true; }
    __device__ __forceinline__ void a_ready(const pg8::Unit& u) const {
        if (threadIdx.x < 64) {
            unsigned polls = 0;
            unsigned* tw = (unsigned*)(ws + WS_CTL) + CW_TDONE + layer * 6144 + 64 * u.pm;
            while ((unsigned)__builtin_amdgcn_readfirstlane(__hip_atomic_load(tw, __ATOMIC_RELAXED, __HIP_MEMORY_SCOPE_AGENT)) < 32u) {
                if (++polls > (1u << 17)) break;
                __builtin_amdgcn_s_sleep(16); }
            __builtin_amdgcn_fence(__ATOMIC_ACQUIRE, "agent");
            asm volatile("s_waitcnt vmcnt(0)" ::: "memory");
        }
        asm volatile("" ::: "memory"); __builtin_amdgcn_s_barrier(); asm volatile("" ::: "memory");
    }
    __device__ __forceinline__ void done(const pg8::Unit&) const {}
};

struct EpiProj {
    static constexpr bool PERM = true, AFTER_DRAIN = false;
    bf16 *d0, *d1, *d2, *d3, *d4, *d5; int e0, e1, e2, e3, e4; int l0, l1, l2, l3, l4, l5; int lastcols;
    __device__ __forceinline__ void operator()(const f32x4 (&acc)[2][2][4][2], const pg8::Unit& u, int wr, int wc, int fr, int fq) const {
        const int pn = u.pn; bf16* base; int ld, tl, ncol = 256;
        if (pn < e0) { base = d0; ld = l0; tl = pn; } else if (pn < e1) { base = d1; ld = l1; tl = pn - e0; } else if (pn < e2) { base = d2; ld = l2; tl = pn - e1; }
        else if (pn < e3) { base = d3; ld = l3; tl = pn - e2; } else if (pn < e4) { base = d4; ld = l4; tl = pn - e3; } else { base = d5; ld = l5; tl = pn - e4; ncol = lastcols; }
        const int row0 = u.pm * 256 + wr * 64 + fr, col0 = wc * 32 + 8 * fq;
#pragma unroll
        for (int ai = 0; ai < 2; ++ai)
#pragma unroll
            for (int m = 0; m < 4; ++m) { bf16* rowp = base + (size_t)(row0 + ai * 128 + m * 16) * ld + tl * 256 + col0;
#pragma unroll
                for (int bj = 0; bj < 2; ++bj) { if (col0 + bj * 128 < ncol) { const f32x4 v0 = acc[ai][bj][m][0], v1 = acc[ai][bj][m][1];
                    u32x4 w; w.x = pg8::cvt_pk_bf16(v0[0], v0[1]); w.y = pg8::cvt_pk_bf16(v0[2], v0[3]); w.z = pg8::cvt_pk_bf16(v1[0], v1[1]); w.w = pg8::cvt_pk_bf16(v1[2], v1[3]);
                    *(u32x4*)(rowp + bj * 128) = w; } } }
    }
};
struct EpiRes {
    static constexpr bool PERM = false, AFTER_DRAIN = true;
    float* slab;
    const float* xin_lat; const float* xin_ctx; float* xout_lat; float* xout_ctx; const float* modbase;
    __device__ __forceinline__ void operator()(const f32x4 (&acc)[2][2][4][2], const pg8::Unit& u, int wr, int wc, int fr, int fq) const {
        if (slab) { float* sp = slab + (size_t)u.tbo * 65536 + (size_t)(wr * 64 + fr) * 256 + wc * 32 + 4 * fq;
#pragma unroll
            for (int ai = 0; ai < 2; ++ai)
#pragma unroll
                for (int m = 0; m < 4; ++m)
#pragma unroll
                    for (int bj = 0; bj < 2; ++bj)
#pragma unroll
                        for (int n = 0; n < 2; ++n) *(f32x4*)(sp + (size_t)(ai * 128 + m * 16) * 256 + bj * 128 + n * 16) = acc[ai][bj][m][n];
            return; }
        const int b = u.pm / 33, qt = u.pm - b * 33; const bool isctx = (qt == 0);
        const size_t rbase = isctx ? (size_t)b * CTXL : (size_t)b * SEQL + (size_t)(qt - 1) * 256;
        const float* xi = (isctx ? xin_ctx : xin_lat) + rbase * DM; float* xo = (isctx ? xout_ctx : xout_lat) + rbase * DM;
        const float* gate = modbase + (size_t)(isctx ? 2 : b) * 6144 + 2 * 1024;
        const int row0 = wr * 64 + fr, col0 = u.pn * 256 + wc * 32 + 4 * fq;
        f32x4 gv[2][2];
#pragma unroll
        for (int bj = 0; bj < 2; ++bj)
#pragma unroll
            for (int n = 0; n < 2; ++n) gv[bj][n] = *(const f32x4*)(gate + col0 + bj * 128 + n * 16);
#pragma unroll
        for (int ai = 0; ai < 2; ++ai)
#pragma unroll
            for (int m = 0; m < 4; ++m) { const size_t off = (size_t)(row0 + ai * 128 + m * 16) * DM + col0;
#pragma unroll
                for (int bj = 0; bj < 2; ++bj)
#pragma unroll
                    for (int n = 0; n < 2; ++n) { const f32x4 xv = *(const f32x4*)(xi + off + bj * 128 + n * 16);
                        *(f32x4*)(xo + off + bj * 128 + n * 16) = xv + gv[bj][n] * acc[ai][bj][m][n]; } }
    }
    __device__ __forceinline__ void fused(const f32x4 (&acc)[2][2][4][2], const pg8::Unit& u, int wr, int wc, int fr, int fq, LAS unsigned char* lds, int wid, int lane) const {
        if (slab) { (*this)(acc, u, wr, wc, fr, fq); return; }
        const int b = u.pm / 33, qt = u.pm - b * 33; const bool isctx = (qt == 0);
        const size_t rbase = isctx ? (size_t)b * CTXL : (size_t)b * SEQL + (size_t)(qt - 1) * 256;
        const float* xi = (isctx ? xin_ctx : xin_lat) + rbase * DM + u.pn * 256 + 4 * lane; float* xo = (isctx ? xout_ctx : xout_lat) + rbase * DM + u.pn * 256 + 4 * lane;
        const f32x4 gv = *(const f32x4*)(modbase + (size_t)(isctx ? 2 : b) * 6144 + 2 * 1024 + u.pn * 256 + 4 * lane);
        LAS float* T = (LAS float*)lds;
#pragma unroll
        for (int ai = 0; ai < 2; ++ai) {
#pragma unroll
            for (int m = 0; m < 4; ++m)
#pragma unroll
                for (int bj = 0; bj < 2; ++bj)
#pragma unroll
                    for (int n = 0; n < 2; ++n) *(LAS f32x4*)(T + (wr * 64 + m * 16 + fr) * 260 + bj * 128 + wc * 32 + n * 16 + 4 * fq) = acc[ai][bj][m][n];
            __syncthreads();
            f32x4 xv[16];
#pragma unroll
            for (int k = 0; k < 16; ++k) xv[k] = *(const f32x4*)(xi + (size_t)(ai * 128 + wid * 16 + k) * DM);
#pragma unroll
            for (int k = 0; k < 16; ++k) { const f32x4 t = *(const LAS f32x4*)(T + (wid * 16 + k) * 260 + 4 * lane); *(f32x4*)(xo + (size_t)(ai * 128 + wid * 16 + k) * DM) = xv[k] + gv * t; }
            __syncthreads();
        }
    }
};
struct EpiMoe1 {
    static constexpr bool PERM = true, AFTER_DRAIN = false;
    unsigned char* ws;
    __device__ __forceinline__ void operator()(const f32x4 (&acc)[2][2][4][2], const pg8::Unit& u, int wr, int wc, int fr, int fq) const {
        const __amdgpu_buffer_rsrc_t hr = __builtin_amdgcn_make_buffer_rsrc((void*)(ws + WS_Z), 0, MAXSLOT * 512 * 2, 0x00020000);
        const int* TBL = (const int*)(ws + WS_TBL); const int* REC = (const int*)(ws + WS_REC);
        const int rho0 = wr * 64 + fr, colh = (u.pn >> 1) * 256 + (u.pn & 1) * 128 + wc * 32 + 8 * fq, which = u.pn >> 1;
        int rr[8]; float gts[8];
#pragma unroll
        for (int k = 0; k < 8; ++k) { const int rho = rho0 + (k >> 2) * 128 + (k & 3) * 16; const int rc = rho < u.nrow ? rho : u.nrow - 1; rr[k] = TBL[u.tbo + rc]; }
#pragma unroll
        for (int k = 0; k < 8; ++k) gts[k] = __uint_as_float((unsigned)REC[(size_t)rr[k] * 4 + 2 + which]);
#pragma unroll
        for (int ai = 0; ai < 2; ++ai)
#pragma unroll
            for (int m = 0; m < 4; ++m) { const int rho = rho0 + ai * 128 + m * 16; const float gt = gts[ai * 4 + m];
                float hv[8];
#pragma unroll
                for (int n = 0; n < 2; ++n)
#pragma unroll
                    for (int e = 0; e < 4; ++e) { const float a = acc[ai][0][m][n][e], uu = acc[ai][1][m][n][e]; hv[n * 4 + e] = silu_f(a) * uu * gt; }
                u32x4 w; w.x = pg8::cvt_pk_bf16(hv[0], hv[1]); w.y = pg8::cvt_pk_bf16(hv[2], hv[3]); w.z = pg8::cvt_pk_bf16(hv[4], hv[5]); w.w = pg8::cvt_pk_bf16(hv[6], hv[7]);
                __builtin_amdgcn_raw_buffer_store_b128(w, hr, (unsigned)(((size_t)(u.pm * 256 + rho) * 512 + colh) * 2), 0, 16); }
    }
};
struct EpiMoe2 {
    static constexpr bool PERM = false, AFTER_DRAIN = true;
    float* out; unsigned char* ws; int layer;
    __device__ __forceinline__ void operator()(const f32x4 (&acc)[2][2][4][2], const pg8::Unit& u, int wr, int wc, int fr, int fq) const {
        const int rho0 = wr * 64 + fr, col0 = u.pn * 256 + wc * 32 + 4 * fq; const int* TBL = (const int*)(ws + WS_TBL); float* xc = (float*)(ws + WS_XC); const float* modbase = (const float*)(ws + WS_MOD) + (size_t)layer * 3 * 6144;
        int rr[8];
#pragma unroll
        for (int k = 0; k < 8; ++k) { const int rho = rho0 + (k >> 2) * 128 + (k & 3) * 16; rr[k] = rho < u.nrow ? TBL[u.tbo + rho] : -1; }
#pragma unroll
        for (int ai = 0; ai < 2; ++ai)
#pragma unroll
            for (int m = 0; m < 4; ++m) { const int r = rr[ai * 4 + m];
                if (r >= 0) { const int b = r / BROWS, q = r - b * BROWS; const bool isctx = q < CTXL;
                    float* xp = isctx ? xc + (size_t)(b * CTXL + q) * DM : out + (size_t)(b * SEQL + (q - CTXL)) * DM;
                    const float* gate = modbase + (size_t)(isctx ? 2 : b) * 6144 + 5 * 1024;
#pragma unroll
                    for (int bj = 0; bj < 2; ++bj)
#pragma unroll
                        for (int n = 0; n < 2; ++n) { const int c = col0 + bj * 128 + n * 16; const f32x4 gv = *(const f32x4*)(gate + c); const f32x4 xv = *(const f32x4*)(xp + c);
                            *(f32x4*)(xp + c) = xv + gv * acc[ai][bj][m][n]; } }
                if (m & 1) asm volatile("" ::: "memory"); }
    }
    __device__ __forceinline__ void fused(const f32x4 (&acc)[2][2][4][2], const pg8::Unit& u, int wr, int wc, int fr, int fq, LAS unsigned char* lds, int wid, int lane) const {
        const int* TBL = (const int*)(ws + WS_TBL); float* xc = (float*)(ws + WS_XC); const float* modbase = (const float*)(ws + WS_MOD) + (size_t)layer * 3 * 6144;
        LAS float* T = (LAS float*)lds;
#pragma unroll
        for (int ai = 0; ai < 2; ++ai) {
#pragma unroll
            for (int m = 0; m < 4; ++m)
#pragma unroll
                for (int bj = 0; bj < 2; ++bj)
#pragma unroll
                    for (int n = 0; n < 2; ++n) *(LAS f32x4*)(T + (wr * 64 + m * 16 + fr) * 260 + bj * 128 + wc * 32 + n * 16 + 4 * fq) = acc[ai][bj][m][n];
            __syncthreads();
            int rr[16];
#pragma unroll
            for (int k = 0; k < 16; ++k) { const int rho = ai * 128 + wid * 16 + k; rr[k] = rho < u.nrow ? TBL[u.tbo + rho] : -1; }
#pragma unroll
            for (int kp = 0; kp < 16; kp += 4) { f32x4 xv[4]; float* xp[4]; f32x4 gv[4];
#pragma unroll
                for (int k = 0; k < 4; ++k) { const int r = rr[kp + k]; const int rc = r < 0 ? 0 : r; const int b = rc / BROWS, q = rc - b * BROWS; const bool isctx = q < CTXL;
                    xp[k] = (isctx ? xc + (size_t)(b * CTXL + q) * DM : out + (size_t)(b * SEQL + (q - CTXL)) * DM) + u.pn * 256 + 4 * lane;
                    gv[k] = *(const f32x4*)(modbase + (size_t)(isctx ? 2 : b) * 6144 + 5 * 1024 + u.pn * 256 + 4 * lane);
                    if (r >= 0) xv[k] = *(const f32x4*)xp[k]; }
#pragma unroll
                for (int k = 0; k < 4; ++k) { if (rr[kp + k] >= 0) { const f32x4 t = *(const LAS f32x4*)(T + (wid * 16 + kp + k) * 260 + 4 * lane); *(f32x4*)xp[k] = xv[k] + gv[k] * t; } } }
            __syncthreads();
        }
    }
};

__device__ __forceinline__ void transpose_item(const float* W, int ldw, int k0, int n0src, bf16* WT, int ldt, int drow0, int dk0, LAS float* scr, int lane) {
    float tv[32];
#pragma unroll
    for (int i = 0; i < 32; ++i) { const int kk = 2 * i + (lane >> 5); tv[i] = n0src >= 0 ? W[(size_t)(k0 + kk) * ldw + n0src + (lane & 31)] : 0.f; }
#pragma unroll
    for (int i = 0; i < 32; ++i) { const int kk = 2 * i + (lane >> 5); scr[kk * 33 + (lane & 31)] = tv[i]; }
    asm volatile("s_waitcnt lgkmcnt(0)" ::: "memory");
    const int c = lane & 7;
#pragma unroll
    for (int j = 0; j < 4; ++j) { const int n = (lane >> 3) + 8 * j; const LAS float* s = scr + (8 * c) * 33 + n;
        u32x4 o; o.x = pk2(s[0 * 33], s[1 * 33]); o.y = pk2(s[2 * 33], s[3 * 33]); o.z = pk2(s[4 * 33], s[5 * 33]); o.w = pk2(s[6 * 33], s[7 * 33]);
        *(u32x4*)(WT + (size_t)(drow0 + n) * ldt + dk0 + 8 * c) = o; }
    asm volatile("s_waitcnt lgkmcnt(0)" ::: "memory");
}
__device__ __forceinline__ int ab_src_col(int n) {
    if (n < 2304) return n;
    if (n < 3840) return n + 32;
    if (n < 3872) return n - 3840 + 2304;
    return -1;
}
__device__ __forceinline__ void ph_convert(const Ctx& C, int layer, LAS unsigned char* lds, int part = 0, int wg0 = 0) {
    const TC T = phase_tc();
    LAS float* scr = (LAS float*)(lds + T.wave * 16384);
    if (part == 1 && C.bid < wg0) return;
    const int gw = (part == 1 ? C.bid - wg0 : C.bid) * NWAVES + T.wave, NGW = (part == 1 ? C.G - wg0 : C.G) * NWAVES;
    bf16* Win = (bf16*)(C.ws + WS_WIN); bf16* Wout = (bf16*)(C.ws + WS_WOUT); bf16* W13 = (bf16*)(C.ws + WS_W13); bf16* W2 = (bf16*)(C.ws + WS_W2);
    const int nin = layer == 0 ? 3872 : 3584;
    const int I_IN = 16 * (nin / 32), I_OUT = 32 * 32, I_E = 16 * 128;
    const int NIT = I_IN + I_OUT + 3 * I_E;
    const float* win = C.in[layer == 0 ? I_ABIN : I_CDIN]; const float* wout = C.in[layer == 0 ? I_ABOUT : I_CDOUT];
    const int ldin = layer == 0 ? 3872 : 3584;
    const int it0 = part == 2 ? I_IN + I_OUT : 0, it1 = part == 1 ? I_IN + I_OUT : NIT;
    for (int it = it0 + gw; it < it1; it += NGW) {
        int r = it;
        if (r < I_IN) { const int nblk = nin / 32, kb = r / nblk, nb = r % nblk; const int src = layer == 0 ? ab_src_col(nb * 32) : nb * 32;
            transpose_item(win, ldin, kb * 64, src, Win, 1024, nb * 32, kb * 64, scr, T.lane); continue; } r -= I_IN;
        if (r < I_OUT) { const int kb = r / 32, nb = r % 32; transpose_item(wout, 1024, kb * 64, nb * 32, Wout, 2048, nb * 32, kb * 64, scr, T.lane); continue; } r -= I_OUT;
        if (r < 2 * I_E) { const int w3 = r >= I_E; if (w3) r -= I_E; const int e = r / 128, q = r % 128, kb = q / 8, nb = q % 8;
            const float* W = C.in[w3 ? I_W3 : I_W1] + (size_t)(layer * 16 + e) * 1024 * 256; const int n0 = nb * 32;
            transpose_item(W, 256, kb * 64, n0, W13 + (size_t)e * 512 * 1024, 1024, (n0 / 128) * 256 + (w3 ? 128 : 0) + (n0 % 128), kb * 64, scr, T.lane); continue; } r -= 2 * I_E;
        { const int e = r / 128, q = r % 128, kb = q / 32, nb = q % 32;
            const float* W = C.in[I_W2] + (size_t)(layer * 16 + e) * 256 * 1024;
            transpose_item(W, 1024, kb * 64, nb * 32, W2 + (size_t)e * 1024 * 256, 256, nb * 32, kb * 64, scr, T.lane); }
    }
}
__device__ __forceinline__ void ph_mod(const Ctx& C, LAS unsigned char* lds) {
    const TC T = phase_tc();
    LAS float* red = (LAS float*)lds;
    LAS float* act = red + 8 * 3 * 256;
    if (C.bid < 48) {
        for (int i = T.tid; i < 3072; i += NTHREADS) { const int v = i >> 10, d = i & 1023; act[i] = silu_f(v < 2 ? C.in[I_C][v * 1024 + d] : C.in[I_CCTX][d]); }
        __syncthreads();
    }
    for (int item = C.bid; item < 48; item += C.G) {
        const int layer = item / 24, chunk = item % 24;
        const float* W = C.in[I_WMOD] + (size_t)layer * 1024 * 6144 + chunk * 256 + T.lane * 4;
        f32x4 a0 = {0, 0, 0, 0}, a1 = a0, a2 = a0;
        const int d0 = T.wave * 128;
        for (int d = d0; d < d0 + 128; d += 8) {
            f32x4 w[8];
#pragma unroll
            for (int u = 0; u < 8; ++u) w[u] = *(const f32x4*)(W + (size_t)(d + u) * 6144);
#pragma unroll
            for (int u = 0; u < 8; ++u) { const float c0 = act[d + u], c1 = act[1024 + d + u], c2 = act[2048 + d + u]; a0 += w[u] * c0; a1 += w[u] * c1; a2 += w[u] * c2; }
        }
        __syncthreads();
#pragma unroll
        for (int e = 0; e < 4; ++e) { red[(T.wave * 3 + 0) * 256 + T.lane * 4 + e] = a0[e]; red[(T.wave * 3 + 1) * 256 + T.lane * 4 + e] = a1[e]; red[(T.wave * 3 + 2) * 256 + T.lane * 4 + e] = a2[e]; }
        __syncthreads();
        for (int o = T.tid; o < 768; o += NTHREADS) { const int v = o >> 8, j = o & 255; float s = 0.f;
#pragma unroll
            for (int w = 0; w < 8; ++w) s += red[(w * 3 + v) * 256 + j];
            C.mod(layer, v)[chunk * 256 + j] = s + C.in[I_BMOD][layer * 6144 + chunk * 256 + j]; }
        asm volatile("s_waitcnt vmcnt(0)" ::: "memory");
        __syncthreads();
        if (T.tid == 0) { __builtin_amdgcn_fence(__ATOMIC_RELEASE, "agent"); asm volatile("s_waitcnt vmcnt(0)" ::: "memory");
            __hip_atomic_fetch_add(C.ctl() + CW_MODDONE, 1u, __ATOMIC_RELAXED, __HIP_MEMORY_SCOPE_AGENT); }
    }
}
__device__ __forceinline__ void mod_wait(const Ctx& C) {
    const TC T = phase_tc();
    if (T.tid < 64) { unsigned polls = 0;
        while ((unsigned)__builtin_amdgcn_readfirstlane(__hip_atomic_load(C.ctl() + CW_MODDONE, __ATOMIC_RELAXED, __HIP_MEMORY_SCOPE_AGENT)) < 48u) { if (++polls > (1u << 17)) break; __builtin_amdgcn_s_sleep(16); }
        __builtin_amdgcn_fence(__ATOMIC_ACQUIRE, "agent"); asm volatile("s_waitcnt vmcnt(0)" ::: "memory"); }
    __syncthreads();
}
__device__ __forceinline__ void ph_prenorm(const Ctx& C, int layer) {
    const TC T = phase_tc();
    bf16* HN = (bf16*)(C.ws + WS_A);
    const float* gm = C.in[I_GMIX] + layer * 1024;
    const int gw = C.bid * NWAVES + T.wave, NGW = C.G * NWAVES;
    for (int r = gw; r < NROWS; r += NGW) {
        const float* xr = layer == 0 ? C.xin_row(r) : C.xrow(r);
        const float* md = C.mod(layer, row_mv(r));
        f32x4 v[4]; float ss = 0.f;
#pragma unroll
        for (int j = 0; j < 4; ++j) { v[j] = *(const f32x4*)(xr + 256 * j + 4 * T.lane); ss += (v[j].x * v[j].x + v[j].y * v[j].y) + (v[j].z * v[j].z + v[j].w * v[j].w); }
        const float rs = rsqrtf(wave_sum(ss) * (1.f / DM) + EPS);
#pragma unroll
        for (int j = 0; j < 4; ++j) { const int c = 256 * j + 4 * T.lane; const f32x4 g = *(const f32x4*)(gm + c), sc = *(const f32x4*)(md + 1024 + c), sh = *(const f32x4*)(md + c);
            const f32x4 h = v[j] * rs * g * (sc + 1.f) + sh;
            u32x2 w; w.x = pk2(h.x, h.y); w.y = pk2(h.z, h.w); *(u32x2*)(HN + (size_t)r * DM + c) = w; }
    }
}
__device__ __forceinline__ bool nb_valid(int r, int dk) { const int b = r / BROWS, q = r - b * BROWS; if (q < CTXL) { const int t = q + dk; return t >= 0 && t < CTXL; } const int t = q - CTXL + dk; return t >= 0 && t < SEQL; }
__device__ __forceinline__ void rope_angle(int r, int lane, float& cs, float& sn, bool& latent) {
    const int b = r / BROWS, q = r - b * BROWS; latent = q >= CTXL; const int t = q - CTXL;
    const int pos = lane < 32 ? (t >> 6) : (t & 63); const int jf = lane & 31;
    const float inv = exp2f(-(float)jf * (13.287712379549449f / 32.f));
    const float ang = (float)pos * inv; sincosf(ang, &sn, &cs);
}
__device__ __forceinline__ void ph_elem0(const Ctx& C) {
    const TC T = phase_tc();
    const bf16* RAW = (const bf16*)(C.ws + WS_RAW); bf16* XBC = (bf16*)C.out;
    float* DT = (float*)(C.ws + WS_DT);
    bf16* Q = (bf16*)(C.ws + WS_YMIX) + 1024; bf16* K = (bf16*)(C.ws + WS_K);
    const float* cw = C.in[I_SCONVW]; const float* cb = C.in[I_SCONVB];
    const int gw = C.bid * NWAVES + T.wave, NGW = C.G * NWAVES, lane = T.lane;
    { const bf16* HN = (const bf16*)(C.ws + WS_A); const bf16* Wd = (const bf16*)(C.ws + WS_WIN) + (size_t)3840 * 1024; const int l15 = lane & 15, lq = lane >> 4;
      const float bias0 = C.in[I_DTBIAS][l15], bias1 = C.in[I_DTBIAS][16 + l15];
      for (int gI = gw; gI < NROWS / 16; gI += NGW) { f32x4 a0 = {0.f, 0.f, 0.f, 0.f}, a1 = a0;
          const bf16* ap = HN + (size_t)(16 * gI + l15) * 1024 + 8 * lq; const bf16* b0p = Wd + (size_t)l15 * 1024 + 8 * lq; const bf16* b1p = Wd + (size_t)(16 + l15) * 1024 + 8 * lq;
#pragma unroll 8
          for (int ks = 0; ks < 32; ++ks) { const bf16x8 af = *(const bf16x8*)(ap + 32 * ks), f0 = *(const bf16x8*)(b0p + 32 * ks), f1 = *(const bf16x8*)(b1p + 32 * ks);
              a0 = __builtin_amdgcn_mfma_f32_16x16x32_bf16(af, f0, a0, 0, 0, 0); a1 = __builtin_amdgcn_mfma_f32_16x16x32_bf16(af, f1, a1, 0, 0, 0); }
#pragma unroll
          for (int rg = 0; rg < 4; ++rg) { const size_t ro = (size_t)(16 * gI + 4 * lq + rg) * 32; DT[ro + l15] = softplus_f(a0[rg] + bias0); DT[ro + 16 + l15] = softplus_f(a1[rg] + bias1); } } }
    for (int r = gw; r < NROWS; r += NGW) {
        for (int ch = lane; ch < 160; ch += 64) { const int c0 = ch * 8; float acc[8];
#pragma unroll
            for (int e = 0; e < 8; ++e) acc[e] = cb[c0 + e];
#pragma unroll
            for (int k = 0; k < 5; ++k) { if (nb_valid(r, k - 2)) { const u32x4 w = *(const u32x4*)(RAW + (size_t)(r + k - 2) * 1280 + c0); float xv[8]; unpack8(w, xv);
#pragma unroll
                for (int e = 0; e < 8; ++e) acc[e] += xv[e] * cw[k * 1280 + c0 + e]; } }
            u32x4 o; o.x = pk2(silu_f(acc[0]), silu_f(acc[1])); o.y = pk2(silu_f(acc[2]), silu_f(acc[3])); o.z = pk2(silu_f(acc[4]), silu_f(acc[5])); o.w = pk2(silu_f(acc[6]), silu_f(acc[7]));
            *(u32x4*)(XBC + (size_t)r * 1280 + c0) = o; }
        float cs, sn; bool latent; rope_angle(r, lane, cs, sn, latent);
        const float qg0 = C.in[I_QG][lane], qg1 = C.in[I_QG][64 + lane], kg0 = C.in[I_KG][lane], kg1 = C.in[I_KG][64 + lane];
#pragma unroll
        for (int h = 8; h < 10; ++h) { bf16* p = K + (size_t)r * 256 + (h - 8) * 128;
            float t1 = bf2f(p[lane]), t2 = bf2f(p[64 + lane]);
            const float rs = rsqrtf(wave_sum(t1 * t1 + t2 * t2) * (1.f / 128.f) + EPS);
            t1 = t1 * rs * (h < 8 ? qg0 : kg0); t2 = t2 * rs * (h < 8 ? qg1 : kg1);
            if (latent) { const float o1 = t1 * cs - t2 * sn, o2 = t1 * sn + t2 * cs; t1 = o1; t2 = o2; }
            p[lane] = (bf16)f2bf(t1); p[64 + lane] = (bf16)f2bf(t2); }
    }
}
__device__ __forceinline__ void ph_elem1(const Ctx& C) {
    const TC T = phase_tc();
    const bf16* RAW = (const bf16*)(C.ws + WS_RAW); bf16* XR = (bf16*)(C.ws + WS_A);
    bf16* Q = (bf16*)(C.ws + WS_YMIX) + 1024; bf16* K = (bf16*)(C.ws + WS_K);
    const float* cw = C.in[I_LCONVW]; const float* cb = C.in[I_LCONVB];
    const int gw = C.bid * NWAVES + T.wave, NGW = C.G * NWAVES, lane = T.lane;
    for (int r = gw; r < NROWS; r += NGW) {
        for (int ch = lane; ch < 128; ch += 64) { const int c0 = ch * 8; float acc[8];
#pragma unroll
            for (int e = 0; e < 8; ++e) acc[e] = cb[c0 + e];
#pragma unroll
            for (int k = 0; k < 5; ++k) { if (nb_valid(r, k - 2)) { const u32x4 w = *(const u32x4*)(RAW + (size_t)(r + k - 2) * 1024 + c0); float xv[8]; unpack8(w, xv);
#pragma unroll
                for (int e = 0; e < 8; ++e) acc[e] += xv[e] * cw[k * 1024 + c0 + e]; } }
            u32x4 o; o.x = pk2(acc[0], acc[1]); o.y = pk2(acc[2], acc[3]); o.z = pk2(acc[4], acc[5]); o.w = pk2(acc[6], acc[7]);
            *(u32x4*)(XR + (size_t)r * 1024 + c0) = o; }
        float cs, sn; bool latent; rope_angle(r, lane, cs, sn, latent);
        if (latent) {
#pragma unroll
            for (int h = 8; h < 10; ++h) { bf16* p = K + (size_t)r * 256 + (h - 8) * 128;
                const float t1 = bf2f(p[lane]), t2 = bf2f(p[64 + lane]);
                p[lane] = (bf16)f2bf(t1 * cs - t2 * sn); p[64 + lane] = (bf16)f2bf(t1 * sn + t2 * cs); }
        }
    }
}
__device__ __forceinline__ int chunk_of(int dir, int ci) { return dir == 0 ? ci : (ci < 2 ? 1 - ci : 67 - ci); }
__device__ __forceinline__ int step_row(int dir, int s) { return dir == 0 ? s : (s < CTXL ? CTXL - 1 - s : BROWS + CTXL - 1 - s); }
__device__ __forceinline__ void ssd_seq_unit(const Ctx& C, int item, LAS unsigned char* lds) {
    const TC T = phase_tc();
    const int b = item >> 5, dir = (item >> 4) & 1, h = item & 15, g = h >> 3, lane = T.lane, wid = T.wave;
    LAS float* part = (LAS float*)lds;
    LAS float* xs = part + 8 * 32 * 64; LAS float* Bs = xs + 32 * 64; LAS float* Cs = Bs + 32 * 64; LAS float* dts = Cs + 32 * 64;
    const float aneg = -__expf(C.in[I_ALOG][dir * 16 + h]);
    const bf16* XBC = (const bf16*)C.out + (size_t)b * BROWS * 1280;
    const float* DT = (const float*)(C.ws + WS_DT) + (size_t)b * BROWS * 32 + dir * 16 + h;
    bf16* Y = dir == 0 ? (bf16*)(C.ws + WS_YMIX) + (size_t)b * BROWS * 2048 + h * 64 : (bf16*)(C.ws + WS_RAW) + (size_t)b * BROWS * 1024 + h * 64;
    const int ldy = dir == 0 ? 2048 : 1024;
    float hs[8];
#pragma unroll
    for (int k = 0; k < 8; ++k) hs[k] = 0.f;
    for (int s0 = 0; s0 < BROWS; s0 += 32) {
        for (int i = T.tid; i < 32 * 192; i += NTHREADS) { const int tt = i / 192, c = i - tt * 192; const int q = step_row(dir, s0 + tt);
            const bf16* row = XBC + (size_t)q * 1280;
            if (c < 64) xs[tt * 64 + c] = bf2f(row[h * 64 + c]); else if (c < 128) Bs[tt * 64 + c - 64] = bf2f(row[1024 + g * 64 + c - 64]); else Cs[tt * 64 + c - 128] = bf2f(row[1152 + g * 64 + c - 128]); }
        if (T.tid < 32) dts[T.tid] = DT[(size_t)step_row(dir, s0 + T.tid) * 32];
        __syncthreads();
        for (int tt = 0; tt < 32; ++tt) {
            const float x = xs[tt * 64 + lane], dt = dts[tt];
            const f32x4 b0 = *(const LAS f32x4*)(Bs + tt * 64 + wid * 8), b1 = *(const LAS f32x4*)(Bs + tt * 64 + wid * 8 + 4);
            const f32x4 c0 = *(const LAS f32x4*)(Cs + tt * 64 + wid * 8), c1 = *(const LAS f32x4*)(Cs + tt * 64 + wid * 8 + 4);
            const float a = __expf(dt * aneg), dx = dt * x; float y = 0.f;
#pragma unroll
            for (int k = 0; k < 4; ++k) { hs[k] = a * hs[k] + dx * b0[k]; y += c0[k] * hs[k]; }
#pragma unroll
            for (int k = 0; k < 4; ++k) { hs[4 + k] = a * hs[4 + k] + dx * b1[k]; y += c1[k] * hs[4 + k]; }
            part[(wid * 32 + tt) * 64 + lane] = y;
        }
        __syncthreads();
        for (int i = T.tid; i < 2048; i += NTHREADS) { const int tt = i >> 6, p = i & 63; float s = 0.f;
#pragma unroll
            for (int w = 0; w < 8; ++w) s += part[(w * 32 + tt) * 64 + p];
            const int q = step_row(dir, s0 + tt); Y[(size_t)q * ldy + p] = (bf16)f2bf(s); }
        __syncthreads();
    }
}

__device__ __forceinline__ int ssd_seg_begin(int s) { return s == 0 ? 0 : (s == 1 ? 17 : (s == 2 ? 34 : (s == 3 ? 50 : 66))); }
__device__ __forceinline__ unsigned short hw_bf16(float x) { unsigned r; asm volatile("v_cvt_pk_bf16_f32 %0, %1, %1" : "=v"(r) : "v"(x)); return (unsigned short)r; }
__device__ __forceinline__ int tswz(int row, int col) { return row * 136 + ((((col >> 3) ^ ((row >> 3) & 7)) << 3) | (col & 7)); }
template <int MODE>
__device__ __forceinline__ void ssd_chunk_unit(const Ctx& C, int item, int seg, LAS unsigned char* lds) {
    const TC T = phase_tc();
    const int b = item >> 5, dir = (item >> 4) & 1, h = item & 15, g = h >> 3, lane = T.lane, wid = T.wave, tid = T.tid;
    const int ci0 = ssd_seg_begin(seg), ci1 = ssd_seg_begin(seg + 1);
    float* SEND = (float*)(C.ws + WS_SSDST) + (size_t)item * 3 * 4096; float* SLD = (float*)(C.ws + WS_SSDLD) + item * 3;
    const int l15 = lane & 15, lq = lane >> 4;
    LAS bf16* Cs = (LAS bf16*)lds;
    LAS bf16* Bs = Cs + 128 * 72;
    LAS bf16* Xt = Bs + 128 * 72;
    LAS bf16* Bwt = Xt + 64 * 136;
    LAS bf16* Ws = Bwt + 64 * 136;
    LAS bf16* Hs = Ws + 128 * 136;
    LAS float* acs = (LAS float*)(Hs + 64 * 72); LAS float* dtv = acs + 128; LAS float* eacs = dtv + 128; LAS float* wend = eacs + 128;
    const float aneg = -__expf(C.in[I_ALOG][dir * 16 + h]);
    const bf16* XBC = (const bf16*)C.out + (size_t)b * BROWS * 1280;
    const float* DT = (const float*)(C.ws + WS_DT) + (size_t)b * BROWS * 32 + dir * 16 + h;
    bf16* Y = dir == 0 ? (bf16*)(C.ws + WS_YMIX) + (size_t)b * BROWS * 2048 + h * 64 : (bf16*)(C.ws + WS_RAW) + (size_t)b * BROWS * 1024 + h * 64;
    const int ldy = dir == 0 ? 2048 : 1024;
    f32x4 Hacc[2]; Hacc[0] = (f32x4){0.f, 0.f, 0.f, 0.f}; Hacc[1] = Hacc[0];
    float ldsum = 0.f;
    if (MODE == 1) {
        for (int sp = 0; sp < seg; ++sp) { const float dseg = __expf(SLD[sp]);
#pragma unroll
            for (int t = 0; t < 2; ++t) { const int tl = 2 * wid + t, nt_ = tl >> 2, pt = tl & 3;
                const f32x4 sv = *(const f32x4*)(SEND + (size_t)sp * 4096 + (16 * pt + l15) * 64 + 16 * nt_ + 4 * lq); Hacc[t] = Hacc[t] * dseg + sv; } }
#pragma unroll
        for (int t = 0; t < 2; ++t) { const int tl = 2 * wid + t, nt_ = tl >> 2, pt = tl & 3;
            u32x2 w; w.x = pg8::cvt_pk_bf16(Hacc[t][0], Hacc[t][1]); w.y = pg8::cvt_pk_bf16(Hacc[t][2], Hacc[t][3]); *(LAS u32x2*)(Hs + (16 * pt + l15) * 72 + 16 * nt_ + 4 * lq) = w; }
    }
    u32x4 xb[4], bb[2], cb[2]; float dt0 = 0.f, dt1 = 0.f;
    const int xtg = tid >> 3, xpg = tid & 7;
#define SSD_ROW(q0_, i_) (XBC + (size_t)(dir == 0 ? (q0_) + (i_) : (q0_) + 127 - (i_)) * 1280)
#define SSD_LOAD(q0_) do { \
        if (tid < 256) { _Pragma("unroll") for (int q_ = 0; q_ < 4; ++q_) xb[q_] = *(const u32x4*)(SSD_ROW(q0_, 4 * xtg + q_) + h * 64 + 8 * xpg); } \
        _Pragma("unroll") for (int k = 0; k < 2; ++k) { const int pidx = tid + 512 * k, i_ = pidx >> 3, c8_ = (pidx & 7) * 8; \
            bb[k] = *(const u32x4*)(SSD_ROW(q0_, i_) + 1024 + g * 64 + c8_); if (MODE == 1) cb[k] = *(const u32x4*)(SSD_ROW(q0_, i_) + 1152 + g * 64 + c8_); } \
        if (wid == 0) { dt0 = DT[(size_t)(dir == 0 ? (q0_) + 2 * lane : (q0_) + 127 - 2 * lane) * 32]; dt1 = DT[(size_t)(dir == 0 ? (q0_) + 2 * lane + 1 : (q0_) + 126 - 2 * lane) * 32]; } } while (0)
    SSD_LOAD(chunk_of(dir, ci0) * 128);
    for (int ci = ci0; ci < ci1; ++ci) {
        const int q0 = chunk_of(dir, ci) * 128;
        __syncthreads();
        if (wid == 0) {
            const float a0 = dt0 * aneg, a1 = dt1 * aneg; float v = a0 + a1;
#pragma unroll
            for (int o = 1; o < 64; o <<= 1) { const float t = __shfl_up(v, o); if (lane >= o) v += t; }
            const float tot = __shfl(v, 63), c0 = v - a1;
            acs[2 * lane] = c0; acs[2 * lane + 1] = v; dtv[2 * lane] = dt0; dtv[2 * lane + 1] = dt1;
            eacs[2 * lane] = __expf(c0); eacs[2 * lane + 1] = __expf(v);
            wend[2 * lane] = __expf(tot - c0) * dt0; wend[2 * lane + 1] = __expf(tot - v) * dt1; }
        if (tid < 256) {
#pragma unroll
            for (int m = 0; m < 4; ++m) { const unsigned w0 = xb[0][m], w1 = xb[1][m], w2 = xb[2][m], w3 = xb[3][m];
                u32x2 lo, hi; lo.x = (w0 & 0xffffu) | (w1 << 16); lo.y = (w2 & 0xffffu) | (w3 << 16); hi.x = (w0 >> 16) | (w1 & 0xffff0000u); hi.y = (w2 >> 16) | (w3 & 0xffff0000u);
                *(LAS u32x2*)(Xt + tswz(8 * xpg + 2 * m, 4 * xtg)) = lo; *(LAS u32x2*)(Xt + tswz(8 * xpg + 2 * m + 1, 4 * xtg)) = hi; } }
#pragma unroll
        for (int k = 0; k < 2; ++k) { const int pidx = tid + 512 * k, i_ = pidx >> 3, c8_ = (pidx & 7) * 8;
            *(LAS u32x4*)(Bs + i_ * 72 + c8_) = bb[k]; if (MODE == 1) *(LAS u32x4*)(Cs + i_ * 72 + c8_) = cb[k]; }
        if (ci + 1 < ci1) SSD_LOAD(chunk_of(dir, ci + 1) * 128);
        __syncthreads();
        const float al = acs[127], dchunk = __expf(al); ldsum += al;
        if (tid < 256) { float f[4][8];
#pragma unroll
            for (int q_ = 0; q_ < 4; ++q_) { const u32x4 w = *(const LAS u32x4*)(Bs + (4 * xtg + q_) * 72 + 8 * xpg); unpack8(w, f[q_]); const float we = wend[4 * xtg + q_];
#pragma unroll
                for (int e = 0; e < 8; ++e) f[q_][e] *= we; }
#pragma unroll
            for (int e = 0; e < 8; ++e) { u32x2 w; w.x = pg8::cvt_pk_bf16(f[0][e], f[1][e]); w.y = pg8::cvt_pk_bf16(f[2][e], f[3][e]); *(LAS u32x2*)(Bwt + tswz(8 * xpg + e, 4 * xtg)) = w; } }
        if (MODE == 1) {
            for (int t = wid; t < 40; t += 8) {
                if (t >= 36) { const int rt = 2 * (t - 36);
                    *(LAS u32x2*)(Ws + (16 * rt + l15) * 136 + 16 * (rt + 1) + 4 * lq) = (u32x2){0u, 0u};
                    continue; }
                int rt = 0, base = 0; while (base + rt + 1 <= t) { base += rt + 1; ++rt; }
                const int ct = t - base;
                f32x4 acc = (f32x4){0.f, 0.f, 0.f, 0.f};
#pragma unroll
                for (int kk = 0; kk < 2; ++kk) { const bf16x8 af = *(const LAS bf16x8*)(Bs + (16 * ct + l15) * 72 + kk * 32 + 8 * lq), bfr = *(const LAS bf16x8*)(Cs + (16 * rt + l15) * 72 + kk * 32 + 8 * lq);
                    acc = __builtin_amdgcn_mfma_f32_16x16x32_bf16(af, bfr, acc, 0, 0, 0); }
                const int i = 16 * rt + l15; const float ai = acs[i];
                const f32x4 aj = *(const LAS f32x4*)(acs + 16 * ct + 4 * lq), dj = *(const LAS f32x4*)(dtv + 16 * ct + 4 * lq);
                float val[4];
#pragma unroll
                for (int rg = 0; rg < 4; ++rg) { const int j = 16 * ct + 4 * lq + rg; val[rg] = j <= i ? acc[rg] * __expf(ai - aj[rg]) * dj[rg] : 0.f; }
                u32x2 w; w.x = pg8::cvt_pk_bf16(val[0], val[1]); w.y = pg8::cvt_pk_bf16(val[2], val[3]); *(LAS u32x2*)(Ws + i * 136 + 16 * ct + 4 * lq) = w; }
        }
        __syncthreads();
        if (MODE == 1) { const int it = wid; f32x4 acc[4];
#pragma unroll
          for (int pt = 0; pt < 4; ++pt) acc[pt] = (f32x4){0.f, 0.f, 0.f, 0.f};
#pragma unroll
          for (int kk = 0; kk < 2; ++kk) { const bf16x8 bfr = *(const LAS bf16x8*)(Cs + (16 * it + l15) * 72 + kk * 32 + 8 * lq);
#pragma unroll
              for (int pt = 0; pt < 4; ++pt) { const bf16x8 af = *(const LAS bf16x8*)(Hs + (16 * pt + l15) * 72 + kk * 32 + 8 * lq); acc[pt] = __builtin_amdgcn_mfma_f32_16x16x32_bf16(af, bfr, acc[pt], 0, 0, 0); } }
          const float ea = eacs[16 * it + l15];
#pragma unroll
          for (int pt = 0; pt < 4; ++pt) acc[pt] = acc[pt] * ea;
          for (int ks = 0; ks <= (it >> 1); ++ks) { const bf16x8 bfr = *(const LAS bf16x8*)(Ws + (16 * it + l15) * 136 + ks * 32 + 8 * lq);
#pragma unroll
              for (int pt = 0; pt < 4; ++pt) { const bf16x8 af = *(const LAS bf16x8*)(Xt + tswz(16 * pt + l15, ks * 32 + 8 * lq)); acc[pt] = __builtin_amdgcn_mfma_f32_16x16x32_bf16(af, bfr, acc[pt], 0, 0, 0); } }
          { const int i = 16 * it + l15; const int q = dir == 0 ? q0 + i : q0 + 127 - i;
#pragma unroll
            for (int pt = 0; pt < 4; ++pt) { u32x2 w; w.x = pg8::cvt_pk_bf16(acc[pt][0], acc[pt][1]); w.y = pg8::cvt_pk_bf16(acc[pt][2], acc[pt][3]); *(u32x2*)(Y + (size_t)q * ldy + 16 * pt + 4 * lq) = w; } } }
#pragma unroll
        for (int t = 0; t < 2; ++t) { const int tl = 2 * wid + t, nt_ = tl >> 2, pt = tl & 3; Hacc[t] = Hacc[t] * dchunk;
#pragma unroll
            for (int ks = 0; ks < 4; ++ks) { const bf16x8 af = *(const LAS bf16x8*)(Bwt + tswz(16 * nt_ + l15, ks * 32 + 8 * lq)), bfr = *(const LAS bf16x8*)(Xt + tswz(16 * pt + l15, ks * 32 + 8 * lq));
                Hacc[t] = __builtin_amdgcn_mfma_f32_16x16x32_bf16(af, bfr, Hacc[t], 0, 0, 0); } }
        if (MODE == 1) {
        __syncthreads();
#pragma unroll
        for (int t = 0; t < 2; ++t) { const int tl = 2 * wid + t, nt_ = tl >> 2, pt = tl & 3;
            u32x2 w; w.x = pg8::cvt_pk_bf16(Hacc[t][0], Hacc[t][1]); w.y = pg8::cvt_pk_bf16(Hacc[t][2], Hacc[t][3]); *(LAS u32x2*)(Hs + (16 * pt + l15) * 72 + 16 * nt_ + 4 * lq) = w; }
        }
    }
    if (MODE == 0) {
#pragma unroll
        for (int t = 0; t < 2; ++t) { const int tl = 2 * wid + t, nt_ = tl >> 2, pt = tl & 3;
            *(f32x4*)(SEND + (size_t)seg * 4096 + (16 * pt + l15) * 64 + 16 * nt_ + 4 * lq) = Hacc[t]; }
        if (tid == 0) SLD[seg] = ldsum;
    }
    __syncthreads();
#undef SSD_ROW
#undef SSD_LOAD
}

__device__ __forceinline__ void lru_seq_unit(const Ctx& C, int item, LAS unsigned char* lds) {
    const TC T = phase_tc();
    const int b = item >> 5, dir = (item >> 4) & 1, hb = item & 15, lane = T.lane, wid = T.wave;
    LAS float* wa = (LAS float*)lds; LAS float* wx = wa + 4096; LAS float* xs = wx + 4096; LAS float* as_ = xs + 512; LAS float* bs_ = as_ + 512;
    const float* gwa = C.in[I_LWA] + (size_t)(dir * 16 + hb) * 4096; const float* gwx = C.in[I_LWX] + (size_t)(dir * 16 + hb) * 4096;
    for (int i = T.tid; i < 4096; i += NTHREADS) { wa[i] = gwa[i]; wx[i] = gwx[i]; }
    const int c = hb * 64 + lane;
    const float ba = C.in[I_LBA][dir * 1024 + c], bx = C.in[I_LBX][dir * 1024 + c], logbase = -8.f * softplus_f(-C.in[I_LAM][dir * 1024 + c]);
    const bf16* XR = (const bf16*)(C.ws + WS_A) + (size_t)b * BROWS * 1024 + hb * 64;
    bf16* Y = dir == 0 ? (bf16*)(C.ws + WS_YMIX) + (size_t)b * BROWS * 2048 + hb * 64 : (bf16*)(C.ws + WS_RAW) + (size_t)b * BROWS * 1024 + hb * 64;
    const int ldy = dir == 0 ? 2048 : 1024;
    float hst = 0.f;
    __syncthreads();
    unsigned short xnext = XR[(size_t)step_row(dir, wid) * 1024 + lane];
    for (int it = 0; it < BROWS / 8; ++it) {
        const float xv = bf2f(xnext);
        if (it + 1 < BROWS / 8) xnext = XR[(size_t)step_row(dir, (it + 1) * 8 + wid) * 1024 + lane];
        xs[wid * 64 + lane] = xv;
        asm volatile("s_waitcnt lgkmcnt(0)" ::: "memory");
        float pa = ba, px = bx;
#pragma unroll 8
        for (int i = 0; i < 64; ++i) { const float xi = xs[wid * 64 + i]; pa += xi * wa[i * 64 + lane]; px += xi * wx[i * 64 + lane]; }
        const float la = logbase * sigmoid_f(pa), a = __expf(la), bc = sqrtf(-expm1f(2.f * la)) * sigmoid_f(px) * xv;
        as_[wid * 64 + lane] = a; bs_[wid * 64 + lane] = bc;
        __syncthreads();
        if (wid == 0) {
#pragma unroll
            for (int tt = 0; tt < 8; ++tt) { hst = as_[tt * 64 + lane] * hst + bs_[tt * 64 + lane]; const int q2 = step_row(dir, it * 8 + tt); Y[(size_t)q2 * ldy + lane] = (bf16)f2bf(hst); }
        }
        __syncthreads();
    }
}

__device__ __forceinline__ float fast_sigmoid(float x) { return __builtin_amdgcn_rcpf(1.f + __expf(-x)); }
__device__ __forceinline__ void lru_chunk_unit(const Ctx& C, int item4, LAS unsigned char* lds) {
    const TC T = phase_tc();
    const int item = item4 >> 2, qc = item4 & 3;
    const int b = item >> 5, dir = (item >> 4) & 1, hb = item & 15, lane = T.lane, wid = T.wave, tid = T.tid;
    LAS bf16* xs0 = (LAS bf16*)lds;
    LAS bf16* wT = (LAS bf16*)(lds + 36864);
    LAS float* sWP = (LAS float*)(lds + 36864 + 4608);
    LAS float* sWH = sWP + 128;
    const float* gwa = C.in[I_LWA] + (size_t)(dir * 16 + hb) * 4096; const float* gwx = C.in[I_LWX] + (size_t)(dir * 16 + hb) * 4096;
    for (int i = tid; i < 1024; i += NTHREADS) { const int ii = i >> 4, j = i & 15; wT[j * 72 + ii] = (bf16)f2bf(gwa[ii * 64 + qc * 16 + j]); wT[16 * 72 + j * 72 + ii] = (bf16)f2bf(gwx[ii * 64 + qc * 16 + j]); }
    const int l15 = lane & 15, lq = lane >> 4;
    const int c = hb * 64 + qc * 16 + l15;
    const float ba = C.in[I_LBA][dir * 1024 + c], bx = C.in[I_LBX][dir * 1024 + c], lb = -8.f * softplus_f(-C.in[I_LAM][dir * 1024 + c]);
    float hst = 0.f;
    const bf16* XR = (const bf16*)(C.ws + WS_A) + (size_t)b * BROWS * 1024 + hb * 64;
    bf16* Y = dir == 0 ? (bf16*)(C.ws + WS_YMIX) + (size_t)b * BROWS * 2048 + hb * 64 + qc * 16 : (bf16*)(C.ws + WS_RAW) + (size_t)b * BROWS * 1024 + hb * 64 + qc * 16;
    const int ldy = dir == 0 ? 2048 : 1024;
    const int pr0 = tid >> 3, pc = (tid & 7) * 8;
    u32x4 st0, st1;
    { const int q0 = chunk_of(dir, 0) * 128; const int qa = dir == 0 ? q0 + pr0 : q0 + 127 - pr0, qb = dir == 0 ? q0 + pr0 + 64 : q0 + 63 - pr0;
      st0 = *(const u32x4*)(XR + (size_t)qa * 1024 + pc); st1 = *(const u32x4*)(XR + (size_t)qb * 1024 + pc); }
    __syncthreads();
    for (int ci = 0; ci < 66; ++ci) {
        const int q0 = chunk_of(dir, ci) * 128;
        LAS bf16* xs = xs0 + (ci & 1) * (128 * 72);
        *(LAS u32x4*)(xs + pr0 * 72 + pc) = st0; *(LAS u32x4*)(xs + (pr0 + 64) * 72 + pc) = st1;
        if (ci + 1 < 66) { const int qn = chunk_of(dir, ci + 1) * 128; const int qa = dir == 0 ? qn + pr0 : qn + 127 - pr0, qb = dir == 0 ? qn + pr0 + 64 : qn + 63 - pr0;
            st0 = *(const u32x4*)(XR + (size_t)qa * 1024 + pc); st1 = *(const u32x4*)(XR + (size_t)qb * 1024 + pc); }
        __syncthreads();
        f32x4 ga = (f32x4){0.f, 0.f, 0.f, 0.f}, gx = ga;
#pragma unroll
        for (int kk = 0; kk < 2; ++kk) { const bf16x8 af = *(const LAS bf16x8*)(xs + (16 * wid + l15) * 72 + kk * 32 + 8 * lq);
            const bf16x8 b0 = *(const LAS bf16x8*)(wT + l15 * 72 + kk * 32 + 8 * lq), b1 = *(const LAS bf16x8*)(wT + 16 * 72 + l15 * 72 + kk * 32 + 8 * lq);
            ga = __builtin_amdgcn_mfma_f32_16x16x32_bf16(af, b0, ga, 0, 0, 0); gx = __builtin_amdgcn_mfma_f32_16x16x32_bf16(af, b1, gx, 0, 0, 0); }
        float p = 1.f, hh = 0.f;
#pragma unroll
        for (int rg = 0; rg < 4; ++rg) { const int i = 16 * wid + 4 * lq + rg;
            const float la = lb * fast_sigmoid(ga[rg] + ba), a = __expf(la), xv = bf2f(xs[i * 72 + qc * 16 + l15]);
            const float x2 = 2.f * la, oms = -x2 * (1.f + 0.5f * x2 * (1.f + (1.f / 3.f) * x2 * (1.f + 0.25f * x2 * (1.f + 0.2f * x2)))), om = x2 < -0.4f ? 1.f - a * a : oms;
            const float bc = __builtin_amdgcn_sqrtf(om) * fast_sigmoid(gx[rg] + bx) * xv;
            hh = a * hh + bc; p *= a; ga[rg] = p; gx[rg] = hh; }
        { const float pp = __shfl_up(p, 16), hp = __shfl_up(hh, 16); if (lq >= 1) { hh = p * hp + hh; p = pp * p; } }
        { const float pp = __shfl_up(p, 32), hp = __shfl_up(hh, 32); if (lq >= 2) { hh = p * hp + hh; p = pp * p; } }
        const float pe_ = __shfl_up(p, 16), he_ = __shfl_up(hh, 16);
        const float Pe = lq >= 1 ? pe_ : 1.f, He = lq >= 1 ? he_ : 0.f;
        if (lq == 3) { sWP[l15 * 8 + wid] = p; sWH[l15 * 8 + wid] = hh; }
        __syncthreads();
        { const f32x4 p0 = *(const LAS f32x4*)(sWP + l15 * 8), p1 = *(const LAS f32x4*)(sWP + l15 * 8 + 4), h0 = *(const LAS f32x4*)(sWH + l15 * 8), h1 = *(const LAS f32x4*)(sWH + l15 * 8 + 4);
            float cin = hst, cw = hst;
#pragma unroll
            for (int w = 0; w < 8; ++w) { if (w == wid) cw = cin; const float pw = w < 4 ? p0[w & 3] : p1[w & 3], hw = w < 4 ? h0[w & 3] : h1[w & 3]; cin = pw * cin + hw; }
            hst = cin;
            const float cl = Pe * cw + He;
#pragma unroll
            for (int rg = 0; rg < 4; ++rg) { const int i = 16 * wid + 4 * lq + rg; const int q = dir == 0 ? q0 + i : q0 + 127 - i;
                Y[(size_t)q * ldy + l15] = hw_bf16(gx[rg] + ga[rg] * cl); } }
    }
    __syncthreads();
}

__device__ __forceinline__ int queue_pop(const Ctx& C, unsigned* qword, LAS unsigned char* lds) {
    const TC T = phase_tc();
    LAS int* slot = (LAS int*)(lds + LDS_BYTES - 64);
    __syncthreads();
    if (T.tid == 0) slot[0] = (int)atomicAdd(qword, 1u);
    __syncthreads();
    const int v = slot[0];
    return __builtin_amdgcn_readfirstlane(v);
}
__device__ __forceinline__ void ph_ssdpre(const Ctx& C, LAS unsigned char* lds) {
    for (int u = C.bid; u < 192; u += C.G) ssd_chunk_unit<0>(C, u / 3, u % 3, lds);
}
__device__ __forceinline__ void ph_mix0(const Ctx& C, LAS unsigned char* lds, char* ldsg) {
    bf16* YM = (bf16*)(C.ws + WS_YMIX); const bf16* K = (const bf16*)(C.ws + WS_K); const bf16* V = (const bf16*)(C.ws + WS_V);
    for (;;) {
        const int item = queue_pop(C, C.ctl() + CW_Q0, lds);
        if (item >= 256 + 512 + 16) break;
#ifdef SPLIT_MIX0
        if (item < 256) continue;
#else
        if (item < 256) { ssd_chunk_unit<1>(C, item >> 2, item & 3, lds); continue; }
#endif
        const int a = item - 256;
        if (a >= 16) { const int a1 = a - 16, hr = a1 & 3, qb = (a1 >> 2) & 31, kvh = (a1 >> 7) & 1, b = a1 >> 8, h = kvh * 4 + hr;
            bf16* Qb = YM + ((size_t)b * BROWS + CTXL + (size_t)qb * 256) * 2048 + 1024 + h * 128;
            att::attn_body<0>(Qb, K + (size_t)b * BROWS * 256 + kvh * 128, V + (size_t)b * BROWS * 256 + kvh * 128, Qb, BROWS / 64, 0, 0, 0.f, ldsg, C.in[I_QG], qb * 256);
        } else { const int b = a >> 3, h = a & 7, kvh = h >> 2;
            bf16* Qb = YM + ((size_t)b * BROWS) * 2048 + 1024 + h * 128;
            att::attn_body<0>(Qb, K + (size_t)b * BROWS * 256 + kvh * 128, V + (size_t)b * BROWS * 256 + kvh * 128, Qb, CTXL / 64, 0, 0, 0.f, ldsg, C.in[I_QG], -1);
        }
    }
}
__device__ __forceinline__ void ph_mix1(const Ctx& C, LAS unsigned char* lds, char* ldsg) {
    bf16* YM = (bf16*)(C.ws + WS_YMIX); const bf16* K = (const bf16*)(C.ws + WS_K); const bf16* V = (const bf16*)(C.ws + WS_V);
    for (;;) {
        const int item = queue_pop(C, C.ctl() + CW_Q1, lds);
        if (item >= 256 + 512) break;
        if (item < 256) { lru_chunk_unit(C, item, lds); continue; }
        const int a = item - 256, hr = a & 3, qb = (a >> 2) & 31, kvh = (a >> 7) & 1, b = a >> 8, h = kvh * 4 + hr;
        const int q0 = qb * 256, lo = q0 - 128 < 0 ? 0 : q0 - 128, hi_ = q0 + 384 > SEQL ? SEQL : q0 + 384;
        bf16* Qb = YM + ((size_t)b * BROWS + CTXL + (size_t)q0) * 2048 + 1024 + h * 128;
        att::attn_body<1>(Qb, K + (size_t)b * BROWS * 256 + kvh * 128, V + (size_t)b * BROWS * 256 + kvh * 128, Qb, 4 + (hi_ - lo) / 64, CTXL + lo, q0, C.in[I_SINK][h], ldsg, nullptr, q0);
    }
}
__device__ __forceinline__ void ph_ssdpost(const Ctx& C) {
    const TC T = phase_tc();
    bf16* YM = (bf16*)(C.ws + WS_YMIX); const bf16* YB = (const bf16*)(C.ws + WS_RAW); const bf16* XBC = (const bf16*)C.out; const bf16* Z = (const bf16*)(C.ws + WS_Z);
    const int gw = C.bid * NWAVES + T.wave, NGW = C.G * NWAVES, lane = T.lane;
    for (int r = gw; r < NROWS; r += NGW) {
        float v[16]; float ss = 0.f;
#pragma unroll
        for (int j = 0; j < 2; ++j) { const int c0 = j * 512 + lane * 8;
            const u32x4 wy = *(const u32x4*)(YM + (size_t)r * 2048 + c0), wb = *(const u32x4*)(YB + (size_t)r * 1024 + c0), wx = *(const u32x4*)(XBC + (size_t)r * 1280 + c0), wz = *(const u32x4*)(Z + (size_t)r * 1024 + c0);
            float fy[8], fb[8], fx[8], fz[8]; unpack8(wy, fy); unpack8(wb, fb); unpack8(wx, fx); unpack8(wz, fz);
            const float dsk = C.in[I_SSDD][c0 >> 6];
#pragma unroll
            for (int e = 0; e < 8; ++e) { const float y = (fy[e] + fb[e] + dsk * fx[e]) * silu_f(fz[e]); v[j * 8 + e] = y; ss += y * y; } }
        const float rs = rsqrtf(wave_sum(ss) * (1.f / 1024.f) + EPS);
#pragma unroll
        for (int j = 0; j < 2; ++j) { const int c0 = j * 512 + lane * 8; const float* ng = C.in[I_SNORMG] + c0;
            u32x4 o; o.x = pk2(v[j * 8 + 0] * rs * ng[0], v[j * 8 + 1] * rs * ng[1]); o.y = pk2(v[j * 8 + 2] * rs * ng[2], v[j * 8 + 3] * rs * ng[3]);
            o.z = pk2(v[j * 8 + 4] * rs * ng[4], v[j * 8 + 5] * rs * ng[5]); o.w = pk2(v[j * 8 + 6] * rs * ng[6], v[j * 8 + 7] * rs * ng[7]);
            *(u32x4*)(YM + (size_t)r * 2048 + c0) = o; }
    }
}
__device__ __forceinline__ void ph_lrupost(const Ctx& C) {
    const TC T = phase_tc();
    bf16* YM = (bf16*)(C.ws + WS_YMIX); const bf16* YB = (const bf16*)(C.ws + WS_RAW); const bf16* GT = (const bf16*)(C.ws + WS_Z);
    const int gw = C.bid * NWAVES + T.wave, NGW = C.G * NWAVES, lane = T.lane;
    for (int r = gw; r < NROWS; r += NGW) {
        if (r % BROWS < CTXL) continue;
#pragma unroll
        for (int j = 0; j < 2; ++j) { const int c0 = j * 512 + lane * 8;
            const u32x4 wy = *(const u32x4*)(YM + (size_t)r * 2048 + c0), wb = *(const u32x4*)(YB + (size_t)r * 1024 + c0), wg = *(const u32x4*)(GT + (size_t)r * 1024 + c0);
            float fy[8], fb[8], fg[8], o[8]; unpack8(wy, fy); unpack8(wb, fb); unpack8(wg, fg);
#pragma unroll
            for (int e = 0; e < 8; ++e) o[e] = gelu_tanh_f(fg[e]) * (fy[e] + fb[e]);
            u32x4 w; w.x = pk2(o[0], o[1]); w.y = pk2(o[2], o[3]); w.z = pk2(o[4], o[5]); w.w = pk2(o[6], o[7]);
            *(u32x4*)(YM + (size_t)r * 2048 + c0) = w; }
    }
}
__device__ __forceinline__ void ph_route(const Ctx& C, int layer, LAS unsigned char* lds) {
    const TC T = phase_tc();
    LAS float* Wt = (LAS float*)lds;
    const float* wg = C.in[I_WGRP] + (size_t)layer * 1024 * 4; const float* wr = C.in[I_WRT] + (size_t)layer * 1024 * 16;
    for (int i = T.tid; i < 4096; i += NTHREADS) Wt[(i & 3) * 1028 + (i >> 2)] = wg[i];
    for (int i = T.tid; i < 16384; i += NTHREADS) Wt[(4 + (i & 15)) * 1028 + (i >> 4)] = wr[i];
    __syncthreads();
    bf16* HN2 = (bf16*)(C.ws + WS_A); int* REC = (int*)(C.ws + WS_REC); int* TBL = (int*)(C.ws + WS_TBL);
    unsigned* cnt = C.ctl() + CW_CNT + layer * 2048;
    const float* gf = C.in[I_GFFN] + layer * 1024;
    const int gw = C.bid * NWAVES + T.wave, NGW = C.G * NWAVES, lane = T.lane;
    for (int r = gw; r < NROWS; r += NGW) {
        if (layer == 1 && (r % BROWS) < CTXL) continue;
        float* xr = C.xrow(r); const float* md = C.mod(layer, row_mv(r));
        f32x4 v[4]; float ss = 0.f;
        if (layer == 0 && (r % BROWS) < CTXL) { const int b_ = r / BROWS, q_ = r - b_ * BROWS; const float* xi = C.in[I_CTX] + (size_t)(b_ * CTXL + q_) * DM; const float* sl = (const float*)(C.ws + WS_RAW);
#pragma unroll
            for (int j = 0; j < 4; ++j) { const float* sp = sl + (size_t)((b_ * 4 + j) * 4) * 65536 + (size_t)q_ * 256 + 4 * lane;
                const f32x4 part = (*(const f32x4*)sp + *(const f32x4*)(sp + 65536)) + (*(const f32x4*)(sp + 2 * 65536) + *(const f32x4*)(sp + 3 * 65536));
                const f32x4 x1 = *(const f32x4*)(xi + 256 * j + 4 * lane) + *(const f32x4*)(md + 2 * 1024 + 256 * j + 4 * lane) * part;
                *(f32x4*)(xr + 256 * j + 4 * lane) = x1; } }
#pragma unroll
        for (int j = 0; j < 4; ++j) { v[j] = *(const f32x4*)(xr + 256 * j + 4 * lane); ss += (v[j].x * v[j].x + v[j].y * v[j].y) + (v[j].z * v[j].z + v[j].w * v[j].w); }
        const float rs = rsqrtf(wave_sum(ss) * (1.f / DM) + EPS);
#pragma unroll
        for (int j = 0; j < 4; ++j) { const int c = 256 * j + 4 * lane; const f32x4 g = *(const f32x4*)(gf + c), sc = *(const f32x4*)(md + 4 * 1024 + c), sh = *(const f32x4*)(md + 3 * 1024 + c);
            v[j] = v[j] * rs * g * (sc + 1.f) + sh;
            u32x2 w; w.x = pk2(v[j].x, v[j].y); w.y = pk2(v[j].z, v[j].w); *(u32x2*)(HN2 + (size_t)r * DM + c) = w; }
        float lg[20];
#pragma unroll
        for (int o = 0; o < 20; ++o) { float s = 0.f;
#pragma unroll
            for (int j = 0; j < 4; ++j) { const f32x4 w = *(const LAS f32x4*)(Wt + o * 1028 + 256 * j + 4 * lane); s += (v[j].x * w.x + v[j].y * w.y) + (v[j].z * w.z + v[j].w * w.w); }
            lg[o] = wave_sum(s); }
        float gl[4];
#pragma unroll
        for (int k = 0; k < 4; ++k) gl[k] = lg[k] + C.in[I_BGRP][layer * 4 + k];
        int gi = 0; float gmx = gl[0];
#pragma unroll
        for (int k = 1; k < 4; ++k) if (gl[k] > gmx) { gmx = gl[k]; gi = k; }
        float den = 0.f;
#pragma unroll
        for (int k = 0; k < 4; ++k) den += __expf(gl[k] - gmx);
        const float pgrp = 1.f / den;
        float el[4];
#pragma unroll
        for (int k = 0; k < 4; ++k) { const float e0 = lg[4 + k] + C.in[I_BRT][layer * 16 + k], e1 = lg[8 + k] + C.in[I_BRT][layer * 16 + 4 + k], e2 = lg[12 + k] + C.in[I_BRT][layer * 16 + 8 + k], e3 = lg[16 + k] + C.in[I_BRT][layer * 16 + 12 + k];
            el[k] = gi == 0 ? e0 : (gi == 1 ? e1 : (gi == 2 ? e2 : e3)); }
        int i1 = 0; float v1 = el[0];
#pragma unroll
        for (int k = 1; k < 4; ++k) if (el[k] > v1) { v1 = el[k]; i1 = k; }
        int i2 = -1; float v2 = -3.4e38f;
#pragma unroll
        for (int k = 0; k < 4; ++k) if (k != i1 && el[k] > v2) { v2 = el[k]; i2 = k; }
        const float w1 = pgrp / (1.f + __expf(v2 - v1)), w2 = pgrp - w1;
        const int ia = i1 < i2 ? i1 : i2, ib = i1 < i2 ? i2 : i1; const float wa = i1 < i2 ? w1 : w2, wb = i1 < i2 ? w2 : w1;
        const int cls = gi * 6 + (ia * (7 - ia)) / 2 + (ib - ia - 1);
        if (lane == 0) { const int pos = (int)atomicAdd(cnt + cls * 64, 1u); TBL[(size_t)cls * NROWS + pos] = r; REC[(size_t)r * 4 + 0] = cls; REC[(size_t)r * 4 + 1] = pos; REC[(size_t)r * 4 + 2] = (int)__float_as_uint(wa); REC[(size_t)r * 4 + 3] = (int)__float_as_uint(wb); }
    }
}
__device__ __forceinline__ void moe_tables(const Ctx& C, int layer, int* mt) {
    unsigned* cnt = C.ctl() + CW_CNT + layer * 2048;
    const TC T = phase_tc();
    { const int t_ = T.tid; if (t_ < 24) mt[32 + t_] = (int)__hip_atomic_load(cnt + t_ * 64, __ATOMIC_RELAXED, __HIP_MEMORY_SCOPE_AGENT); }
    asm volatile("s_waitcnt vmcnt(0)" ::: "memory");
    __syncthreads();
    if (T.tid == 0) { int acc = 0; for (int c = 0; c < 24; ++c) { const int n = mt[32 + c]; mt[c] = acc; const int nt = (n + 255) >> 8; for (int t = 0; t < nt; ++t) mt[64 + acc + t] = c; acc += nt; } mt[24] = acc; }
    asm volatile("s_waitcnt vmcnt(0)" ::: "memory");
    __syncthreads();
}
__device__ __forceinline__ void ph_final(const Ctx& C) {
    const TC T = phase_tc();
    const float* gf = C.in[I_GFINAL];
    const int gw = C.bid * NWAVES + T.wave, NGW = C.G * NWAVES, lane = T.lane;
    for (int r = gw; r < NBATCH * SEQL; r += NGW) {
        float* xr = C.out + (size_t)r * DM;
        f32x4 v[4]; float ss = 0.f;
#pragma unroll
        for (int j = 0; j < 4; ++j) { v[j] = *(const f32x4*)(xr + 256 * j + 4 * lane); ss += (v[j].x * v[j].x + v[j].y * v[j].y) + (v[j].z * v[j].z + v[j].w * v[j].w); }
        const float rs = rsqrtf(wave_sum(ss) * (1.f / DM) + EPS);
#pragma unroll
        for (int j = 0; j < 4; ++j) { const int c = 256 * j + 4 * lane; f32x4 o = v[j] * rs * *(const f32x4*)(gf + c);
#ifdef PROBE_A
            { const unsigned long long* st = (const unsigned long long*)(C.ws + WS_STAMP);
              const float ta = (float)(st[PROBE_A + 1] - st[PROBE_A]) * 0.01f, tb = (float)(st[PROBE_B + 1] - st[PROBE_B]) * 0.01f;
              int na = 0, nb = 0; float th = 15.f;
              for (int i = 0; i < 31; ++i) { na += ta > th; nb += tb > th; th *= 1.2f; }
              o = o * (1.f + 0.02f * (float)na);
              if (r == 0 && c == 0) o.x += 10.f + (float)nb; }
#endif
            *(f32x4*)(xr + c) = o; }
    }
}


#define XB_TMO      128
#define XB_XCNT(j)  (256  + 64 * (j))
#define XB_XSUB(j)  (1280 + 64 * (j))
#define XB_XGEN(j)  (2304 + 64 * (j))
#define XB_TOP      3328
#define XB_TOPGEN   3392
#define XCD_BAR_WORDS 3456
#define XB_SPIN_CAP (1u << 18)
__device__ __forceinline__ unsigned xb_ld(unsigned* p)              { return __hip_atomic_load(p, __ATOMIC_RELAXED, __HIP_MEMORY_SCOPE_AGENT); }
__device__ __forceinline__ unsigned xb_add(unsigned* p, unsigned v) { return __hip_atomic_fetch_add(p, v, __ATOMIC_RELAXED, __HIP_MEMORY_SCOPE_AGENT); }
__device__ __forceinline__ unsigned xb_xcc_id() { return (unsigned)__builtin_amdgcn_s_getreg((3 << 11) | 20) & 0xFu; }
#define XB_SPIN(cond, bar) do { unsigned _sp = 0; while (cond) { __builtin_amdgcn_s_sleep(1); \
    if ((++_sp & 255u) == 0u) { if (xb_ld(&(bar)[XB_TMO])) break; if (_sp > XB_SPIN_CAP) { atomicAdd(&(bar)[XB_TMO], 1u); break; } } } } while (0)
struct XcdBarrier { unsigned* bar; unsigned x; volatile LAS unsigned* st; };
__device__ __forceinline__ XcdBarrier xcd_barrier_post(unsigned* bar, volatile LAS unsigned* st) {
    XcdBarrier b; b.bar = bar; b.x = xb_xcc_id(); b.st = st;
    if (threadIdx.x == 0) (void)xb_add(&bar[XB_XCNT(b.x)], 1u);
    return b;
}
__device__ __forceinline__ void xcd_barrier_complete(unsigned* bar, unsigned x, unsigned& nloc, unsigned& nx) {
    const unsigned G = gridDim.x * gridDim.y * gridDim.z;
    unsigned sum, cnt, mine, sp = 0u;
    for (;;) {
        sum = 0u; cnt = 0u; mine = 0u;
#pragma unroll
        for (unsigned j = 0; j < 16; ++j) { const unsigned c = xb_ld(&bar[XB_XCNT(j)]); sum += c; cnt += (c > 0u) ? 1u : 0u; mine = (j == x) ? c : mine; }
        if (sum == G) break;
        __builtin_amdgcn_s_sleep(1);
        if ((++sp & 255u) == 0u) { if (xb_ld(&bar[XB_TMO])) break; if (sp > XB_SPIN_CAP) { atomicAdd(&bar[XB_TMO], 1u); break; } }
    }
    nloc = mine > 0u ? mine : 1u; nx = cnt > 0u ? cnt : 1u;
}
__device__ __forceinline__ void xcd_barrier(const XcdBarrier& b) {
    asm volatile("s_waitcnt vmcnt(0)" ::: "memory");
    __syncthreads();
    if (threadIdx.x == 0) {
        unsigned* bar = b.bar;
        __builtin_amdgcn_s_waitcnt(0);
        unsigned nloc = b.st[0], nx = b.st[1];
        if (nloc == 0u) { xcd_barrier_complete(bar, b.x, nloc, nx); b.st[0] = nloc; b.st[1] = nx; }
        const unsigned old = xb_add(&bar[XB_XSUB(b.x)], 1u);
        const unsigned gen = old / nloc;
        if (old + 1u == (gen + 1u) * nloc) {
            __builtin_amdgcn_fence(__ATOMIC_RELEASE, "agent");
            asm volatile("s_waitcnt vmcnt(0)" ::: "memory");
            const unsigned og = xb_add(&bar[XB_TOP], 1u);
            const unsigned tg = og / nx;
            if (og + 1u == (tg + 1u) * nx) xb_add(&bar[XB_TOPGEN], 1u);
            else XB_SPIN(xb_ld(&bar[XB_TOPGEN]) == tg, bar);
            __builtin_amdgcn_fence(__ATOMIC_ACQUIRE, "agent");
            xb_add(&bar[XB_XGEN(b.x)], 1u);
            asm volatile("s_waitcnt vmcnt(0)" ::: "memory");
        } else {
            XB_SPIN(xb_ld(&bar[XB_XGEN(b.x)]) == gen, bar);
            __builtin_amdgcn_fence(__ATOMIC_ACQUIRE, "agent");
            asm volatile("s_waitcnt vmcnt(0)" ::: "memory");
        }
    }
    __syncthreads();
}

__global__ void __launch_bounds__(NTHREADS, 2) fwd_kernel(Args args) {
    extern __shared__ __attribute__((aligned(16))) unsigned char lds_raw[];
    LAS unsigned char* lds = (LAS unsigned char*)lds_raw;
    Ctx C; C.in = args.in; C.out = args.out; C.ws = args.ws;
    C.bid = blockIdx.x; C.G = gridDim.x;
    const int lo = args.ph_lo, hi = args.ph_hi;
    int ph = 0;
    volatile LAS unsigned* bst = (volatile LAS unsigned*)(lds + LDS_BYTES - 32);
    if (threadIdx.x < 2) bst[threadIdx.x] = 0u;
    __syncthreads();
    XcdBarrier bar; bar.bar = (unsigned*)(C.ws + WS_CTL) + CW_BAR; bar.x = 0; bar.st = bst;
    if (hi - lo > 1) bar = xcd_barrier_post((unsigned*)(C.ws + WS_CTL) + CW_BAR, bst);
    if (lo < 0) cg::this_grid().sync();
#ifdef PROBE_A
    if (blockIdx.x == 0 && threadIdx.x == 0) ((unsigned long long*)(C.ws + WS_STAMP))[0] = __builtin_amdgcn_s_memrealtime();
#endif
#define IN(k) (lo <= (k) && (k) < hi)
#ifdef PROBE_A
#define STAMP(k) do { if (blockIdx.x == 0 && threadIdx.x == 0) ((unsigned long long*)(C.ws + WS_STAMP))[(k) + 1] = __builtin_amdgcn_s_memrealtime(); } while (0)
#else
#define STAMP(k) do { } while (0)
#endif
#ifdef PROBE_A
#define SEAM(k) do { if (IN(k) && IN((k) + 1)) { cg::this_grid().sync(); STAMP(k); } } while (0)
#else
#define SEAM(k) do { if (IN(k) && IN((k) + 1)) { xcd_barrier(bar); } } while (0)
#endif
    if (EN(0) && IN(0)) { ph_mod(C, lds); ph_convert(C, 0, lds); mod_wait(C); ph_prenorm(C, 0); }
    SEAM(0);
#pragma unroll 1
    for (int layer = 0; layer < 2; ++layer) {
        const int pb = 1 + 10 * layer;
        unsigned char* ws = C.ws;
        if (EN(1) && IN(pb + 0) && layer == 1) { ph_convert(C, 1, lds, C.G >= 224 ? 2 : 0); ph_prenorm(C, layer); }
        if (layer == 1) SEAM(pb + 0);
        if (EN(2) && IN(pb + 1)) {
            const int nN = layer == 0 ? 15 : 14;
            pg8::Gemm g{1024, 1024, 1024, 1 << 30};
            RowSched S; S.nM = 66; S.nN = nN; S.nwg = 66 * nN; S.G = C.G; S.c = C.bid; S.skipctx = 0; S.A = (const char*)(ws + WS_A); S.Bt = (const char*)(ws + WS_WIN); S.a_tile = (size_t)256 * 1024 * 2; S.b_tile = (size_t)256 * 1024 * 2;
            EpiProj E;
            if (layer == 0) { E.d0 = (bf16*)(ws + WS_Z); E.l0 = 1024; E.e0 = 4; E.d1 = (bf16*)(ws + WS_RAW); E.l1 = 1280; E.e1 = 9; E.d2 = (bf16*)(ws + WS_YMIX) + 1024; E.l2 = 2048; E.e2 = 13;
                E.d3 = (bf16*)(ws + WS_K); E.l3 = 256; E.e3 = 14; E.d4 = (bf16*)(ws + WS_V); E.l4 = 256; E.e4 = 15; E.d5 = (bf16*)(ws + WS_DTR); E.l5 = 32; E.lastcols = 32; }
            else { E.d0 = (bf16*)(ws + WS_Z); E.l0 = 1024; E.e0 = 4; E.d1 = (bf16*)(ws + WS_RAW); E.l1 = 1024; E.e1 = 8; E.d2 = (bf16*)(ws + WS_YMIX) + 1024; E.l2 = 2048; E.e2 = 12;
                E.d3 = (bf16*)(ws + WS_K); E.l3 = 256; E.e3 = 13; E.d4 = (bf16*)(ws + WS_V); E.l4 = 256; E.e4 = 14; E.d5 = (bf16*)(ws + WS_DTR); E.l5 = 32; E.lastcols = 32; }
            pg8::gemm_phase<EpiProj, RowSched>(lds, g, S, E);
        }
        SEAM(pb + 1);
        if (EN(3) && IN(pb + 2)) { if (layer == 0) ph_elem0(C); else ph_elem1(C); }
        SEAM(pb + 2);
        if (IN(pb + 3)) { if (layer == 0) { ph_ssdpre(C, lds);
#ifdef SPLIT_MIX0
            xcd_barrier(bar); for (int u = C.bid; u < 256; u += C.G) ssd_chunk_unit<1>(C, u >> 2, u & 3, lds);
#endif
        } }
        if (layer == 0) SEAM(pb + 3);
        if (IN(pb + 4)) { if (layer == 0) { if (EN(4)) ph_mix0(C, lds, (char*)lds_raw); } else { if (EN(5)) ph_mix1(C, lds, (char*)lds_raw); } }
        SEAM(pb + 4);
        if (EN(6) && IN(pb + 5)) { if (layer == 0) ph_ssdpost(C); else ph_lrupost(C); }
        SEAM(pb + 5);
        if (EN(7) && IN(pb + 6)) {
            for (int pass = 0; pass < (layer == 0 ? 2 : 1); ++pass) {
                pg8::Gemm g{2048, 2048, pass == 0 ? 2048 : 512, 1 << 30};
                RowSched S; S.nM = 64; S.nN = 4; S.nwg = pass == 0 ? 256 : 32; S.G = C.G; S.c = C.bid; S.skipctx = pass == 0 ? 1 : 2; S.A = (const char*)(ws + WS_YMIX); S.Bt = (const char*)(ws + WS_WOUT); S.a_tile = (size_t)256 * 2048 * 2; S.b_tile = (size_t)256 * 2048 * 2;
                EpiRes E; E.slab = pass == 0 ? nullptr : (float*)(ws + WS_RAW); E.xin_lat = layer == 0 ? C.in[I_X] : C.out; E.xin_ctx = layer == 0 ? C.in[I_CTX] : C.xc(); E.xout_lat = C.out; E.xout_ctx = C.xc(); E.modbase = C.mod(layer, 0);
                pg8::gemm_phase<EpiRes, RowSched>(lds, g, S, E);
            }
        }
        SEAM(pb + 6);
        if (EN(8) && IN(pb + 7)) ph_route(C, layer, lds);
        SEAM(pb + 7);
        if (EN(10) && IN(pb + 8)) {
            int* mt = (int*)(ws + WS_MTG) + (size_t)(layer * 256 + C.bid) * 256;
            moe_tables(C, layer, mt);
            { pg8::Gemm g{1024, 1024, 1024, 1 << 30};
              MoeSched1 S; S.mt = mt; S.G = C.G; S.c = C.bid; S.layer = layer; S.ws = ws;
              EpiMoe1 E; E.ws = ws;
              pg8::gemm_phase<EpiMoe1, MoeSched1, true>(lds, g, S, E, (const int*)(ws + WS_TBL)); }
            { pg8::Gemm g{512, 256, 512, 4};
              const int nun = mt[24] * 4, extra = nun > C.G ? nun - C.G : 0;
              MoeSched2 S; S.mt = mt; S.G = C.G; S.c = (C.bid - extra % C.G + C.G) % C.G; S.layer = layer; S.ws = ws;
              EpiMoe2 E; E.out = C.out; E.ws = ws; E.layer = layer;
              pg8::gemm_phase<EpiMoe2, MoeSched2, false>(lds, g, S, E); }
            if (layer == 0 && C.G >= 224) { __syncthreads(); ph_convert(C, 1, lds, 1, 112); }
        }
        SEAM(pb + 8);
    }
#ifdef PROBE_A
    cg::this_grid().sync();
#endif
    if (EN(12) && IN(21)) ph_final(C);

    (void)ph;
#undef IN
#undef SEAM
}

extern "C" void kernel_launch(void* const* d_in, const int* in_sizes, int n_in, void* d_out, int out_size, void* d_ws, size_t ws_size, hipStream_t stream) {
    static int grid = 0;
    if (grid == 0) {
        if (n_in != 36 || out_size != NBATCH * SEQL * DM || ws_size < WS_END) { fprintf(stderr, "kernel_launch: unexpected shapes (n_in %d, out %d, ws %zu)\n", n_in, out_size, ws_size); grid = -1; return; }
        int dev = 0, cus = 0, per_cu = 0;
        if (hipGetDevice(&dev) != hipSuccess || hipDeviceGetAttribute(&cus, hipDeviceAttributeMultiprocessorCount, dev) != hipSuccess) { grid = -1; return; }
        if (hipFuncSetAttribute((const void*)fwd_kernel, hipFuncAttributeMaxDynamicSharedMemorySize, LDS_BYTES) != hipSuccess) { fprintf(stderr, "kernel_launch: hipFuncSetAttribute failed\n"); grid = -1; return; }
        if (hipOccupancyMaxActiveBlocksPerMultiprocessor(&per_cu, (const void*)fwd_kernel, NTHREADS, LDS_BYTES) != hipSuccess || per_cu < 1) { fprintf(stderr, "kernel_launch: occupancy query failed (%d)\n", per_cu); (void)hipGetLastError(); per_cu = 1; }
        grid = cus * 1;
    }
    if (grid < 0) return;
    (void)hipMemsetAsync((char*)d_ws + WS_CTL, 0, CTL_ZERO_BYTES, stream);
    Args a{};
    for (int i = 0; i < 36; ++i) a.in[i] = (const float*)d_in[i];
    a.out = (float*)d_out; a.ws = (unsigned char*)d_ws;
#if MK_PER_PHASE
    for (int p = 0; p < N_PHASES; ++p) { a.ph_lo = p; a.ph_hi = p + 1; hipLaunchKernelGGL(fwd_kernel, dim3(grid), dim3(NTHREADS), LDS_BYTES, stream, a); }
#else
    void* kargs[] = {&a};
#ifdef REPEAT_K
    a.ph_lo = 0; a.ph_hi = REPEAT_K + 1;
    (void)hipLaunchCooperativeKernel((const void*)fwd_kernel, dim3(grid), dim3(NTHREADS), kargs, LDS_BYTES, stream);
    (void)hipMemsetAsync((char*)d_ws + WS_CTL, 0, CTL_ZERO_BYTES, stream);
#endif
    a.ph_lo = 0; a.ph_hi = N_PHASES;
    hipError_t e = hipLaunchCooperativeKernel((const void*)fwd_kernel, dim3(grid), dim3(NTHREADS), kargs, LDS_BYTES, stream);
    if (e != hipSuccess) fprintf(stderr, "kernel_launch: cooperative launch failed: %s (grid %d)\n", hipGetErrorString(e), grid);
#endif
}
```

```cpp
#include <hip/hip_runtime.h>
#include <hip/hip_cooperative_groups.h>
#include <cstdio>
#include <cstdint>
namespace cg = cooperative_groups;

#ifndef MK_PER_PHASE
#define MK_PER_PHASE 0
#endif

#ifndef EN_MASK
#define EN_MASK 0xFFFF
#endif
#define EN(k) (((EN_MASK) >> (k)) & 1)
#define LAS __attribute__((address_space(3)))
typedef unsigned short bf16;
typedef short bf16x8 __attribute__((ext_vector_type(8)));
typedef short s16x4 __attribute__((ext_vector_type(4)));
typedef float f32x4 __attribute__((ext_vector_type(4)));
typedef float f32x2 __attribute__((ext_vector_type(2)));
typedef float f32x16 __attribute__((ext_vector_type(16)));
typedef unsigned u32x4 __attribute__((ext_vector_type(4)));
typedef unsigned u32x2 __attribute__((ext_vector_type(2)));

constexpr int DM = 1024, NBATCH = 2, SEQL = 8192, CTXL = 256;
constexpr int BROWS = CTXL + SEQL;
constexpr int NROWS = NBATCH * BROWS;
constexpr float EPS = 1e-6f;
constexpr int NWAVES = 8, NTHREADS = 512;
constexpr int LDS_BYTES = 147456;
constexpr int N_PHASES = 22;

constexpr size_t MiB = 1u << 20;
constexpr size_t WS_CTL = 0, CTL_ZERO_BYTES = 128 * 1024;
constexpr size_t WS_MOD = 1 * MiB;
constexpr size_t WS_REC = 1 * MiB + 256 * 1024;
constexpr size_t WS_TOK = 2 * MiB;
constexpr size_t WS_GAB = 2 * MiB + 128 * 1024;
constexpr size_t WS_MT  = 2 * MiB + 512 * 1024;
constexpr size_t WS_STAMP = 2 * MiB + 768 * 1024;
constexpr size_t WS_XC  = 3 * MiB;
constexpr size_t WS_W   = 5 * MiB;
constexpr size_t WS_WIN = WS_W, WS_WOUT = WS_W + 8 * MiB, WS_W13 = WS_W + 12 * MiB, WS_W2 = WS_W + 28 * MiB;
constexpr size_t WS_A   = 41 * MiB;
constexpr size_t WS_Z   = 83 * MiB;
constexpr size_t WS_RAW = 116 * MiB;
constexpr size_t WS_DTR = 158 * MiB;
constexpr size_t WS_DT  = 160 * MiB;
constexpr size_t WS_K   = 163 * MiB;
constexpr size_t WS_V   = 172 * MiB;
constexpr size_t WS_YMIX = 181 * MiB;
constexpr size_t WS_SSDST = 247 * MiB;
constexpr size_t WS_SSDLD = WS_SSDST + 64 * 3 * 16384;
constexpr size_t WS_TBL = 251 * MiB;
constexpr size_t WS_MTG = 253 * MiB;
constexpr size_t WS_END = 254 * MiB;
constexpr int MAXTILES = 90, MAXSLOT = MAXTILES * 256;
constexpr int CW_MODDONE = 192;
constexpr int CW_Q0 = 64, CW_Q1 = 128, CW_CNT = 256, CW_BAR = 4096, CW_TDONE = 8192;

__device__ __forceinline__ float bf2f(unsigned short b) { return __uint_as_float(((unsigned)b) << 16); }
__device__ __forceinline__ unsigned f2bf(float f) { unsigned u = __float_as_uint(f); return (u + 0x7fffu + ((u >> 16) & 1u)) >> 16; }
__device__ __forceinline__ unsigned pk2(float lo, float hi) { return f2bf(lo) | (f2bf(hi) << 16); }
__device__ __forceinline__ float dpp_add(float v, float src, const int ctrl_unused) { return v + src; }
#define DPP_F(v, ctrl, rmask) __builtin_bit_cast(float, __builtin_amdgcn_update_dpp(0, __builtin_bit_cast(int, v), ctrl, rmask, 0xf, false))
__device__ __forceinline__ float wave_sum(float v) {
    v += DPP_F(v, 0xB1, 0xf);
    v += DPP_F(v, 0x4E, 0xf);
    v += DPP_F(v, 0x141, 0xf);
    v += DPP_F(v, 0x140, 0xf);
    v += DPP_F(v, 0x142, 0xa);
    v += DPP_F(v, 0x143, 0xc);
    return __builtin_bit_cast(float, __builtin_amdgcn_readlane(__builtin_bit_cast(int, v), 63));
}
#define DPP_FB(v, ctrl, rmask, bmask) __builtin_bit_cast(float, __builtin_amdgcn_update_dpp(0, __builtin_bit_cast(int, v), ctrl, rmask, bmask, false))
__device__ __forceinline__ float wave_scan_incl(float v) {
    float s = v + DPP_FB(v, 0x111, 0xf, 0xf);
    s += DPP_FB(v, 0x112, 0xf, 0xf);
    s += DPP_FB(v, 0x113, 0xf, 0xf);
    s += DPP_FB(s, 0x114, 0xf, 0xe);
    s += DPP_FB(s, 0x118, 0xf, 0xc);
    s += DPP_FB(s, 0x142, 0xa, 0xf);
    s += DPP_FB(s, 0x143, 0xc, 0xf);
    return s;
}
__device__ __forceinline__ float silu_f(float x) { return x / (1.f + __expf(-x)); }
__device__ __forceinline__ float sigmoid_f(float x) { return 1.f / (1.f + __expf(-x)); }
__device__ __forceinline__ float softplus_f(float x) { return fmaxf(x, 0.f) + log1pf(__expf(-fabsf(x))); }
__device__ __forceinline__ float gelu_tanh_f(float x) { const float u = 0.7978845608028654f * (x + 0.044715f * x * x * x); return 0.5f * x * (1.f + tanhf(u)); }
__device__ __forceinline__ void unpack8(const u32x4 w, float* f) {
    f[0] = __uint_as_float(w.x << 16); f[1] = __uint_as_float(w.x & 0xffff0000u);
    f[2] = __uint_as_float(w.y << 16); f[3] = __uint_as_float(w.y & 0xffff0000u);
    f[4] = __uint_as_float(w.z << 16); f[5] = __uint_as_float(w.z & 0xffff0000u);
    f[6] = __uint_as_float(w.w << 16); f[7] = __uint_as_float(w.w & 0xffff0000u);
}

namespace pg8 {
constexpr int BM = 256, BK = 64, HALF = 128, HTB = HALF * BK * 2, STAGE_BYTES = 8 * HTB, NXCD = 8, WGM = 8;
__host__ __device__ __forceinline__ int lds_byte(int r, int c) { const int st = (r >> 4) * 2 + (c >> 5), rr = r & 15, cc = c & 31, ob = rr * 64 + cc * 2; return st * 1024 + (ob ^ (((ob >> 9) & 1) << 5)); }
__host__ __device__ __forceinline__ void stage_rc(int b, int& R, int& C) { const int st = b / 1024, sb = b % 1024, swz = sb ^ (((sb >> 9) & 1) << 5); R = (st >> 1) * 16 + swz / 64; C = (st & 1) * 32 + (swz % 64) / 2; }
__host__ __device__ __forceinline__ int perm32(int rho) { const int n = rho >> 4, i = rho & 15; return 8 * (i >> 2) + 4 * n + (i & 3); }

struct Unit { int pm, pn; const char* a; const char* b; long bd; int tbo; int nrow; };
struct Gemm { int lda, ldb, K, ksplit; };

__device__ __forceinline__ unsigned cvt_pk_bf16(float lo, float hi) { unsigned r; asm volatile("v_cvt_pk_bf16_f32 %0, %1, %2" : "=v"(r) : "v"(lo), "v"(hi)); return r; }

template <class Epi, class Sched, bool GATHER = false>
__device__ __forceinline__ void gemm_phase(LAS unsigned char* lds, const Gemm g, const Sched& S, const Epi& E, const int* gtbl = nullptr) {
    int tid_ = threadIdx.x; asm volatile("" : "+v"(tid_));
    const int tid = tid_, wid = __builtin_amdgcn_readfirstlane(tid >> 6), lane = tid & 63, wr = wid >> 2, wc = wid & 3, fr = lane & 15, fq = lane >> 4;
    const int nt = g.K / BK;
    unsigned voffA[2][2], nvoffA[2][2], voffB[2];
#pragma unroll
    for (int i = 0; i < 2; ++i) { int R, C; stage_rc(tid * 16 + i * 8192, R, C); const int Rb = Epi::PERM ? ((R & ~31) + perm32(R & 31)) : R;
        voffA[0][i] = (unsigned)(R * g.lda + C) * 2u; voffA[1][i] = (unsigned)((R + HALF) * g.lda + C) * 2u; nvoffA[0][i] = voffA[0][i]; nvoffA[1][i] = voffA[1][i];
        voffB[i] = (unsigned)(Rb * g.ldb + C) * 2u; }
#define PG8_GATHER_OFF(dst, uu) do { if constexpr (GATHER) { int _t = tid; asm volatile("" : "+v"(_t)); _Pragma("unroll") for (int _i = 0; _i < 2; ++_i) { int _R, _C; stage_rc(_t * 16 + _i * 8192, _R, _C); \
        _Pragma("unroll") for (int _h = 0; _h < 2; ++_h) { int _rho = _h * HALF + _R; _rho = _rho < (uu).nrow ? _rho : (uu).nrow - 1; dst[_h][_i] = (unsigned)gtbl[(uu).tbo + _rho] * (unsigned)(g.lda * 2) + (unsigned)_C * 2u; } } } } while (0)
    const size_t kstep = (size_t)(BK * 2);
    const size_t hstepA = (size_t)HALF * g.lda * 2, hstepB = (size_t)HALF * g.ldb * 2;
    const unsigned ldsw = (unsigned)wid * 1024u;
    const int aoff = lds_byte(wr * 64 + fr, fq * 8), boff = lds_byte(wc * 32 + fr, fq * 8);
#define PG8_SA(b, h) (((b) * 2 + (h)) * HTB)
#define PG8_SB(b, h) ((4 + (b) * 2 + (h)) * HTB)
#define PG8_STAGE(bufoff, gbase, voff) do { _Pragma("unroll") for (int _i = 0; _i < 2; ++_i) \
        __builtin_amdgcn_global_load_lds((const unsigned*)((const char*)(gbase) + (voff)[_i]), (LAS unsigned*)(lds + (bufoff) + ldsw + _i * 8192), 16, 0, 0); } while (0)
#define PG8_STAGE_A(bufoff, gbase, hh, usenext) do { _Pragma("unroll") for (int _i = 0; _i < 2; ++_i) { \
        if constexpr (GATHER) { const unsigned _vo = (usenext) ? nvoffA[hh][_i] : voffA[hh][_i]; \
            __builtin_amdgcn_global_load_lds((const unsigned*)((const char*)(gbase) + _vo), (LAS unsigned*)(lds + (bufoff) + ldsw + _i * 8192), 16, 0, 0); } \
        else __builtin_amdgcn_global_load_lds((const unsigned*)((const char*)(gbase) + (hh) * hstepA + voffA[0][_i]), (LAS unsigned*)(lds + (bufoff) + ldsw + _i * 8192), 16, 0, 0); } } while (0)
#define PG8_LDA(dst, b, h) do { _Pragma("unroll") for (int m = 0; m < 4; ++m) _Pragma("unroll") for (int k = 0; k < 2; ++k) dst[m][k] = *(const LAS bf16x8*)(lds + PG8_SA(b, h) + aoff + m * 2048 + k * 1024); } while (0)
#define PG8_LDB(dst, b, h) do { _Pragma("unroll") for (int n = 0; n < 2; ++n) _Pragma("unroll") for (int k = 0; k < 2; ++k) dst[n][k] = *(const LAS bf16x8*)(lds + PG8_SB(b, h) + boff + n * 2048 + k * 1024); } while (0)
#define PG8_MMA(ai, bj, At, Bt) do { __builtin_amdgcn_s_setprio(1); _Pragma("unroll") for (int m = 0; m < 4; ++m) _Pragma("unroll") for (int n = 0; n < 2; ++n) _Pragma("unroll") for (int k = 0; k < 2; ++k) \
        acc[ai][bj][m][n] = __builtin_amdgcn_mfma_f32_16x16x32_bf16(Bt[n][k], At[m][k], acc[ai][bj][m][n], 0, 0, 0); __builtin_amdgcn_s_setprio(0); } while (0)
#define PG8_WAIT_V(n) asm volatile("s_waitcnt vmcnt(" #n ")" ::: "memory")
#define PG8_WAIT_L(n) asm volatile("s_waitcnt lgkmcnt(" #n ")" ::: "memory")
#define PG8_BAR __builtin_amdgcn_s_barrier()
#define PG8_SCHED __builtin_amdgcn_sched_barrier(0)
    Unit cur, nxt; int ui = 0;
    if (!S.next(0, cur)) return;
    f32x4 acc[2][2][4][2];
#pragma unroll
    for (int a = 0; a < 2; ++a)
#pragma unroll
        for (int b = 0; b < 2; ++b)
#pragma unroll
            for (int m = 0; m < 4; ++m)
#pragma unroll
                for (int n = 0; n < 2; ++n) acc[a][b][m][n] = (f32x4){0.f, 0.f, 0.f, 0.f};
    bf16x8 At[4][2], B0[2][2], B1[2][2];
    const char* cA = cur.a; const char* cB = cur.b; long cBd = cur.bd;
    S.a_ready(cur);
    PG8_GATHER_OFF(voffA, cur);
    PG8_STAGE(PG8_SB(0, 0), cB, voffB); PG8_STAGE_A(PG8_SA(0, 0), cA, 0, false); PG8_STAGE(PG8_SB(0, 1), cB + hstepB, voffB); PG8_STAGE_A(PG8_SA(0, 1), cA, 1, false);
    if (wr == 1) PG8_BAR;
    PG8_WAIT_V(4); PG8_BAR;
    PG8_STAGE(PG8_SB(1, 0), cB + kstep, voffB); PG8_STAGE_A(PG8_SA(1, 0), cA + kstep, 0, false); PG8_STAGE(PG8_SB(1, 1), cB + hstepB + kstep, voffB);
    PG8_WAIT_V(6); PG8_BAR;
    for (;;) {
        const bool has_next = S.next(ui + 1, nxt);
        const char* nA = has_next ? nxt.a : cA; const char* nB = has_next ? nxt.b : cB;
        if constexpr (GATHER) { if (has_next) PG8_GATHER_OFF(nvoffA, nxt); else {
#pragma unroll
            for (int _h = 0; _h < 2; ++_h)
#pragma unroll
                for (int _i = 0; _i < 2; ++_i) nvoffA[_h][_i] = voffA[_h][_i]; } }
#pragma unroll 1
        for (int t = 0; t < nt; t += 2) {
            const bool last = (t == nt - 2);
            const char* a1 = cA + (size_t)(t + 1) * kstep;
            const char* a2 = last ? nA : cA + (size_t)(t + 2) * kstep;
            const char* b2 = last ? nB : cB + (size_t)(t + 2) * kstep + ((t + 2) >= g.ksplit ? cBd : 0);
            const char* a3 = a2 + kstep; const char* b3 = b2 + kstep;
            if (last && has_next) S.a_ready(nxt);
            PG8_LDB(B0, 0, 0); PG8_SCHED; PG8_LDA(At, 0, 0); PG8_STAGE_A(PG8_SA(1, 1), a1, 1, false);
            PG8_WAIT_L(8); PG8_BAR; PG8_WAIT_L(0); PG8_MMA(0, 0, At, B0); PG8_BAR; PG8_SCHED;
            PG8_LDB(B1, 0, 1); PG8_STAGE(PG8_SB(0, 0), b2, voffB);
            PG8_BAR; PG8_WAIT_L(0); PG8_MMA(0, 1, At, B1); PG8_BAR;
            PG8_LDA(At, 0, 1); PG8_STAGE_A(PG8_SA(0, 0), a2, 0, last);
            PG8_BAR; PG8_WAIT_L(0); PG8_MMA(1, 0, At, B0); PG8_BAR; PG8_SCHED;
            PG8_STAGE(PG8_SB(0, 1), b2 + hstepB, voffB);
            PG8_WAIT_V(6); PG8_BAR; PG8_MMA(1, 1, At, B1); PG8_BAR;
            PG8_LDB(B0, 1, 0); PG8_SCHED; PG8_LDA(At, 1, 0); PG8_STAGE_A(PG8_SA(0, 1), a2, 1, last);
            PG8_WAIT_L(8); PG8_BAR; PG8_WAIT_L(0); PG8_MMA(0, 0, At, B0); PG8_BAR; PG8_SCHED;
            PG8_LDB(B1, 1, 1); PG8_STAGE(PG8_SB(1, 0), b3, voffB);
            PG8_BAR; PG8_WAIT_L(0); PG8_MMA(0, 1, At, B1); PG8_BAR;
            PG8_LDA(At, 1, 1); PG8_STAGE_A(PG8_SA(1, 0), a3, 0, last);
            PG8_BAR; PG8_WAIT_L(0); PG8_MMA(1, 0, At, B0); PG8_BAR; PG8_SCHED;
            PG8_STAGE(PG8_SB(1, 1), b3 + hstepB, voffB);
            PG8_WAIT_V(6); PG8_BAR; PG8_MMA(1, 1, At, B1); PG8_BAR;
        }
        if (!(Epi::AFTER_DRAIN && !has_next)) { E(acc, cur, wr, wc, fr, fq); S.done(cur); }
        if (!has_next) break;
#pragma unroll
        for (int a = 0; a < 2; ++a)
#pragma unroll
            for (int b = 0; b < 2; ++b)
#pragma unroll
                for (int m = 0; m < 4; ++m)
#pragma unroll
                    for (int n = 0; n < 2; ++n) acc[a][b][m][n] = (f32x4){0.f, 0.f, 0.f, 0.f};
        cur = nxt; cA = nA; cB = nB; cBd = cur.bd; ++ui;
        if constexpr (GATHER) {
#pragma unroll
            for (int _h = 0; _h < 2; ++_h)
#pragma unroll
                for (int _i = 0; _i < 2; ++_i) voffA[_h][_i] = nvoffA[_h][_i]; }
    }
    PG8_WAIT_V(0);
    if (wr == 0) PG8_BAR;
    PG8_BAR;
    if constexpr (Epi::AFTER_DRAIN) { E.fused(acc, cur, wr, wc, fr, fq, lds, wid, lane); S.done(cur); }
#undef PG8_SA
#undef PG8_SB
#undef PG8_STAGE
#undef PG8_STAGE_A
#undef PG8_GATHER_OFF
#undef PG8_LDA
#undef PG8_LDB
#undef PG8_MMA
#undef PG8_WAIT_V
#undef PG8_WAIT_L
#undef PG8_BAR
#undef PG8_SCHED
}
}

namespace att {
constexpr int D = 128, NW = 8, QBLK = 32, KVBLK = 64;
constexpr float SCALE = 0.088388347648318440f;
constexpr float THR = 8.f;
constexpr int LDQ = 2048, LDK = 256, LDO = 2048;
constexpr size_t SHM_V = KVBLK * D * 2, SHM_K = KVBLK * D * 2, SHM_ATTN = 2 * SHM_V + 2 * SHM_K + NW * 64 * 4;
#define KSWZ(row, colB) ((row) * 256 + ((colB) ^ (((row) & 7) << 4)))
#define SBAR() __builtin_amdgcn_sched_barrier(0)
__device__ __forceinline__ int crow(int r, int hi) { return (r & 3) + 8 * (r >> 2) + 4 * hi; }
__device__ __forceinline__ unsigned cvtpk(float lo, float hi) { unsigned r; asm volatile("v_cvt_pk_bf16_f32 %0, %1, %2" : "=v"(r) : "v"(lo), "v"(hi)); return r; }

__device__ __forceinline__ void partialSM(f32x16& p0, f32x16& p1, float& m_reg, float& mn, float& alpha) {
  constexpr float C = SCALE * 1.4426950408889634f;
  float pmax = p0[0]; for (int r = 1; r < 16; ++r) pmax = fmaxf(pmax, p0[r]); for (int r = 0; r < 16; ++r) pmax = fmaxf(pmax, p1[r]);
  { auto rr = __builtin_amdgcn_permlane32_swap(__float_as_uint(pmax), __float_as_uint(pmax), false, false);
    pmax = fmaxf(__uint_as_float(rr[0]), __uint_as_float(rr[1])); }
  if (__builtin_expect(__all(pmax - m_reg <= THR / SCALE), 1)) { mn = m_reg; alpha = 1.f; }
  else { mn = fmaxf(m_reg, pmax); alpha = __builtin_amdgcn_exp2f((m_reg - mn) * C); m_reg = mn; }
  float mnC = -mn * C;
  for (int r = 0; r < 16; ++r) p0[r] = fmaf(p0[r], C, mnC); for (int r = 0; r < 16; ++r) p1[r] = fmaf(p1[r], C, mnC);
  for (int r = 0; r < 16; ++r) p0[r] = __builtin_amdgcn_exp2f(p0[r]);
}
__device__ __forceinline__ void finishSM(f32x16& p0, f32x16& p1, float alpha, float& l_reg, bf16x8& pa0, bf16x8& pa1, bf16x8& pa2, bf16x8& pa3) {
  for (int r = 0; r < 16; ++r) p1[r] = __builtin_amdgcn_exp2f(p1[r]);
  float ps = 0; for (int r = 0; r < 16; ++r) ps += p0[r]; for (int r = 0; r < 16; ++r) ps += p1[r];
  { auto rr = __builtin_amdgcn_permlane32_swap(__float_as_uint(ps), __float_as_uint(ps), false, false);
    ps = __uint_as_float(rr[0]) + __uint_as_float(rr[1]); }
  l_reg = l_reg * alpha + ps;
#define PK4(P, BASE, OUT) do { unsigned a0 = cvtpk(P[BASE + 0], P[BASE + 1]), a1 = cvtpk(P[BASE + 2], P[BASE + 3]);   \
    unsigned b0 = cvtpk(P[BASE + 4], P[BASE + 5]), b1 = cvtpk(P[BASE + 6], P[BASE + 7]);                              \
    auto r0 = __builtin_amdgcn_permlane32_swap(a0, b0, false, false); auto r1 = __builtin_amdgcn_permlane32_swap(a1, b1, false, false); \
    u32x4 w = {r0[0], r1[0], r0[1], r1[1]}; OUT = *reinterpret_cast<bf16x8*>(&w); } while (0)
  PK4(p0, 0, pa0); PK4(p0, 8, pa1); PK4(p1, 0, pa2); PK4(p1, 8, pa3);
#undef PK4
}
__device__ __forceinline__ void qkt(f32x16& p0, f32x16& p1, const bf16* Ks, const bf16x8* qr, int r32, int hi) {
  p0 = f32x16{}; p1 = f32x16{};
  for (int d0 = 0; d0 < 8; ++d0) { int cb = (d0 * 16 + hi * 8) * 2;
    bf16x8 b0 = *reinterpret_cast<const bf16x8*>((const char*)Ks + KSWZ(r32, cb));
    bf16x8 b1 = *reinterpret_cast<const bf16x8*>((const char*)Ks + KSWZ(32 + r32, cb));
    p0 = __builtin_amdgcn_mfma_f32_32x32x16_bf16(b0, qr[d0], p0, 0, 0, 0);
    p1 = __builtin_amdgcn_mfma_f32_32x32x16_bf16(b1, qr[d0], p1, 0, 0, 0); }
}
__device__ __forceinline__ int v_st(int k, int c) { const int kk = (k & ~0xC) | ((k & 4) << 1) | ((k & 8) >> 1); return ((kk >> 3) * 4 + (c >> 5)) * 512 + ((kk & 7) * 32 + (c & 31)) * 2; }
__device__ __forceinline__ int v_rd_base(int lane) { return ((lane & 3) << 3) | (((lane >> 2) & 3) << 6) | (((lane >> 4) & 1) << 5) | (((lane >> 5) & 1) << 8); }
constexpr int v_rd_off(int d0, int ks, int half) { return d0 * 512 + ks * 4096 + half * 2048; }
template <int OFF> __device__ __forceinline__ s16x4 tr_read(int vb) {
  s16x4 r; asm volatile("ds_read_b64_tr_b16 %0, %1 offset:%2" : "=&v"(r) : "v"(vb), "i"(OFF) : "memory"); return r;
}
template <int D0> __device__ __forceinline__ void pv_one(f32x16& od, int vb, bf16x8 pa0, bf16x8 pa1, bf16x8 pa2, bf16x8 pa3) {
  const s16x4 l0 = tr_read<v_rd_off(D0, 0, 0)>(vb), h0 = tr_read<v_rd_off(D0, 0, 1)>(vb), l1 = tr_read<v_rd_off(D0, 1, 0)>(vb), h1 = tr_read<v_rd_off(D0, 1, 1)>(vb);
  const s16x4 l2 = tr_read<v_rd_off(D0, 2, 0)>(vb), h2 = tr_read<v_rd_off(D0, 2, 1)>(vb), l3 = tr_read<v_rd_off(D0, 3, 0)>(vb), h3 = tr_read<v_rd_off(D0, 3, 1)>(vb);
  asm volatile("s_waitcnt lgkmcnt(0)" ::: "memory"); SBAR();
#define PK(L, H) (bf16x8){L[0], L[1], L[2], L[3], H[0], H[1], H[2], H[3]}
  od = __builtin_amdgcn_mfma_f32_32x32x16_bf16(pa0, PK(l0, h0), od, 0, 0, 0);
  od = __builtin_amdgcn_mfma_f32_32x32x16_bf16(pa1, PK(l1, h1), od, 0, 0, 0);
  od = __builtin_amdgcn_mfma_f32_32x32x16_bf16(pa2, PK(l2, h2), od, 0, 0, 0);
  od = __builtin_amdgcn_mfma_f32_32x32x16_bf16(pa3, PK(l3, h3), od, 0, 0, 0);
#undef PK
}
__device__ __forceinline__ void pv_d0(f32x16* o, int vb, bf16x8 pa0, bf16x8 pa1, bf16x8 pa2, bf16x8 pa3) {
  pv_one<0>(o[0], vb, pa0, pa1, pa2, pa3); pv_one<1>(o[1], vb, pa0, pa1, pa2, pa3); pv_one<2>(o[2], vb, pa0, pa1, pa2, pa3); pv_one<3>(o[3], vb, pa0, pa1, pa2, pa3);
}
__device__ __forceinline__ void band_mask(f32x16& p0, f32x16& p1, int dbase, int hi) {
#pragma unroll
  for (int r = 0; r < 16; ++r) { const int d = dbase + crow(r, hi);
    if (d < -128 || d > 128) p0[r] = -1e30f;
    if (d + 32 < -128 || d + 32 > 128) p1[r] = -1e30f; }
}
template <int MODE>
__device__ __forceinline__ void attn_body(const bf16* Qb, const bf16* Kh, const bf16* Vh, bf16* Ob, int NT, int kb0, int q0, float sink, char* lds, const float* qg, int tq0) {
  int tid_ = threadIdx.x; asm volatile("" : "+v"(tid_));
  const int tid = tid_, wid = tid >> 6, lane = tid & 63, r32 = lane & 31, hi = lane >> 5;
  bf16* V_lds = (bf16*)lds; bf16* K_lds = (bf16*)(lds + 3 * SHM_V);
  float* ws = (float*)(lds + 3 * SHM_V + 3 * SHM_K) + wid * 64; float* li_l = ws; float* al_l = ws + 32;
  bf16x8 qr[8];
  const bf16* Qw = Qb + (long)(wid * QBLK + r32) * LDQ + hi * 8;
  { u32x4 raw[8];
#pragma unroll
    for (int d0 = 0; d0 < 8; ++d0) raw[d0] = *reinterpret_cast<const u32x4*>(Qw + d0 * 16);
    float rs = 1.f;
    if (qg != nullptr) { float ssq = 0.f;
#pragma unroll
      for (int d0 = 0; d0 < 8; ++d0) { float f[8]; unpack8(raw[d0], f);
#pragma unroll
        for (int e = 0; e < 8; ++e) ssq += f[e] * f[e]; }
      { auto rr = __builtin_amdgcn_permlane32_swap(__float_as_uint(ssq), __float_as_uint(ssq), false, false); ssq = __uint_as_float(rr[0]) + __uint_as_float(rr[1]); }
      rs = rsqrtf(ssq * (1.f / 128.f) + 1e-6f); }
    const int t = tq0 + wid * QBLK + r32;
#pragma unroll
    for (int d0 = 0; d0 < 4; ++d0) { float fa[8], fb[8]; unpack8(raw[d0], fa); unpack8(raw[d0 + 4], fb);
      if (qg != nullptr) { const f32x4 ga0 = *reinterpret_cast<const f32x4*>(qg + 16 * d0 + 8 * hi), ga1 = *reinterpret_cast<const f32x4*>(qg + 16 * d0 + 8 * hi + 4);
        const f32x4 gb0 = *reinterpret_cast<const f32x4*>(qg + 64 + 16 * d0 + 8 * hi), gb1 = *reinterpret_cast<const f32x4*>(qg + 64 + 16 * d0 + 8 * hi + 4);
#pragma unroll
        for (int e = 0; e < 4; ++e) { fa[e] *= rs * ga0[e]; fa[4 + e] *= rs * ga1[e]; fb[e] *= rs * gb0[e]; fb[4 + e] *= rs * gb1[e]; } }
      if (tq0 >= 0) {
#pragma unroll
        for (int e = 0; e < 8; ++e) { const int j = 16 * d0 + 8 * hi + e; const int pos = j < 32 ? (t >> 6) : (t & 63);
          const float inv = exp2f(-(float)(j & 31) * (13.287712379549449f / 32.f)); float sn, cs; sincosf((float)pos * inv, &sn, &cs);
          const float a = fa[e], b2 = fb[e]; fa[e] = a * cs - b2 * sn; fb[e] = a * sn + b2 * cs; } }
      u32x4 wa, wb; wa.x = cvtpk(fa[0], fa[1]); wa.y = cvtpk(fa[2], fa[3]); wa.z = cvtpk(fa[4], fa[5]); wa.w = cvtpk(fa[6], fa[7]);
      wb.x = cvtpk(fb[0], fb[1]); wb.y = cvtpk(fb[2], fb[3]); wb.z = cvtpk(fb[4], fb[5]); wb.w = cvtpk(fb[6], fb[7]);
      qr[d0] = *reinterpret_cast<bf16x8*>(&wa); qr[d0 + 4] = *reinterpret_cast<bf16x8*>(&wb); } }
  float m_reg = -1e30f, l_reg = 0; f32x16 o[4] = {};
  const int sr = tid >> 4, sc = (tid & 15) * 8, vst0 = v_st(sr, sc), vst1 = v_st(32 + sr, sc);
  const int vb0 = (int)(uintptr_t)V_lds + v_rd_base(lane);
  struct { bf16x8 vs0, vs1, ks0, ks1; } sr_;
#define TK0(j) ((MODE == 0 || (j) < 4) ? (j) * KVBLK : kb0 + ((j) - 4) * KVBLK)
#define SLOAD(k0) do { sr_.vs0 = *reinterpret_cast<const bf16x8*>(&Vh[(long)((k0) + sr) * LDK + sc]); sr_.vs1 = *reinterpret_cast<const bf16x8*>(&Vh[(long)((k0) + 32 + sr) * LDK + sc]); \
    sr_.ks0 = *reinterpret_cast<const bf16x8*>(&Kh[(long)((k0) + sr) * LDK + sc]); sr_.ks1 = *reinterpret_cast<const bf16x8*>(&Kh[(long)((k0) + 32 + sr) * LDK + sc]); } while (0)
#define SWRITE(b) do { *(bf16x8*)((char*)V_lds + (b) * (int)SHM_V + vst0) = sr_.vs0;          \
    *(bf16x8*)((char*)V_lds + (b) * (int)SHM_V + vst1) = sr_.vs1; int kc = sc * 2;               \
    *(bf16x8*)((char*)K_lds + (b) * (int)SHM_K + KSWZ(sr, kc)) = sr_.ks0;                       \
    *(bf16x8*)((char*)K_lds + (b) * (int)SHM_K + KSWZ(32 + sr, kc)) = sr_.ks1; } while (0)
#define SWAIT() asm volatile("s_waitcnt vmcnt(0)" ::: "memory")
#define RESC(a) do { if (__any((a) < 1.f)) { if (hi == 0) al_l[r32] = (a); asm volatile("s_waitcnt lgkmcnt(0)" ::: "memory"); \
    for (int d = 0; d < 4; ++d) for (int r = 0; r < 16; ++r) o[d][r] *= al_l[crow(r, hi)]; } } while (0)
#define MASKT(P0, P1, j) do { if (MODE == 1 && (j) >= 4) { const int s0_ = kb0 - 256 + ((j) - 4) * KVBLK, tw_ = q0 + wid * QBLK; \
    if (!(s0_ - (tw_ + 31) >= -128 && (s0_ + 63) - tw_ <= 128)) band_mask(P0, P1, s0_ - tw_ - r32, hi); } } while (0)
  f32x16 pA0, pA1, pB0, pB1; float mnA, mnB, alA, alB; bf16x8 pa0, pa1, pa2, pa3;
  int bp = 0, bq = 1;
  SLOAD(TK0(0)); SWAIT(); SWRITE(0); __syncthreads();
  qkt(pA0, pA1, K_lds, qr, r32, hi); partialSM(pA0, pA1, m_reg, mnA, alA);
  SLOAD(TK0(1));
  SWAIT(); SWRITE(1); __syncthreads();
  for (int j = 1; j + 1 < NT; j += 2) {
    { const int bw = 3 - bp - bq;
      SBAR(); qkt(pB0, pB1, (bf16*)((char*)K_lds + bq * (int)SHM_K), qr, r32, hi);
      finishSM(pA0, pA1, alA, l_reg, pa0, pa1, pa2, pa3); SBAR();
      SLOAD(TK0(j + 1)); SBAR();
      pv_d0(o, vb0 + bp * (int)SHM_V, pa0, pa1, pa2, pa3); MASKT(pB0, pB1, j); partialSM(pB0, pB1, m_reg, mnB, alB);
      SWAIT(); SWRITE(bw);
      RESC(alB); __syncthreads();
      bp = bq; bq = bw; }
    { const int bw = 3 - bp - bq;
      SBAR(); qkt(pA0, pA1, (bf16*)((char*)K_lds + bq * (int)SHM_K), qr, r32, hi);
      finishSM(pB0, pB1, alB, l_reg, pa0, pa1, pa2, pa3); SBAR();
      SLOAD(TK0(j + 2)); SBAR();
      pv_d0(o, vb0 + bp * (int)SHM_V, pa0, pa1, pa2, pa3); MASKT(pA0, pA1, j + 1); partialSM(pA0, pA1, m_reg, mnA, alA);
      SWAIT(); SWRITE(bw);
      RESC(alA); __syncthreads();
      bp = bq; bq = bw; }
  }
  SBAR(); qkt(pB0, pB1, (bf16*)((char*)K_lds + bq * (int)SHM_K), qr, r32, hi);
  finishSM(pA0, pA1, alA, l_reg, pa0, pa1, pa2, pa3); SBAR();
  pv_d0(o, vb0 + bp * (int)SHM_V, pa0, pa1, pa2, pa3); MASKT(pB0, pB1, NT - 1); partialSM(pB0, pB1, m_reg, mnB, alB);
  RESC(alB);
  finishSM(pB0, pB1, alB, l_reg, pa0, pa1, pa2, pa3); SBAR();
  pv_d0(o, vb0 + bq * (int)SHM_V, pa0, pa1, pa2, pa3);
  if (MODE == 1) { constexpr float C = SCALE * 1.4426950408889634f; l_reg += __builtin_amdgcn_exp2f(sink * 1.4426950408889634f - m_reg * C); }
  if (hi == 0) li_l[r32] = l_reg; asm volatile("s_waitcnt lgkmcnt(0)" ::: "memory");
  float rli[16];
#pragma unroll
  for (int r = 0; r < 16; ++r) rli[r] = __builtin_amdgcn_rcpf(li_l[crow(r, hi)]);
  bf16* Ow = Ob + (long)(wid * QBLK) * LDO;
#pragma unroll
  for (int r = 0; r < 16; ++r) { int orow = crow(r, hi);
    for (int d0 = 0; d0 < 4; ++d0) Ow[(long)orow * LDO + d0 * 32 + r32] = (bf16)f2bf(o[d0][r] * rli[r]); }
  asm volatile("s_waitcnt vmcnt(0) lgkmcnt(0)" ::: "memory");
  __syncthreads();
#undef TK0
#undef SLOAD
#undef SWRITE
#undef SWAIT
#undef RESC
#undef MASKT
}
#undef KSWZ
#undef SBAR
}

struct Args { const float* in[36]; float* out; unsigned char* ws; int ph_lo, ph_hi; };
enum { I_X = 0, I_C, I_CTX, I_CCTX, I_WMOD, I_BMOD, I_GMIX, I_GFFN, I_WGRP, I_BGRP, I_WRT, I_BRT, I_W1, I_W3, I_W2, I_ABIN, I_ABOUT, I_SCONVW, I_SCONVB,
       I_DTBIAS, I_ALOG, I_SSDD, I_SNORMG, I_QG, I_KG, I_CDIN, I_CDOUT, I_LCONVW, I_LCONVB, I_LWA, I_LBA, I_LWX, I_LBX, I_LAM, I_SINK, I_GFINAL };

struct Ctx {
    const float* const* in; float* out; unsigned char* ws;
    int bid, G;
    __device__ __forceinline__ unsigned* ctl() const { return (unsigned*)(ws + WS_CTL); }
    __device__ __forceinline__ float* mod(int layer, int mv) const { return (float*)(ws + WS_MOD) + (size_t)(layer * 3 + mv) * 6144; }
    __device__ __forceinline__ float* xc() const { return (float*)(ws + WS_XC); }
    __device__ __forceinline__ float* xrow(int r) const { const int b = r / BROWS, q = r - b * BROWS; return q < CTXL ? xc() + (size_t)(b * CTXL + q) * DM : out + (size_t)(b * SEQL + (q - CTXL)) * DM; }
    __device__ __forceinline__ const float* xin_row(int r) const { const int b = r / BROWS, q = r - b * BROWS; return q < CTXL ? in[I_CTX] + (size_t)(b * CTXL + q) * DM : in[I_X] + (size_t)(b * SEQL + (q - CTXL)) * DM; }
};
struct TC { int tid, lane, wave; };
__device__ __forceinline__ TC phase_tc() { TC t; int x = threadIdx.x; asm volatile("" : "+v"(x)); t.tid = x; t.lane = x & 63; t.wave = __builtin_amdgcn_readfirstlane(x >> 6); return t; }
__device__ __forceinline__ int row_mv(int r) { const int b = r / BROWS, q = r - b * BROWS; return q < CTXL ? 2 : b; }

struct RowSched {
    int nM, nN, nwg, G, c, skipctx; const char* A; const char* Bt; size_t a_tile, b_tile;
    __device__ __forceinline__ bool next(int i, pg8::Unit& u) const {
        const long L = (long)i * G + c; if (L >= nwg) return false;
        if (skipctx == 2) { const int t8 = (int)L >> 2, ks = (int)L & 3; u.pm = (t8 >> 2) * 33; u.pn = t8 & 3;
            u.a = A + (size_t)u.pm * a_tile + (size_t)ks * 1024; u.b = Bt + (size_t)u.pn * b_tile + (size_t)ks * 1024; u.bd = 0; u.tbo = (int)L; u.nrow = 0; return true; }
        int wgid = (int)L; { const int q = nwg / 8, r = nwg % 8, xcd = wgid % 8, off = wgid / 8; wgid = (xcd < r ? xcd * (q + 1) : r * (q + 1) + (xcd - r) * q) + off; }
        const int nig = 8 * nN, gid = wgid / nig, fm = gid * 8, gsz = (nM - fm) < 8 ? (nM - fm) : 8;
        const int pmi = fm + ((wgid % nig) % gsz); u.pn = (wgid % nig) / gsz;
        u.pm = skipctx ? (pmi / 32) * 33 + 1 + (pmi % 32) : pmi;
        u.a = A + (size_t)u.pm * a_tile; u.b = Bt + (size_t)u.pn * b_tile; u.bd = 0; u.tbo = 0; u.nrow = 0; return true;
    }
    __device__ __forceinline__ void a_ready(const pg8::Unit&) const {}
    __device__ __forceinline__ void done(const pg8::Unit&) const {}
};
struct MoeSchedBase {
    const int* mt; int G, c, layer; unsigned char* ws;
    __device__ __forceinline__ bool locate(int i, pg8::Unit& u, int& ea, int& eb) const {
        const int ntl = mt[24]; const long L = (long)i * G + c; if (L >= (long)ntl * 4) return false;
        const int tile = (int)(L >> 2), pn = (int)(L & 3), cls = mt[64 + tile], g = cls / 6, pi = cls - g * 6;
        const int ia = pi < 3 ? 0 : (pi < 5 ? 1 : 2), ib = pi < 3 ? pi + 1 : (pi < 5 ? pi - 1 : 3);
        ea = g * 4 + ia; eb = g * 4 + ib;
        const int ti = tile - mt[cls];
        u.pm = tile; u.pn = pn; u.tbo = cls * NROWS + ti * 256; u.nrow = mt[32 + cls] - ti * 256;
        return true;
    }
};
struct MoeSched1 : MoeSchedBase {
    __device__ __forceinline__ bool next(int i, pg8::Unit& u) const { int ea, eb; if (!locate(i, u, ea, eb)) return false;
        const int e = (u.pn >> 1) ? eb : ea; u.a = (const char*)(ws + WS_A); u.b = (const char*)(ws + WS_W13) + ((size_t)e * 512 + (u.pn & 1) * 256) * 1024 * 2; u.bd = 0; return true; }
    __device__ __forceinline__ void a_ready(const pg8::Unit&) const {}
    __device__ __forceinline__ void done(const pg8::Unit& u) const {
        asm volatile("s_waitcnt vmcnt(0)" ::: "memory");
        if ((threadIdx.x & 63) == 0) __hip_atomic_fetch_add((unsigned*)(ws + WS_CTL) + CW_TDONE + layer * 6144 + 64 * u.pm, 1u, __ATOMIC_RELAXED, __HIP_MEMORY_SCOPE_AGENT);
    }
};
struct MoeSched2 : MoeSchedBase {
    __device__ __forceinline__ bool next(int i, pg8::Unit& u) const { int ea, eb; if (!locate(i, u, ea, eb)) return false;
        u.a = (const char*)(ws + WS_Z) + (size_t)u.pm * 256 * 512 * 2; u.b = (const char*)(ws + WS_W2) + ((size_t)ea * 1024 + u.pn * 256) * 256 * 2; u.bd = (long)(eb - ea) * 1024 * 256 * 2 - 4 * 128; return true; }
    __device__ __forceinline__ void a_ready(const pg8::Unit& u) const {
        if (threadIdx.x < 64) {
            unsigned polls = 0;
            unsigned* tw = (unsigned*)(ws + WS_CTL) + CW_TDONE + layer * 6144 + 64 * u.pm;
            while ((unsigned)__builtin_amdgcn_readfirstlane(__hip_atomic_load(tw, __ATOMIC_RELAXED, __HIP_MEMORY_SCOPE_AGENT)) < 32u) {
                if (++polls > (1u << 17)) break;
                __builtin_amdgcn_s_sleep(16); }
            __builtin_amdgcn_fence(__ATOMIC_ACQUIRE, "agent");
            asm volatile("s_waitcnt vmcnt(0)" ::: "memory");
        }
        asm volatile("" ::: "memory"); __builtin_amdgcn_s_barrier(); asm volatile("" ::: "memory");
    }
    __device__ __forceinline__ void done(const pg8::Unit&) const {}
};

struct EpiProj {
    static constexpr bool PERM = true, AFTER_DRAIN = false;
    bf16 *d0, *d1, *d2, *d3, *d4, *d5; int e0, e1, e2, e3, e4; int l0, l1, l2, l3, l4, l5; int lastcols;
    __device__ __forceinline__ void operator()(const f32x4 (&acc)[2][2][4][2], const pg8::Unit& u, int wr, int wc, int fr, int fq) const {
        const int pn = u.pn; bf16* base; int ld, tl, ncol = 256;
        if (pn < e0) { base = d0; ld = l0; tl = pn; } else if (pn < e1) { base = d1; ld = l1; tl = pn - e0; } else if (pn < e2) { base = d2; ld = l2; tl = pn - e1; }
        else if (pn < e3) { base = d3; ld = l3; tl = pn - e2; } else if (pn < e4) { base = d4; ld = l4; tl = pn - e3; } else { base = d5; ld = l5; tl = pn - e4; ncol = lastcols; }
        const int row0 = u.pm * 256 + wr * 64 + fr, col0 = wc * 32 + 8 * fq;
#pragma unroll
        for (int ai = 0; ai < 2; ++ai)
#pragma unroll
            for (int m = 0; m < 4; ++m) { bf16* rowp = base + (size_t)(row0 + ai * 128 + m * 16) * ld + tl * 256 + col0;
#pragma unroll
                for (int bj = 0; bj < 2; ++bj) { if (col0 + bj * 128 < ncol) { const f32x4 v0 = acc[ai][bj][m][0], v1 = acc[ai][bj][m][1];
                    u32x4 w; w.x = pg8::cvt_pk_bf16(v0[0], v0[1]); w.y = pg8::cvt_pk_bf16(v0[2], v0[3]); w.z = pg8::cvt_pk_bf16(v1[0], v1[1]); w.w = pg8::cvt_pk_bf16(v1[2], v1[3]);
                    *(u32x4*)(rowp + bj * 128) = w; } } }
    }
};
struct EpiRes {
    static constexpr bool PERM = false, AFTER_DRAIN = true;
    float* slab;
    const float* xin_lat; const float* xin_ctx; float* xout_lat; float* xout_ctx; const float* modbase;
    __device__ __forceinline__ void operator()(const f32x4 (&acc)[2][2][4][2], const pg8::Unit& u, int wr, int wc, int fr, int fq) const {
        if (slab) { float* sp = slab + (size_t)u.tbo * 65536 + (size_t)(wr * 64 + fr) * 256 + wc * 32 + 4 * fq;
#pragma unroll
            for (int ai = 0; ai < 2; ++ai)
#pragma unroll
                for (int m = 0; m < 4; ++m)
#pragma unroll
                    for (int bj = 0; bj < 2; ++bj)
#pragma unroll
                        for (int n = 0; n < 2; ++n) *(f32x4*)(sp + (size_t)(ai * 128 + m * 16) * 256 + bj * 128 + n * 16) = acc[ai][bj][m][n];
            return; }
        const int b = u.pm / 33, qt = u.pm - b * 33; const bool isctx = (qt == 0);
        const size_t rbase = isctx ? (size_t)b * CTXL : (size_t)b * SEQL + (size_t)(qt - 1) * 256;
        const float* xi = (isctx ? xin_ctx : xin_lat) + rbase * DM; float* xo = (isctx ? xout_ctx : xout_lat) + rbase * DM;
        const float* gate = modbase + (size_t)(isctx ? 2 : b) * 6144 + 2 * 1024;
        const int row0 = wr * 64 + fr, col0 = u.pn * 256 + wc * 32 + 4 * fq;
        f32x4 gv[2][2];
#pragma unroll
        for (int bj = 0; bj < 2; ++bj)
#pragma unroll
            for (int n = 0; n < 2; ++n) gv[bj][n] = *(const f32x4*)(gate + col0 + bj * 128 + n * 16);
#pragma unroll
        for (int ai = 0; ai < 2; ++ai)
#pragma unroll
            for (int m = 0; m < 4; ++m) { const size_t off = (size_t)(row0 + ai * 128 + m * 16) * DM + col0;
#pragma unroll
                for (int bj = 0; bj < 2; ++bj)
#pragma unroll
                    for (int n = 0; n < 2; ++n) { const f32x4 xv = *(const f32x4*)(xi + off + bj * 128 + n * 16);
                        *(f32x4*)(xo + off + bj * 128 + n * 16) = xv + gv[bj][n] * acc[ai][bj][m][n]; } }
    }
    __device__ __forceinline__ void fused(const f32x4 (&acc)[2][2][4][2], const pg8::Unit& u, int wr, int wc, int fr, int fq, LAS unsigned char* lds, int wid, int lane) const {
        if (slab) { (*this)(acc, u, wr, wc, fr, fq); return; }
        const int b = u.pm / 33, qt = u.pm - b * 33; const bool isctx = (qt == 0);
        const size_t rbase = isctx ? (size_t)b * CTXL : (size_t)b * SEQL + (size_t)(qt - 1) * 256;
        const float* xi = (isctx ? xin_ctx : xin_lat) + rbase * DM + u.pn * 256 + 4 * lane; float* xo = (isctx ? xout_ctx : xout_lat) + rbase * DM + u.pn * 256 + 4 * lane;
        const f32x4 gv = *(const f32x4*)(modbase + (size_t)(isctx ? 2 : b) * 6144 + 2 * 1024 + u.pn * 256 + 4 * lane);
        LAS float* T = (LAS float*)lds;
#pragma unroll
        for (int ai = 0; ai < 2; ++ai) {
#pragma unroll
            for (int m = 0; m < 4; ++m)
#pragma unroll
                for (int bj = 0; bj < 2; ++bj)
#pragma unroll
                    for (int n = 0; n < 2; ++n) *(LAS f32x4*)(T + (wr * 64 + m * 16 + fr) * 260 + bj * 128 + wc * 32 + n * 16 + 4 * fq) = acc[ai][bj][m][n];
            __syncthreads();
            f32x4 xv[16];
#pragma unroll
            for (int k = 0; k < 16; ++k) xv[k] = *(const f32x4*)(xi + (size_t)(ai * 128 + wid * 16 + k) * DM);
#pragma unroll
            for (int k = 0; k < 16; ++k) { const f32x4 t = *(const LAS f32x4*)(T + (wid * 16 + k) * 260 + 4 * lane); *(f32x4*)(xo + (size_t)(ai * 128 + wid * 16 + k) * DM) = xv[k] + gv * t; }
            __syncthreads();
        }
    }
};
struct EpiMoe1 {
    static constexpr bool PERM = true, AFTER_DRAIN = false;
    unsigned char* ws;
    __device__ __forceinline__ void operator()(const f32x4 (&acc)[2][2][4][2], const pg8::Unit& u, int wr, int wc, int fr, int fq) const {
        const __amdgpu_buffer_rsrc_t hr = __builtin_amdgcn_make_buffer_rsrc((void*)(ws + WS_Z), 0, MAXSLOT * 512 * 2, 0x00020000);
        const int* TBL = (const int*)(ws + WS_TBL); const int* REC = (const int*)(ws + WS_REC);
        const int rho0 = wr * 64 + fr, colh = (u.pn >> 1) * 256 + (u.pn & 1) * 128 + wc * 32 + 8 * fq, which = u.pn >> 1;
        int rr[8]; float gts[8];
#pragma unroll
        for (int k = 0; k < 8; ++k) { const int rho = rho0 + (k >> 2) * 128 + (k & 3) * 16; const int rc = rho < u.nrow ? rho : u.nrow - 1; rr[k] = TBL[u.tbo + rc]; }
#pragma unroll
        for (int k = 0; k < 8; ++k) gts[k] = __uint_as_float((unsigned)REC[(size_t)rr[k] * 4 + 2 + which]);
#pragma unroll
        for (int ai = 0; ai < 2; ++ai)
#pragma unroll
            for (int m = 0; m < 4; ++m) { const int rho = rho0 + ai * 128 + m * 16; const float gt = gts[ai * 4 + m];
                float hv[8];
#pragma unroll
                for (int n = 0; n < 2; ++n)
#pragma unroll
                    for (int e = 0; e < 4; ++e) { const float a = acc[ai][0][m][n][e], uu = acc[ai][1][m][n][e]; hv[n * 4 + e] = silu_f(a) * uu * gt; }
                u32x4 w; w.x = pg8::cvt_pk_bf16(hv[0], hv[1]); w.y = pg8::cvt_pk_bf16(hv[2], hv[3]); w.z = pg8::cvt_pk_bf16(hv[4], hv[5]); w.w = pg8::cvt_pk_bf16(hv[6], hv[7]);
                __builtin_amdgcn_raw_buffer_store_b128(w, hr, (unsigned)(((size_t)(u.pm * 256 + rho) * 512 + colh) * 2), 0, 16); }
    }
};
struct EpiMoe2 {
    static constexpr bool PERM = false, AFTER_DRAIN = true;
    float* out; unsigned char* ws; int layer;
    __device__ __forceinline__ void operator()(const f32x4 (&acc)[2][2][4][2], const pg8::Unit& u, int wr, int wc, int fr, int fq) const {
        const int rho0 = wr * 64 + fr, col0 = u.pn * 256 + wc * 32 + 4 * fq; const int* TBL = (const int*)(ws + WS_TBL); float* xc = (float*)(ws + WS_XC); const float* modbase = (const float*)(ws + WS_MOD) + (size_t)layer * 3 * 6144;
        int rr[8];
#pragma unroll
        for (int k = 0; k < 8; ++k) { const int rho = rho0 + (k >> 2) * 128 + (k & 3) * 16; rr[k] = rho < u.nrow ? TBL[u.tbo + rho] : -1; }
#pragma unroll
        for (int ai = 0; ai < 2; ++ai)
#pragma unroll
            for (int m = 0; m < 4; ++m) { const int r = rr[ai * 4 + m];
                if (r >= 0) { const int b = r / BROWS, q = r - b * BROWS; const bool isctx = q < CTXL;
                    float* xp = isctx ? xc + (size_t)(b * CTXL + q) * DM : out + (size_t)(b * SEQL + (q - CTXL)) * DM;
                    const float* gate = modbase + (size_t)(isctx ? 2 : b) * 6144 + 5 * 1024;
#pragma unroll
                    for (int bj = 0; bj < 2; ++bj)
#pragma unroll
                        for (int n = 0; n < 2; ++n) { const int c = col0 + bj * 128 + n * 16; const f32x4 gv = *(const f32x4*)(gate + c); const f32x4 xv = *(const f32x4*)(xp + c);
                            *(f32x4*)(xp + c) = xv + gv * acc[ai][bj][m][n]; } }
                if (m & 1) asm volatile("" ::: "memory"); }
    }
    __device__ __forceinline__ void fused(const f32x4 (&acc)[2][2][4][2], const pg8::Unit& u, int wr, int wc, int fr, int fq, LAS unsigned char* lds, int wid, int lane) const {
        const int* TBL = (const int*)(ws + WS_TBL); float* xc = (float*)(ws + WS_XC); const float* modbase = (const float*)(ws + WS_MOD) + (size_t)layer * 3 * 6144;
        LAS float* T = (LAS float*)lds;
#pragma unroll
        for (int ai = 0; ai < 2; ++ai) {
#pragma unroll
            for (int m = 0; m < 4; ++m)
#pragma unroll
                for (int bj = 0; bj < 2; ++bj)
#pragma unroll
                    for (int n = 0; n < 2; ++n) *(LAS f32x4*)(T + (wr * 64 + m * 16 + fr) * 260 + bj * 128 + wc * 32 + n * 16 + 4 * fq) = acc[ai][bj][m][n];
            __syncthreads();
            int rr[16];
#pragma unroll
            for (int k = 0; k < 16; ++k) { const int rho = ai * 128 + wid * 16 + k; rr[k] = rho < u.nrow ? TBL[u.tbo + rho] : -1; }
#pragma unroll
            for (int kp = 0; kp < 16; kp += 4) { f32x4 xv[4]; float* xp[4]; f32x4 gv[4];
#pragma unroll
                for (int k = 0; k < 4; ++k) { const int r = rr[kp + k]; const int rc = r < 0 ? 0 : r; const int b = rc / BROWS, q = rc - b * BROWS; const bool isctx = q < CTXL;
                    xp[k] = (isctx ? xc + (size_t)(b * CTXL + q) * DM : out + (size_t)(b * SEQL + (q - CTXL)) * DM) + u.pn * 256 + 4 * lane;
                    gv[k] = *(const f32x4*)(modbase + (size_t)(isctx ? 2 : b) * 6144 + 5 * 1024 + u.pn * 256 + 4 * lane);
                    if (r >= 0) xv[k] = *(const f32x4*)xp[k]; }
#pragma unroll
                for (int k = 0; k < 4; ++k) { if (rr[kp + k] >= 0) { const f32x4 t = *(const LAS f32x4*)(T + (wid * 16 + kp + k) * 260 + 4 * lane); *(f32x4*)xp[k] = xv[k] + gv[k] * t; } } }
            __syncthreads();
        }
    }
};

__device__ __forceinline__ void transpose_item(const float* W, int ldw, int k0, int n0src, bf16* WT, int ldt, int drow0, int dk0, LAS float* scr, int lane) {
    float tv[32];
#pragma unroll
    for (int i = 0; i < 32; ++i) { const int kk = 2 * i + (lane >> 5); tv[i] = n0src >= 0 ? W[(size_t)(k0 + kk) * ldw + n0src + (lane & 31)] : 0.f; }
#pragma unroll
    for (int i = 0; i < 32; ++i) { const int kk = 2 * i + (lane >> 5); scr[kk * 33 + (lane & 31)] = tv[i]; }
    asm volatile("s_waitcnt lgkmcnt(0)" ::: "memory");
    const int c = lane & 7;
#pragma unroll
    for (int j = 0; j < 4; ++j) { const int n = (lane >> 3) + 8 * j; const LAS float* s = scr + (8 * c) * 33 + n;
        u32x4 o; o.x = pk2(s[0 * 33], s[1 * 33]); o.y = pk2(s[2 * 33], s[3 * 33]); o.z = pk2(s[4 * 33], s[5 * 33]); o.w = pk2(s[6 * 33], s[7 * 33]);
        *(u32x4*)(WT + (size_t)(drow0 + n) * ldt + dk0 + 8 * c) = o; }
    asm volatile("s_waitcnt lgkmcnt(0)" ::: "memory");
}
__device__ __forceinline__ int ab_src_col(int n) {
    if (n < 2304) return n;
    if (n < 3840) return n + 32;
    if (n < 3872) return n - 3840 + 2304;
    return -1;
}
__device__ __forceinline__ void ph_convert(const Ctx& C, int layer, LAS unsigned char* lds, int part = 0, int wg0 = 0) {
    const TC T = phase_tc();
    LAS float* scr = (LAS float*)(lds + T.wave * 16384);
    if (part == 1 && C.bid < wg0) return;
    const int gw = (part == 1 ? C.bid - wg0 : C.bid) * NWAVES + T.wave, NGW = (part == 1 ? C.G - wg0 : C.G) * NWAVES;
    bf16* Win = (bf16*)(C.ws + WS_WIN); bf16* Wout = (bf16*)(C.ws + WS_WOUT); bf16* W13 = (bf16*)(C.ws + WS_W13); bf16* W2 = (bf16*)(C.ws + WS_W2);
    const int nin = layer == 0 ? 3872 : 3584;
    const int I_IN = 16 * (nin / 32), I_OUT = 32 * 32, I_E = 16 * 128;
    const int NIT = I_IN + I_OUT + 3 * I_E;
    const float* win = C.in[layer == 0 ? I_ABIN : I_CDIN]; const float* wout = C.in[layer == 0 ? I_ABOUT : I_CDOUT];
    const int ldin = layer == 0 ? 3872 : 3584;
    const int it0 = part == 2 ? I_IN + I_OUT : 0, it1 = part == 1 ? I_IN + I_OUT : NIT;
    for (int it = it0 + gw; it < it1; it += NGW) {
        int r = it;
        if (r < I_IN) { const int nblk = nin / 32, kb = r / nblk, nb = r % nblk; const int src = layer == 0 ? ab_src_col(nb * 32) : nb * 32;
            transpose_item(win, ldin, kb * 64, src, Win, 1024, nb * 32, kb * 64, scr, T.lane); continue; } r -= I_IN;
        if (r < I_OUT) { const int kb = r / 32, nb = r % 32; transpose_item(wout, 1024, kb * 64, nb * 32, Wout, 2048, nb * 32, kb * 64, scr, T.lane); continue; } r -= I_OUT;
        if (r < 2 * I_E) { const int w3 = r >= I_E; if (w3) r -= I_E; const int e = r / 128, q = r % 128, kb = q / 8, nb = q % 8;
            const float* W = C.in[w3 ? I_W3 : I_W1] + (size_t)(layer * 16 + e) * 1024 * 256; const int n0 = nb * 32;
            transpose_item(W, 256, kb * 64, n0, W13 + (size_t)e * 512 * 1024, 1024, (n0 / 128) * 256 + (w3 ? 128 : 0) + (n0 % 128), kb * 64, scr, T.lane); continue; } r -= 2 * I_E;
        { const int e = r / 128, q = r % 128, kb = q / 32, nb = q % 32;
            const float* W = C.in[I_W2] + (size_t)(layer * 16 + e) * 256 * 1024;
            transpose_item(W, 1024, kb * 64, nb * 32, W2 + (size_t)e * 1024 * 256, 256, nb * 32, kb * 64, scr, T.lane); }
    }
}
__device__ __forceinline__ void ph_mod(const Ctx& C, LAS unsigned char* lds) {
    const TC T = phase_tc();
    LAS float* red = (LAS float*)lds;
    LAS float* act = red + 8 * 3 * 256;
    if (C.bid < 48) {
        for (int i = T.tid; i < 3072; i += NTHREADS) { const int v = i >> 10, d = i & 1023; act[i] = silu_f(v < 2 ? C.in[I_C][v * 1024 + d] : C.in[I_CCTX][d]); }
        __syncthreads();
    }
    for (int item = C.bid; item < 48; item += C.G) {
        const int layer = item / 24, chunk = item % 24;
        const float* W = C.in[I_WMOD] + (size_t)layer * 1024 * 6144 + chunk * 256 + T.lane * 4;
        f32x4 a0 = {0, 0, 0, 0}, a1 = a0, a2 = a0;
        const int d0 = T.wave * 128;
        for (int d = d0; d < d0 + 128; d += 8) {
            f32x4 w[8];
#pragma unroll
            for (int u = 0; u < 8; ++u) w[u] = *(const f32x4*)(W + (size_t)(d + u) * 6144);
#pragma unroll
            for (int u = 0; u < 8; ++u) { const float c0 = act[d + u], c1 = act[1024 + d + u], c2 = act[2048 + d + u]; a0 += w[u] * c0; a1 += w[u] * c1; a2 += w[u] * c2; }
        }
        __syncthreads();
#pragma unroll
        for (int e = 0; e < 4; ++e) { red[(T.wave * 3 + 0) * 256 + T.lane * 4 + e] = a0[e]; red[(T.wave * 3 + 1) * 256 + T.lane * 4 + e] = a1[e]; red[(T.wave * 3 + 2) * 256 + T.lane * 4 + e] = a2[e]; }
        __syncthreads();
        for (int o = T.tid; o < 768; o += NTHREADS) { const int v = o >> 8, j = o & 255; float s = 0.f;
#pragma unroll
            for (int w = 0; w < 8; ++w) s += red[(w * 3 + v) * 256 + j];
            C.mod(layer, v)[chunk * 256 + j] = s + C.in[I_BMOD][layer * 6144 + chunk * 256 + j]; }
        asm volatile("s_waitcnt vmcnt(0)" ::: "memory");
        __syncthreads();
        if (T.tid == 0) { __builtin_amdgcn_fence(__ATOMIC_RELEASE, "agent"); asm volatile("s_waitcnt vmcnt(0)" ::: "memory");
            __hip_atomic_fetch_add(C.ctl() + CW_MODDONE, 1u, __ATOMIC_RELAXED, __HIP_MEMORY_SCOPE_AGENT); }
    }
}
__device__ __forceinline__ void mod_wait(const Ctx& C) {
    const TC T = phase_tc();
    if (T.tid < 64) { unsigned polls = 0;
        while ((unsigned)__builtin_amdgcn_readfirstlane(__hip_atomic_load(C.ctl() + CW_MODDONE, __ATOMIC_RELAXED, __HIP_MEMORY_SCOPE_AGENT)) < 48u) { if (++polls > (1u << 17)) break; __builtin_amdgcn_s_sleep(16); }
        __builtin_amdgcn_fence(__ATOMIC_ACQUIRE, "agent"); asm volatile("s_waitcnt vmcnt(0)" ::: "memory"); }
    __syncthreads();
}
__device__ __forceinline__ void ph_prenorm(const Ctx& C, int layer) {
    const TC T = phase_tc();
    bf16* HN = (bf16*)(C.ws + WS_A);
    const float* gm = C.in[I_GMIX] + layer * 1024;
    const int gw = C.bid * NWAVES + T.wave, NGW = C.G * NWAVES;
    for (int r = gw; r < NROWS; r += NGW) {
        const float* xr = layer == 0 ? C.xin_row(r) : C.xrow(r);
        const float* md = C.mod(layer, row_mv(r));
        f32x4 v[4]; float ss = 0.f;
#pragma unroll
        for (int j = 0; j < 4; ++j) { v[j] = *(const f32x4*)(xr + 256 * j + 4 * T.lane); ss += (v[j].x * v[j].x + v[j].y * v[j].y) + (v[j].z * v[j].z + v[j].w * v[j].w); }
        const float rs = rsqrtf(wave_sum(ss) * (1.f / DM) + EPS);
#pragma unroll
        for (int j = 0; j < 4; ++j) { const int c = 256 * j + 4 * T.lane; const f32x4 g = *(const f32x4*)(gm + c), sc = *(const f32x4*)(md + 1024 + c), sh = *(const f32x4*)(md + c);
            const f32x4 h = v[j] * rs * g * (sc + 1.f) + sh;
            u32x2 w; w.x = pk2(h.x, h.y); w.y = pk2(h.z, h.w); *(u32x2*)(HN + (size_t)r * DM + c) = w; }
    }
}
__device__ __forceinline__ bool nb_valid(int r, int dk) { const int b = r / BROWS, q = r - b * BROWS; if (q < CTXL) { const int t = q + dk; return t >= 0 && t < CTXL; } const int t = q - CTXL + dk; return t >= 0 && t < SEQL; }
__device__ __forceinline__ void rope_angle(int r, int lane, float& cs, float& sn, bool& latent) {
    const int b = r / BROWS, q = r - b * BROWS; latent = q >= CTXL; const int t = q - CTXL;
    const int pos = lane < 32 ? (t >> 6) : (t & 63); const int jf = lane & 31;
    const float inv = exp2f(-(float)jf * (13.287712379549449f / 32.f));
    const float ang = (float)pos * inv; sincosf(ang, &sn, &cs);
}
__device__ __forceinline__ void ph_elem0(const Ctx& C) {
    const TC T = phase_tc();
    const bf16* RAW = (const bf16*)(C.ws + WS_RAW); bf16* XBC = (bf16*)C.out;
    float* DT = (float*)(C.ws + WS_DT);
    bf16* Q = (bf16*)(C.ws + WS_YMIX) + 1024; bf16* K = (bf16*)(C.ws + WS_K);
    const float* cw = C.in[I_SCONVW]; const float* cb = C.in[I_SCONVB];
    const int gw = C.bid * NWAVES + T.wave, NGW = C.G * NWAVES, lane = T.lane;
    { const bf16* HN = (const bf16*)(C.ws + WS_A); const bf16* Wd = (const bf16*)(C.ws + WS_WIN) + (size_t)3840 * 1024; const int l15 = lane & 15, lq = lane >> 4;
      const float bias0 = C.in[I_DTBIAS][l15], bias1 = C.in[I_DTBIAS][16 + l15];
      for (int gI = gw; gI < NROWS / 16; gI += NGW) { f32x4 a0 = {0.f, 0.f, 0.f, 0.f}, a1 = a0;
          const bf16* ap = HN + (size_t)(16 * gI + l15) * 1024 + 8 * lq; const bf16* b0p = Wd + (size_t)l15 * 1024 + 8 * lq; const bf16* b1p = Wd + (size_t)(16 + l15) * 1024 + 8 * lq;
#pragma unroll 8
          for (int ks = 0; ks < 32; ++ks) { const bf16x8 af = *(const bf16x8*)(ap + 32 * ks), f0 = *(const bf16x8*)(b0p + 32 * ks), f1 = *(const bf16x8*)(b1p + 32 * ks);
              a0 = __builtin_amdgcn_mfma_f32_16x16x32_bf16(af, f0, a0, 0, 0, 0); a1 = __builtin_amdgcn_mfma_f32_16x16x32_bf16(af, f1, a1, 0, 0, 0); }
#pragma unroll
          for (int rg = 0; rg < 4; ++rg) { const size_t ro = (size_t)(16 * gI + 4 * lq + rg) * 32; DT[ro + l15] = softplus_f(a0[rg] + bias0); DT[ro + 16 + l15] = softplus_f(a1[rg] + bias1); } } }
    for (int r = gw; r < NROWS; r += NGW) {
        for (int ch = lane; ch < 160; ch += 64) { const int c0 = ch * 8; float acc[8];
#pragma unroll
            for (int e = 0; e < 8; ++e) acc[e] = cb[c0 + e];
#pragma unroll
            for (int k = 0; k < 5; ++k) { if (nb_valid(r, k - 2)) { const u32x4 w = *(const u32x4*)(RAW + (size_t)(r + k - 2) * 1280 + c0); float xv[8]; unpack8(w, xv);
#pragma unroll
                for (int e = 0; e < 8; ++e) acc[e] += xv[e] * cw[k * 1280 + c0 + e]; } }
            u32x4 o; o.x = pk2(silu_f(acc[0]), silu_f(acc[1])); o.y = pk2(silu_f(acc[2]), silu_f(acc[3])); o.z = pk2(silu_f(acc[4]), silu_f(acc[5])); o.w = pk2(silu_f(acc[6]), silu_f(acc[7]));
            *(u32x4*)(XBC + (size_t)r * 1280 + c0) = o; }
        float cs, sn; bool latent; rope_angle(r, lane, cs, sn, latent);
        const float qg0 = C.in[I_QG][lane], qg1 = C.in[I_QG][64 + lane], kg0 = C.in[I_KG][lane], kg1 = C.in[I_KG][64 + lane];
#pragma unroll
        for (int h = 8; h < 10; ++h) { bf16* p = K + (size_t)r * 256 + (h - 8) * 128;
            float t1 = bf2f(p[lane]), t2 = bf2f(p[64 + lane]);
            const float rs = rsqrtf(wave_sum(t1 * t1 + t2 * t2) * (1.f / 128.f) + EPS);
            t1 = t1 * rs * (h < 8 ? qg0 : kg0); t2 = t2 * rs * (h < 8 ? qg1 : kg1);
            if (latent) { const float o1 = t1 * cs - t2 * sn, o2 = t1 * sn + t2 * cs; t1 = o1; t2 = o2; }
            p[lane] = (bf16)f2bf(t1); p[64 + lane] = (bf16)f2bf(t2); }
    }
}
__device__ __forceinline__ void ph_elem1(const Ctx& C) {
    const TC T = phase_tc();
    const bf16* RAW = (const bf16*)(C.ws + WS_RAW); bf16* XR = (bf16*)(C.ws + WS_A);
    bf16* Q = (bf16*)(C.ws + WS_YMIX) + 1024; bf16* K = (bf16*)(C.ws + WS_K);
    const float* cw = C.in[I_LCONVW]; const float* cb = C.in[I_LCONVB];
    const int gw = C.bid * NWAVES + T.wave, NGW = C.G * NWAVES, lane = T.lane;
    for (int r = gw; r < NROWS; r += NGW) {
        for (int ch = lane; ch < 128; ch += 64) { const int c0 = ch * 8; float acc[8];
#pragma unroll
            for (int e = 0; e < 8; ++e) acc[e] = cb[c0 + e];
#pragma unroll
            for (int k = 0; k < 5; ++k) { if (nb_valid(r, k - 2)) { const u32x4 w = *(const u32x4*)(RAW + (size_t)(r + k - 2) * 1024 + c0); float xv[8]; unpack8(w, xv);
#pragma unroll
                for (int e = 0; e < 8; ++e) acc[e] += xv[e] * cw[k * 1024 + c0 + e]; } }
            u32x4 o; o.x = pk2(acc[0], acc[1]); o.y = pk2(acc[2], acc[3]); o.z = pk2(acc[4], acc[5]); o.w = pk2(acc[6], acc[7]);
            *(u32x4*)(XR + (size_t)r * 1024 + c0) = o; }
        float cs, sn; bool latent; rope_angle(r, lane, cs, sn, latent);
        if (latent) {
#pragma unroll
            for (int h = 8; h < 10; ++h) { bf16* p = K + (size_t)r * 256 + (h - 8) * 128;
                const float t1 = bf2f(p[lane]), t2 = bf2f(p[64 + lane]);
                p[lane] = (bf16)f2bf(t1 * cs - t2 * sn); p[64 + lane] = (bf16)f2bf(t1 * sn + t2 * cs); }
        }
    }
}
__device__ __forceinline__ int chunk_of(int dir, int ci) { return dir == 0 ? ci : (ci < 2 ? 1 - ci : 67 - ci); }
__device__ __forceinline__ int step_row(int dir, int s) { return dir == 0 ? s : (s < CTXL ? CTXL - 1 - s : BROWS + CTXL - 1 - s); }
__device__ __forceinline__ void ssd_seq_unit(const Ctx& C, int item, LAS unsigned char* lds) {
    const TC T = phase_tc();
    const int b = item >> 5, dir = (item >> 4) & 1, h = item & 15, g = h >> 3, lane = T.lane, wid = T.wave;
    LAS float* part = (LAS float*)lds;
    LAS float* xs = part + 8 * 32 * 64; LAS float* Bs = xs + 32 * 64; LAS float* Cs = Bs + 32 * 64; LAS float* dts = Cs + 32 * 64;
    const float aneg = -__expf(C.in[I_ALOG][dir * 16 + h]);
    const bf16* XBC = (const bf16*)C.out + (size_t)b * BROWS * 1280;
    const float* DT = (const float*)(C.ws + WS_DT) + (size_t)b * BROWS * 32 + dir * 16 + h;
    bf16* Y = dir == 0 ? (bf16*)(C.ws + WS_YMIX) + (size_t)b * BROWS * 2048 + h * 64 : (bf16*)(C.ws + WS_RAW) + (size_t)b * BROWS * 1024 + h * 64;
    const int ldy = dir == 0 ? 2048 : 1024;
    float hs[8];
#pragma unroll
    for (int k = 0; k < 8; ++k) hs[k] = 0.f;
    for (int s0 = 0; s0 < BROWS; s0 += 32) {
        for (int i = T.tid; i < 32 * 192; i += NTHREADS) { const int tt = i / 192, c = i - tt * 192; const int q = step_row(dir, s0 + tt);
            const bf16* row = XBC + (size_t)q * 1280;
            if (c < 64) xs[tt * 64 + c] = bf2f(row[h * 64 + c]); else if (c < 128) Bs[tt * 64 + c - 64] = bf2f(row[1024 + g * 64 + c - 64]); else Cs[tt * 64 + c - 128] = bf2f(row[1152 + g * 64 + c - 128]); }
        if (T.tid < 32) dts[T.tid] = DT[(size_t)step_row(dir, s0 + T.tid) * 32];
        __syncthreads();
        for (int tt = 0; tt < 32; ++tt) {
            const float x = xs[tt * 64 + lane], dt = dts[tt];
            const f32x4 b0 = *(const LAS f32x4*)(Bs + tt * 64 + wid * 8), b1 = *(const LAS f32x4*)(Bs + tt * 64 + wid * 8 + 4);
            const f32x4 c0 = *(const LAS f32x4*)(Cs + tt * 64 + wid * 8), c1 = *(const LAS f32x4*)(Cs + tt * 64 + wid * 8 + 4);
            const float a = __expf(dt * aneg), dx = dt * x; float y = 0.f;
#pragma unroll
            for (int k = 0; k < 4; ++k) { hs[k] = a * hs[k] + dx * b0[k]; y += c0[k] * hs[k]; }
#pragma unroll
            for (int k = 0; k < 4; ++k) { hs[4 + k] = a * hs[4 + k] + dx * b1[k]; y += c1[k] * hs[4 + k]; }
            part[(wid * 32 + tt) * 64 + lane] = y;
        }
        __syncthreads();
        for (int i = T.tid; i < 2048; i += NTHREADS) { const int tt = i >> 6, p = i & 63; float s = 0.f;
#pragma unroll
            for (int w = 0; w < 8; ++w) s += part[(w * 32 + tt) * 64 + p];
            const int q = step_row(dir, s0 + tt); Y[(size_t)q * ldy + p] = (bf16)f2bf(s); }
        __syncthreads();
    }
}

__device__ __forceinline__ int ssd_seg_begin(int s) { return s == 0 ? 0 : (s == 1 ? 17 : (s == 2 ? 34 : (s == 3 ? 50 : 66))); }
__device__ __forceinline__ unsigned short hw_bf16(float x) { unsigned r; asm volatile("v_cvt_pk_bf16_f32 %0, %1, %1" : "=v"(r) : "v"(x)); return (unsigned short)r; }
__device__ __forceinline__ int tswz(int row, int col) { return row * 136 + ((((col >> 3) ^ ((row >> 3) & 7)) << 3) | (col & 7)); }
struct SsdSt { u32x4 xb[4], bb[2], cb[2]; float dt0, dt1; };
template <int MODE>
__device__ __forceinline__ void ssd_chunk_unit(const Ctx& C, int item, int seg, LAS unsigned char* lds) {
    const TC T = phase_tc();
    const int b = item >> 5, dir = (item >> 4) & 1, h = item & 15, g = h >> 3, lane = T.lane, wid = T.wave, tid = T.tid;
    const int ci0 = ssd_seg_begin(seg), ci1 = ssd_seg_begin(seg + 1);
    float* SEND = (float*)(C.ws + WS_SSDST) + (size_t)item * 3 * 4096; float* SLD = (float*)(C.ws + WS_SSDLD) + item * 3;
    const int l15 = lane & 15, lq = lane >> 4;
    LAS bf16* Cs = (LAS bf16*)lds;
    LAS bf16* Bs = Cs + 128 * 72;
    LAS bf16* Xt = Bs + 128 * 72;
    LAS bf16* Bwt = Xt + 64 * 136;
    LAS bf16* Ws = Bwt + 64 * 136;
    LAS bf16* Hs = Ws + 128 * 136;
    LAS float* acs = (LAS float*)(Hs + 64 * 72); LAS float* dtv = acs + 128; LAS float* eacs = dtv + 128; LAS float* wend = eacs + 128;
    const float aneg = -__expf(C.in[I_ALOG][dir * 16 + h]);
    const bf16* XBC = (const bf16*)C.out + (size_t)b * BROWS * 1280;
    const float* DT = (const float*)(C.ws + WS_DT) + (size_t)b * BROWS * 32 + dir * 16 + h;
    bf16* Y = dir == 0 ? (bf16*)(C.ws + WS_YMIX) + (size_t)b * BROWS * 2048 + h * 64 : (bf16*)(C.ws + WS_RAW) + (size_t)b * BROWS * 1024 + h * 64;
    const int ldy = dir == 0 ? 2048 : 1024;
    f32x4 Hacc[2]; Hacc[0] = (f32x4){0.f, 0.f, 0.f, 0.f}; Hacc[1] = Hacc[0];
    float ldsum = 0.f;
    if (MODE == 1) {
        for (int sp = 0; sp < seg; ++sp) { const float dseg = __expf(SLD[sp]);
#pragma unroll
            for (int t = 0; t < 2; ++t) { const int tl = 2 * wid + t, nt_ = tl >> 2, pt = tl & 3;
                const f32x4 sv = *(const f32x4*)(SEND + (size_t)sp * 4096 + (16 * pt + l15) * 64 + 16 * nt_ + 4 * lq); Hacc[t] = Hacc[t] * dseg + sv; } }
#pragma unroll
        for (int t = 0; t < 2; ++t) { const int tl = 2 * wid + t, nt_ = tl >> 2, pt = tl & 3;
            u32x2 w; w.x = pg8::cvt_pk_bf16(Hacc[t][0], Hacc[t][1]); w.y = pg8::cvt_pk_bf16(Hacc[t][2], Hacc[t][3]); *(LAS u32x2*)(Hs + (16 * pt + l15) * 72 + 16 * nt_ + 4 * lq) = w; }
    }
    const int xtg = tid >> 3, xpg = tid & 7;
#define SSD_ROW(q0_, i_) (XBC + (size_t)(dir == 0 ? (q0_) + (i_) : (q0_) + 127 - (i_)) * 1280)
#define SSD_LOAD(R, q0_) do { \
        if (tid < 256) { _Pragma("unroll") for (int q_ = 0; q_ < 4; ++q_) R.xb[q_] = *(const u32x4*)(SSD_ROW(q0_, 4 * xtg + q_) + h * 64 + 8 * xpg); } \
        _Pragma("unroll") for (int k = 0; k < 2; ++k) { const int pidx = tid + 512 * k, i_ = pidx >> 3, c8_ = (pidx & 7) * 8; \
            R.bb[k] = *(const u32x4*)(SSD_ROW(q0_, i_) + 1024 + g * 64 + c8_); if (MODE == 1) R.cb[k] = *(const u32x4*)(SSD_ROW(q0_, i_) + 1152 + g * 64 + c8_); } \
        if (wid == 0) { R.dt0 = DT[(size_t)(dir == 0 ? (q0_) + 2 * lane : (q0_) + 127 - 2 * lane) * 32]; R.dt1 = DT[(size_t)(dir == 0 ? (q0_) + 2 * lane + 1 : (q0_) + 126 - 2 * lane) * 32]; } } while (0)
    auto chunk = [&](SsdSt& R, const int ci, const int cin) __attribute__((always_inline)) {
        const int q0 = chunk_of(dir, ci) * 128;
        __syncthreads();
        if (wid == 0) {
            const float a0 = R.dt0 * aneg, a1 = R.dt1 * aneg; const float v = wave_scan_incl(a0 + a1);
            const float tot = __builtin_bit_cast(float, __builtin_amdgcn_readlane(__builtin_bit_cast(int, v), 63)), c0 = v - a1;
            acs[2 * lane] = c0; acs[2 * lane + 1] = v; dtv[2 * lane] = R.dt0; dtv[2 * lane + 1] = R.dt1;
            eacs[2 * lane] = __expf(c0); eacs[2 * lane + 1] = __expf(v);
            wend[2 * lane] = __expf(tot - c0) * R.dt0; wend[2 * lane + 1] = __expf(tot - v) * R.dt1; }
        if (tid < 256) {
#pragma unroll
            for (int m = 0; m < 4; ++m) { const unsigned w0 = R.xb[0][m], w1 = R.xb[1][m], w2 = R.xb[2][m], w3 = R.xb[3][m];
                u32x2 lo, hi; lo.x = (w0 & 0xffffu) | (w1 << 16); lo.y = (w2 & 0xffffu) | (w3 << 16); hi.x = (w0 >> 16) | (w1 & 0xffff0000u); hi.y = (w2 >> 16) | (w3 & 0xffff0000u);
                *(LAS u32x2*)(Xt + tswz(8 * xpg + 2 * m, 4 * xtg)) = lo; *(LAS u32x2*)(Xt + tswz(8 * xpg + 2 * m + 1, 4 * xtg)) = hi; } }
#pragma unroll
        for (int k = 0; k < 2; ++k) { const int pidx = tid + 512 * k, i_ = pidx >> 3, c8_ = (pidx & 7) * 8;
            *(LAS u32x4*)(Bs + i_ * 72 + c8_) = R.bb[k]; if (MODE == 1) *(LAS u32x4*)(Cs + i_ * 72 + c8_) = R.cb[k]; }
        if (cin < ci1) SSD_LOAD(R, chunk_of(dir, cin) * 128);
        __syncthreads();
        const float al = acs[127], dchunk = __expf(al); ldsum += al;
        if (tid < 256) { float f[4][8];
#pragma unroll
            for (int q_ = 0; q_ < 4; ++q_) { const u32x4 w = *(const LAS u32x4*)(Bs + (4 * xtg + q_) * 72 + 8 * xpg); unpack8(w, f[q_]); const float we = wend[4 * xtg + q_];
#pragma unroll
                for (int e = 0; e < 8; ++e) f[q_][e] *= we; }
#pragma unroll
            for (int e = 0; e < 8; ++e) { u32x2 w; w.x = pg8::cvt_pk_bf16(f[0][e], f[1][e]); w.y = pg8::cvt_pk_bf16(f[2][e], f[3][e]); *(LAS u32x2*)(Bwt + tswz(8 * xpg + e, 4 * xtg)) = w; } }
        if (MODE == 1) {
            for (int t = wid; t < 40; t += 8) {
                if (t >= 36) { const int rt = 2 * (t - 36);
                    *(LAS u32x2*)(Ws + (16 * rt + l15) * 136 + 16 * (rt + 1) + 4 * lq) = (u32x2){0u, 0u};
                    continue; }
                int rt = 0, base = 0; while (base + rt + 1 <= t) { base += rt + 1; ++rt; }
                const int ct = t - base;
                f32x4 acc = (f32x4){0.f, 0.f, 0.f, 0.f};
#pragma unroll
                for (int kk = 0; kk < 2; ++kk) { const bf16x8 af = *(const LAS bf16x8*)(Bs + (16 * ct + l15) * 72 + kk * 32 + 8 * lq), bfr = *(const LAS bf16x8*)(Cs + (16 * rt + l15) * 72 + kk * 32 + 8 * lq);
                    acc = __builtin_amdgcn_mfma_f32_16x16x32_bf16(af, bfr, acc, 0, 0, 0); }
                const int i = 16 * rt + l15; const float ai = acs[i];
                const f32x4 aj = *(const LAS f32x4*)(acs + 16 * ct + 4 * lq), dj = *(const LAS f32x4*)(dtv + 16 * ct + 4 * lq);
                float val[4];
#pragma unroll
                for (int rg = 0; rg < 4; ++rg) { const int j = 16 * ct + 4 * lq + rg; val[rg] = j <= i ? acc[rg] * __expf(ai - aj[rg]) * dj[rg] : 0.f; }
                u32x2 w; w.x = pg8::cvt_pk_bf16(val[0], val[1]); w.y = pg8::cvt_pk_bf16(val[2], val[3]); *(LAS u32x2*)(Ws + i * 136 + 16 * ct + 4 * lq) = w; }
        }
        __syncthreads();
        if (MODE == 1) { const int it = wid; f32x4 acc[4];
#pragma unroll
          for (int pt = 0; pt < 4; ++pt) acc[pt] = (f32x4){0.f, 0.f, 0.f, 0.f};
#pragma unroll
          for (int kk = 0; kk < 2; ++kk) { const bf16x8 bfr = *(const LAS bf16x8*)(Cs + (16 * it + l15) * 72 + kk * 32 + 8 * lq);
#pragma unroll
              for (int pt = 0; pt < 4; ++pt) { const bf16x8 af = *(const LAS bf16x8*)(Hs + (16 * pt + l15) * 72 + kk * 32 + 8 * lq); acc[pt] = __builtin_amdgcn_mfma_f32_16x16x32_bf16(af, bfr, acc[pt], 0, 0, 0); } }
          const float ea = eacs[16 * it + l15];
#pragma unroll
          for (int pt = 0; pt < 4; ++pt) acc[pt] = acc[pt] * ea;
          for (int ks = 0; ks <= (it >> 1); ++ks) { const bf16x8 bfr = *(const LAS bf16x8*)(Ws + (16 * it + l15) * 136 + ks * 32 + 8 * lq);
#pragma unroll
              for (int pt = 0; pt < 4; ++pt) { const bf16x8 af = *(const LAS bf16x8*)(Xt + tswz(16 * pt + l15, ks * 32 + 8 * lq)); acc[pt] = __builtin_amdgcn_mfma_f32_16x16x32_bf16(af, bfr, acc[pt], 0, 0, 0); } }
          { const int i = 16 * it + l15; const int q = dir == 0 ? q0 + i : q0 + 127 - i;
#pragma unroll
            for (int pt = 0; pt < 4; ++pt) { u32x2 w; w.x = pg8::cvt_pk_bf16(acc[pt][0], acc[pt][1]); w.y = pg8::cvt_pk_bf16(acc[pt][2], acc[pt][3]); *(u32x2*)(Y + (size_t)q * ldy + 16 * pt + 4 * lq) = w; } } }
#pragma unroll
        for (int t = 0; t < 2; ++t) { const int tl = 2 * wid + t, nt_ = tl >> 2, pt = tl & 3; Hacc[t] = Hacc[t] * dchunk;
#pragma unroll
            for (int ks = 0; ks < 4; ++ks) { const bf16x8 af = *(const LAS bf16x8*)(Bwt + tswz(16 * nt_ + l15, ks * 32 + 8 * lq)), bfr = *(const LAS bf16x8*)(Xt + tswz(16 * pt + l15, ks * 32 + 8 * lq));
                Hacc[t] = __builtin_amdgcn_mfma_f32_16x16x32_bf16(af, bfr, Hacc[t], 0, 0, 0); } }
        if (MODE == 1) {
        __syncthreads();
#pragma unroll
        for (int t = 0; t < 2; ++t) { const int tl = 2 * wid + t, nt_ = tl >> 2, pt = tl & 3;
            u32x2 w; w.x = pg8::cvt_pk_bf16(Hacc[t][0], Hacc[t][1]); w.y = pg8::cvt_pk_bf16(Hacc[t][2], Hacc[t][3]); *(LAS u32x2*)(Hs + (16 * pt + l15) * 72 + 16 * nt_ + 4 * lq) = w; }
        }
        };
    if (MODE == 0) {
        SsdSt RA, RB; RA.dt0 = RA.dt1 = RB.dt0 = RB.dt1 = 0.f;
        SSD_LOAD(RA, chunk_of(dir, ci0) * 128); if (ci0 + 1 < ci1) SSD_LOAD(RB, chunk_of(dir, ci0 + 1) * 128);
        for (int ci = ci0; ci < ci1; ci += 2) { chunk(RA, ci, ci + 2); if (ci + 1 < ci1) chunk(RB, ci + 1, ci + 3); }
    } else {
        SsdSt RA; RA.dt0 = RA.dt1 = 0.f;
        SSD_LOAD(RA, chunk_of(dir, ci0) * 128);
        for (int ci = ci0; ci < ci1; ++ci) chunk(RA, ci, ci + 1);
    }
    if (MODE == 0) {
#pragma unroll
        for (int t = 0; t < 2; ++t) { const int tl = 2 * wid + t, nt_ = tl >> 2, pt = tl & 3;
            *(f32x4*)(SEND + (size_t)seg * 4096 + (16 * pt + l15) * 64 + 16 * nt_ + 4 * lq) = Hacc[t]; }
        if (tid == 0) SLD[seg] = ldsum;
    }
    __syncthreads();
#undef SSD_ROW
#undef SSD_LOAD
}

__device__ __forceinline__ void lru_seq_unit(const Ctx& C, int item, LAS unsigned char* lds) {
    const TC T = phase_tc();
    const int b = item >> 5, dir = (item >> 4) & 1, hb = item & 15, lane = T.lane, wid = T.wave;
    LAS float* wa = (LAS float*)lds; LAS float* wx = wa + 4096; LAS float* xs = wx + 4096; LAS float* as_ = xs + 512; LAS float* bs_ = as_ + 512;
    const float* gwa = C.in[I_LWA] + (size_t)(dir * 16 + hb) * 4096; const float* gwx = C.in[I_LWX] + (size_t)(dir * 16 + hb) * 4096;
    for (int i = T.tid; i < 4096; i += NTHREADS) { wa[i] = gwa[i]; wx[i] = gwx[i]; }
    const int c = hb * 64 + lane;
    const float ba = C.in[I_LBA][dir * 1024 + c], bx = C.in[I_LBX][dir * 1024 + c], logbase = -8.f * softplus_f(-C.in[I_LAM][dir * 1024 + c]);
    const bf16* XR = (const bf16*)(C.ws + WS_A) + (size_t)b * BROWS * 1024 + hb * 64;
    bf16* Y = dir == 0 ? (bf16*)(C.ws + WS_YMIX) + (size_t)b * BROWS * 2048 + hb * 64 : (bf16*)(C.ws + WS_RAW) + (size_t)b * BROWS * 1024 + hb * 64;
    const int ldy = dir == 0 ? 2048 : 1024;
    float hst = 0.f;
    __syncthreads();
    unsigned short xnext = XR[(size_t)step_row(dir, wid) * 1024 + lane];
    for (int it = 0; it < BROWS / 8; ++it) {
        const float xv = bf2f(xnext);
        if (it + 1 < BROWS / 8) xnext = XR[(size_t)step_row(dir, (it + 1) * 8 + wid) * 1024 + lane];
        xs[wid * 64 + lane] = xv;
        asm volatile("s_waitcnt lgkmcnt(0)" ::: "memory");
        float pa = ba, px = bx;
#pragma unroll 8
        for (int i = 0; i < 64; ++i) { const float xi = xs[wid * 64 + i]; pa += xi * wa[i * 64 + lane]; px += xi * wx[i * 64 + lane]; }
        const float la = logbase * sigmoid_f(pa), a = __expf(la), bc = sqrtf(-expm1f(2.f * la)) * sigmoid_f(px) * xv;
        as_[wid * 64 + lane] = a; bs_[wid * 64 + lane] = bc;
        __syncthreads();
        if (wid == 0) {
#pragma unroll
            for (int tt = 0; tt < 8; ++tt) { hst = as_[tt * 64 + lane] * hst + bs_[tt * 64 + lane]; const int q2 = step_row(dir, it * 8 + tt); Y[(size_t)q2 * ldy + lane] = (bf16)f2bf(hst); }
        }
        __syncthreads();
    }
}

__device__ __forceinline__ float fast_sigmoid(float x) { return __builtin_amdgcn_rcpf(1.f + __expf(-x)); }
__device__ __forceinline__ void lru_chunk_unit(const Ctx& C, int item4, LAS unsigned char* lds) {
    const TC T = phase_tc();
    const int item = item4 >> 2, qc = item4 & 3;
    const int b = item >> 5, dir = (item >> 4) & 1, hb = item & 15, lane = T.lane, wid = T.wave, tid = T.tid;
    LAS bf16* xs0 = (LAS bf16*)lds;
    LAS bf16* wT = (LAS bf16*)(lds + 36864);
    LAS float* sWP = (LAS float*)(lds + 36864 + 4608);
    LAS float* sWH = sWP + 128;
    const float* gwa = C.in[I_LWA] + (size_t)(dir * 16 + hb) * 4096; const float* gwx = C.in[I_LWX] + (size_t)(dir * 16 + hb) * 4096;
    for (int i = tid; i < 1024; i += NTHREADS) { const int ii = i >> 4, j = i & 15; wT[j * 72 + ii] = (bf16)f2bf(gwa[ii * 64 + qc * 16 + j]); wT[16 * 72 + j * 72 + ii] = (bf16)f2bf(gwx[ii * 64 + qc * 16 + j]); }
    const int l15 = lane & 15, lq = lane >> 4;
    const int c = hb * 64 + qc * 16 + l15;
    const float ba = C.in[I_LBA][dir * 1024 + c], bx = C.in[I_LBX][dir * 1024 + c], lb = -8.f * softplus_f(-C.in[I_LAM][dir * 1024 + c]);
    float hst = 0.f;
    const bf16* XR = (const bf16*)(C.ws + WS_A) + (size_t)b * BROWS * 1024 + hb * 64;
    bf16* Y = dir == 0 ? (bf16*)(C.ws + WS_YMIX) + (size_t)b * BROWS * 2048 + hb * 64 + qc * 16 : (bf16*)(C.ws + WS_RAW) + (size_t)b * BROWS * 1024 + hb * 64 + qc * 16;
    const int ldy = dir == 0 ? 2048 : 1024;
    const int pr0 = tid >> 3, pc = (tid & 7) * 8;
    u32x4 st0, st1;
    { const int q0 = chunk_of(dir, 0) * 128; const int qa = dir == 0 ? q0 + pr0 : q0 + 127 - pr0, qb = dir == 0 ? q0 + pr0 + 64 : q0 + 63 - pr0;
      st0 = *(const u32x4*)(XR + (size_t)qa * 1024 + pc); st1 = *(const u32x4*)(XR + (size_t)qb * 1024 + pc); }
    __syncthreads();
    for (int ci = 0; ci < 66; ++ci) {
        const int q0 = chunk_of(dir, ci) * 128;
        LAS bf16* xs = xs0 + (ci & 1) * (128 * 72);
        *(LAS u32x4*)(xs + pr0 * 72 + pc) = st0; *(LAS u32x4*)(xs + (pr0 + 64) * 72 + pc) = st1;
        if (ci + 1 < 66) { const int qn = chunk_of(dir, ci + 1) * 128; const int qa = dir == 0 ? qn + pr0 : qn + 127 - pr0, qb = dir == 0 ? qn + pr0 + 64 : qn + 63 - pr0;
            st0 = *(const u32x4*)(XR + (size_t)qa * 1024 + pc); st1 = *(const u32x4*)(XR + (size_t)qb * 1024 + pc); }
        __syncthreads();
        f32x4 ga = (f32x4){0.f, 0.f, 0.f, 0.f}, gx = ga;
#pragma unroll
        for (int kk = 0; kk < 2; ++kk) { const bf16x8 af = *(const LAS bf16x8*)(xs + (16 * wid + l15) * 72 + kk * 32 + 8 * lq);
            const bf16x8 b0 = *(const LAS bf16x8*)(wT + l15 * 72 + kk * 32 + 8 * lq), b1 = *(const LAS bf16x8*)(wT + 16 * 72 + l15 * 72 + kk * 32 + 8 * lq);
            ga = __builtin_amdgcn_mfma_f32_16x16x32_bf16(af, b0, ga, 0, 0, 0); gx = __builtin_amdgcn_mfma_f32_16x16x32_bf16(af, b1, gx, 0, 0, 0); }
        float p = 1.f, hh = 0.f;
#pragma unroll
        for (int rg = 0; rg < 4; ++rg) { const int i = 16 * wid + 4 * lq + rg;
            const float la = lb * fast_sigmoid(ga[rg] + ba), a = __expf(la), xv = bf2f(xs[i * 72 + qc * 16 + l15]);
            const float x2 = 2.f * la, oms = -x2 * (1.f + 0.5f * x2 * (1.f + (1.f / 3.f) * x2 * (1.f + 0.25f * x2 * (1.f + 0.2f * x2)))), om = x2 < -0.4f ? 1.f - a * a : oms;
            const float bc = __builtin_amdgcn_sqrtf(om) * fast_sigmoid(gx[rg] + bx) * xv;
            hh = a * hh + bc; p *= a; ga[rg] = p; gx[rg] = hh; }
#define LRU_SHUP(v, o) __builtin_bit_cast(float, __builtin_amdgcn_ds_bpermute(((lane - (o)) & 63) << 2, __builtin_bit_cast(int, v)))
        { const float pp = LRU_SHUP(p, 16), hp = LRU_SHUP(hh, 16); if (lq >= 1) { hh = p * hp + hh; p = pp * p; } }
        { const float pp = LRU_SHUP(p, 32), hp = LRU_SHUP(hh, 32); if (lq >= 2) { hh = p * hp + hh; p = pp * p; } }
        const float pe_ = LRU_SHUP(p, 16), he_ = LRU_SHUP(hh, 16);
#undef LRU_SHUP
        const float Pe = lq >= 1 ? pe_ : 1.f, He = lq >= 1 ? he_ : 0.f;
        if (lq == 3) { sWP[l15 * 8 + wid] = p; sWH[l15 * 8 + wid] = hh; }
        __syncthreads();
        { const f32x4 p0 = *(const LAS f32x4*)(sWP + l15 * 8), p1 = *(const LAS f32x4*)(sWP + l15 * 8 + 4), h0 = *(const LAS f32x4*)(sWH + l15 * 8), h1 = *(const LAS f32x4*)(sWH + l15 * 8 + 4);
            float cin = hst, cw = hst;
#pragma unroll
            for (int w = 0; w < 8; ++w) { if (w == wid) cw = cin; const float pw = w < 4 ? p0[w & 3] : p1[w & 3], hw = w < 4 ? h0[w & 3] : h1[w & 3]; cin = pw * cin + hw; }
            hst = cin;
            const float cl = Pe * cw + He;
#pragma unroll
            for (int rg = 0; rg < 4; ++rg) { const int i = 16 * wid + 4 * lq + rg; const int q = dir == 0 ? q0 + i : q0 + 127 - i;
                Y[(size_t)q * ldy + l15] = hw_bf16(gx[rg] + ga[rg] * cl); } }
    }
    __syncthreads();
}

__device__ __forceinline__ int queue_pop(const Ctx& C, unsigned* qword, LAS unsigned char* lds) {
    const TC T = phase_tc();
    LAS int* slot = (LAS int*)(lds + LDS_BYTES - 64);
    __syncthreads();
    if (T.tid == 0) slot[0] = (int)atomicAdd(qword, 1u);
    __syncthreads();
    const int v = slot[0];
    return __builtin_amdgcn_readfirstlane(v);
}
__device__ __forceinline__ void ph_ssdpre(const Ctx& C, LAS unsigned char* lds) {
    for (int u = C.bid; u < 192; u += C.G) ssd_chunk_unit<0>(C, u / 3, u % 3, lds);
}
__device__ __forceinline__ void ph_mix0(const Ctx& C, LAS unsigned char* lds, char* ldsg) {
    bf16* YM = (bf16*)(C.ws + WS_YMIX); const bf16* K = (const bf16*)(C.ws + WS_K); const bf16* V = (const bf16*)(C.ws + WS_V);
    for (;;) {
        const int item = queue_pop(C, C.ctl() + CW_Q0, lds);
        if (item >= 256 + 512 + 16) break;
#ifdef SPLIT_MIX0
        if (item < 256) continue;
#else
        if (item < 256) { ssd_chunk_unit<1>(C, item >> 2, item & 3, lds); continue; }
#endif
        const int a = item - 256;
        if (a >= 16) { const int a1 = a - 16, hr = a1 & 3, qb = (a1 >> 2) & 31, kvh = (a1 >> 7) & 1, b = a1 >> 8, h = kvh * 4 + hr;
            bf16* Qb = YM + ((size_t)b * BROWS + CTXL + (size_t)qb * 256) * 2048 + 1024 + h * 128;
            att::attn_body<0>(Qb, K + (size_t)b * BROWS * 256 + kvh * 128, V + (size_t)b * BROWS * 256 + kvh * 128, Qb, BROWS / 64, 0, 0, 0.f, ldsg, C.in[I_QG], qb * 256);
        } else { const int b = a >> 3, h = a & 7, kvh = h >> 2;
            bf16* Qb = YM + ((size_t)b * BROWS) * 2048 + 1024 + h * 128;
            att::attn_body<0>(Qb, K + (size_t)b * BROWS * 256 + kvh * 128, V + (size_t)b * BROWS * 256 + kvh * 128, Qb, CTXL / 64, 0, 0, 0.f, ldsg, C.in[I_QG], -1);
        }
    }
}
__device__ __forceinline__ void ph_mix1(const Ctx& C, LAS unsigned char* lds, char* ldsg) {
    bf16* YM = (bf16*)(C.ws + WS_YMIX); const bf16* K = (const bf16*)(C.ws + WS_K); const bf16* V = (const bf16*)(C.ws + WS_V);
    for (;;) {
        const int item = queue_pop(C, C.ctl() + CW_Q1, lds);
        if (item >= 256 + 512) break;
        if (item < 256) { lru_chunk_unit(C, item, lds); continue; }
        const int a = item - 256, hr = a & 3, qb = (a >> 2) & 31, kvh = (a >> 7) & 1, b = a >> 8, h = kvh * 4 + hr;
        const int q0 = qb * 256, lo = q0 - 128 < 0 ? 0 : q0 - 128, hi_ = q0 + 384 > SEQL ? SEQL : q0 + 384;
        bf16* Qb = YM + ((size_t)b * BROWS + CTXL + (size_t)q0) * 2048 + 1024 + h * 128;
        att::attn_body<1>(Qb, K + (size_t)b * BROWS * 256 + kvh * 128, V + (size_t)b * BROWS * 256 + kvh * 128, Qb, 4 + (hi_ - lo) / 64, CTXL + lo, q0, C.in[I_SINK][h], ldsg, nullptr, q0);
    }
}
__device__ __forceinline__ void ph_ssdpost(const Ctx& C) {
    const TC T = phase_tc();
    bf16* YM = (bf16*)(C.ws + WS_YMIX); const bf16* YB = (const bf16*)(C.ws + WS_RAW); const bf16* XBC = (const bf16*)C.out; const bf16* Z = (const bf16*)(C.ws + WS_Z);
    const int gw = C.bid * NWAVES + T.wave, NGW = C.G * NWAVES, lane = T.lane;
    for (int r = gw; r < NROWS; r += NGW) {
        float v[16]; float ss = 0.f;
#pragma unroll
        for (int j = 0; j < 2; ++j) { const int c0 = j * 512 + lane * 8;
            const u32x4 wy = *(const u32x4*)(YM + (size_t)r * 2048 + c0), wb = *(const u32x4*)(YB + (size_t)r * 1024 + c0), wx = *(const u32x4*)(XBC + (size_t)r * 1280 + c0), wz = *(const u32x4*)(Z + (size_t)r * 1024 + c0);
            float fy[8], fb[8], fx[8], fz[8]; unpack8(wy, fy); unpack8(wb, fb); unpack8(wx, fx); unpack8(wz, fz);
            const float dsk = C.in[I_SSDD][c0 >> 6];
#pragma unroll
            for (int e = 0; e < 8; ++e) { const float y = (fy[e] + fb[e] + dsk * fx[e]) * silu_f(fz[e]); v[j * 8 + e] = y; ss += y * y; } }
        const float rs = rsqrtf(wave_sum(ss) * (1.f / 1024.f) + EPS);
#pragma unroll
        for (int j = 0; j < 2; ++j) { const int c0 = j * 512 + lane * 8; const float* ng = C.in[I_SNORMG] + c0;
            u32x4 o; o.x = pk2(v[j * 8 + 0] * rs * ng[0], v[j * 8 + 1] * rs * ng[1]); o.y = pk2(v[j * 8 + 2] * rs * ng[2], v[j * 8 + 3] * rs * ng[3]);
            o.z = pk2(v[j * 8 + 4] * rs * ng[4], v[j * 8 + 5] * rs * ng[5]); o.w = pk2(v[j * 8 + 6] * rs * ng[6], v[j * 8 + 7] * rs * ng[7]);
            *(u32x4*)(YM + (size_t)r * 2048 + c0) = o; }
    }
}
__device__ __forceinline__ void ph_lrupost(const Ctx& C) {
    const TC T = phase_tc();
    bf16* YM = (bf16*)(C.ws + WS_YMIX); const bf16* YB = (const bf16*)(C.ws + WS_RAW); const bf16* GT = (const bf16*)(C.ws + WS_Z);
    const int gw = C.bid * NWAVES + T.wave, NGW = C.G * NWAVES, lane = T.lane;
    for (int r = gw; r < NROWS; r += NGW) {
        if (r % BROWS < CTXL) continue;
#pragma unroll
        for (int j = 0; j < 2; ++j) { const int c0 = j * 512 + lane * 8;
            const u32x4 wy = *(const u32x4*)(YM + (size_t)r * 2048 + c0), wb = *(const u32x4*)(YB + (size_t)r * 1024 + c0), wg = *(const u32x4*)(GT + (size_t)r * 1024 + c0);
            float fy[8], fb[8], fg[8], o[8]; unpack8(wy, fy); unpack8(wb, fb); unpack8(wg, fg);
#pragma unroll
            for (int e = 0; e < 8; ++e) o[e] = gelu_tanh_f(fg[e]) * (fy[e] + fb[e]);
            u32x4 w; w.x = pk2(o[0], o[1]); w.y = pk2(o[2], o[3]); w.z = pk2(o[4], o[5]); w.w = pk2(o[6], o[7]);
            *(u32x4*)(YM + (size_t)r * 2048 + c0) = w; }
    }
}
__device__ __forceinline__ void ph_route(const Ctx& C, int layer, LAS unsigned char* lds) {
    const TC T = phase_tc();
    LAS float* Wt = (LAS float*)lds;
    const float* wg = C.in[I_WGRP] + (size_t)layer * 1024 * 4; const float* wr = C.in[I_WRT] + (size_t)layer * 1024 * 16;
    for (int i = T.tid; i < 4096; i += NTHREADS) Wt[(i & 3) * 1028 + (i >> 2)] = wg[i];
    for (int i = T.tid; i < 16384; i += NTHREADS) Wt[(4 + (i & 15)) * 1028 + (i >> 4)] = wr[i];
    __syncthreads();
    bf16* HN2 = (bf16*)(C.ws + WS_A); int* REC = (int*)(C.ws + WS_REC); int* TBL = (int*)(C.ws + WS_TBL);
    unsigned* cnt = C.ctl() + CW_CNT + layer * 2048;
    const float* gf = C.in[I_GFFN] + layer * 1024;
    const int gw = C.bid * NWAVES + T.wave, NGW = C.G * NWAVES, lane = T.lane;
    for (int r = gw; r < NROWS; r += NGW) {
        if (layer == 1 && (r % BROWS) < CTXL) continue;
        float* xr = C.xrow(r); const float* md = C.mod(layer, row_mv(r));
        f32x4 v[4]; float ss = 0.f;
        if (layer == 0 && (r % BROWS) < CTXL) { const int b_ = r / BROWS, q_ = r - b_ * BROWS; const float* xi = C.in[I_CTX] + (size_t)(b_ * CTXL + q_) * DM; const float* sl = (const float*)(C.ws + WS_RAW);
#pragma unroll
            for (int j = 0; j < 4; ++j) { const float* sp = sl + (size_t)((b_ * 4 + j) * 4) * 65536 + (size_t)q_ * 256 + 4 * lane;
                const f32x4 part = (*(const f32x4*)sp + *(const f32x4*)(sp + 65536)) + (*(const f32x4*)(sp + 2 * 65536) + *(const f32x4*)(sp + 3 * 65536));
                const f32x4 x1 = *(const f32x4*)(xi + 256 * j + 4 * lane) + *(const f32x4*)(md + 2 * 1024 + 256 * j + 4 * lane) * part;
                *(f32x4*)(xr + 256 * j + 4 * lane) = x1; } }
#pragma unroll
        for (int j = 0; j < 4; ++j) { v[j] = *(const f32x4*)(xr + 256 * j + 4 * lane); ss += (v[j].x * v[j].x + v[j].y * v[j].y) + (v[j].z * v[j].z + v[j].w * v[j].w); }
        const float rs = rsqrtf(wave_sum(ss) * (1.f / DM) + EPS);
#pragma unroll
        for (int j = 0; j < 4; ++j) { const int c = 256 * j + 4 * lane; const f32x4 g = *(const f32x4*)(gf + c), sc = *(const f32x4*)(md + 4 * 1024 + c), sh = *(const f32x4*)(md + 3 * 1024 + c);
            v[j] = v[j] * rs * g * (sc + 1.f) + sh;
            u32x2 w; w.x = pk2(v[j].x, v[j].y); w.y = pk2(v[j].z, v[j].w); *(u32x2*)(HN2 + (size_t)r * DM + c) = w; }
        float lg[20];
#pragma unroll
        for (int o = 0; o < 20; ++o) { float s = 0.f;
#pragma unroll
            for (int j = 0; j < 4; ++j) { const f32x4 w = *(const LAS f32x4*)(Wt + o * 1028 + 256 * j + 4 * lane); s += (v[j].x * w.x + v[j].y * w.y) + (v[j].z * w.z + v[j].w * w.w); }
            lg[o] = wave_sum(s); }
        float gl[4];
#pragma unroll
        for (int k = 0; k < 4; ++k) gl[k] = lg[k] + C.in[I_BGRP][layer * 4 + k];
        int gi = 0; float gmx = gl[0];
#pragma unroll
        for (int k = 1; k < 4; ++k) if (gl[k] > gmx) { gmx = gl[k]; gi = k; }
        float den = 0.f;
#pragma unroll
        for (int k = 0; k < 4; ++k) den += __expf(gl[k] - gmx);
        const float pgrp = 1.f / den;
        float el[4];
#pragma unroll
        for (int k = 0; k < 4; ++k) { const float e0 = lg[4 + k] + C.in[I_BRT][layer * 16 + k], e1 = lg[8 + k] + C.in[I_BRT][layer * 16 + 4 + k], e2 = lg[12 + k] + C.in[I_BRT][layer * 16 + 8 + k], e3 = lg[16 + k] + C.in[I_BRT][layer * 16 + 12 + k];
            el[k] = gi == 0 ? e0 : (gi == 1 ? e1 : (gi == 2 ? e2 : e3)); }
        int i1 = 0; float v1 = el[0];
#pragma unroll
        for (int k = 1; k < 4; ++k) if (el[k] > v1) { v1 = el[k]; i1 = k; }
        int i2 = -1; float v2 = -3.4e38f;
#pragma unroll
        for (int k = 0; k < 4; ++k) if (k != i1 && el[k] > v2) { v2 = el[k]; i2 = k; }
        const float w1 = pgrp / (1.f + __expf(v2 - v1)), w2 = pgrp - w1;
        const int ia = i1 < i2 ? i1 : i2, ib = i1 < i2 ? i2 : i1; const float wa = i1 < i2 ? w1 : w2, wb = i1 < i2 ? w2 : w1;
        const int cls = gi * 6 + (ia * (7 - ia)) / 2 + (ib - ia - 1);
        if (lane == 0) { const int pos = (int)atomicAdd(cnt + cls * 64, 1u); TBL[(size_t)cls * NROWS + pos] = r; REC[(size_t)r * 4 + 0] = cls; REC[(size_t)r * 4 + 1] = pos; REC[(size_t)r * 4 + 2] = (int)__float_as_uint(wa); REC[(size_t)r * 4 + 3] = (int)__float_as_uint(wb); }
    }
}
__device__ __forceinline__ void moe_tables(const Ctx& C, int layer, int* mt) {
    unsigned* cnt = C.ctl() + CW_CNT + layer * 2048;
    const TC T = phase_tc();
    { const int t_ = T.tid; if (t_ < 24) mt[32 + t_] = (int)__hip_atomic_load(cnt + t_ * 64, __ATOMIC_RELAXED, __HIP_MEMORY_SCOPE_AGENT); }
    asm volatile("s_waitcnt vmcnt(0)" ::: "memory");
    __syncthreads();
    if (T.tid == 0) { int acc = 0; for (int c = 0; c < 24; ++c) { const int n = mt[32 + c]; mt[c] = acc; const int nt = (n + 255) >> 8; for (int t = 0; t < nt; ++t) mt[64 + acc + t] = c; acc += nt; } mt[24] = acc; }
    asm volatile("s_waitcnt vmcnt(0)" ::: "memory");
    __syncthreads();
}
__device__ __forceinline__ void ph_final(const Ctx& C) {
    const TC T = phase_tc();
    const float* gf = C.in[I_GFINAL];
    const int gw = C.bid * NWAVES + T.wave, NGW = C.G * NWAVES, lane = T.lane;
    for (int r = gw; r < NBATCH * SEQL; r += NGW) {
        float* xr = C.out + (size_t)r * DM;
        f32x4 v[4]; float ss = 0.f;
#pragma unroll
        for (int j = 0; j < 4; ++j) { v[j] = *(const f32x4*)(xr + 256 * j + 4 * lane); ss += (v[j].x * v[j].x + v[j].y * v[j].y) + (v[j].z * v[j].z + v[j].w * v[j].w); }
        const float rs = rsqrtf(wave_sum(ss) * (1.f / DM) + EPS);
#pragma unroll
        for (int j = 0; j < 4; ++j) { const int c = 256 * j + 4 * lane; f32x4 o = v[j] * rs * *(const f32x4*)(gf + c);
#ifdef PROBE_A
            { const unsigned long long* st = (const unsigned long long*)(C.ws + WS_STAMP);
              const float ta = (float)(st[PROBE_A + 1] - st[PROBE_A]) * 0.01f, tb = (float)(st[PROBE_B + 1] - st[PROBE_B]) * 0.01f;
              int na = 0, nb = 0; float th = 15.f;
              for (int i = 0; i < 31; ++i) { na += ta > th; nb += tb > th; th *= 1.2f; }
              o = o * (1.f + 0.02f * (float)na);
              if (r == 0 && c == 0) o.x += 10.f + (float)nb; }
#endif
            *(f32x4*)(xr + c) = o; }
    }
}


#define XB_TMO      128
#define XB_XCNT(j)  (256  + 64 * (j))
#define XB_XSUB(j)  (1280 + 64 * (j))
#define XB_XGEN(j)  (2304 + 64 * (j))
#define XB_TOP      3328
#define XB_TOPGEN   3392
#define XCD_BAR_WORDS 3456
#define XB_SPIN_CAP (1u << 18)
__device__ __forceinline__ unsigned xb_ld(unsigned* p)              { return __hip_atomic_load(p, __ATOMIC_RELAXED, __HIP_MEMORY_SCOPE_AGENT); }
__device__ __forceinline__ unsigned xb_add(unsigned* p, unsigned v) { return __hip_atomic_fetch_add(p, v, __ATOMIC_RELAXED, __HIP_MEMORY_SCOPE_AGENT); }
__device__ __forceinline__ unsigned xb_xcc_id() { return (unsigned)__builtin_amdgcn_s_getreg((3 << 11) | 20) & 0xFu; }
#define XB_SPIN(cond, bar) do { unsigned _sp = 0; while (cond) { __builtin_amdgcn_s_sleep(1); \
    if ((++_sp & 255u) == 0u) { if (xb_ld(&(bar)[XB_TMO])) break; if (_sp > XB_SPIN_CAP) { atomicAdd(&(bar)[XB_TMO], 1u); break; } } } } while (0)
struct XcdBarrier { unsigned* bar; unsigned x; volatile LAS unsigned* st; };
__device__ __forceinline__ XcdBarrier xcd_barrier_post(unsigned* bar, volatile LAS unsigned* st) {
    XcdBarrier b; b.bar = bar; b.x = xb_xcc_id(); b.st = st;
    if (threadIdx.x == 0) (void)xb_add(&bar[XB_XCNT(b.x)], 1u);
    return b;
}
__device__ __forceinline__ void xcd_barrier_complete(unsigned* bar, unsigned x, unsigned& nloc, unsigned& nx) {
    const unsigned G = gridDim.x * gridDim.y * gridDim.z;
    unsigned sum, cnt, mine, sp = 0u;
    for (;;) {
        sum = 0u; cnt = 0u; mine = 0u;
#pragma unroll
        for (unsigned j = 0; j < 16; ++j) { const unsigned c = xb_ld(&bar[XB_XCNT(j)]); sum += c; cnt += (c > 0u) ? 1u : 0u; mine = (j == x) ? c : mine; }
        if (sum == G) break;
        __builtin_amdgcn_s_sleep(1);
        if ((++sp & 255u) == 0u) { if (xb_ld(&bar[XB_TMO])) break; if (sp > XB_SPIN_CAP) { atomicAdd(&bar[XB_TMO], 1u); break; } }
    }
    nloc = mine > 0u ? mine : 1u; nx = cnt > 0u ? cnt : 1u;
}
__device__ __forceinline__ void xcd_barrier(const XcdBarrier& b) {
    asm volatile("s_waitcnt vmcnt(0)" ::: "memory");
    __syncthreads();
    if (threadIdx.x == 0) {
        unsigned* bar = b.bar;
        __builtin_amdgcn_s_waitcnt(0);
        unsigned nloc = b.st[0], nx = b.st[1];
        if (nloc == 0u) { xcd_barrier_complete(bar, b.x, nloc, nx); b.st[0] = nloc; b.st[1] = nx; }
        const unsigned old = xb_add(&bar[XB_XSUB(b.x)], 1u);
        const unsigned gen = old / nloc;
        if (old + 1u == (gen + 1u) * nloc) {
            __builtin_amdgcn_fence(__ATOMIC_RELEASE, "agent");
            asm volatile("s_waitcnt vmcnt(0)" ::: "memory");
            const unsigned og = xb_add(&bar[XB_TOP], 1u);
            const unsigned tg = og / nx;
            if (og + 1u == (tg + 1u) * nx) xb_add(&bar[XB_TOPGEN], 1u);
            else XB_SPIN(xb_ld(&bar[XB_TOPGEN]) == tg, bar);
            __builtin_amdgcn_fence(__ATOMIC_ACQUIRE, "agent");
            xb_add(&bar[XB_XGEN(b.x)], 1u);
            asm volatile("s_waitcnt vmcnt(0)" ::: "memory");
        } else {
            XB_SPIN(xb_ld(&bar[XB_XGEN(b.x)]) == gen, bar);
            __builtin_amdgcn_fence(__ATOMIC_ACQUIRE, "agent");
            asm volatile("s_waitcnt vmcnt(0)" ::: "memory");
        }
    }
    __syncthreads();
}

__global__ void __launch_bounds__(NTHREADS, 2) fwd_kernel(Args args) {
    extern __shared__ __attribute__((aligned(16))) unsigned char lds_raw[];
    LAS unsigned char* lds = (LAS unsigned char*)lds_raw;
    Ctx C; C.in = args.in; C.out = args.out; C.ws = args.ws;
    C.bid = blockIdx.x; C.G = gridDim.x;
    const int lo = args.ph_lo, hi = args.ph_hi;
    int ph = 0;
    volatile LAS unsigned* bst = (volatile LAS unsigned*)(lds + LDS_BYTES - 32);
    if (threadIdx.x < 2) bst[threadIdx.x] = 0u;
    __syncthreads();
    XcdBarrier bar; bar.bar = (unsigned*)(C.ws + WS_CTL) + CW_BAR; bar.x = 0; bar.st = bst;
    if (hi - lo > 1) bar = xcd_barrier_post((unsigned*)(C.ws + WS_CTL) + CW_BAR, bst);
    if (lo < 0) cg::this_grid().sync();
#ifdef PROBE_A
    if (blockIdx.x == 0 && threadIdx.x == 0) ((unsigned long long*)(C.ws + WS_STAMP))[0] = __builtin_amdgcn_s_memrealtime();
#endif
#define IN(k) (lo <= (k) && (k) < hi)
#ifdef PROBE_A
#define STAMP(k) do { if (blockIdx.x == 0 && threadIdx.x == 0) ((unsigned long long*)(C.ws + WS_STAMP))[(k) + 1] = __builtin_amdgcn_s_memrealtime(); } while (0)
#else
#define STAMP(k) do { } while (0)
#endif
#ifdef PROBE_A
#define SEAM(k) do { if (IN(k) && IN((k) + 1)) { cg::this_grid().sync(); STAMP(k); } } while (0)
#else
#define SEAM(k) do { if (IN(k) && IN((k) + 1)) { xcd_barrier(bar); } } while (0)
#endif
    if (EN(0) && IN(0)) { ph_mod(C, lds); ph_convert(C, 0, lds); mod_wait(C); ph_prenorm(C, 0); }
    SEAM(0);
#pragma unroll 1
    for (int layer = 0; layer < 2; ++layer) {
        const int pb = 1 + 10 * layer;
        unsigned char* ws = C.ws;
        if (EN(1) && IN(pb + 0) && layer == 1) { ph_convert(C, 1, lds, C.G >= 224 ? 2 : 0); ph_prenorm(C, layer); }
        if (layer == 1) SEAM(pb + 0);
        if (EN(2) && IN(pb + 1)) {
            const int nN = layer == 0 ? 15 : 14;
            pg8::Gemm g{1024, 1024, 1024, 1 << 30};
            RowSched S; S.nM = 66; S.nN = nN; S.nwg = 66 * nN; S.G = C.G; S.c = C.bid; S.skipctx = 0; S.A = (const char*)(ws + WS_A); S.Bt = (const char*)(ws + WS_WIN); S.a_tile = (size_t)256 * 1024 * 2; S.b_tile = (size_t)256 * 1024 * 2;
            EpiProj E;
            if (layer == 0) { E.d0 = (bf16*)(ws + WS_Z); E.l0 = 1024; E.e0 = 4; E.d1 = (bf16*)(ws + WS_RAW); E.l1 = 1280; E.e1 = 9; E.d2 = (bf16*)(ws + WS_YMIX) + 1024; E.l2 = 2048; E.e2 = 13;
                E.d3 = (bf16*)(ws + WS_K); E.l3 = 256; E.e3 = 14; E.d4 = (bf16*)(ws + WS_V); E.l4 = 256; E.e4 = 15; E.d5 = (bf16*)(ws + WS_DTR); E.l5 = 32; E.lastcols = 32; }
            else { E.d0 = (bf16*)(ws + WS_Z); E.l0 = 1024; E.e0 = 4; E.d1 = (bf16*)(ws + WS_RAW); E.l1 = 1024; E.e1 = 8; E.d2 = (bf16*)(ws + WS_YMIX) + 1024; E.l2 = 2048; E.e2 = 12;
                E.d3 = (bf16*)(ws + WS_K); E.l3 = 256; E.e3 = 13; E.d4 = (bf16*)(ws + WS_V); E.l4 = 256; E.e4 = 14; E.d5 = (bf16*)(ws + WS_DTR); E.l5 = 32; E.lastcols = 32; }
            pg8::gemm_phase<EpiProj, RowSched>(lds, g, S, E);
        }
        SEAM(pb + 1);
        if (EN(3) && IN(pb + 2)) { if (layer == 0) ph_elem0(C); else ph_elem1(C); }
        SEAM(pb + 2);
        if (IN(pb + 3)) { if (layer == 0) { ph_ssdpre(C, lds);
#ifdef SPLIT_MIX0
            xcd_barrier(bar); for (int u = C.bid; u < 256; u += C.G) ssd_chunk_unit<1>(C, u >> 2, u & 3, lds);
#endif
        } }
        if (layer == 0) SEAM(pb + 3);
        if (IN(pb + 4)) { if (layer == 0) { if (EN(4)) ph_mix0(C, lds, (char*)lds_raw); } else { if (EN(5)) ph_mix1(C, lds, (char*)lds_raw); } }
        SEAM(pb + 4);
        if (EN(6) && IN(pb + 5)) { if (layer == 0) ph_ssdpost(C); else ph_lrupost(C); }
        SEAM(pb + 5);
        if (EN(7) && IN(pb + 6)) {
            for (int pass = 0; pass < (layer == 0 ? 2 : 1); ++pass) {
                pg8::Gemm g{2048, 2048, pass == 0 ? 2048 : 512, 1 << 30};
                RowSched S; S.nM = 64; S.nN = 4; S.nwg = pass == 0 ? 256 : 32; S.G = C.G; S.c = C.bid; S.skipctx = pass == 0 ? 1 : 2; S.A = (const char*)(ws + WS_YMIX); S.Bt = (const char*)(ws + WS_WOUT); S.a_tile = (size_t)256 * 2048 * 2; S.b_tile = (size_t)256 * 2048 * 2;
                EpiRes E; E.slab = pass == 0 ? nullptr : (float*)(ws + WS_RAW); E.xin_lat = layer == 0 ? C.in[I_X] : C.out; E.xin_ctx = layer == 0 ? C.in[I_CTX] : C.xc(); E.xout_lat = C.out; E.xout_ctx = C.xc(); E.modbase = C.mod(layer, 0);
                pg8::gemm_phase<EpiRes, RowSched>(lds, g, S, E);
            }
        }
        SEAM(pb + 6);
        if (EN(8) && IN(pb + 7)) ph_route(C, layer, lds);
        SEAM(pb + 7);
        if (EN(10) && IN(pb + 8)) {
            int* mt = (int*)(ws + WS_MTG) + (size_t)(layer * 256 + C.bid) * 256;
            moe_tables(C, layer, mt);
            { pg8::Gemm g{1024, 1024, 1024, 1 << 30};
              MoeSched1 S; S.mt = mt; S.G = C.G; S.c = C.bid; S.layer = layer; S.ws = ws;
              EpiMoe1 E; E.ws = ws;
              pg8::gemm_phase<EpiMoe1, MoeSched1, true>(lds, g, S, E, (const int*)(ws + WS_TBL)); }
            { pg8::Gemm g{512, 256, 512, 4};
              const int nun = mt[24] * 4, extra = nun > C.G ? nun - C.G : 0;
              MoeSched2 S; S.mt = mt; S.G = C.G; S.c = (C.bid - extra % C.G + C.G) % C.G; S.layer = layer; S.ws = ws;
              EpiMoe2 E; E.out = C.out; E.ws = ws; E.layer = layer;
              pg8::gemm_phase<EpiMoe2, MoeSched2, false>(lds, g, S, E); }
            if (layer == 0 && C.G >= 224) { __syncthreads(); ph_convert(C, 1, lds, 1, 112); }
        }
        SEAM(pb + 8);
    }
#ifdef PROBE_A
    cg::this_grid().sync();
#endif
    if (EN(12) && IN(21)) ph_final(C);

    (void)ph;
#undef IN
#undef SEAM
}

extern "C" void kernel_launch(void* const* d_in, const int* in_sizes, int n_in, void* d_out, int out_size, void* d_ws, size_t ws_size, hipStream_t stream) {
    static int grid = 0;
    if (grid == 0) {
        if (n_in != 36 || out_size != NBATCH * SEQL * DM || ws_size < WS_END) { fprintf(stderr, "kernel_launch: unexpected shapes (n_in %d, out %d, ws %zu)\n", n_in, out_size, ws_size); grid = -1; return; }
        int dev = 0, cus = 0, per_cu = 0;
        if (hipGetDevice(&dev) != hipSuccess || hipDeviceGetAttribute(&cus, hipDeviceAttributeMultiprocessorCount, dev) != hipSuccess) { grid = -1; return; }
        if (hipFuncSetAttribute((const void*)fwd_kernel, hipFuncAttributeMaxDynamicSharedMemorySize, LDS_BYTES) != hipSuccess) { fprintf(stderr, "kernel_launch: hipFuncSetAttribute failed\n"); grid = -1; return; }
        if (hipOccupancyMaxActiveBlocksPerMultiprocessor(&per_cu, (const void*)fwd_kernel, NTHREADS, LDS_BYTES) != hipSuccess || per_cu < 1) { fprintf(stderr, "kernel_launch: occupancy query failed (%d)\n", per_cu); (void)hipGetLastError(); per_cu = 1; }
        grid = cus * 1;
    }
    if (grid < 0) return;
    (void)hipMemsetAsync((char*)d_ws + WS_CTL, 0, CTL_ZERO_BYTES, stream);
    Args a{};
    for (int i = 0; i < 36; ++i) a.in[i] = (const float*)d_in[i];
    a.out = (float*)d_out; a.ws = (unsigned char*)d_ws;
#if MK_PER_PHASE
    for (int p = 0; p < N_PHASES; ++p) { a.ph_lo = p; a.ph_hi = p + 1; hipLaunchKernelGGL(fwd_kernel, dim3(grid), dim3(NTHREADS), LDS_BYTES, stream, a); }
#else
    void* kargs[] = {&a};
#ifdef REPEAT_K
    a.ph_lo = 0; a.ph_hi = REPEAT_K + 1;
    (void)hipLaunchCooperativeKernel((const void*)fwd_kernel, dim3(grid), dim3(NTHREADS), kargs, LDS_BYTES, stream);
    (void)hipMemsetAsync((char*)d_ws + WS_CTL, 0, CTL_ZERO_BYTES, stream);
#endif
    a.ph_lo = 0; a.ph_hi = N_PHASES;
    hipError_t e = hipLaunchCooperativeKernel((const void*)fwd_kernel, dim3(grid), dim3(NTHREADS), kargs, LDS_BYTES, stream);
    if (e != hipSuccess) fprintf(stderr, "kernel_launch: cooperative launch failed: %s (grid %d)\n", hipGetErrorString(e), grid);
#endif
}
```
